# Optimizing an MI355X kernel written in HIP

```python
import math
import jax, jax.numpy as jnp
from jax import lax
import numpy as np

D_MODEL = 1024
BATCH = 8
SEQ = 8192
DEPTH = 2

PLE_DIM = 256

GRID_W = 64
NA_HEADS = 8
NA_HEAD_DIM = 64
NA_ROWS = 8
NA_COLS = 16
NA_BAND = 2 * NA_COLS
NA_NCB = GRID_W // NA_COLS
NA_WIDTH = NA_HEADS * NA_HEAD_DIM

MLA_HEADS = 8
MLA_NOPE = 64
MLA_ROPE = 32
MLA_V = 64
MLA_Q_LORA = 768
MLA_KV_LORA = 256
MLA_WIDTH = MLA_HEADS * MLA_V
ROPE_THETA = 10000.0
Q_BLOCK = 128

N_IN = 3 * NA_WIDTH + MLA_Q_LORA + MLA_KV_LORA + MLA_ROPE + 2 * D_MODEL

D_FF = 2816
N_EXPERTS = 8
TOP_K = 2
D_FF_EXPERT = 3584
N_DENSE = (DEPTH + 1) // 2
N_MOE = DEPTH // 2

DEEPNORM_ALPHA = (2 * DEPTH) ** 0.25
DEEPNORM_BETA = (8 * DEPTH) ** -0.25
LN_EPS = 1e-5
RMS_EPS = 1e-6
MASK_VALUE = -1e30

kernel_name = 'hybrid_natten_mla_moe_deepnorm_encoder'


def _layer_norm(x, g, b):
    xf = x.astype(jnp.float32)
    mu = jnp.mean(xf, axis=-1, keepdims=True)
    var = jnp.mean(jnp.square(xf - mu), axis=-1, keepdims=True)
    y = (xf - mu) * lax.rsqrt(var + LN_EPS)
    return (y * g.astype(jnp.float32) + b.astype(jnp.float32)).astype(x.dtype)


def _rms_norm(x, g):
    xf = x.astype(jnp.float32)
    y = xf * lax.rsqrt(jnp.mean(jnp.square(xf), axis=-1, keepdims=True) + RMS_EPS)
    return (y * g.astype(jnp.float32)).astype(x.dtype)


def _rope(x, cos, sin):
    half = x.shape[-1] // 2
    x1, x2 = x[..., :half], x[..., half:]
    return jnp.concatenate([x1 * cos - x2 * sin, x2 * cos + x1 * sin], axis=-1)


def _swiglu(x, w1, w3, w2):
    return (jax.nn.silu(x @ w1) * (x @ w3)) @ w2


def _na_column_structure():
    band_start = np.clip(np.arange(NA_NCB) * NA_COLS - NA_COLS // 2, 0, GRID_W - NA_BAND)
    band_idx = band_start[:, None] + np.arange(NA_BAND)[None, :]
    q_col = np.arange(GRID_W).reshape(NA_NCB, NA_COLS)
    win_start = np.clip(q_col - NA_COLS // 2, 0, GRID_W - NA_COLS)
    k_col = band_idx[:, None, :]
    valid = (k_col >= win_start[..., None]) & (k_col < win_start[..., None] + NA_COLS)
    dc_idx = np.clip(k_col - q_col[..., None] + NA_COLS - 1, 0, 2 * NA_COLS - 2)
    return band_idx.astype(np.int32), valid, dc_idx.astype(np.int32)


def neighborhood_attention(q, k, v, rpb):
    b, s, h, dh = q.shape
    rows = s // GRID_W
    kr = min(NA_ROWS, rows)
    band_idx, valid, dc_idx = _na_column_structure()
    valid = jnp.asarray(valid)[:, :, None, :]
    col_bias = rpb[:, :, dc_idx]
    kg = k.reshape(b, rows, GRID_W, h, dh)
    vg = v.reshape(b, rows, GRID_W, h, dh)
    qg = q.reshape(b, rows, NA_NCB, NA_COLS, h, dh).transpose(1, 0, 2, 3, 4, 5)
    scale = dh ** -0.5

    def row_block(args):
        r, q_row = args
        rs = jnp.clip(r - kr // 2, 0, rows - kr)
        k_band = jnp.take(lax.dynamic_slice_in_dim(kg, rs, kr, axis=1), band_idx, axis=2)
        v_band = jnp.take(lax.dynamic_slice_in_dim(vg, rs, kr, axis=1), band_idx, axis=2)
        dr_idx = rs + jnp.arange(kr, dtype=jnp.int32) - r + (NA_ROWS - 1)
        bias = jnp.take(col_bias, dr_idx, axis=1).transpose(0, 2, 3, 1, 4)
        sc = jnp.einsum('bnqhd,bknjhd->bhnqkj', q_row, k_band).astype(jnp.float32) * scale
        sc = jnp.where(valid, sc + bias.astype(jnp.float32), MASK_VALUE)
        pr = jax.nn.softmax(sc.reshape(sc.shape[:4] + (kr * NA_BAND,)), axis=-1).reshape(sc.shape)
        o = jnp.einsum('bhnqkj,bknjhd->bnqhd', pr.astype(v.dtype), v_band)
        return o.reshape(b, GRID_W, h * dh)

    out = lax.map(row_block, (jnp.arange(rows, dtype=jnp.int32), qg))
    return out.transpose(1, 0, 2, 3).reshape(b, s, h * dh)


def latent_attention(q, k, v):
    b, s, h, dq = q.shape
    nb = s // Q_BLOCK
    scale = dq ** -0.5
    qb = q.reshape(b, nb, Q_BLOCK, h, dq).transpose(1, 0, 2, 3, 4)

    def block(qi):
        sc = jnp.einsum('bqhd,bkhd->bhqk', qi, k).astype(jnp.float32) * scale
        pr = jax.nn.softmax(sc, axis=-1)
        return jnp.einsum('bhqk,bkhd->bqhd', pr.astype(v.dtype), v)

    o = lax.map(block, qb)
    return o.transpose(1, 0, 2, 3, 4).reshape(b, s, h * v.shape[-1])


def moe_swiglu(x, w_router, b_router, w1, w3, w2):
    logits = (x @ w_router).astype(jnp.float32) + b_router.astype(jnp.float32)
    top_vals, top_idx = lax.top_k(logits, TOP_K)
    top_w = jax.nn.softmax(top_vals, axis=-1)
    gates = jnp.sum(jax.nn.one_hot(top_idx, N_EXPERTS, dtype=jnp.float32) * top_w[..., None], axis=-2)
    out = jnp.zeros_like(x)
    for e in range(N_EXPERTS):
        out = out + gates[..., e:e + 1].astype(x.dtype) * _swiglu(x, w1[e], w3[e], w2[e])
    return out


def setup_inputs(seed: int = 0) -> dict:
    key = jax.random.key(seed)
    ks = jax.random.split(key, 26)
    f32 = jnp.float32

    def nrm(k, shape, fan_in, scale=1.0):
        return jax.random.normal(k, shape, f32) * (scale * fan_in ** -0.5)

    def gain(k, shape):
        return 1.0 + 0.05 * jax.random.normal(k, shape, f32)

    def bias(k, shape, s=0.02):
        return s * jax.random.normal(k, shape, f32)

    beta = DEEPNORM_BETA
    return {
        'x': jax.random.normal(ks[0], (BATCH, SEQ, D_MODEL), f32),
        'p': jax.random.normal(ks[1], (DEPTH, BATCH, SEQ, PLE_DIM), f32),
        'w_in': nrm(ks[2], (DEPTH, D_MODEL, N_IN), D_MODEL),
        'b_gate': bias(ks[3], (DEPTH, 2 * D_MODEL)),
        'q_norm_g': gain(ks[4], (DEPTH, MLA_Q_LORA)),
        'w_uq': nrm(ks[5], (DEPTH, MLA_Q_LORA, MLA_HEADS * (MLA_NOPE + MLA_ROPE)), MLA_Q_LORA),
        'kv_norm_g': gain(ks[6], (DEPTH, MLA_KV_LORA)),
        'w_ukv': nrm(ks[7], (DEPTH, MLA_KV_LORA, MLA_HEADS * (MLA_NOPE + MLA_V)), MLA_KV_LORA),
        'na_rpb': bias(ks[8], (DEPTH, NA_HEADS, 2 * NA_ROWS - 1, 2 * NA_COLS - 1), 0.1),
        'w_na_o': nrm(ks[9], (DEPTH, NA_WIDTH, D_MODEL), NA_WIDTH, beta),
        'w_mla_o': nrm(ks[10], (DEPTH, MLA_WIDTH, D_MODEL), MLA_WIDTH, beta),
        'w_out': nrm(ks[11], (DEPTH, D_MODEL, D_MODEL), D_MODEL, beta),
        'ln1_g': gain(ks[12], (DEPTH, D_MODEL)),
        'ln1_b': bias(ks[13], (DEPTH, D_MODEL)),
        'ffn_w1': nrm(ks[14], (N_DENSE, D_MODEL, D_FF), D_MODEL),
        'ffn_w3': nrm(ks[15], (N_DENSE, D_MODEL, D_FF), D_MODEL),
        'ffn_w2': nrm(ks[16], (N_DENSE, D_FF, D_MODEL), D_FF, beta),
        'moe_w_router': nrm(ks[17], (N_MOE, D_MODEL, N_EXPERTS), D_MODEL),
        'moe_b_router': bias(ks[18], (N_MOE, N_EXPERTS), 0.01),
        'moe_w1': nrm(ks[19], (N_MOE, N_EXPERTS, D_MODEL, D_FF_EXPERT), D_MODEL),
        'moe_w3': nrm(ks[20], (N_MOE, N_EXPERTS, D_MODEL, D_FF_EXPERT), D_MODEL),
        'moe_w2': nrm(ks[21], (N_MOE, N_EXPERTS, D_FF_EXPERT, D_MODEL), D_FF_EXPERT, beta),
        'w_ple_gate': nrm(ks[22], (DEPTH, D_MODEL, D_MODEL), D_MODEL),
        'w_ple': nrm(ks[23], (DEPTH, PLE_DIM, D_MODEL), PLE_DIM, beta),
        'ln2_g': gain(ks[24], (DEPTH, D_MODEL)),
        'ln2_b': bias(ks[25], (DEPTH, D_MODEL)),
    }


def reference(x, p, w_in, b_gate, q_norm_g, w_uq, kv_norm_g, w_ukv, na_rpb, w_na_o, w_mla_o,
              w_out, ln1_g, ln1_b, ffn_w1, ffn_w3, ffn_w2, moe_w_router, moe_b_router,
              moe_w1, moe_w3, moe_w2, w_ple_gate, w_ple, ln2_g, ln2_b):
    b, s, _ = x.shape
    pos = jnp.arange(s, dtype=jnp.float32)
    inv_freq = ROPE_THETA ** (-jnp.arange(0, MLA_ROPE // 2, dtype=jnp.float32) * (2.0 / MLA_ROPE))
    ang = pos[:, None] * inv_freq[None, :]
    cos = jnp.cos(ang)[:, None, :].astype(x.dtype)
    sin = jnp.sin(ang)[:, None, :].astype(x.dtype)
    splits = list(np.cumsum([3 * NA_WIDTH, MLA_Q_LORA, MLA_KV_LORA, MLA_ROPE, D_MODEL]))

    for i in range(DEPTH):
        proj = x @ w_in[i]
        na_qkv, q_lat, kv_lat, k_rope, g_na, g_mla = jnp.split(proj, [int(o) for o in splits], axis=-1)

        q_na, k_na, v_na = jnp.split(na_qkv.reshape(b, s, 3, NA_HEADS, NA_HEAD_DIM), 3, axis=2)
        o_na = neighborhood_attention(q_na[:, :, 0], k_na[:, :, 0], v_na[:, :, 0], na_rpb[i])

        q_mla = (_rms_norm(q_lat, q_norm_g[i]) @ w_uq[i]).reshape(b, s, MLA_HEADS, MLA_NOPE + MLA_ROPE)
        q_mla = jnp.concatenate([q_mla[..., :MLA_NOPE], _rope(q_mla[..., MLA_NOPE:], cos, sin)], axis=-1)
        kv = (_rms_norm(kv_lat, kv_norm_g[i]) @ w_ukv[i]).reshape(b, s, MLA_HEADS, MLA_NOPE + MLA_V)
        k_r = jnp.broadcast_to(_rope(k_rope[:, :, None, :], cos, sin), (b, s, MLA_HEADS, MLA_ROPE))
        k_mla = jnp.concatenate([kv[..., :MLA_NOPE], k_r], axis=-1)
        o_mla = latent_attention(q_mla, k_mla, kv[..., MLA_NOPE:])

        merged = (jax.nn.sigmoid(g_na + b_gate[i, :D_MODEL]) * (o_na @ w_na_o[i])
                  + jax.nn.sigmoid(g_mla + b_gate[i, D_MODEL:]) * (o_mla @ w_mla_o[i]))
        x = _layer_norm(DEEPNORM_ALPHA * x + merged @ w_out[i], ln1_g[i], ln1_b[i])

        if i % 2 == 0:
            j = i // 2
            f = _swiglu(x, ffn_w1[j], ffn_w3[j], ffn_w2[j])
        else:
            j = i // 2
            f = moe_swiglu(x, moe_w_router[j], moe_b_router[j], moe_w1[j], moe_w3[j], moe_w2[j])

        ple = jax.nn.sigmoid(x @ w_ple_gate[i]) * (p[i] @ w_ple[i])
        x = _layer_norm(DEEPNORM_ALPHA * x + f + ple, ln2_g[i], ln2_b[i])
    return x
```

```cpp
#include <hip/hip_runtime.h>
#include <cstdio>
#include <cstdint>
#include <cmath>
namespace pg8 {
#define PG8_LAS __attribute__((address_space(3)))
typedef unsigned short bf16_t;
typedef short bf16x8 __attribute__((ext_vector_type(8)));
typedef float f32x4 __attribute__((ext_vector_type(4)));
typedef unsigned u32x4 __attribute__((ext_vector_type(4)));
constexpr int BM = 256, BK = 64, HALF = 128, HTB = HALF * BK * 2  , STAGE_BYTES = 8 * HTB, NXCD = 8, WGM = 8;

__host__ __device__ __forceinline__ int lds_byte(int r, int c) { const int st = (r >> 4) * 2 + (c >> 5), rr = r & 15, cc = c & 31, ob = rr * 64 + cc * 2; return st * 1024 + (ob ^ (((ob >> 9) & 1) << 5)); }
__host__ __device__ __forceinline__ void stage_rc(int b, int& R, int& C) { const int st = b / 1024, sb = b % 1024, swz = sb ^ (((sb >> 9) & 1) << 5); R = (st >> 1) * 16 + swz / 64; C = (st & 1) * 32 + (swz % 64) / 2; }
__host__ __device__ __forceinline__ int perm32(int rho) { const int n = rho >> 4, i = rho & 15; return 8 * (i >> 2) + 4 * n + (i & 3); }

struct Unit { int pm, pn, pa, pb, slot; };
struct Gemm { const bf16_t* A; const bf16_t* Bt; int M, N, K; };

struct StaticOrder {
    int nM, nN, nwg, G, c;
    __host__ __device__ void init(int M, int N, int G_, int c_) { nM = M / BM; nN = N / BM; nwg = nM * nN; G = G_; c = c_; }
    __host__ __device__ bool next(int i, Unit& u) const {
        const long L = (long)i * G + c; if (L >= nwg) return false;
        int wgid = (int)L; { const int q = nwg / NXCD, r = nwg % NXCD, xcd = wgid % NXCD, off = wgid / NXCD; wgid = (xcd < r ? xcd * (q + 1) : r * (q + 1) + (xcd - r) * q) + off; }
        const int nig = WGM * nN, gid = wgid / nig, fm = gid * WGM, gsz = (nM - fm) < WGM ? (nM - fm) : WGM;
        u.pm = fm + ((wgid % nig) % gsz); u.pn = (wgid % nig) / gsz; u.pa = u.pm; u.pb = u.pn; u.slot = i; return true;
    }
    __device__ __forceinline__ void a_ready(const Unit&) const {}
    __device__ __forceinline__ void done(const Unit&) const {}
};

__device__ __forceinline__ unsigned cvt_pk_bf16(float lo, float hi) { unsigned r; asm volatile("v_cvt_pk_bf16_f32 %0, %1, %2" : "=v"(r) : "v"(lo), "v"(hi)); return r; }
typedef float f32x2 __attribute__((ext_vector_type(2)));
__device__ __forceinline__ f32x2 gelu_pk(f32x2 v) {
    const f32x2 av = __builtin_elementwise_abs(v), d = av * 0.2316418882f + 1.0f;
    f32x2 t; t.x = __builtin_amdgcn_rcpf(d.x); t.y = __builtin_amdgcn_rcpf(d.y);
    f32x2 q = t * 0.5307027145f + (-0.7265760135f); q = q * t + 0.7107068705f; q = q * t + (-0.142248368f); q = q * t + 0.127414796f; q = q * t;
    const f32x2 s = (v * v) * (-0.72134752044f);
    f32x2 e; e.x = __builtin_amdgcn_exp2f(s.x); e.y = __builtin_amdgcn_exp2f(s.y);
    const f32x2 m = v * (q * e), r = v - m;
    f32x2 o; o.x = v.x < 0.f ? m.x : r.x; o.y = v.y < 0.f ? m.y : r.y; return o;
}

template <int ACT  > struct EpiBf16 {
    static constexpr bool PERM = true, AFTER_DRAIN = false; static_assert(ACT == 0 || ACT == 1, "EpiBf16: ACT is 0 (none) or 1 (gelu_pk)");
    bf16_t* O; int ldc; const float* bias; int split_cols; size_t split_stride; float scale0;
    __device__ __forceinline__ void operator()(const f32x4 (&acc)[2][2][4][2], const Unit& u, int wr, int wc, int fr, int fq) const {
        const int row0 = u.pm * BM + wr * 64 + fr; int colt = u.pn * BM; bf16_t* base = O;
        float sc = 1.f; if (split_cols) { const int t = colt / split_cols; base += (size_t)t * split_stride; colt -= t * split_cols; if (t == 0) sc = scale0; }
        const int col0 = colt + wc * 32 + 8 * fq, bcol0 = u.pn * BM + wc * 32 + 8 * fq;
        f32x4 bv[2][2];
#pragma unroll
        for (int bj = 0; bj < 2; ++bj)
#pragma unroll
            for (int n = 0; n < 2; ++n) bv[bj][n] = bias ? *(const f32x4*)(bias + bcol0 + bj * HALF + 4 * n) : (f32x4){0.f, 0.f, 0.f, 0.f};
#pragma unroll
        for (int ai = 0; ai < 2; ++ai)
#pragma unroll
            for (int m = 0; m < 4; ++m) { bf16_t* rowp = base + (size_t)(row0 + ai * HALF + m * 16) * ldc + col0;
#pragma unroll
                for (int bj = 0; bj < 2; ++bj) { f32x4 v0 = acc[ai][bj][m][0] + bv[bj][0], v1 = acc[ai][bj][m][1] + bv[bj][1];
                    if (ACT == 1) { f32x2 a = gelu_pk((f32x2){v0[0], v0[1]}), b = gelu_pk((f32x2){v0[2], v0[3]}), c = gelu_pk((f32x2){v1[0], v1[1]}), d = gelu_pk((f32x2){v1[2], v1[3]});
                        v0 = (f32x4){a.x, a.y, b.x, b.y}; v1 = (f32x4){c.x, c.y, d.x, d.y}; }
                    v0 = v0 * sc; v1 = v1 * sc; u32x4 w; w.x = cvt_pk_bf16(v0[0], v0[1]); w.y = cvt_pk_bf16(v0[2], v0[3]); w.z = cvt_pk_bf16(v1[0], v1[1]); w.w = cvt_pk_bf16(v1[2], v1[3]);
                    *(u32x4*)(rowp + bj * HALF) = w; } }
    }
};

template <class Epi, class Sched, bool ALIGN_EPI = false, bool SP2 = false>
__device__ __forceinline__ void gemm_phase(PG8_LAS unsigned char* lds, const Gemm g, const Sched& S, const Epi& E) {
    int tid_ = threadIdx.x; asm volatile("" : "+v"(tid_));
    const int tid = tid_, wid = __builtin_amdgcn_readfirstlane(tid >> 6), lane = tid & 63, wr = wid >> 2, wc = wid & 3, fr = lane & 15, fq = lane >> 4;
    int K_ = g.K; asm volatile("" : "+s"(K_)); const int K = K_, nt = K / BK;
    unsigned voffA[2], voffB[2];
#pragma unroll
    for (int i = 0; i < 2; ++i) { int R, C; stage_rc(tid * 16 + i * 8192, R, C); const int Rb = Epi::PERM ? ((R & ~31) + perm32(R & 31)) : R;
        voffA[i] = (unsigned)(R * K + C) * 2u; voffB[i] = (unsigned)(Rb * K + C) * 2u; }
    const size_t kstep = (size_t)(BK * 2);
    const size_t hstep = (size_t)HALF * K * 2;
    const size_t tstep = 2 * hstep;
    const unsigned ldsw = (unsigned)wid * 1024u;
    const int aoff = lds_byte(wr * 64 + fr, fq * 8), boff = lds_byte(wc * 32 + fr, fq * 8);
#define PG8_SA(b, h) (((b) * 2 + (h)) * HTB)
#define PG8_SB(b, h) ((4 + (b) * 2 + (h)) * HTB)
#define PG8_STAGE(bufoff, gbase, voff) do { _Pragma("unroll") for (int _i = 0; _i < 2; ++_i) \
        __builtin_amdgcn_global_load_lds((const unsigned*)((const char*)(gbase) + (voff)[_i]), (PG8_LAS unsigned*)(lds + (bufoff) + ldsw + _i * 8192), 16, 0, 0); } while (0)
#define PG8_LDA(dst, b, h) do { _Pragma("unroll") for (int m = 0; m < 4; ++m) _Pragma("unroll") for (int k = 0; k < 2; ++k) dst[m][k] = *(const PG8_LAS bf16x8*)(lds + PG8_SA(b, h) + aoff + m * 2048 + k * 1024); } while (0)
#define PG8_LDB(dst, b, h) do { _Pragma("unroll") for (int n = 0; n < 2; ++n) _Pragma("unroll") for (int k = 0; k < 2; ++k) dst[n][k] = *(const PG8_LAS bf16x8*)(lds + PG8_SB(b, h) + boff + n * 2048 + k * 1024); } while (0)
#define PG8_MMA(ai, bj, At, Bt) do { __builtin_amdgcn_s_setprio(1); _Pragma("unroll") for (int m = 0; m < 4; ++m) _Pragma("unroll") for (int n = 0; n < 2; ++n) _Pragma("unroll") for (int k = 0; k < 2; ++k) \
        acc[ai][bj][m][n] = __builtin_amdgcn_mfma_f32_16x16x32_bf16(Bt[n][k], At[m][k], acc[ai][bj][m][n], 0, 0, 0); __builtin_amdgcn_s_setprio(0); } while (0)
#define PG8_WAIT_V(n) asm volatile("s_waitcnt vmcnt(" #n ")" ::: "memory")
#define PG8_WAIT_L(n) asm volatile("s_waitcnt lgkmcnt(" #n ")" ::: "memory")
#define PG8_BAR __builtin_amdgcn_s_barrier()
#define PG8_SCHED __builtin_amdgcn_sched_barrier(0)
    Unit cur, nxt; int ui = 0;
    if (!S.next(0, cur)) return;
    f32x4 acc[2][2][4][2];
#pragma unroll
    for (int a = 0; a < 2; ++a)
#pragma unroll
        for (int b = 0; b < 2; ++b)
#pragma unroll
            for (int m = 0; m < 4; ++m)
#pragma unroll
                for (int n = 0; n < 2; ++n) acc[a][b][m][n] = (f32x4){0.f, 0.f, 0.f, 0.f};
    bf16x8 At[4][2], B0[2][2], B1[2][2];
    const char* cA = (const char*)g.A + (size_t)cur.pa * tstep; const char* cB = (const char*)g.Bt + (size_t)cur.pb * tstep;
    S.a_ready(cur);
    if constexpr (SP2) {
        PG8_STAGE(PG8_SB(0, 0), cB, voffB); PG8_STAGE(PG8_SB(0, 1), cB + hstep, voffB); PG8_STAGE(PG8_SA(0, 0), cA, voffA); PG8_STAGE(PG8_SA(0, 1), cA + hstep, voffA);
        if (wr == 1) PG8_BAR;
        PG8_WAIT_V(2); PG8_BAR;
        PG8_STAGE(PG8_SB(1, 0), cB + kstep, voffB); PG8_STAGE(PG8_SA(1, 0), cA + kstep, voffA); PG8_STAGE(PG8_SB(1, 1), cB + hstep + kstep, voffB);
        PG8_WAIT_V(6); PG8_BAR;
    } else {
        PG8_STAGE(PG8_SB(0, 0), cB, voffB); PG8_STAGE(PG8_SA(0, 0), cA, voffA); PG8_STAGE(PG8_SB(0, 1), cB + hstep, voffB); PG8_STAGE(PG8_SA(0, 1), cA + hstep, voffA);
        if (wr == 1) PG8_BAR;
        PG8_WAIT_V(4); PG8_BAR;
        PG8_STAGE(PG8_SB(1, 0), cB + kstep, voffB); PG8_STAGE(PG8_SA(1, 0), cA + kstep, voffA); PG8_STAGE(PG8_SB(1, 1), cB + hstep + kstep, voffB);
        PG8_WAIT_V(6); PG8_BAR;
    }
    for (;;) {
        const bool has_next = S.next(ui + 1, nxt);
        const char* nA = has_next ? (const char*)g.A + (size_t)nxt.pa * tstep : cA; const char* nB = has_next ? (const char*)g.Bt + (size_t)nxt.pb * tstep : cB;
        for (int t = 0; t < nt; t += 2) {
            const bool last = (t == nt - 2);
            const char* a1 = cA + (size_t)(t + 1) * kstep;
            const char* a2 = last ? nA : cA + (size_t)(t + 2) * kstep; const char* b2 = last ? nB : cB + (size_t)(t + 2) * kstep;
            const char* a3 = a2 + kstep; const char* b3 = b2 + kstep;
            if (last && has_next) S.a_ready(nxt);
            if constexpr (SP2) {
            PG8_LDB(B0, 0, 0); PG8_LDB(B1, 0, 1); PG8_SCHED; PG8_LDA(At, 0, 0); PG8_STAGE(PG8_SA(1, 1), a1 + hstep, voffA);
            PG8_WAIT_V(8); PG8_WAIT_L(0); PG8_BAR; PG8_MMA(0, 0, At, B0); PG8_MMA(0, 1, At, B1); PG8_BAR; PG8_SCHED;
            PG8_LDA(At, 0, 1); PG8_STAGE(PG8_SB(0, 0), b2, voffB); PG8_STAGE(PG8_SB(0, 1), b2 + hstep, voffB); PG8_STAGE(PG8_SA(0, 0), a2, voffA);
            PG8_WAIT_V(8); PG8_WAIT_L(0); PG8_BAR; PG8_MMA(1, 0, At, B0); PG8_MMA(1, 1, At, B1); PG8_BAR; PG8_SCHED;
            PG8_LDB(B0, 1, 0); PG8_LDB(B1, 1, 1); PG8_SCHED; PG8_LDA(At, 1, 0); PG8_STAGE(PG8_SA(0, 1), a2 + hstep, voffA);
            PG8_WAIT_V(8); PG8_WAIT_L(0); PG8_BAR; PG8_MMA(0, 0, At, B0); PG8_MMA(0, 1, At, B1); PG8_BAR; PG8_SCHED;
            PG8_LDA(At, 1, 1); PG8_STAGE(PG8_SB(1, 0), b3, voffB); PG8_STAGE(PG8_SB(1, 1), b3 + hstep, voffB); PG8_STAGE(PG8_SA(1, 0), a3, voffA);
            PG8_WAIT_V(8); PG8_WAIT_L(0); PG8_BAR; PG8_MMA(1, 0, At, B0); PG8_MMA(1, 1, At, B1); PG8_BAR; PG8_SCHED;
            } else {
            PG8_LDB(B0, 0, 0); PG8_SCHED; PG8_LDA(At, 0, 0); PG8_STAGE(PG8_SA(1, 1), a1 + hstep, voffA);
            PG8_WAIT_L(8); PG8_BAR; PG8_WAIT_L(0); PG8_MMA(0, 0, At, B0); PG8_BAR; PG8_SCHED;
            PG8_LDB(B1, 0, 1); PG8_STAGE(PG8_SB(0, 0), b2, voffB);
            PG8_BAR; PG8_WAIT_L(0); PG8_MMA(0, 1, At, B1); PG8_BAR;
            PG8_LDA(At, 0, 1); PG8_STAGE(PG8_SA(0, 0), a2, voffA);
            PG8_BAR; PG8_WAIT_L(0); PG8_MMA(1, 0, At, B0); PG8_BAR; PG8_SCHED;
            PG8_STAGE(PG8_SB(0, 1), b2 + hstep, voffB);
            PG8_WAIT_V(6); PG8_BAR; PG8_MMA(1, 1, At, B1); PG8_BAR;
            PG8_LDB(B0, 1, 0); PG8_SCHED; PG8_LDA(At, 1, 0); PG8_STAGE(PG8_SA(0, 1), a2 + hstep, voffA);
            PG8_WAIT_L(8); PG8_BAR; PG8_WAIT_L(0); PG8_MMA(0, 0, At, B0); PG8_BAR; PG8_SCHED;
            PG8_LDB(B1, 1, 1); PG8_STAGE(PG8_SB(1, 0), b3, voffB);
            PG8_BAR; PG8_WAIT_L(0); PG8_MMA(0, 1, At, B1); PG8_BAR;
            PG8_LDA(At, 1, 1); PG8_STAGE(PG8_SA(1, 0), a3, voffA);
            PG8_BAR; PG8_WAIT_L(0); PG8_MMA(1, 0, At, B0); PG8_BAR; PG8_SCHED;
            PG8_STAGE(PG8_SB(1, 1), b3 + hstep, voffB);
            PG8_WAIT_V(6); PG8_BAR; PG8_MMA(1, 1, At, B1); PG8_BAR;
            }
        }
        if constexpr (ALIGN_EPI) { if (wr == 0) PG8_BAR; }
        if constexpr (!Epi::AFTER_DRAIN) { E(acc, cur, wr, wc, fr, fq); S.done(cur); }
        if (!has_next) break;
#pragma unroll
        for (int a = 0; a < 2; ++a)
#pragma unroll
            for (int b = 0; b < 2; ++b)
#pragma unroll
                for (int m = 0; m < 4; ++m)
#pragma unroll
                    for (int n = 0; n < 2; ++n) acc[a][b][m][n] = (f32x4){0.f, 0.f, 0.f, 0.f};
        cur = nxt; cA = nA; cB = nB; ++ui;
        if constexpr (ALIGN_EPI) { if (wr == 1) PG8_BAR; }
    }
    PG8_WAIT_V(0);
    if constexpr (!ALIGN_EPI) { if (wr == 0) PG8_BAR; }
    PG8_BAR;
    if constexpr (Epi::AFTER_DRAIN) { E.fused(acc, cur, wr, wc, fr, fq, lds, wid, lane); S.done(cur); }
#undef PG8_SA
#undef PG8_SB
#undef PG8_STAGE
#undef PG8_LDA
#undef PG8_LDB
#undef PG8_MMA
#undef PG8_WAIT_V
#undef PG8_WAIT_L
#undef PG8_BAR
#undef PG8_SCHED
}
}
namespace pg8 {
typedef unsigned u32x2 __attribute__((ext_vector_type(2)));
__device__ __forceinline__ float sigm(float x) { return __builtin_amdgcn_rcpf(1.0f + __builtin_amdgcn_exp2f(-1.4426950408889634f * x)); }
__device__ __forceinline__ u32x4 pack8(const f32x4& v0, const f32x4& v1) { u32x4 w; w.x = cvt_pk_bf16(v0[0], v0[1]); w.y = cvt_pk_bf16(v0[2], v0[3]); w.z = cvt_pk_bf16(v1[0], v1[1]); w.w = cvt_pk_bf16(v1[2], v1[3]); return w; }
__device__ __forceinline__ void unpack8(const u32x4& w, f32x4& v0, f32x4& v1) {
    v0[0] = __uint_as_float(w.x << 16); v0[1] = __uint_as_float(w.x & 0xffff0000u); v0[2] = __uint_as_float(w.y << 16); v0[3] = __uint_as_float(w.y & 0xffff0000u);
    v1[0] = __uint_as_float(w.z << 16); v1[1] = __uint_as_float(w.z & 0xffff0000u); v1[2] = __uint_as_float(w.w << 16); v1[3] = __uint_as_float(w.w & 0xffff0000u); }
__device__ __forceinline__ void rope8(f32x4& v0, f32x4& v1, const float* tab, int fq) {
    f32x4 p0, p1;
#pragma unroll
    for (int j = 0; j < 4; ++j) { p0[j] = __shfl_xor(v0[j], 32); p1[j] = __shfl_xor(v1[j], 32); }
    const float* t = tab + 16 * (fq & 1);
    const f32x4 c0 = *(const f32x4*)(t), c1 = *(const f32x4*)(t + 4), c2 = *(const f32x4*)(t + 8), c3 = *(const f32x4*)(t + 12);
    const float sg = (fq < 2) ? -1.f : 1.f;
    v0[0] = v0[0] * c0[0] + sg * p0[0] * c0[1]; v0[1] = v0[1] * c0[2] + sg * p0[1] * c0[3];
    v0[2] = v0[2] * c1[0] + sg * p0[2] * c1[1]; v0[3] = v0[3] * c1[2] + sg * p0[3] * c1[3];
    v1[0] = v1[0] * c2[0] + sg * p1[0] * c2[1]; v1[1] = v1[1] * c2[2] + sg * p1[1] * c2[3];
    v1[2] = v1[2] * c3[0] + sg * p1[2] * c3[1]; v1[3] = v1[3] * c3[2] + sg * p1[3] * c3[3];
}

struct EpiProj {
    static constexpr bool PERM = true, AFTER_DRAIN = false;
    bf16_t *NAQKV, *QLAT, *GATES, *KVLAT, *KMLA; const float* bgate; const float* rope; float qscale;
    __device__ __forceinline__ void operator()(const f32x4 (&acc)[2][2][4][2], const Unit& u, int wr, int wc, int fr, int fq) const {
        const int pn = u.pn; const int row0 = u.pm * BM + wr * 64 + fr;
        if (pn == 18) {
            if (wc == 0) {
#pragma unroll
                for (int ai = 0; ai < 2; ++ai)
#pragma unroll
                    for (int m = 0; m < 4; ++m) { const int row = row0 + ai * HALF + m * 16; f32x4 v0 = acc[ai][0][m][0], v1 = acc[ai][0][m][1];
                        rope8(v0, v1, rope + (size_t)(row & 8191) * 32, fq); const u32x4 w = pack8(v0, v1); bf16_t* dp = KMLA + (size_t)row * 768 + 64 + 8 * fq;
#pragma unroll
                        for (int h = 0; h < 8; ++h) *(u32x4*)(dp + 96 * h) = w; }
            }
            return;
        }
        bf16_t* base; int ldc, colt, mode = 0;
        if (pn < 6) { base = NAQKV; ldc = 1536; colt = pn * BM; mode = (pn < 2) ? 1 : 0; }
        else if (pn < 9) { base = QLAT; ldc = 768; colt = (pn - 6) * BM; }
        else if (pn < 17) { base = GATES; ldc = 2048; colt = (pn - 9) * BM; mode = 2; }
        else { base = KVLAT; ldc = 256; colt = 0; }
        const int col0 = colt + wc * 32 + 8 * fq;
        f32x4 bv[2][2];
#pragma unroll
        for (int bj = 0; bj < 2; ++bj)
#pragma unroll
            for (int n = 0; n < 2; ++n) bv[bj][n] = (mode == 2) ? *(const f32x4*)(bgate + col0 + bj * HALF + 4 * n) : (f32x4){0.f, 0.f, 0.f, 0.f};
        const float sc = (mode == 1) ? qscale : 1.f;
#pragma unroll
        for (int ai = 0; ai < 2; ++ai)
#pragma unroll
            for (int m = 0; m < 4; ++m) { bf16_t* rowp = base + (size_t)(row0 + ai * HALF + m * 16) * ldc + col0;
#pragma unroll
                for (int bj = 0; bj < 2; ++bj) { f32x4 v0 = acc[ai][bj][m][0] + bv[bj][0], v1 = acc[ai][bj][m][1] + bv[bj][1];
                    if (mode == 2) {
#pragma unroll
                        for (int j = 0; j < 4; ++j) { v0[j] = sigm(v0[j]); v1[j] = sigm(v1[j]); } }
                    v0 = v0 * sc; v1 = v1 * sc; *(u32x4*)(rowp + bj * HALF) = pack8(v0, v1); } }
    }
};
struct EpiQup {
    static constexpr bool PERM = true, AFTER_DRAIN = false;
    bf16_t* Q; const PG8_LAS float* rtab; const float* rope; float sc;
    __device__ __forceinline__ void operator()(const f32x4 (&acc)[2][2][4][2], const Unit& u, int wr, int wc, int fr, int fq) const {
        const int lr0 = wr * 64 + fr;
#pragma unroll
        for (int ai = 0; ai < 2; ++ai)
#pragma unroll
            for (int m = 0; m < 4; ++m) { const int lr = lr0 + ai * HALF + m * 16, row = u.pm * BM + lr; const float rr = rtab[u.slot * BM + lr];
                const float* rt = rope + (size_t)(row & 8191) * 32; bf16_t* rowp = Q + (size_t)row * 768 + u.pn * BM + wc * 32 + 8 * fq;
#pragma unroll
                for (int bj = 0; bj < 2; ++bj) { f32x4 v0 = acc[ai][bj][m][0] * rr, v1 = acc[ai][bj][m][1] * rr;
                    if ((8 * u.pn + 4 * bj + wc) % 3 == 2) rope8(v0, v1, rt, fq);
                    v0 = v0 * sc; v1 = v1 * sc; *(u32x4*)(rowp + bj * HALF) = pack8(v0, v1); }
                asm volatile("" ::: "memory"); }
    }
};
struct EpiKVup {
    static constexpr bool PERM = true, AFTER_DRAIN = false;
    bf16_t *KM, *VM; const PG8_LAS float* rtab;
    __device__ __forceinline__ void operator()(const f32x4 (&acc)[2][2][4][2], const Unit& u, int wr, int wc, int fr, int fq) const {
        const int lr0 = wr * 64 + fr;
#pragma unroll
        for (int ai = 0; ai < 2; ++ai)
#pragma unroll
            for (int m = 0; m < 4; ++m) { const int lr = lr0 + ai * HALF + m * 16, row = u.pm * BM + lr; const float rr = rtab[u.slot * BM + lr];
#pragma unroll
                for (int bj = 0; bj < 2; ++bj) { const f32x4 v0 = acc[ai][bj][m][0] * rr, v1 = acc[ai][bj][m][1] * rr;
                    bf16_t* dp;
                    if (u.pn < 2) { const int h = 4 * u.pn + 2 * bj + (wc >> 1); dp = KM + (size_t)row * 768 + 96 * h + 32 * (wc & 1) + 8 * fq; }
                    else { dp = VM + (size_t)row * 512 + (u.pn - 2) * BM + bj * HALF + wc * 32 + 8 * fq; }
                    *(u32x4*)dp = pack8(v0, v1); }
                asm volatile("" ::: "memory"); }
    }
};
struct EpiMerge {
    static constexpr bool PERM = true, AFTER_DRAIN = false;
    const bf16_t* G; bf16_t* T; int second;
    __device__ __forceinline__ void operator()(const f32x4 (&acc)[2][2][4][2], const Unit& u, int wr, int wc, int fr, int fq) const {
        const int row0 = u.pm * BM + wr * 64 + fr, col0 = u.pn * BM + wc * 32 + 8 * fq;
#pragma unroll
        for (int ai = 0; ai < 2; ++ai)
#pragma unroll
            for (int m = 0; m < 4; ++m) { const size_t row = (size_t)(row0 + ai * HALF + m * 16);
#pragma unroll
                for (int bj = 0; bj < 2; ++bj) { const int c = col0 + bj * HALF; f32x4 g0, g1; unpack8(*(const u32x4*)(G + row * 2048 + c), g0, g1);
                    f32x4 v0 = acc[ai][bj][m][0] * g0, v1 = acc[ai][bj][m][1] * g1;
                    if (second) { f32x4 t0, t1; unpack8(*(const u32x4*)(T + row * 1024 + c), t0, t1); v0 = v0 + t0; v1 = v1 + t1; }
                    *(u32x4*)(T + row * 1024 + c) = pack8(v0, v1); }
                asm volatile("" ::: "memory"); }
    }
};
struct EpiPlain {
    static constexpr bool PERM = true, AFTER_DRAIN = false;
    bf16_t* O; int ldc;
    __device__ __forceinline__ void operator()(const f32x4 (&acc)[2][2][4][2], const Unit& u, int wr, int wc, int fr, int fq) const {
        const int row0 = u.pm * BM + wr * 64 + fr, col0 = u.pn * BM + wc * 32 + 8 * fq;
#pragma unroll
        for (int ai = 0; ai < 2; ++ai)
#pragma unroll
            for (int m = 0; m < 4; ++m) { bf16_t* rowp = O + (size_t)(row0 + ai * HALF + m * 16) * ldc + col0;
#pragma unroll
                for (int bj = 0; bj < 2; ++bj) *(u32x4*)(rowp + bj * HALF) = pack8(acc[ai][bj][m][0], acc[ai][bj][m][1]); }
    }
};
template <int MODE> struct EpiRes {
    static constexpr bool PERM = false, AFTER_DRAIN = false;
    const float* xin; float* out; const bf16_t* PP; float alpha;
    __device__ __forceinline__ void operator()(const f32x4 (&acc)[2][2][4][2], const Unit& u, int wr, int wc, int fr, int fq) const {
        const int row0 = u.pm * BM + wr * 64 + fr, col0 = u.pn * BM + wc * 32 + 4 * fq;
#pragma unroll
        for (int ai = 0; ai < 2; ++ai)
#pragma unroll
            for (int m = 0; m < 4; ++m) { const size_t off = (size_t)(row0 + ai * HALF + m * 16) * 1024 + col0;
#pragma unroll
                for (int bj = 0; bj < 2; ++bj)
#pragma unroll
                    for (int n = 0; n < 2; ++n) { const size_t o = off + bj * HALF + n * 16; const f32x4 a = acc[ai][bj][m][n]; f32x4 r;
                        if (MODE == 0) { r = *(const f32x4*)(xin + o) * alpha + a; }
                        else if (MODE == 1) { const u32x2 pw = *(const u32x2*)(PP + o); f32x4 pp; pp[0] = __uint_as_float(pw.x << 16); pp[1] = __uint_as_float(pw.x & 0xffff0000u); pp[2] = __uint_as_float(pw.y << 16); pp[3] = __uint_as_float(pw.y & 0xffff0000u);
                            f32x4 s; s[0] = sigm(a[0]); s[1] = sigm(a[1]); s[2] = sigm(a[2]); s[3] = sigm(a[3]); r = *(const f32x4*)(out + o) * alpha + s * pp; }
                        else { r = *(const f32x4*)(out + o) + a; }
                        *(f32x4*)(out + o) = r; }
                asm volatile("" ::: "memory"); }
    }
};
struct EpiGLU {
    static constexpr bool PERM = true, AFTER_DRAIN = false;
    bf16_t* H; int ldh;
    __device__ __forceinline__ void operator()(const f32x4 (&acc)[2][2][4][2], const Unit& u, int wr, int wc, int fr, int fq) const {
        const int row0 = u.pm * BM + wr * 64 + fr, col0 = u.pn * HALF + wc * 32 + 8 * fq;
#pragma unroll
        for (int ai = 0; ai < 2; ++ai)
#pragma unroll
            for (int m = 0; m < 4; ++m) { f32x4 h0, h1;
#pragma unroll
                for (int j = 0; j < 4; ++j) { const float a0 = acc[ai][0][m][0][j], a1 = acc[ai][0][m][1][j]; h0[j] = a0 * sigm(a0) * acc[ai][1][m][0][j]; h1[j] = a1 * sigm(a1) * acc[ai][1][m][1][j]; }
                *(u32x4*)(H + (size_t)(row0 + ai * HALF + m * 16) * ldh + col0) = pack8(h0, h1); }
    }
};
struct EpiMoeDown {
    static constexpr bool PERM = true, AFTER_DRAIN = false;
    bf16_t* O; const float* SW;
    __device__ __forceinline__ void operator()(const f32x4 (&acc)[2][2][4][2], const Unit& u, int wr, int wc, int fr, int fq) const {
        const int row0 = u.pm * BM + wr * 64 + fr, col0 = u.pn * BM + wc * 32 + 8 * fq;
#pragma unroll
        for (int ai = 0; ai < 2; ++ai)
#pragma unroll
            for (int m = 0; m < 4; ++m) { const int row = row0 + ai * HALF + m * 16; const float gw = SW[row]; bf16_t* rowp = O + (size_t)row * 1024 + col0;
#pragma unroll
                for (int bj = 0; bj < 2; ++bj) *(u32x4*)(rowp + bj * HALF) = pack8(acc[ai][bj][m][0] * gw, acc[ai][bj][m][1] * gw); }
    }
};
template <bool UP> struct MoeOrder {
    int nMc, nN, nwg, G, c, t0; int ts1, ts2, ts3, ts4, ts5, ts6, ts7;
    __device__ __forceinline__ bool next(int i, Unit& u) const {
        const long L = (long)i * G + c; if (L >= nwg) return false;
        int wgid = (int)L; { const int q = nwg / NXCD, r = nwg % NXCD, xcd = wgid % NXCD, off = wgid / NXCD; wgid = (xcd < r ? xcd * (q + 1) : r * (q + 1) + (xcd - r) * q) + off; }
        const int nig = WGM * nN, gid = wgid / nig, fm = gid * WGM, gsz = (nMc - fm) < WGM ? (nMc - fm) : WGM;
        const int pml = fm + ((wgid % nig) % gsz), pn = (wgid % nig) / gsz, t = t0 + pml;
        const int e = (t >= ts1) + (t >= ts2) + (t >= ts3) + (t >= ts4) + (t >= ts5) + (t >= ts6) + (t >= ts7);
        u.pn = pn; u.pb = e * nN + pn; u.slot = i;
        if (UP) { u.pa = t; u.pm = pml; } else { u.pa = pml; u.pm = t; }
        return true;
    }
    __device__ __forceinline__ void a_ready(const Unit&) const {}
    __device__ __forceinline__ void done(const Unit&) const {}
};
}
namespace att {
#define ATT_LAS __attribute__((address_space(3)))
typedef unsigned short bf16;
using bf16x8 = __attribute__((ext_vector_type(8))) short;
using s16x4  = __attribute__((ext_vector_type(4))) short;
using f32x16 = __attribute__((ext_vector_type(16))) float;
using u32x4  = __attribute__((ext_vector_type(4))) unsigned;
#define SBAR() __builtin_amdgcn_sched_barrier(0)
__device__ __forceinline__ int crow(int r, int hi) { return (r & 3) + 8 * (r >> 2) + 4 * hi; }
__device__ __forceinline__ unsigned cvtpk(float lo, float hi) { unsigned r; asm volatile("v_cvt_pk_bf16_f32 %0, %1, %2" : "=v"(r) : "v"(lo), "v"(hi)); return r; }
__device__ __forceinline__ unsigned short f2bf(float f) { return (unsigned short)(cvtpk(f, f) & 0xffffu); }
__device__ __forceinline__ int v_st(int k, int c) { const int kk = (k & ~0xC) | ((k & 4) << 1) | ((k & 8) >> 1); return ((kk >> 3) * 2 + (c >> 5)) * 512 + ((kk & 7) * 32 + (c & 31)) * 2; }
__device__ __forceinline__ int v_rd_base(int lane) { return ((lane & 3) << 3) | (((lane >> 2) & 3) << 6) | (((lane >> 4) & 1) << 5) | (((lane >> 5) & 1) << 8); }
constexpr int v_rd_off(int d0, int ks, int half) { return d0 * 512 + ks * 2048 + half * 1024; }
template <int OFF> __device__ __forceinline__ s16x4 tr_read(int vb) { s16x4 r; asm volatile("ds_read_b64_tr_b16 %0, %1 offset:%2" : "=&v"(r) : "v"(vb), "i"(OFF) : "memory"); return r; }
template <int D0> __device__ __forceinline__ void pv_one(f32x16& od, int vb, bf16x8 pa0, bf16x8 pa1, bf16x8 pa2, bf16x8 pa3) {
  const s16x4 l0 = tr_read<v_rd_off(D0, 0, 0)>(vb), h0 = tr_read<v_rd_off(D0, 0, 1)>(vb), l1 = tr_read<v_rd_off(D0, 1, 0)>(vb), h1 = tr_read<v_rd_off(D0, 1, 1)>(vb);
  const s16x4 l2 = tr_read<v_rd_off(D0, 2, 0)>(vb), h2 = tr_read<v_rd_off(D0, 2, 1)>(vb), l3 = tr_read<v_rd_off(D0, 3, 0)>(vb), h3 = tr_read<v_rd_off(D0, 3, 1)>(vb);
  asm volatile("s_waitcnt lgkmcnt(0)" ::: "memory"); SBAR();
#define PK(L, H) (bf16x8){L[0], L[1], L[2], L[3], H[0], H[1], H[2], H[3]}
  od = __builtin_amdgcn_mfma_f32_32x32x16_bf16(pa0, PK(l0, h0), od, 0, 0, 0);
  od = __builtin_amdgcn_mfma_f32_32x32x16_bf16(pa1, PK(l1, h1), od, 0, 0, 0);
  od = __builtin_amdgcn_mfma_f32_32x32x16_bf16(pa2, PK(l2, h2), od, 0, 0, 0);
  od = __builtin_amdgcn_mfma_f32_32x32x16_bf16(pa3, PK(l3, h3), od, 0, 0, 0);
#undef PK
}
__device__ __forceinline__ void pv2(f32x16* o, int vb, bf16x8 pa0, bf16x8 pa1, bf16x8 pa2, bf16x8 pa3) { pv_one<0>(o[0], vb, pa0, pa1, pa2, pa3); pv_one<1>(o[1], vb, pa0, pa1, pa2, pa3); }
template <int NS, int ROWB> __device__ __forceinline__ void qkt(f32x16& p0, f32x16& p1, const ATT_LAS char* Ks, const bf16x8* qr, int r32, int hi) {
  p0 = f32x16{}; p1 = f32x16{};
#pragma unroll
  for (int d0 = 0; d0 < NS; ++d0) { const int cb = d0 * 32 + hi * 16;
    const bf16x8 b0 = *(const ATT_LAS bf16x8*)(Ks + r32 * ROWB + cb);
    const bf16x8 b1 = *(const ATT_LAS bf16x8*)(Ks + (32 + r32) * ROWB + cb);
    p0 = __builtin_amdgcn_mfma_f32_32x32x16_bf16(b0, qr[d0], p0, 0, 0, 0);
    p1 = __builtin_amdgcn_mfma_f32_32x32x16_bf16(b1, qr[d0], p1, 0, 0, 0); }
}
constexpr float THR = 8.f;
__device__ __forceinline__ void partialSM(f32x16& p0, f32x16& p1, float& m_reg, float& alpha) {
  float pmax = p0[0];
#pragma unroll
  for (int r = 1; r < 16; ++r) pmax = fmaxf(pmax, p0[r]);
#pragma unroll
  for (int r = 0; r < 16; ++r) pmax = fmaxf(pmax, p1[r]);
  { auto rr = __builtin_amdgcn_permlane32_swap(__float_as_uint(pmax), __float_as_uint(pmax), false, false); pmax = fmaxf(__uint_as_float(rr[0]), __uint_as_float(rr[1])); }
  float mn;
  if (__builtin_expect(__all(pmax - m_reg <= THR), 1)) { mn = m_reg; alpha = 1.f; }
  else { mn = fmaxf(m_reg, pmax); alpha = __builtin_amdgcn_exp2f(m_reg - mn); m_reg = mn; }
#pragma unroll
  for (int r = 0; r < 16; ++r) p0[r] = p0[r] - mn;
#pragma unroll
  for (int r = 0; r < 16; ++r) p1[r] = p1[r] - mn;
#pragma unroll
  for (int r = 0; r < 16; ++r) p0[r] = __builtin_amdgcn_exp2f(p0[r]);
}
__device__ __forceinline__ void finishSM(f32x16& p0, f32x16& p1, float alpha, float& l_reg, bf16x8& pa0, bf16x8& pa1, bf16x8& pa2, bf16x8& pa3) {
#pragma unroll
  for (int r = 0; r < 16; ++r) p1[r] = __builtin_amdgcn_exp2f(p1[r]);
  float ps = 0;
#pragma unroll
  for (int r = 0; r < 16; ++r) ps += p0[r];
#pragma unroll
  for (int r = 0; r < 16; ++r) ps += p1[r];
  { auto rr = __builtin_amdgcn_permlane32_swap(__float_as_uint(ps), __float_as_uint(ps), false, false); ps = __uint_as_float(rr[0]) + __uint_as_float(rr[1]); }
  l_reg = l_reg * alpha + ps;
#define PK4(P, BASE, OUT) do { unsigned a0 = cvtpk(P[BASE + 0], P[BASE + 1]), a1 = cvtpk(P[BASE + 2], P[BASE + 3]);   \
    unsigned b0 = cvtpk(P[BASE + 4], P[BASE + 5]), b1 = cvtpk(P[BASE + 6], P[BASE + 7]);                              \
    auto r0 = __builtin_amdgcn_permlane32_swap(a0, b0, false, false); auto r1 = __builtin_amdgcn_permlane32_swap(a1, b1, false, false); \
    u32x4 w = {r0[0], r1[0], r0[1], r1[1]}; OUT = *reinterpret_cast<bf16x8*>(&w); } while (0)
  PK4(p0, 0, pa0); PK4(p0, 8, pa1); PK4(p1, 0, pa2); PK4(p1, 8, pa3);
#undef PK4
}

constexpr int KROWB = 208, SHM_K = 64 * KROWB, SHM_V = 8192, MLA_LDS = 2 * SHM_V + 2 * SHM_K + 8 * 256;
__device__ __forceinline__ void mla_unit(const bf16* __restrict__ Qb, const bf16* __restrict__ Kh, const bf16* __restrict__ Vh, bf16* __restrict__ Ob, int seq, ATT_LAS char* lds) {
  int tid_ = threadIdx.x; asm volatile("" : "+v"(tid_));
  const int tid = tid_, wid = __builtin_amdgcn_readfirstlane(tid >> 6), lane = tid & 63, r32 = lane & 31, hi = lane >> 5;
  ATT_LAS char* V_lds = lds; ATT_LAS char* K_lds = lds + 2 * SHM_V;
  ATT_LAS float* ws = (ATT_LAS float*)(lds + 2 * SHM_V + 2 * SHM_K) + wid * 64; ATT_LAS float* li_l = ws; ATT_LAS float* al_l = ws + 32;
  float m_reg = -1e30f, l_reg = 0; f32x16 o[2] = {}; bf16x8 qr[6];
  const bf16* Qw = Qb + (long)(wid * 32 + r32) * 768 + hi * 8;
#pragma unroll
  for (int d0 = 0; d0 < 6; ++d0) qr[d0] = *reinterpret_cast<const bf16x8*>(Qw + d0 * 16);
  const int cA = tid, rowA = cA / 12, chA = cA % 12; const int cB = 512 + (tid & 255), rowB = cB / 12, chB = cB % 12; const bool hasB = tid < 256;
  const int rowV = tid >> 3, chV = tid & 7, vst = v_st(rowV, chV * 8);
  const int kstA = rowA * KROWB + chA * 16, kstB = rowB * KROWB + chB * 16;
  const int vb0 = (int)(unsigned)(uintptr_t)V_lds + v_rd_base(lane);
  struct { bf16x8 vs, ks0, ks1; } sr_[2];
#define SLOAD(i, k0) do { sr_[i].vs = *reinterpret_cast<const bf16x8*>(&Vh[(long)((k0) + rowV) * 512 + chV * 8]); \
    sr_[i].ks0 = *reinterpret_cast<const bf16x8*>(&Kh[(long)((k0) + rowA) * 768 + chA * 8]); sr_[i].ks1 = *reinterpret_cast<const bf16x8*>(&Kh[(long)((k0) + rowB) * 768 + chB * 8]); } while (0)
#define SWRITE(b, i) do { *(ATT_LAS bf16x8*)(V_lds + (b) * SHM_V + vst) = sr_[i].vs; *(ATT_LAS bf16x8*)(K_lds + (b) * SHM_K + kstA) = sr_[i].ks0; \
    if (hasB) *(ATT_LAS bf16x8*)(K_lds + (b) * SHM_K + kstB) = sr_[i].ks1; } while (0)
#define SWAIT() asm volatile("s_waitcnt vmcnt(3)" ::: "memory")
#define RESC(a) do { if (__any((a) < 1.f)) { if (hi == 0) al_l[r32] = (a); asm volatile("s_waitcnt lgkmcnt(0)" ::: "memory"); \
    _Pragma("unroll") for (int d = 0; d < 2; ++d) _Pragma("unroll") for (int r = 0; r < 16; ++r) o[d][r] *= al_l[crow(r, hi)]; } } while (0)
  f32x16 pA0, pA1, pB0, pB1; float alA, alB; bf16x8 pa0, pa1, pa2, pa3; const int NT = seq / 64;
  constexpr int SE = 0, SO = 1;
  SLOAD(SE, 0); asm volatile("s_waitcnt vmcnt(0)" ::: "memory"); SWRITE(0, SE); __syncthreads();
  qkt<6, KROWB>(pA0, pA1, K_lds, qr, r32, hi); partialSM(pA0, pA1, m_reg, alA);
  SLOAD(SO, 64); if (2 < NT) SLOAD(SE, 128);
  SWAIT(); SWRITE(1, SO); __syncthreads();
  for (int j = 1; j + 1 < NT; j += 2) {
    SBAR(); qkt<6, KROWB>(pB0, pB1, K_lds + SHM_K, qr, r32, hi);
    finishSM(pA0, pA1, alA, l_reg, pa0, pa1, pa2, pa3); SBAR();
    SLOAD(SO, (j + 2) * 64); SBAR();
    pv2(o, vb0, pa0, pa1, pa2, pa3); partialSM(pB0, pB1, m_reg, alB);
    __syncthreads(); SWAIT(); SWRITE(0, SE);
    RESC(alB); __syncthreads();
    SBAR(); qkt<6, KROWB>(pA0, pA1, K_lds, qr, r32, hi);
    finishSM(pB0, pB1, alB, l_reg, pa0, pa1, pa2, pa3); SBAR();
    if (j + 3 < NT) SLOAD(SE, (j + 3) * 64); SBAR();
    pv2(o, vb0 + SHM_V, pa0, pa1, pa2, pa3); partialSM(pA0, pA1, m_reg, alA);
    __syncthreads(); SWAIT(); SWRITE(1, SO);
    RESC(alA); __syncthreads();
  }
  SBAR(); qkt<6, KROWB>(pB0, pB1, K_lds + SHM_K, qr, r32, hi);
  finishSM(pA0, pA1, alA, l_reg, pa0, pa1, pa2, pa3); SBAR();
  pv2(o, vb0, pa0, pa1, pa2, pa3); partialSM(pB0, pB1, m_reg, alB);
  __syncthreads(); RESC(alB);
  finishSM(pB0, pB1, alB, l_reg, pa0, pa1, pa2, pa3); SBAR();
  pv2(o, vb0 + SHM_V, pa0, pa1, pa2, pa3);
  if (hi == 0) li_l[r32] = l_reg; asm volatile("s_waitcnt lgkmcnt(0)" ::: "memory");
  float rli[16];
#pragma unroll
  for (int r = 0; r < 16; ++r) rli[r] = __builtin_amdgcn_rcpf(li_l[crow(r, hi)]);
  bf16* Ow = Ob + (long)(wid * 32) * 512;
#pragma unroll
  for (int r = 0; r < 16; ++r) { const int orow = crow(r, hi);
#pragma unroll
    for (int d0 = 0; d0 < 2; ++d0) Ow[(long)orow * 512 + d0 * 32 + r32] = f2bf(o[d0][r] * rli[r]); }
  __syncthreads();
#undef SLOAD
#undef SWRITE
#undef SWAIT
#undef RESC
}

constexpr int NA_KROWB = 144, NA_LDS_K = 64 * NA_KROWB  , NA_LDS = NA_LDS_K + 8192 + 15 * 32 * 4 + 8 * 256;
__device__ __forceinline__ void na_unit(int b, int h, int rg, const bf16* __restrict__ QKV, bf16* __restrict__ O, const float* __restrict__ rpb, ATT_LAS char* lds) {
  int tid_ = threadIdx.x; asm volatile("" : "+v"(tid_));
  const int tid = tid_, wid = __builtin_amdgcn_readfirstlane(tid >> 6), lane = tid & 63, r32 = lane & 31, hi = lane >> 5;
  ATT_LAS char* K_lds = lds; ATT_LAS char* V_lds = lds + NA_LDS_K; ATT_LAS float* tab = (ATT_LAS float*)(lds + NA_LDS_K + 8192);
  ATT_LAS float* ws = (ATT_LAS float*)(lds + NA_LDS_K + 8192 + 15 * 32 * 4) + wid * 64; ATT_LAS float* li_l = ws; ATT_LAS float* al_l = ws + 32;
  const int r0 = 4 * rg, r = r0 + (wid >> 1), ch = wid & 1, qcol = 32 * ch + r32;
  const int rs = min(max(r - 4, 0), 120), lo = min(max(r0 - 4, 0), 120), hiR = min(max(r0 + 3 - 4, 0), 120) + 7;
  const int wstart = min(max(qcol - 8, 0), 48);
  const long tok0 = (long)b * 8192;
  if (tid < 15 * 32) { const int dr = tid >> 5, dc = tid & 31; tab[tid] = (dc < 31) ? rpb[(h * 15 + dr) * 31 + dc] * 1.4426950408889634f : 0.f; }
  bf16x8 qr[4];
  { const bf16* Qw = QKV + (tok0 + r * 64 + qcol) * 1536 + h * 64 + hi * 8;
#pragma unroll
    for (int d0 = 0; d0 < 4; ++d0) qr[d0] = *reinterpret_cast<const bf16x8*>(Qw + d0 * 16); }
  const int srow = tid >> 3, sch = tid & 7; const int kst = srow * NA_KROWB + sch * 16, vst = v_st(srow, sch * 8);
  const int vb0 = (int)(unsigned)(uintptr_t)V_lds + v_rd_base(lane);
  const bf16* Ksrc = QKV + (tok0 + srow) * 1536 + 512 + h * 64 + sch * 8; const bf16* Vsrc = Ksrc + 512;
  float m_reg = -1e30f, l_reg = 0.f; f32x16 o[2] = {};
  bf16x8 kreg = *reinterpret_cast<const bf16x8*>(Ksrc + (long)lo * 64 * 1536), vreg = *reinterpret_cast<const bf16x8*>(Vsrc + (long)lo * 64 * 1536);
  for (int kr = lo; kr <= hiR; ++kr) {
    __syncthreads();
    *(ATT_LAS bf16x8*)(K_lds + kst) = kreg; *(ATT_LAS bf16x8*)(V_lds + vst) = vreg;
    if (kr + 1 <= hiR) { kreg = *reinterpret_cast<const bf16x8*>(Ksrc + (long)(kr + 1) * 64 * 1536); vreg = *reinterpret_cast<const bf16x8*>(Vsrc + (long)(kr + 1) * 64 * 1536); }
    __syncthreads();
    if (kr >= rs && kr < rs + 8) {
      f32x16 p0, p1; qkt<4, NA_KROWB>(p0, p1, K_lds, qr, r32, hi);
      const ATT_LAS float* trow = tab + (kr - r + 7) * 32;
#pragma unroll
      for (int q = 0; q < 16; ++q) { const int kc0 = crow(q, hi), kc1 = kc0 + 32;
        const int i0 = min(max(kc0 - qcol + 15, 0), 30), i1 = min(max(kc1 - qcol + 15, 0), 30);
        const float b0 = trow[i0], b1 = trow[i1];
        p0[q] = ((unsigned)(kc0 - wstart) < 16u) ? p0[q] + b0 : -1e30f;
        p1[q] = ((unsigned)(kc1 - wstart) < 16u) ? p1[q] + b1 : -1e30f; }
      float pmax = p0[0];
#pragma unroll
      for (int q = 1; q < 16; ++q) pmax = fmaxf(pmax, p0[q]);
#pragma unroll
      for (int q = 0; q < 16; ++q) pmax = fmaxf(pmax, p1[q]);
      { auto rr = __builtin_amdgcn_permlane32_swap(__float_as_uint(pmax), __float_as_uint(pmax), false, false); pmax = fmaxf(__uint_as_float(rr[0]), __uint_as_float(rr[1])); }
      const float mn = fmaxf(m_reg, pmax), alpha = __builtin_amdgcn_exp2f(m_reg - mn); m_reg = mn;
#pragma unroll
      for (int q = 0; q < 16; ++q) { p0[q] = __builtin_amdgcn_exp2f(p0[q] - mn); p1[q] = __builtin_amdgcn_exp2f(p1[q] - mn); }
      float ps = 0.f;
#pragma unroll
      for (int q = 0; q < 16; ++q) ps += p0[q] + p1[q];
      { auto rr = __builtin_amdgcn_permlane32_swap(__float_as_uint(ps), __float_as_uint(ps), false, false); ps = __uint_as_float(rr[0]) + __uint_as_float(rr[1]); }
      l_reg = l_reg * alpha + ps;
      if (hi == 0) al_l[r32] = alpha; asm volatile("s_waitcnt lgkmcnt(0)" ::: "memory");
#pragma unroll
      for (int d = 0; d < 2; ++d)
#pragma unroll
        for (int q = 0; q < 16; ++q) o[d][q] *= al_l[crow(q, hi)];
      bf16x8 pa0, pa1, pa2, pa3;
#define PK4(P, BASE, OUT) do { unsigned a0 = cvtpk(P[BASE + 0], P[BASE + 1]), a1 = cvtpk(P[BASE + 2], P[BASE + 3]);   \
    unsigned b0_ = cvtpk(P[BASE + 4], P[BASE + 5]), b1_ = cvtpk(P[BASE + 6], P[BASE + 7]);                              \
    auto r0_ = __builtin_amdgcn_permlane32_swap(a0, b0_, false, false); auto r1_ = __builtin_amdgcn_permlane32_swap(a1, b1_, false, false); \
    u32x4 w = {r0_[0], r1_[0], r0_[1], r1_[1]}; OUT = *reinterpret_cast<bf16x8*>(&w); } while (0)
      PK4(p0, 0, pa0); PK4(p0, 8, pa1); PK4(p1, 0, pa2); PK4(p1, 8, pa3);
#undef PK4
      SBAR(); pv2(o, vb0, pa0, pa1, pa2, pa3);
    }
  }
  if (hi == 0) li_l[r32] = l_reg; asm volatile("s_waitcnt lgkmcnt(0)" ::: "memory");
  float rli[16];
#pragma unroll
  for (int q = 0; q < 16; ++q) rli[q] = __builtin_amdgcn_rcpf(li_l[crow(q, hi)]);
  bf16* Ow = O + (tok0 + r * 64 + 32 * ch) * 512 + h * 64;
#pragma unroll
  for (int q = 0; q < 16; ++q) { const int orow = crow(q, hi);
#pragma unroll
    for (int d0 = 0; d0 < 2; ++d0) Ow[(long)orow * 512 + d0 * 32 + r32] = f2bf(o[d0][q] * rli[q]); }
  __syncthreads();
}
#undef SBAR
}

constexpr int NWAVES = 8;
constexpr int NB = 8, SEQ = 8192, DM = 1024, MTOK = NB * SEQ;
constexpr int NIN = 4640, NPROJ = 4864;
constexpr int DFF = 2816, DFFE = 3584, NEXP = 8, PLED = 256;
constexpr int QLORA = 768, KVLORA = 256;
constexpr float ALPHA = 1.4142135623730951f;
constexpr float LN_EPS = 1e-5f, RMS_EPS = 1e-6f;
constexpr float LOG2E = 1.4426950408889634f;
constexpr float NA_QSCALE = 0.125f * LOG2E;
constexpr float MLA_QSCALE = 0.10206207261596575f * LOG2E;
constexpr int MOE_CHUNK = 128, MOE_NCHUNK = 5, MOE_MAXT = 520;

constexpr size_t MiB = 1u << 20;
constexpr size_t WS_CTL = 0, CTL_ZERO_BYTES = 64 * 1024;
constexpr size_t WS_ROPE = 1 * MiB;
constexpr size_t WS_W = 2 * MiB;
constexpr size_t W_WIN = 0, W_WUQ = W_WIN + (size_t)NPROJ * 1024 * 2, W_WUKV = W_WUQ + 768 * 768 * 2, W_WNAO = W_WUKV + 1024 * 256 * 2, W_WMLAO = W_WNAO + 1024 * 512 * 2,
                 W_WOUT = W_WMLAO + 1024 * 512 * 2, W_WPG = W_WOUT + 1024 * 1024 * 2, W_WPLE = W_WPG + 1024 * 1024 * 2, W_LAYER = W_WPLE + 1024 * 256 * 2;
constexpr size_t WS_W13 = WS_W + 2 * W_LAYER, WS_W2 = WS_W13 + (size_t)2 * DFF * 1024 * 2, WS_WEND = WS_W2 + (size_t)1024 * DFF * 2;
static_assert(WS_WEND <= 56 * MiB, "weights");
constexpr size_t WS_PB = 56 * MiB;
constexpr size_t WS_TE = 88 * MiB, WS_TP = 89 * MiB, WS_TW = 90 * MiB, WS_TPOS = 91 * MiB, WS_SW = 92 * MiB, WS_CNT = 93 * MiB;
constexpr size_t WS_XB = 96 * MiB;
constexpr size_t WS_QMLA = WS_XB;
constexpr size_t WS_GATES = 224 * MiB;
constexpr size_t WS_NAQKV = 480 * MiB;
constexpr size_t WS_MERGED = WS_NAQKV;
constexpr size_t WS_QLAT = 672 * MiB, WS_KVLAT = 768 * MiB;
constexpr size_t WS_ONA = 672 * MiB, WS_OMLA = 736 * MiB;
constexpr size_t WS_KMLA = 800 * MiB, WS_VMLA = 896 * MiB;
constexpr size_t WS_H = 224 * MiB, WS_PP_DENSE = 576 * MiB;
constexpr size_t WS_PP_MOE = 224 * MiB, WS_XS = 352 * MiB, WS_HS = 612 * MiB, WS_WM13 = 856 * MiB, WS_WM2 = 968 * MiB, WS_END = 1024 * MiB;
static_assert(WS_XS + (size_t)MOE_MAXT * 256 * 1024 * 2 <= WS_HS && WS_HS + (size_t)MOE_CHUNK * 256 * DFFE * 2 <= WS_WM13 && WS_WM13 + (size_t)NEXP * 2 * DFFE * 1024 * 2 == WS_WM2 && WS_WM2 + (size_t)NEXP * 1024 * DFFE * 2 == WS_END, "moe map");
static_assert(WS_H + (size_t)MTOK * DFF * 2 <= WS_PP_DENSE, "dense map");
constexpr int CW_BAR = 4096;
constexpr int RING_OFF = 0, RING_BYTES = 131072;
constexpr int LDSCTL_OFF = RING_BYTES;
constexpr int X_LCNT = RING_BYTES + 512, X_OFF = X_LCNT + 64, X_TOT = X_OFF + 64, X_RTAB = X_TOT + 64, X_PRE = X_RTAB + 4 * 256 * 4, X_END = X_PRE + 256 * 8 * 4;
constexpr int LDS_BYTES = 155648;
static_assert(X_END <= LDS_BYTES, "LDS map");

#include <hip/hip_bf16.h>
#define GAS __attribute__((address_space(1)))
#define LAS __attribute__((address_space(3)))
typedef unsigned short bf16;
typedef unsigned v4u __attribute__((ext_vector_type(4)));
typedef float f32x4 __attribute__((ext_vector_type(4)));
typedef short bf16x8 __attribute__((ext_vector_type(8)));
typedef GAS unsigned gu32;
typedef GAS unsigned long long gu64;
#define RLX_AGENT __ATOMIC_RELAXED, __HIP_MEMORY_SCOPE_AGENT
#define LDS_WAIT() asm volatile("s_waitcnt lgkmcnt(0)" ::: "memory")
#define VM_WAIT() asm volatile("s_waitcnt vmcnt(0)" ::: "memory")
__device__ __forceinline__ unsigned long long rt() { return __builtin_amdgcn_s_memrealtime(); }
__device__ __forceinline__ unsigned f2bf(float f) { unsigned u = __builtin_bit_cast(unsigned, f); return (u + 0x7fffu + ((u >> 16) & 1u)) >> 16; }
__device__ __forceinline__ unsigned pk2(float lo, float hi) { return f2bf(lo) | (f2bf(hi) << 16); }

#define XB_TMO      128
#define XB_XCNT(j)  (256  + 64 * (j))
#define XB_XSUB(j)  (1280 + 64 * (j))
#define XB_XGEN(j)  (2304 + 64 * (j))
#define XB_TOP      3328
#define XB_TOPGEN   3392
#define XCD_BAR_WORDS 3456
#define XB_SPIN_CAP (1u << 18)

__device__ __forceinline__ unsigned xb_ld(unsigned* p)              { return __hip_atomic_load(p, __ATOMIC_RELAXED, __HIP_MEMORY_SCOPE_AGENT); }
__device__ __forceinline__ unsigned xb_add(unsigned* p, unsigned v) { return __hip_atomic_fetch_add(p, v, __ATOMIC_RELAXED, __HIP_MEMORY_SCOPE_AGENT); }
__device__ __forceinline__ unsigned xb_xcc_id() { return (unsigned)__builtin_amdgcn_s_getreg((3 << 11) | 20) & 0xFu; }
#define XB_SPIN(cond, bar) do { unsigned _sp = 0; while (cond) { __builtin_amdgcn_s_sleep(1); \
    if ((++_sp & 255u) == 0u) { if (xb_ld(&(bar)[XB_TMO])) break; if (_sp > XB_SPIN_CAP) { atomicAdd(&(bar)[XB_TMO], 1u); break; } } } } while (0)

struct XcdBarrier {
    unsigned* bar; unsigned x;
    volatile LAS unsigned* st;
};

__device__ __forceinline__ XcdBarrier xcd_barrier_post(unsigned* bar, volatile LAS unsigned* st) {
    XcdBarrier b; b.bar = bar; b.x = xb_xcc_id(); b.st = st;
    if (threadIdx.x == 0) (void)xb_add(&bar[XB_XCNT(b.x)], 1u);
    return b;
}
__device__ __forceinline__ void xcd_barrier_complete(unsigned* bar, unsigned x, unsigned& nloc, unsigned& nx) {
    const unsigned G = gridDim.x * gridDim.y * gridDim.z;
    unsigned sum, cnt, mine, sp = 0u;
    for (;;) {
        sum = 0u; cnt = 0u; mine = 0u;
#pragma unroll
        for (unsigned j = 0; j < 16; ++j) { const unsigned c = xb_ld(&bar[XB_XCNT(j)]); sum += c; cnt += (c > 0u) ? 1u : 0u; mine = (j == x) ? c : mine; }
        if (sum == G) break;
        __builtin_amdgcn_s_sleep(1);
        if ((++sp & 255u) == 0u) { if (xb_ld(&bar[XB_TMO])) break; if (sp > XB_SPIN_CAP) { atomicAdd(&bar[XB_TMO], 1u); break; } }
    }
    nloc = mine > 0u ? mine : 1u; nx = cnt > 0u ? cnt : 1u;
}

__device__ __forceinline__ void xcd_barrier(const XcdBarrier& b) {
    asm volatile("s_waitcnt vmcnt(0)" ::: "memory");
    __syncthreads();
    if (threadIdx.x == 0) {
        unsigned* bar = b.bar;
        __builtin_amdgcn_s_waitcnt(0);
        unsigned nloc = b.st[0], nx = b.st[1];
        if (nloc == 0u) { xcd_barrier_complete(bar, b.x, nloc, nx); b.st[0] = nloc; b.st[1] = nx; }
        const unsigned old = xb_add(&bar[XB_XSUB(b.x)], 1u);
        const unsigned gen = old / nloc;
        if (old + 1u == (gen + 1u) * nloc) {
            __builtin_amdgcn_fence(__ATOMIC_RELEASE, "agent");
            asm volatile("s_waitcnt vmcnt(0)" ::: "memory");
            const unsigned og = xb_add(&bar[XB_TOP], 1u);
            const unsigned tg = og / nx;
            if (og + 1u == (tg + 1u) * nx) xb_add(&bar[XB_TOPGEN], 1u);
            else XB_SPIN(xb_ld(&bar[XB_TOPGEN]) == tg, bar);
            __builtin_amdgcn_fence(__ATOMIC_ACQUIRE, "agent");
            xb_add(&bar[XB_XGEN(b.x)], 1u);
            asm volatile("s_waitcnt vmcnt(0)" ::: "memory");
        } else {
            XB_SPIN(xb_ld(&bar[XB_XGEN(b.x)]) == gen, bar);
            __builtin_amdgcn_fence(__ATOMIC_ACQUIRE, "agent");
            asm volatile("s_waitcnt vmcnt(0)" ::: "memory");
        }
    }
    __syncthreads();
}


typedef unsigned v2u __attribute__((ext_vector_type(2)));
struct Args { const float* in[26]; float* out; unsigned char* ws; int ph_lo, ph_hi; };
struct Frame {
    LAS unsigned char* lds;
    int tid, lane, wave, vcu, G;
};
__device__ __forceinline__ float wave_sum(float v) {
#pragma unroll
    for (int o = 1; o < 64; o <<= 1) v += __shfl_xor(v, o);
    return v;
}
__device__ __forceinline__ float bflo(unsigned w) { return __uint_as_float(w << 16); }
__device__ __forceinline__ float bfhi(unsigned w) { return __uint_as_float(w & 0xffff0000u); }

__device__ __forceinline__ void tr_item(const float* W, int K, int N, bf16* WT, int g, int s0, int ss, int d0, int ds, const float* gs, LAS float* scr, int item, int ncols, int lane) {
    const int nblk = ncols / 32, kb = item / nblk, nb = item % nblk, k0 = 64 * kb, j0 = 32 * nb;
    const int grp = j0 / g, jin = j0 % g, sn0 = s0 + grp * ss + jin, dn0 = d0 + grp * ds + jin;
#pragma unroll 8
    for (int i = 0; i < 32; ++i) { const int kk = 2 * i + (lane >> 5); float v = W[(size_t)(k0 + kk) * N + sn0 + (lane & 31)]; if (gs) v *= gs[k0 + kk]; scr[kk * 33 + (lane & 31)] = v; }
    LDS_WAIT(); asm volatile("" ::: "memory");
    const int c = lane & 7;
#pragma unroll
    for (int j = 0; j < 4; ++j) { const int n = (lane >> 3) + 8 * j; const LAS float* s = scr + (8 * c) * 33 + n;
        v4u o; o.x = pk2(s[0 * 33], s[1 * 33]); o.y = pk2(s[2 * 33], s[3 * 33]); o.z = pk2(s[4 * 33], s[5 * 33]); o.w = pk2(s[6 * 33], s[7 * 33]);
        *(GAS v4u*)(WT + (size_t)(dn0 + n) * K + k0 + 8 * c) = o; }
    LDS_WAIT(); asm volatile("" ::: "memory");
}
__device__ __forceinline__ void tr_job(Frame& F, int& rot, const float* W, int K, int N, int ncols, bf16* WT, int g, int s0, int ss, int d0, int ds, const float* gs) {
    LAS float* scr = (LAS float*)(F.lds + RING_OFF + F.wave * 16384);
    const int NGW = F.G * NWAVES, gw = F.vcu * NWAVES + F.wave, nitems = (K / 64) * (ncols / 32);
    int first = (gw - rot) % NGW; if (first < 0) first += NGW;
    for (int it = first; it < nitems; it += NGW) tr_item(W, K, N, WT, g, s0, ss, d0, ds, gs, scr, it, ncols, F.lane);
    rot = (rot + nitems) % NGW;
}
__device__ __forceinline__ void tr_plain(Frame& F, int& rot, const float* W, int K, int N, bf16* WT) { tr_job(F, rot, W, K, N, N, WT, N, 0, 0, 0, 0, nullptr); }
__device__ __forceinline__ void cvt_rows(Frame& F, const float* src, bf16* dst, size_t n8) {
    const size_t NT = (size_t)F.G * NWAVES * 64, t0 = (size_t)(F.vcu * NWAVES + F.wave) * 64 + F.lane;
    for (size_t i = t0; i < n8; i += NT) { const f32x4 a = *(const GAS f32x4*)(src + i * 8), b = *(const GAS f32x4*)(src + i * 8 + 4);
        v4u o; o.x = pk2(a.x, a.y); o.y = pk2(a.z, a.w); o.z = pk2(b.x, b.y); o.w = pk2(b.z, b.w); *(GAS v4u*)(dst + i * 8) = o; }
}

template <class Sched> __device__ __forceinline__ void rms_prepass(Frame& F, const Sched& S, const bf16* A, int K) {
    LAS float* rtab = (LAS float*)(F.lds + X_RTAB); pg8::Unit u;
    const int sub = F.lane >> 4, l16 = F.lane & 15;
    for (int i = 0; i < 4 && S.next(i, u); ++i) {
#pragma unroll 2
        for (int it = 0; it < 8; ++it) { const int lr = F.wave * 32 + it * 4 + sub; const bf16* rp = A + (size_t)(u.pa * 256 + lr) * K;
            float s = 0.f;
            for (int c = l16 * 8; c < K; c += 128) { const v4u w = *(const GAS v4u*)(rp + c);
                const float a0 = bflo(w.x), a1 = bfhi(w.x), a2 = bflo(w.y), a3 = bfhi(w.y), a4 = bflo(w.z), a5 = bfhi(w.z), a6 = bflo(w.w), a7 = bfhi(w.w);
                s += (a0 * a0 + a1 * a1) + (a2 * a2 + a3 * a3) + (a4 * a4 + a5 * a5) + (a6 * a6 + a7 * a7); }
            s += __shfl_xor(s, 1); s += __shfl_xor(s, 2); s += __shfl_xor(s, 4); s += __shfl_xor(s, 8);
            if (l16 == 0) rtab[i * 256 + lr] = 1.0f / sqrtf(s / (float)K + RMS_EPS); }
    }
    LDS_WAIT(); __syncthreads();
}

__device__ __forceinline__ void ln_core(f32x4 (&v)[4], const f32x4 (&g)[4], const f32x4 (&bb)[4]) {
    float s = 0.f;
#pragma unroll
    for (int j = 0; j < 4; ++j) s += (v[j].x + v[j].y) + (v[j].z + v[j].w);
    const float mean = wave_sum(s) * (1.f / DM); float s2 = 0.f;
#pragma unroll
    for (int j = 0; j < 4; ++j) { v[j] = v[j] - mean; s2 += (v[j].x * v[j].x + v[j].y * v[j].y) + (v[j].z * v[j].z + v[j].w * v[j].w); }
    const float rstd = 1.f / sqrtf(wave_sum(s2) * (1.f / DM) + LN_EPS);
#pragma unroll
    for (int j = 0; j < 4; ++j) v[j] = v[j] * rstd * g[j] + bb[j];
}
__device__ __forceinline__ void store_row(float* R, bf16* XB, size_t m, const f32x4 (&v)[4], int lane, bool wb) {
    GAS f32x4* o = (GAS f32x4*)(R + m * DM) + lane;
#pragma unroll
    for (int j = 0; j < 4; ++j) o[64 * j] = v[j];
    if (wb) { GAS unsigned long long* o8 = (GAS unsigned long long*)(XB + m * DM) + lane;
#pragma unroll
        for (int j = 0; j < 4; ++j) o8[64 * j] = (unsigned long long)pk2(v[j].x, v[j].y) | ((unsigned long long)pk2(v[j].z, v[j].w) << 32); }
}

__device__ __forceinline__ void moe_tables(Frame& F, const int* CNT, bool wantPre) {
    LAS int* tot = (LAS int*)(F.lds + X_TOT); LAS int* off = (LAS int*)(F.lds + X_OFF); LAS int* pre = (LAS int*)(F.lds + X_PRE);
    const int e = F.wave;
    int carry = 0;
    for (int b0 = 0; b0 < F.G; b0 += 64) { const int blk = b0 + F.lane; const int v = (blk < F.G) ? CNT[blk * 8 + e] : 0;
        int inc = v;
#pragma unroll
        for (int o = 1; o < 64; o <<= 1) { const int t = __shfl_up(inc, o); if (F.lane >= o) inc += t; }
        if (wantPre && blk < F.G && blk < 256) pre[blk * 8 + e] = carry + inc - v;
        carry += __shfl(inc, 63); }
    if (F.lane == 0) tot[e] = carry;
    LDS_WAIT(); __syncthreads();
    if (F.tid == 0) { int o = 0; for (int j = 0; j < 8; ++j) { off[j] = o; o += (tot[j] + 255) & ~255; } off[8] = o; }
    LDS_WAIT(); __syncthreads();
}

#ifndef EN_P0
#define EN_P0 1
#endif
#ifndef EN_A
#define EN_A 1
#endif
#ifndef EN_B
#define EN_B 1
#endif
#ifndef EN_C
#define EN_C 1
#endif
#ifndef EN_D
#define EN_D 1
#endif
#ifndef EN_E
#define EN_E 1
#endif
#ifndef EN_F
#define EN_F 1
#endif
#ifndef EN_G0
#define EN_G0 1
#endif
#ifndef EN_H0
#define EN_H0 1
#endif
#ifndef EN_G1
#define EN_G1 1
#endif
#ifndef EN_U1
#define EN_U1 1
#endif
#ifndef EN_D1
#define EN_D1 1
#endif
#ifndef EN_I
#define EN_I 1
#endif
__global__ void __launch_bounds__(NWAVES * 64, 2) mk_fwd(Args args) {
    extern __shared__ __attribute__((aligned(16))) unsigned char lds[];
    Frame F;
    F.lds = (LAS unsigned char*)lds;
    volatile LAS unsigned* MISC = (volatile LAS unsigned*)(F.lds + LDSCTL_OFF);
    F.tid = threadIdx.x; F.lane = F.tid & 63; F.wave = __builtin_amdgcn_readfirstlane(F.tid >> 6);
    F.G = gridDim.x; { const int bx = blockIdx.x; F.vcu = (F.G % 8 == 0) ? (bx % 8) * (F.G / 8) + bx / 8 : bx; }
    unsigned char* ws = args.ws; float* R = args.out;
    for (int u = F.tid; u < 128; u += NWAVES * 64) ((LAS unsigned*)(F.lds + LDSCTL_OFF))[u] = 0u;
    __syncthreads();
    const int lo = args.ph_lo, hi = args.ph_hi;
    const bool multi = (hi - lo) > 1;
    XcdBarrier bar; bar.bar = (unsigned*)(ws + WS_CTL) + CW_BAR; bar.x = 0; bar.st = nullptr;
    if (multi) bar = xcd_barrier_post((unsigned*)(ws + WS_CTL) + CW_BAR, MISC + 8);
    int ph = 0;
#define IN() (lo <= ph && ph < hi)
#define PH_BEGIN() do { asm volatile("" : "+v"(F.tid)); F.lane = F.tid & 63; } while (0)
#define SEAM() do { if (lo <= ph && ph + 1 < hi) xcd_barrier(bar); ++ph; } while (0)
    LAS unsigned char* ring = F.lds + RING_OFF;
    bf16* const XB = (bf16*)(ws + WS_XB);
    const float* const ROPE = (const float*)(ws + WS_ROPE);

    if (IN() && EN_P0) { PH_BEGIN();
        int rot = 0;
        for (int L = 0; L < 2; ++L) {
            bf16* WL = (bf16*)(ws + WS_W + (size_t)L * W_LAYER);
            const float* win = args.in[2] + (size_t)L * 1024 * NIN;
            bf16* WIN = (bf16*)((unsigned char*)WL + W_WIN);
            tr_job(F, rot, win, 1024, NIN, 1536, WIN, 1536, 0, 0, 0, 0, nullptr);
            tr_job(F, rot, win, 1024, NIN, 768, WIN, 768, 1536, 0, 1536, 0, nullptr);
            tr_job(F, rot, win, 1024, NIN, 2048, WIN, 2048, 2592, 0, 2304, 0, nullptr);
            tr_job(F, rot, win, 1024, NIN, 256, WIN, 256, 2304, 0, 4352, 0, nullptr);
            tr_job(F, rot, win, 1024, NIN, 32, WIN, 32, 2560, 0, 4608, 0, nullptr);
            { const size_t n8 = (size_t)(NPROJ - 4640) * 1024 / 8, NT = (size_t)F.G * NWAVES * 64; bf16* z = WIN + (size_t)4640 * 1024;
              for (size_t i = (size_t)(F.vcu * NWAVES + F.wave) * 64 + F.lane; i < n8; i += NT) *(GAS v4u*)(z + i * 8) = (v4u){0u, 0u, 0u, 0u}; }
            tr_job(F, rot, args.in[5] + (size_t)L * 768 * 768, 768, 768, 768, (bf16*)((unsigned char*)WL + W_WUQ), 768, 0, 0, 0, 0, args.in[4] + L * 768);
            const float* wukv = args.in[7] + (size_t)L * 256 * 1024; const float* kvg = args.in[6] + L * 256;
            tr_job(F, rot, wukv, 256, 1024, 512, (bf16*)((unsigned char*)WL + W_WUKV), 64, 0, 128, 0, 64, kvg);
            tr_job(F, rot, wukv, 256, 1024, 512, (bf16*)((unsigned char*)WL + W_WUKV), 64, 64, 128, 512, 64, kvg);
            tr_plain(F, rot, args.in[9] + (size_t)L * 512 * 1024, 512, 1024, (bf16*)((unsigned char*)WL + W_WNAO));
            tr_plain(F, rot, args.in[10] + (size_t)L * 512 * 1024, 512, 1024, (bf16*)((unsigned char*)WL + W_WMLAO));
            tr_plain(F, rot, args.in[11] + (size_t)L * 1024 * 1024, 1024, 1024, (bf16*)((unsigned char*)WL + W_WOUT));
            tr_plain(F, rot, args.in[22] + (size_t)L * 1024 * 1024, 1024, 1024, (bf16*)((unsigned char*)WL + W_WPG));
            tr_plain(F, rot, args.in[23] + (size_t)L * 256 * 1024, 256, 1024, (bf16*)((unsigned char*)WL + W_WPLE));
        }
        tr_job(F, rot, args.in[14], 1024, DFF, DFF, (bf16*)(ws + WS_W13), 128, 0, 128, 0, 256, nullptr);
        tr_job(F, rot, args.in[15], 1024, DFF, DFF, (bf16*)(ws + WS_W13), 128, 0, 128, 128, 256, nullptr);
        tr_plain(F, rot, args.in[16], DFF, 1024, (bf16*)(ws + WS_W2));
        { const int NT = F.G * NWAVES * 64; float* rt_ = (float*)(ws + WS_ROPE);
          for (int i = (F.vcu * NWAVES + F.wave) * 64 + F.lane; i < SEQ * 16; i += NT) { const int pos = i >> 4, k = i & 15;
              double invf = 1.0; for (int q_ = 0; q_ < k; ++q_) invf *= 0.5623413251903491;
              const double rev = (double)pos * invf * 0.15915494309189535; const float fr_ = (float)(rev - floor(rev));
              rt_[2 * i] = __builtin_amdgcn_cosf(fr_); rt_[2 * i + 1] = __builtin_amdgcn_sinf(fr_); } }
        cvt_rows(F, args.in[0], XB, (size_t)MTOK * DM / 8);
    }
    SEAM();

    for (int L = 0; L < 2; ++L) {
        unsigned char* WL = ws + WS_W + (size_t)L * W_LAYER;
        if (IN() && EN_A) { PH_BEGIN();
            pg8::Gemm g{(const pg8::bf16_t*)XB, (const pg8::bf16_t*)(WL + W_WIN), MTOK, NPROJ, 1024}; pg8::StaticOrder S; S.init(MTOK, NPROJ, F.G, (int)blockIdx.x);
            pg8::EpiProj E{(bf16*)(ws + WS_NAQKV), (bf16*)(ws + WS_QLAT), (bf16*)(ws + WS_GATES), (bf16*)(ws + WS_KVLAT), (bf16*)(ws + WS_KMLA), args.in[3] + L * 2048, ROPE, NA_QSCALE};
            pg8::gemm_phase<pg8::EpiProj, pg8::StaticOrder, true, true>(ring, g, S, E);
        }
        SEAM();
        if (IN() && EN_B) { PH_BEGIN();
            { pg8::Gemm g{(const pg8::bf16_t*)(ws + WS_QLAT), (const pg8::bf16_t*)(WL + W_WUQ), MTOK, 768, 768}; pg8::StaticOrder S; S.init(MTOK, 768, F.G, (int)blockIdx.x);
              asm volatile("" : "+s"(S.c), "+s"(S.G)); rms_prepass(F, S, (const bf16*)(ws + WS_QLAT), 768); asm volatile("" : "+s"(S.c), "+s"(S.G));
              pg8::EpiQup E{(bf16*)(ws + WS_QMLA), (const LAS float*)(F.lds + X_RTAB), ROPE, MLA_QSCALE};
              pg8::gemm_phase<pg8::EpiQup, pg8::StaticOrder, true, true>(ring, g, S, E); }
            __syncthreads();
            { pg8::Gemm g{(const pg8::bf16_t*)(ws + WS_KVLAT), (const pg8::bf16_t*)(WL + W_WUKV), MTOK, 1024, 256}; pg8::StaticOrder S; S.init(MTOK, 1024, F.G, (int)blockIdx.x);
              asm volatile("" : "+s"(S.c), "+s"(S.G)); rms_prepass(F, S, (const bf16*)(ws + WS_KVLAT), 256); asm volatile("" : "+s"(S.c), "+s"(S.G));
              pg8::EpiKVup E{(bf16*)(ws + WS_KMLA), (bf16*)(ws + WS_VMLA), (const LAS float*)(F.lds + X_RTAB)};
              pg8::gemm_phase<pg8::EpiKVup, pg8::StaticOrder, true, true>(ring, g, S, E); }
        }
        SEAM();
        if (IN() && EN_C) { PH_BEGIN();
            const float* rpb = args.in[8] + (size_t)L * 8 * 15 * 31;
            for (int uid = F.vcu; uid < 2048; uid += F.G) { const int pair = uid >> 5, rg = uid & 31;
                att::na_unit(pair >> 3, pair & 7, rg, (const att::bf16*)(ws + WS_NAQKV), (att::bf16*)(ws + WS_ONA), rpb, (LAS char*)ring); }
            for (int uid = F.vcu; uid < 2048; uid += F.G) { const int pair = uid >> 5, qb = uid & 31, b = pair >> 3, h = pair & 7;
                const size_t row0 = (size_t)b * SEQ;
                att::mla_unit((const att::bf16*)(ws + WS_QMLA) + (row0 + qb * 256) * 768 + h * 96, (const att::bf16*)(ws + WS_KMLA) + row0 * 768 + h * 96,
                              (const att::bf16*)(ws + WS_VMLA) + row0 * 512 + h * 64, (att::bf16*)(ws + WS_OMLA) + (row0 + qb * 256) * 512 + h * 64, SEQ, (LAS char*)ring); }
        }
        SEAM();
        if (IN() && EN_D) { PH_BEGIN();
            pg8::StaticOrder S; S.init(MTOK, 1024, F.G, (int)blockIdx.x);
            { pg8::Gemm g{(const pg8::bf16_t*)(ws + WS_ONA), (const pg8::bf16_t*)(WL + W_WNAO), MTOK, 1024, 512};
              pg8::EpiMerge E{(const pg8::bf16_t*)(ws + WS_GATES), (pg8::bf16_t*)(ws + WS_MERGED), 0};
              pg8::gemm_phase<pg8::EpiMerge, pg8::StaticOrder, true, true>(ring, g, S, E); }
            __syncthreads();
            { pg8::Gemm g{(const pg8::bf16_t*)(ws + WS_OMLA), (const pg8::bf16_t*)(WL + W_WMLAO), MTOK, 1024, 512};
              pg8::EpiMerge E{(const pg8::bf16_t*)(ws + WS_GATES) + 1024, (pg8::bf16_t*)(ws + WS_MERGED), 1};
              pg8::gemm_phase<pg8::EpiMerge, pg8::StaticOrder, true, true>(ring, g, S, E); }
        }
        SEAM();
        if (IN() && EN_E) { PH_BEGIN();
            { pg8::Gemm g{(const pg8::bf16_t*)(ws + WS_MERGED), (const pg8::bf16_t*)(WL + W_WOUT), MTOK, 1024, 1024}; pg8::StaticOrder S; S.init(MTOK, 1024, F.G, (int)blockIdx.x);
              pg8::EpiRes<0> E{L == 0 ? args.in[0] : (const float*)R, R, nullptr, ALPHA};
              pg8::gemm_phase<pg8::EpiRes<0>, pg8::StaticOrder, true, true>(ring, g, S, E); }
            if (L == 1) { __syncthreads(); int rot = 0;
                for (int e = 0; e < NEXP; ++e) {
                    bf16* w13 = (bf16*)(ws + WS_WM13) + (size_t)e * 2 * DFFE * 1024;
                    tr_job(F, rot, args.in[19] + (size_t)e * 1024 * DFFE, 1024, DFFE, DFFE, w13, 128, 0, 128, 0, 256, nullptr);
                    tr_job(F, rot, args.in[20] + (size_t)e * 1024 * DFFE, 1024, DFFE, DFFE, w13, 128, 0, 128, 128, 256, nullptr);
                    tr_plain(F, rot, args.in[21] + (size_t)e * DFFE * 1024, DFFE, 1024, (bf16*)(ws + WS_WM2) + (size_t)e * 1024 * DFFE); } }
        }
        SEAM();
        if (IN() && EN_F) { PH_BEGIN();
            f32x4 g[4], bb[4];
            { const GAS f32x4* gp = (const GAS f32x4*)(args.in[12] + L * DM) + F.lane; const GAS f32x4* bp = (const GAS f32x4*)(args.in[13] + L * DM) + F.lane;
#pragma unroll
              for (int j = 0; j < 4; ++j) { g[j] = gp[64 * j]; bb[j] = bp[64 * j]; } }
            LAS float* wrl = (LAS float*)ring; LAS int* lcnt = (LAS int*)(F.lds + X_LCNT);
            if (L == 1) { const float* wr = args.in[17];
                for (int i = F.tid; i < 1024 * 8 / 4; i += NWAVES * 64) ((LAS f32x4*)wrl)[i] = ((const GAS f32x4*)wr)[i];
                if (F.tid < 8) lcnt[F.tid] = 0;
                LDS_WAIT(); __syncthreads(); }
            const int gw = F.vcu * NWAVES + F.wave, NGW = F.G * NWAVES;
            for (int m = gw; m < MTOK; m += NGW) {
                f32x4 v[4]; const GAS f32x4* xr = (const GAS f32x4*)(R + (size_t)m * DM) + F.lane;
#pragma unroll
                for (int j = 0; j < 4; ++j) v[j] = xr[64 * j];
                ln_core(v, g, bb);
                store_row(R, XB, (size_t)m, v, F.lane, true);
                if (L == 1) {
                    float lg[8];
#pragma unroll
                    for (int e = 0; e < 8; ++e) lg[e] = 0.f;
#pragma unroll
                    for (int j = 0; j < 4; ++j)
#pragma unroll
                        for (int t = 0; t < 4; ++t) { const int k = 4 * F.lane + 256 * j + t; const f32x4 w0 = *(const LAS f32x4*)(wrl + k * 8), w1 = *(const LAS f32x4*)(wrl + k * 8 + 4); const float xv = v[j][t];
                            lg[0] += xv * w0.x; lg[1] += xv * w0.y; lg[2] += xv * w0.z; lg[3] += xv * w0.w; lg[4] += xv * w1.x; lg[5] += xv * w1.y; lg[6] += xv * w1.z; lg[7] += xv * w1.w; }
#pragma unroll
                    for (int e = 0; e < 8; ++e) lg[e] = wave_sum(lg[e]) + args.in[18][e];
                    int i0 = 0; float l0 = lg[0];
#pragma unroll
                    for (int e = 1; e < 8; ++e) if (lg[e] > l0) { l0 = lg[e]; i0 = e; }
                    int i1 = -1; float l1 = -3.0e38f;
#pragma unroll
                    for (int e = 0; e < 8; ++e) if (e != i0 && lg[e] > l1) { l1 = lg[e]; i1 = e; }
                    const float w0 = 1.0f / (1.0f + __expf(l1 - l0)), w1 = 1.0f - w0;
                    if (F.lane == 0) {
                        const int lp0 = __hip_atomic_fetch_add(lcnt + i0, 1, __ATOMIC_RELAXED, __HIP_MEMORY_SCOPE_WORKGROUP), lp1 = __hip_atomic_fetch_add(lcnt + i1, 1, __ATOMIC_RELAXED, __HIP_MEMORY_SCOPE_WORKGROUP);
                        ((int*)(ws + WS_TE))[m] = i0 | (i1 << 4) | ((int)blockIdx.x << 8);
                        ((int2*)(ws + WS_TP))[m] = make_int2(lp0, lp1); ((float2*)(ws + WS_TW))[m] = make_float2(w0, w1); }
                }
            }
            if (L == 1) { LDS_WAIT(); __syncthreads(); if (F.tid < 8) ((int*)(ws + WS_CNT))[blockIdx.x * 8 + F.tid] = lcnt[F.tid]; }
            cvt_rows(F, args.in[1] + (size_t)L * MTOK * PLED, (bf16*)(ws + WS_PB), (size_t)MTOK * PLED / 8);
        }
        SEAM();
        if (L == 0) {
            if (IN() && EN_G0) { PH_BEGIN();
                { pg8::Gemm g{(const pg8::bf16_t*)XB, (const pg8::bf16_t*)(ws + WS_W13), MTOK, 2 * DFF, 1024}; pg8::StaticOrder S; S.init(MTOK, 2 * DFF, F.G, (int)blockIdx.x);
                  pg8::EpiGLU E{(pg8::bf16_t*)(ws + WS_H), DFF};
                  pg8::gemm_phase<pg8::EpiGLU, pg8::StaticOrder, true, true>(ring, g, S, E); }
                __syncthreads();
                pg8::StaticOrder S; S.init(MTOK, 1024, F.G, (int)blockIdx.x);
                { pg8::Gemm g{(const pg8::bf16_t*)(ws + WS_PB), (const pg8::bf16_t*)(WL + W_WPLE), MTOK, 1024, 256};
                  pg8::EpiPlain E{(pg8::bf16_t*)(ws + WS_PP_DENSE), 1024};
                  pg8::gemm_phase<pg8::EpiPlain, pg8::StaticOrder, true, true>(ring, g, S, E); }
                __syncthreads();
                { pg8::Gemm g{(const pg8::bf16_t*)XB, (const pg8::bf16_t*)(WL + W_WPG), MTOK, 1024, 1024};
                  pg8::EpiRes<1> E{nullptr, R, (const pg8::bf16_t*)(ws + WS_PP_DENSE), ALPHA};
                  pg8::gemm_phase<pg8::EpiRes<1>, pg8::StaticOrder, true, true>(ring, g, S, E); }
            }
            SEAM();
            if (IN() && EN_H0) { PH_BEGIN();
                pg8::Gemm g{(const pg8::bf16_t*)(ws + WS_H), (const pg8::bf16_t*)(ws + WS_W2), MTOK, 1024, DFF}; pg8::StaticOrder S; S.init(MTOK, 1024, F.G, (int)blockIdx.x);
                pg8::EpiRes<2> E{nullptr, R, nullptr, 1.f};
                pg8::gemm_phase<pg8::EpiRes<2>, pg8::StaticOrder, true, true>(ring, g, S, E);
            }
            SEAM();
        } else {
            if (IN() && EN_G1) { PH_BEGIN();
                moe_tables(F, (const int*)(ws + WS_CNT), true);
                { const LAS int* off = (const LAS int*)(F.lds + X_OFF); const LAS int* pre = (const LAS int*)(F.lds + X_PRE);
                  const int gw = F.vcu * NWAVES + F.wave, NGW = F.G * NWAVES;
                  for (int m = gw; m < MTOK; m += NGW) {
                      const int te = ((const int*)(ws + WS_TE))[m]; const int2 tp = ((const int2*)(ws + WS_TP))[m]; const float2 tw = ((const float2*)(ws + WS_TW))[m];
                      const int e0 = te & 15, e1 = (te >> 4) & 15, blk = te >> 8;
                      const int d0 = off[e0] + pre[blk * 8 + e0] + tp.x, d1 = off[e1] + pre[blk * 8 + e1] + tp.y;
                      const GAS v4u* src = (const GAS v4u*)(XB + (size_t)m * DM) + F.lane; const v4u a = src[0], b = src[64];
                      GAS v4u* q0 = (GAS v4u*)((bf16*)(ws + WS_XS) + (size_t)d0 * DM) + F.lane; GAS v4u* q1 = (GAS v4u*)((bf16*)(ws + WS_XS) + (size_t)d1 * DM) + F.lane;
                      q0[0] = a; q0[64] = b; q1[0] = a; q1[64] = b;
                      if (F.lane == 0) { ((float*)(ws + WS_SW))[d0] = tw.x; ((float*)(ws + WS_SW))[d1] = tw.y; ((int2*)(ws + WS_TPOS))[m] = make_int2(d0, d1); } } }
                __syncthreads();
                pg8::StaticOrder S; S.init(MTOK, 1024, F.G, (int)blockIdx.x);
                { pg8::Gemm g{(const pg8::bf16_t*)(ws + WS_PB), (const pg8::bf16_t*)(WL + W_WPLE), MTOK, 1024, 256};
                  pg8::EpiPlain E{(pg8::bf16_t*)(ws + WS_PP_MOE), 1024};
                  pg8::gemm_phase<pg8::EpiPlain, pg8::StaticOrder, true, true>(ring, g, S, E); }
                __syncthreads();
                { pg8::Gemm g{(const pg8::bf16_t*)XB, (const pg8::bf16_t*)(WL + W_WPG), MTOK, 1024, 1024};
                  pg8::EpiRes<1> E{nullptr, R, (const pg8::bf16_t*)(ws + WS_PP_MOE), ALPHA};
                  pg8::gemm_phase<pg8::EpiRes<1>, pg8::StaticOrder, true, true>(ring, g, S, E); }
            }
            SEAM();
            for (int c = 0; c < MOE_NCHUNK; ++c) {
                if (IN() && EN_U1) { PH_BEGIN();
                    moe_tables(F, (const int*)(ws + WS_CNT), false);
                    const LAS int* off = (const LAS int*)(F.lds + X_OFF);
                    const int NT = __builtin_amdgcn_readfirstlane(off[8]) >> 8; int nMc = NT - c * MOE_CHUNK; nMc = nMc < 0 ? 0 : (nMc > MOE_CHUNK ? MOE_CHUNK : nMc);
                    pg8::MoeOrder<true> S; S.nMc = nMc; S.nN = 2 * DFFE / 256; S.nwg = nMc * S.nN; S.G = F.G; S.c = (int)blockIdx.x; S.t0 = c * MOE_CHUNK;
                    S.ts1 = __builtin_amdgcn_readfirstlane(off[1]) >> 8; S.ts2 = __builtin_amdgcn_readfirstlane(off[2]) >> 8; S.ts3 = __builtin_amdgcn_readfirstlane(off[3]) >> 8; S.ts4 = __builtin_amdgcn_readfirstlane(off[4]) >> 8;
                    S.ts5 = __builtin_amdgcn_readfirstlane(off[5]) >> 8; S.ts6 = __builtin_amdgcn_readfirstlane(off[6]) >> 8; S.ts7 = __builtin_amdgcn_readfirstlane(off[7]) >> 8;
                    pg8::Gemm g{(const pg8::bf16_t*)(ws + WS_XS), (const pg8::bf16_t*)(ws + WS_WM13), MOE_MAXT * 256, 2 * DFFE, 1024};
                    pg8::EpiGLU E{(pg8::bf16_t*)(ws + WS_HS), DFFE};
                    pg8::gemm_phase<pg8::EpiGLU, pg8::MoeOrder<true>, true, true>(ring, g, S, E);
                }
                SEAM();
                if (IN() && EN_D1) { PH_BEGIN();
                    moe_tables(F, (const int*)(ws + WS_CNT), false);
                    const LAS int* off = (const LAS int*)(F.lds + X_OFF);
                    const int NT = __builtin_amdgcn_readfirstlane(off[8]) >> 8; int nMc = NT - c * MOE_CHUNK; nMc = nMc < 0 ? 0 : (nMc > MOE_CHUNK ? MOE_CHUNK : nMc);
                    pg8::MoeOrder<false> S; S.nMc = nMc; S.nN = 4; S.nwg = nMc * 4; S.G = F.G; S.c = (int)blockIdx.x; S.t0 = c * MOE_CHUNK;
                    S.ts1 = __builtin_amdgcn_readfirstlane(off[1]) >> 8; S.ts2 = __builtin_amdgcn_readfirstlane(off[2]) >> 8; S.ts3 = __builtin_amdgcn_readfirstlane(off[3]) >> 8; S.ts4 = __builtin_amdgcn_readfirstlane(off[4]) >> 8;
                    S.ts5 = __builtin_amdgcn_readfirstlane(off[5]) >> 8; S.ts6 = __builtin_amdgcn_readfirstlane(off[6]) >> 8; S.ts7 = __builtin_amdgcn_readfirstlane(off[7]) >> 8;
                    pg8::Gemm g{(const pg8::bf16_t*)(ws + WS_HS), (const pg8::bf16_t*)(ws + WS_WM2), MOE_CHUNK * 256, 1024, DFFE};
                    pg8::EpiMoeDown E{(pg8::bf16_t*)(ws + WS_XS), (const float*)(ws + WS_SW)};
                    pg8::gemm_phase<pg8::EpiMoeDown, pg8::MoeOrder<false>, true, true>(ring, g, S, E);
                }
                SEAM();
            }
        }
        if (IN() && EN_I) { PH_BEGIN();
            f32x4 g[4], bb[4];
            { const GAS f32x4* gp = (const GAS f32x4*)(args.in[24] + L * DM) + F.lane; const GAS f32x4* bp = (const GAS f32x4*)(args.in[25] + L * DM) + F.lane;
#pragma unroll
              for (int j = 0; j < 4; ++j) { g[j] = gp[64 * j]; bb[j] = bp[64 * j]; } }
            const int gw = F.vcu * NWAVES + F.wave, NGW = F.G * NWAVES;
            const bool tmo = (L == 1) && (__hip_atomic_load((unsigned*)(ws + WS_CTL) + CW_BAR + XB_TMO, __ATOMIC_RELAXED, __HIP_MEMORY_SCOPE_AGENT) != 0u);
            for (int m = gw; m < MTOK; m += NGW) {
                f32x4 v[4]; const GAS f32x4* xr = (const GAS f32x4*)(R + (size_t)m * DM) + F.lane;
#pragma unroll
                for (int j = 0; j < 4; ++j) v[j] = xr[64 * j];
                if (L == 1) { const int2 tp = ((const int2*)(ws + WS_TPOS))[m];
                    const GAS v2u* f0 = (const GAS v2u*)((const bf16*)(ws + WS_XS) + (size_t)tp.x * DM) + F.lane; const GAS v2u* f1 = (const GAS v2u*)((const bf16*)(ws + WS_XS) + (size_t)tp.y * DM) + F.lane;
#pragma unroll
                    for (int j = 0; j < 4; ++j) { const v2u a = f0[64 * j], b = f1[64 * j];
                        v[j].x += bflo(a.x) + bflo(b.x); v[j].y += bfhi(a.x) + bfhi(b.x); v[j].z += bflo(a.y) + bflo(b.y); v[j].w += bfhi(a.y) + bfhi(b.y); } }
                ln_core(v, g, bb);
                if (tmo) { const float qn = __builtin_nanf("");
#pragma unroll
                    for (int j = 0; j < 4; ++j) v[j] = (f32x4){qn, qn, qn, qn}; }
                store_row(R, XB, (size_t)m, v, F.lane, L == 0);
            }
        }
        if (L == 0) SEAM();
    }
#undef IN
#undef SEAM
}

constexpr int N_PHASES = 28;
#ifndef MK_ONE_LAUNCH
#define MK_ONE_LAUNCH 0
#endif
extern "C" void kernel_launch(void* const* d_in, const int* in_sizes, int n_in, void* d_out, int out_size, void* d_ws, size_t ws_size, hipStream_t stream) {
    static int grid = 0;
    if (grid == 0) {
        if (n_in != 26 || in_sizes[0] != MTOK * DM || out_size != MTOK * DM || ws_size < WS_END) {
            fprintf(stderr, "kernel_launch: shape mismatch: n_in %d in0 %d out %d ws %zu (need %zu)\n", n_in, n_in > 0 ? in_sizes[0] : -1, out_size, ws_size, (size_t)WS_END); grid = -1; return; }
        int dev = 0, cus = 0, per_cu = 0;
        if (hipGetDevice(&dev) != hipSuccess || hipDeviceGetAttribute(&cus, hipDeviceAttributeMultiprocessorCount, dev) != hipSuccess) { fprintf(stderr, "kernel_launch: device query failed\n"); grid = -1; return; }
        if (hipFuncSetAttribute((const void*)mk_fwd, hipFuncAttributeMaxDynamicSharedMemorySize, LDS_BYTES) != hipSuccess) { fprintf(stderr, "kernel_launch: hipFuncSetAttribute failed\n"); grid = -1; return; }
        if (hipOccupancyMaxActiveBlocksPerMultiprocessor(&per_cu, (const void*)mk_fwd, NWAVES * 64, LDS_BYTES) != hipSuccess || per_cu < 1)
            fprintf(stderr, "kernel_launch: note: occupancy query reports %d workgroups per CU\n", per_cu);
        (void)hipGetLastError();
        grid = cus > 256 ? 256 : cus;
    }
    if (grid < 0) return;
    if (hipMemsetAsync((char*)d_ws + WS_CTL, 0, CTL_ZERO_BYTES, stream) != hipSuccess) { fprintf(stderr, "kernel_launch: memset failed\n"); return; }
    Args a{};
    for (int i = 0; i < 26; ++i) a.in[i] = (const float*)d_in[i];
    a.out = (float*)d_out; a.ws = (unsigned char*)d_ws;
#if MK_ONE_LAUNCH
    a.ph_lo = 0; a.ph_hi = N_PHASES;
    hipLaunchKernelGGL(mk_fwd, dim3(grid), dim3(NWAVES * 64), LDS_BYTES, stream, a);
#else
    for (int p = 0; p < N_PHASES; ++p) { a.ph_lo = p; a.ph_hi = p + 1; hipLaunchKernelGGL(mk_fwd, dim3(grid), dim3(NWAVES * 64), LDS_BYTES, stream, a); }
#endif
    const hipError_t le = hipPeekAtLastError();
    if (le != hipSuccess) fprintf(stderr, "kernel_launch: launch failed: %s (grid %d)\n", hipGetErrorName(le), grid);
}
```

```cpp
#include <hip/hip_runtime.h>
#include <cstdio>
#include <cstdint>
#include <cmath>
#ifndef PG8_WGM
#define PG8_WGM 8
#endif
namespace pg8 {
#define PG8_LAS __attribute__((address_space(3)))
typedef unsigned short bf16_t;
typedef short bf16x8 __attribute__((ext_vector_type(8)));
typedef float f32x4 __attribute__((ext_vector_type(4)));
typedef unsigned u32x4 __attribute__((ext_vector_type(4)));
typedef int i32x4 __attribute__((ext_vector_type(4)));
constexpr int BM = 256, BK = 64, HALF = 128, HTB = HALF * BK * 2  , STAGE_BYTES = 8 * HTB, NXCD = 8, WGM = PG8_WGM;

__host__ __device__ __forceinline__ int lds_byte(int r, int c) { const int st = (r >> 4) * 2 + (c >> 5), rr = r & 15, cc = c & 31, ob = rr * 64 + cc * 2; return st * 1024 + (ob ^ (((ob >> 9) & 1) << 5)); }
__host__ __device__ __forceinline__ void stage_rc(int b, int& R, int& C) { const int st = b / 1024, sb = b % 1024, swz = sb ^ (((sb >> 9) & 1) << 5); R = (st >> 1) * 16 + swz / 64; C = (st & 1) * 32 + (swz % 64) / 2; }
__host__ __device__ __forceinline__ int perm32(int rho) { const int n = rho >> 4, i = rho & 15; return 8 * (i >> 2) + 4 * n + (i & 3); }

struct Unit { int pm, pn, pa, pb, slot, kofs, aux; };
struct Gemm { const bf16_t* A; const bf16_t* Bt; int M, N, K; int lda, ldb; };

struct StaticOrder {
    int nM, nN, nwg, G, c;
    __host__ __device__ void init(int M, int N, int G_, int c_) { nM = M / BM; nN = N / BM; nwg = nM * nN; G = G_; c = c_; }
    __host__ __device__ bool next(int i, Unit& u) const {
        const long L = (long)i * G + c; if (L >= nwg) return false;
        int wgid = (int)L; { const int q = nwg / NXCD, r = nwg % NXCD, xcd = wgid % NXCD, off = wgid / NXCD; wgid = (xcd < r ? xcd * (q + 1) : r * (q + 1) + (xcd - r) * q) + off; }
        const int nig = WGM * nN, gid = wgid / nig, fm = gid * WGM, gsz = (nM - fm) < WGM ? (nM - fm) : WGM;
        u.pm = fm + ((wgid % nig) % gsz); u.pn = (wgid % nig) / gsz; u.pa = u.pm; u.pb = u.pn; u.slot = i; u.kofs = 0; u.aux = 0; return true;
    }
    __device__ __forceinline__ void a_ready(const Unit&) const {}
    __device__ __forceinline__ void done(const Unit&) const {}
};

__device__ __forceinline__ unsigned cvt_pk_bf16(float lo, float hi) { unsigned r; asm volatile("v_cvt_pk_bf16_f32 %0, %1, %2" : "=v"(r) : "v"(lo), "v"(hi)); return r; }
typedef float f32x2 __attribute__((ext_vector_type(2)));
__device__ __forceinline__ f32x2 gelu_pk(f32x2 v) {
    const f32x2 av = __builtin_elementwise_abs(v), d = av * 0.2316418882f + 1.0f;
    f32x2 t; t.x = __builtin_amdgcn_rcpf(d.x); t.y = __builtin_amdgcn_rcpf(d.y);
    f32x2 q = t * 0.5307027145f + (-0.7265760135f); q = q * t + 0.7107068705f; q = q * t + (-0.142248368f); q = q * t + 0.127414796f; q = q * t;
    const f32x2 s = (v * v) * (-0.72134752044f);
    f32x2 e; e.x = __builtin_amdgcn_exp2f(s.x); e.y = __builtin_amdgcn_exp2f(s.y);
    const f32x2 m = v * (q * e), r = v - m;
    f32x2 o; o.x = v.x < 0.f ? m.x : r.x; o.y = v.y < 0.f ? m.y : r.y; return o;
}

template <int ACT  > struct EpiBf16 {
    static constexpr bool PERM = true, AFTER_DRAIN = false, SCALES = false; static_assert(ACT == 0 || ACT == 1, "EpiBf16: ACT is 0 (none) or 1 (gelu_pk)");
    bf16_t* O; int ldc; const float* bias; int split_cols; size_t split_stride; float scale0;
    __device__ __forceinline__ void operator()(const f32x4 (&acc)[2][2][4][2], const Unit& u, int wr, int wc, int fr, int fq) const {
        const int row0 = u.pm * BM + wr * 64 + fr; int colt = u.pn * BM; bf16_t* base = O;
        float sc = 1.f; if (split_cols) { const int t = colt / split_cols; base += (size_t)t * split_stride; colt -= t * split_cols; if (t == 0) sc = scale0; }
        const int col0 = colt + wc * 32 + 8 * fq, bcol0 = u.pn * BM + wc * 32 + 8 * fq;
        f32x4 bv[2][2];
#pragma unroll
        for (int bj = 0; bj < 2; ++bj)
#pragma unroll
            for (int n = 0; n < 2; ++n) bv[bj][n] = bias ? *(const f32x4*)(bias + bcol0 + bj * HALF + 4 * n) : (f32x4){0.f, 0.f, 0.f, 0.f};
#pragma unroll
        for (int ai = 0; ai < 2; ++ai)
#pragma unroll
            for (int m = 0; m < 4; ++m) { bf16_t* rowp = base + (size_t)(row0 + ai * HALF + m * 16) * ldc + col0;
#pragma unroll
                for (int bj = 0; bj < 2; ++bj) { f32x4 v0 = acc[ai][bj][m][0] + bv[bj][0], v1 = acc[ai][bj][m][1] + bv[bj][1];
                    if (ACT == 1) { f32x2 a = gelu_pk((f32x2){v0[0], v0[1]}), b = gelu_pk((f32x2){v0[2], v0[3]}), c = gelu_pk((f32x2){v1[0], v1[1]}), d = gelu_pk((f32x2){v1[2], v1[3]});
                        v0 = (f32x4){a.x, a.y, b.x, b.y}; v1 = (f32x4){c.x, c.y, d.x, d.y}; }
                    v0 = v0 * sc; v1 = v1 * sc; u32x4 w; w.x = cvt_pk_bf16(v0[0], v0[1]); w.y = cvt_pk_bf16(v0[2], v0[3]); w.z = cvt_pk_bf16(v1[0], v1[1]); w.w = cvt_pk_bf16(v1[2], v1[3]);
                    *(u32x4*)(rowp + bj * HALF) = w; } }
    }
};

template <class Epi, class Sched, bool ALIGN_EPI = false, bool SP2 = false, bool I8 = false>
__device__ __forceinline__ void gemm_phase(PG8_LAS unsigned char* lds, const Gemm g, const Sched& S, const Epi& E, const int wave_id) {
    int lane_; asm volatile("v_mbcnt_lo_u32_b32 %0, -1, 0\n\tv_mbcnt_hi_u32_b32 %0, -1, %0" : "=v"(lane_));
    int w_ = wave_id; asm volatile("" : "+s"(w_));
    const int wid = w_, lane = lane_, tid = wid * 64 + lane, wr = wid >> 2, wc = wid & 3, fr = lane & 15, fq = lane >> 4;
    int K_ = g.K; asm volatile("" : "+s"(K_)); const int K = K_, nt = K / BK; int la_ = g.lda ? g.lda : g.K, lb_ = g.ldb ? g.ldb : g.K; asm volatile("" : "+s"(la_), "+s"(lb_)); const int lda = la_, ldb = lb_;
    unsigned voffA[2], voffB[2];
#pragma unroll
    for (int i = 0; i < 2; ++i) { int R, C; stage_rc(tid * 16 + i * 8192, R, C); const int Rb = Epi::PERM ? ((R & ~31) + perm32(R & 31)) : R;
        voffA[i] = (unsigned)(R * lda + C) * 2u; voffB[i] = (unsigned)(Rb * ldb + C) * 2u; }
    const size_t kstep = (size_t)(BK * 2);
    const size_t hstepA = (size_t)HALF * lda * 2, hstepB = (size_t)HALF * ldb * 2;
    const size_t tstepA = 2 * hstepA, tstepB = 2 * hstepB;
    const unsigned ldsw = (unsigned)wid * 1024u;
    const int aoff = lds_byte(wr * 64 + fr, fq * 8), boff = lds_byte(wc * 32 + fr, fq * 8);
#define PG8_SA(b, h) (((b) * 2 + (h)) * HTB)
#define PG8_SB(b, h) ((4 + (b) * 2 + (h)) * HTB)
#define PG8_STAGE(bufoff, gbase, voff) do { _Pragma("unroll") for (int _i = 0; _i < 2; ++_i) \
        __builtin_amdgcn_global_load_lds((const unsigned*)((const char*)(gbase) + (voff)[_i]), (PG8_LAS unsigned*)(lds + (bufoff) + ldsw + _i * 8192), 16, 0, 0); } while (0)
#define PG8_LDA(dst, b, h) do { _Pragma("unroll") for (int m = 0; m < 4; ++m) _Pragma("unroll") for (int k = 0; k < 2; ++k) dst[m][k] = *(const PG8_LAS bf16x8*)(lds + PG8_SA(b, h) + aoff + m * 2048 + k * 1024); } while (0)
#define PG8_LDB(dst, b, h) do { _Pragma("unroll") for (int n = 0; n < 2; ++n) _Pragma("unroll") for (int k = 0; k < 2; ++k) dst[n][k] = *(const PG8_LAS bf16x8*)(lds + PG8_SB(b, h) + boff + n * 2048 + k * 1024); } while (0)
#define PG8_MMA(ai, bj, At, Bt) do { __builtin_amdgcn_s_setprio(1); _Pragma("unroll") for (int m = 0; m < 4; ++m) _Pragma("unroll") for (int n = 0; n < 2; ++n) _Pragma("unroll") for (int k = 0; k < 2; ++k) \
        { if constexpr (I8) acc[ai][bj][m][n] = __builtin_bit_cast(f32x4, __builtin_amdgcn_mfma_i32_16x16x64_i8(__builtin_bit_cast(i32x4, Bt[n][k]), __builtin_bit_cast(i32x4, At[m][k]), __builtin_bit_cast(i32x4, acc[ai][bj][m][n]), 0, 0, 0)); \
          else acc[ai][bj][m][n] = __builtin_amdgcn_mfma_f32_16x16x32_bf16(Bt[n][k], At[m][k], acc[ai][bj][m][n], 0, 0, 0); } __builtin_amdgcn_s_setprio(0); } while (0)
#define PG8_WAIT_V(n) asm volatile("s_waitcnt vmcnt(" #n ")" ::: "memory")
#define PG8_WAIT_L(n) asm volatile("s_waitcnt lgkmcnt(" #n ")" ::: "memory")
#define PG8_BAR __builtin_amdgcn_s_barrier()
#define PG8_SCHED __builtin_amdgcn_sched_barrier(0)
    Unit cur, nxt; int ui = 0;
    if (!S.next(0, cur)) return;
    f32x4 acc[2][2][4][2];
#pragma unroll
    for (int a = 0; a < 2; ++a)
#pragma unroll
        for (int b = 0; b < 2; ++b)
#pragma unroll
            for (int m = 0; m < 4; ++m)
#pragma unroll
                for (int n = 0; n < 2; ++n) acc[a][b][m][n] = (f32x4){0.f, 0.f, 0.f, 0.f};
    bf16x8 At[4][2], B0[2][2], B1[2][2];
    const char* cA = (const char*)g.A + (size_t)cur.pa * tstepA + (size_t)cur.kofs * 2; const char* cB = (const char*)g.Bt + (size_t)cur.pb * tstepB + (size_t)cur.kofs * 2;
    S.a_ready(cur);
    if constexpr (Epi::SCALES) E.prefetch(cur, wid, lane);
    if constexpr (SP2) {
        PG8_STAGE(PG8_SB(0, 0), cB, voffB); PG8_STAGE(PG8_SB(0, 1), cB + hstepB, voffB); PG8_STAGE(PG8_SA(0, 0), cA, voffA); PG8_STAGE(PG8_SA(0, 1), cA + hstepA, voffA);
        if (wr == 1) PG8_BAR;
        PG8_WAIT_V(2); PG8_BAR;
        PG8_STAGE(PG8_SB(1, 0), cB + kstep, voffB); PG8_STAGE(PG8_SA(1, 0), cA + kstep, voffA); PG8_STAGE(PG8_SB(1, 1), cB + hstepB + kstep, voffB);
        PG8_WAIT_V(6); PG8_BAR;
    } else {
        PG8_STAGE(PG8_SB(0, 0), cB, voffB); PG8_STAGE(PG8_SA(0, 0), cA, voffA); PG8_STAGE(PG8_SB(0, 1), cB + hstepB, voffB); PG8_STAGE(PG8_SA(0, 1), cA + hstepA, voffA);
        if (wr == 1) PG8_BAR;
        PG8_WAIT_V(4); PG8_BAR;
        PG8_STAGE(PG8_SB(1, 0), cB + kstep, voffB); PG8_STAGE(PG8_SA(1, 0), cA + kstep, voffA); PG8_STAGE(PG8_SB(1, 1), cB + hstepB + kstep, voffB);
        PG8_WAIT_V(6); PG8_BAR;
    }
    for (;;) {
        const bool has_next = S.next(ui + 1, nxt);
        const char* nA = has_next ? (const char*)g.A + (size_t)nxt.pa * tstepA + (size_t)nxt.kofs * 2 : cA; const char* nB = has_next ? (const char*)g.Bt + (size_t)nxt.pb * tstepB + (size_t)nxt.kofs * 2 : cB;
        for (int t = 0; t < nt; t += 2) {
            const bool last = (t == nt - 2);
            const char* a1 = cA + (size_t)(t + 1) * kstep;
            const char* a2 = last ? nA : cA + (size_t)(t + 2) * kstep; const char* b2 = last ? nB : cB + (size_t)(t + 2) * kstep;
            const char* a3 = a2 + kstep; const char* b3 = b2 + kstep;
            if (last && has_next) { S.a_ready(nxt); if constexpr (Epi::SCALES) E.prefetch(nxt, wid, lane); }
            if constexpr (SP2) {
            PG8_LDB(B0, 0, 0); PG8_LDB(B1, 0, 1); PG8_SCHED; PG8_LDA(At, 0, 0); PG8_STAGE(PG8_SA(1, 1), a1 + hstepA, voffA);
            PG8_WAIT_V(8); PG8_WAIT_L(0); PG8_BAR; PG8_MMA(0, 0, At, B0); PG8_MMA(0, 1, At, B1); PG8_BAR; PG8_SCHED;
            PG8_LDA(At, 0, 1); PG8_STAGE(PG8_SB(0, 0), b2, voffB); PG8_STAGE(PG8_SB(0, 1), b2 + hstepB, voffB); PG8_STAGE(PG8_SA(0, 0), a2, voffA);
            PG8_WAIT_V(8); PG8_WAIT_L(0); PG8_BAR; PG8_MMA(1, 0, At, B0); PG8_MMA(1, 1, At, B1); PG8_BAR; PG8_SCHED;
            PG8_LDB(B0, 1, 0); PG8_LDB(B1, 1, 1); PG8_SCHED; PG8_LDA(At, 1, 0); PG8_STAGE(PG8_SA(0, 1), a2 + hstepA, voffA);
            PG8_WAIT_V(8); PG8_WAIT_L(0); PG8_BAR; PG8_MMA(0, 0, At, B0); PG8_MMA(0, 1, At, B1); PG8_BAR; PG8_SCHED;
            PG8_LDA(At, 1, 1); PG8_STAGE(PG8_SB(1, 0), b3, voffB); PG8_STAGE(PG8_SB(1, 1), b3 + hstepB, voffB); PG8_STAGE(PG8_SA(1, 0), a3, voffA);
            PG8_WAIT_V(8); PG8_WAIT_L(0); PG8_BAR; PG8_MMA(1, 0, At, B0); PG8_MMA(1, 1, At, B1); PG8_BAR; PG8_SCHED;
            } else {
            PG8_LDB(B0, 0, 0); PG8_SCHED; PG8_LDA(At, 0, 0); PG8_STAGE(PG8_SA(1, 1), a1 + hstepA, voffA);
            PG8_WAIT_L(8); PG8_BAR; PG8_WAIT_L(0); PG8_MMA(0, 0, At, B0); PG8_BAR; PG8_SCHED;
            PG8_LDB(B1, 0, 1); PG8_STAGE(PG8_SB(0, 0), b2, voffB);
            PG8_BAR; PG8_WAIT_L(0); PG8_MMA(0, 1, At, B1); PG8_BAR;
            PG8_LDA(At, 0, 1); PG8_STAGE(PG8_SA(0, 0), a2, voffA);
            PG8_BAR; PG8_WAIT_L(0); PG8_MMA(1, 0, At, B0); PG8_BAR; PG8_SCHED;
            PG8_STAGE(PG8_SB(0, 1), b2 + hstepB, voffB);
            PG8_WAIT_V(6); PG8_BAR; PG8_MMA(1, 1, At, B1); PG8_BAR;
            PG8_LDB(B0, 1, 0); PG8_SCHED; PG8_LDA(At, 1, 0); PG8_STAGE(PG8_SA(0, 1), a2 + hstepA, voffA);
            PG8_WAIT_L(8); PG8_BAR; PG8_WAIT_L(0); PG8_MMA(0, 0, At, B0); PG8_BAR; PG8_SCHED;
            PG8_LDB(B1, 1, 1); PG8_STAGE(PG8_SB(1, 0), b3, voffB);
            PG8_BAR; PG8_WAIT_L(0); PG8_MMA(0, 1, At, B1); PG8_BAR;
            PG8_LDA(At, 1, 1); PG8_STAGE(PG8_SA(1, 0), a3, voffA);
            PG8_BAR; PG8_WAIT_L(0); PG8_MMA(1, 0, At, B0); PG8_BAR; PG8_SCHED;
            PG8_STAGE(PG8_SB(1, 1), b3 + hstepB, voffB);
            PG8_WAIT_V(6); PG8_BAR; PG8_MMA(1, 1, At, B1); PG8_BAR;
            }
        }
        if constexpr (ALIGN_EPI) { if (wr == 0) PG8_BAR; }
        if constexpr (!Epi::AFTER_DRAIN) { E(acc, cur, wr, wc, fr, fq); S.done(cur); }
        if (!has_next) break;
#pragma unroll
        for (int a = 0; a < 2; ++a)
#pragma unroll
            for (int b = 0; b < 2; ++b)
#pragma unroll
                for (int m = 0; m < 4; ++m)
#pragma unroll
                    for (int n = 0; n < 2; ++n) acc[a][b][m][n] = (f32x4){0.f, 0.f, 0.f, 0.f};
        cur = nxt; cA = nA; cB = nB; ++ui;
        if constexpr (ALIGN_EPI) { if (wr == 1) PG8_BAR; }
    }
    PG8_WAIT_V(0);
    if constexpr (!ALIGN_EPI) { if (wr == 0) PG8_BAR; }
    PG8_BAR;
    if constexpr (Epi::AFTER_DRAIN) { E.fused(acc, cur, wr, wc, fr, fq, lds, wid, lane); S.done(cur); }
#undef PG8_SA
#undef PG8_SB
#undef PG8_STAGE
#undef PG8_LDA
#undef PG8_LDB
#undef PG8_MMA
#undef PG8_WAIT_V
#undef PG8_WAIT_L
#undef PG8_BAR
#undef PG8_SCHED
}
}
#ifndef EPI_FENCE_GRP
#define EPI_FENCE_GRP 8
#endif
namespace pg8 {
typedef unsigned u32x2 __attribute__((ext_vector_type(2)));
__device__ __forceinline__ float sigm(float x) { return __builtin_amdgcn_rcpf(1.0f + __builtin_amdgcn_exp2f(-1.4426950408889634f * x)); }
__device__ __forceinline__ u32x4 pack8(const f32x4& v0, const f32x4& v1) { u32x4 w; w.x = cvt_pk_bf16(v0[0], v0[1]); w.y = cvt_pk_bf16(v0[2], v0[3]); w.z = cvt_pk_bf16(v1[0], v1[1]); w.w = cvt_pk_bf16(v1[2], v1[3]); return w; }
__device__ __forceinline__ void unpack8(const u32x4& w, f32x4& v0, f32x4& v1) {
    v0[0] = __uint_as_float(w.x << 16); v0[1] = __uint_as_float(w.x & 0xffff0000u); v0[2] = __uint_as_float(w.y << 16); v0[3] = __uint_as_float(w.y & 0xffff0000u);
    v1[0] = __uint_as_float(w.z << 16); v1[1] = __uint_as_float(w.z & 0xffff0000u); v1[2] = __uint_as_float(w.w << 16); v1[3] = __uint_as_float(w.w & 0xffff0000u); }
__device__ __forceinline__ f32x4 i2f4(const f32x4& x) { return __builtin_convertvector(__builtin_bit_cast(i32x4, x), f32x4); }
struct RopeTab { f32x4 c0, c1, c2, c3; };
__device__ __forceinline__ RopeTab rope_load(const float* tab, int fq) { const float* t = tab + 16 * (fq & 1); RopeTab r; r.c0 = *(const f32x4*)(t); r.c1 = *(const f32x4*)(t + 4); r.c2 = *(const f32x4*)(t + 8); r.c3 = *(const f32x4*)(t + 12); return r; }
__device__ __forceinline__ void rope_apply(f32x4& v0, f32x4& v1, const RopeTab& r, int fq) {
    f32x4 p0, p1;
#pragma unroll
    for (int j = 0; j < 4; ++j) { const auto a_ = __builtin_amdgcn_permlane32_swap(__float_as_uint(v0[j]), __float_as_uint(v0[j]), false, false), b_ = __builtin_amdgcn_permlane32_swap(__float_as_uint(v1[j]), __float_as_uint(v1[j]), false, false);
        p0[j] = __uint_as_float(fq < 2 ? a_[1] : a_[0]); p1[j] = __uint_as_float(fq < 2 ? b_[1] : b_[0]); }
    const f32x4 c0 = r.c0, c1 = r.c1, c2 = r.c2, c3 = r.c3;
    const float sg = (fq < 2) ? -1.f : 1.f;
    v0[0] = v0[0] * c0[0] + sg * p0[0] * c0[1]; v0[1] = v0[1] * c0[2] + sg * p0[1] * c0[3];
    v0[2] = v0[2] * c1[0] + sg * p0[2] * c1[1]; v0[3] = v0[3] * c1[2] + sg * p0[3] * c1[3];
    v1[0] = v1[0] * c2[0] + sg * p1[0] * c2[1]; v1[1] = v1[1] * c2[2] + sg * p1[1] * c2[3];
    v1[2] = v1[2] * c3[0] + sg * p1[2] * c3[1]; v1[3] = v1[3] * c3[2] + sg * p1[3] * c3[3];
}
#define EPI_MEMBAR() asm volatile("" ::: "memory")
struct EpiProj {
    static constexpr bool PERM = true, AFTER_DRAIN = false, SCALES = true;
    bf16_t *NAQKV, *QLAT, *GATES, *KVLAT, *KMLA; const float* bgate; const float* rope; float qscale; float* PS; const float* sa; const float* sb; PG8_LAS float* tbl;
    __device__ __forceinline__ void prefetch(const Unit& u, int wid, int) const {
        int lane; asm volatile("v_mbcnt_lo_u32_b32 %0, -1, 0\n\tv_mbcnt_hi_u32_b32 %0, -1, %0" : "=v"(lane));
        const float* src = (wid < 4) ? sa + (size_t)u.pa * BM + wid * 64 + lane : sb + (size_t)u.pb * BM + (wid - 4) * 64 + lane;
        __builtin_amdgcn_global_load_lds((const unsigned*)src, (PG8_LAS unsigned*)(tbl + (u.slot & 1) * 512 + wid * 64), 4, 0, 0);
    }
    __device__ __forceinline__ void operator()(f32x4 (&acc)[2][2][4][2], const Unit& u, int wr, int wc, int fr, int fq) const {
        const int pn = u.pn; const int row0 = u.pm * BM + wr * 64 + fr;
        {
            const PG8_LAS float* tb = tbl + (u.slot & 1) * 512; const PG8_LAS float* sbp = tb + 256 + wc * 32 + 8 * fq;
            const f32x4 s00 = *(const PG8_LAS f32x4*)(sbp), s01 = *(const PG8_LAS f32x4*)(sbp + 4), s10 = *(const PG8_LAS f32x4*)(sbp + HALF), s11 = *(const PG8_LAS f32x4*)(sbp + HALF + 4);
#pragma unroll
            for (int ai = 0; ai < 2; ++ai)
#pragma unroll
                for (int m = 0; m < 4; ++m) { const float ra = tb[wr * 64 + fr + ai * HALF + m * 16];
                    acc[ai][0][m][0] = i2f4(acc[ai][0][m][0]) * (s00 * ra); acc[ai][0][m][1] = i2f4(acc[ai][0][m][1]) * (s01 * ra);
                    acc[ai][1][m][0] = i2f4(acc[ai][1][m][0]) * (s10 * ra); acc[ai][1][m][1] = i2f4(acc[ai][1][m][1]) * (s11 * ra); }
        }
        if (pn == 18) {
            if (wc == 0) {
#pragma unroll
                for (int ai = 0; ai < 2; ++ai) { RopeTab rt[4];
#pragma unroll
                    for (int m = 0; m < 4; ++m) rt[m] = rope_load(rope + (size_t)((row0 + ai * HALF + m * 16) & 8191) * 32, fq);
                    EPI_MEMBAR();
#pragma unroll
                    for (int m = 0; m < 4; ++m) { const int row = row0 + ai * HALF + m * 16; f32x4 v0 = acc[ai][0][m][0], v1 = acc[ai][0][m][1];
                        rope_apply(v0, v1, rt[m], fq); const u32x4 w = pack8(v0, v1); bf16_t* dp = KMLA + (size_t)row * 768 + 64 + 8 * fq;
#pragma unroll
                        for (int h = 0; h < 8; ++h) *(u32x4*)(dp + 96 * h) = w; }
                    EPI_MEMBAR(); }
            }
            return;
        }
        if (pn >= 9 && pn < 17) {
            const int col0 = (pn - 9) * BM + wc * 32 + 8 * fq;
            f32x4 bv[2][2];
#pragma unroll
            for (int bj = 0; bj < 2; ++bj)
#pragma unroll
                for (int n = 0; n < 2; ++n) bv[bj][n] = *(const f32x4*)(bgate + col0 + bj * HALF + 4 * n);
#pragma unroll
            for (int ai = 0; ai < 2; ++ai)
#pragma unroll
                for (int m = 0; m < 4; ++m) { unsigned char* rowp = (unsigned char*)GATES + (size_t)(row0 + ai * HALF + m * 16) * 2048 + col0;
#pragma unroll
                    for (int bj = 0; bj < 2; ++bj) { const f32x4 v0 = acc[ai][bj][m][0] + bv[bj][0], v1 = acc[ai][bj][m][1] + bv[bj][1]; u32x2 w = {0u, 0u};
#pragma unroll
                        for (int j = 0; j < 4; ++j) { w.x = __builtin_amdgcn_cvt_pk_u8_f32(sigm(v0[j]) * 255.f, j, w.x); w.y = __builtin_amdgcn_cvt_pk_u8_f32(sigm(v1[j]) * 255.f, j, w.y); }
                        *(u32x2*)(rowp + bj * HALF) = w; } }
            return;
        }
        bf16_t* base; int ldc, colt, mode = 0;
        if (pn < 6) { base = NAQKV; ldc = 1536; colt = pn * BM; mode = (pn < 2) ? 1 : 0; }
        else if (pn < 9) { base = QLAT; ldc = 768; colt = (pn - 6) * BM; }
        else { base = KVLAT; ldc = 256; colt = 0; }
        const int col0 = colt + wc * 32 + 8 * fq;
        if (mode == 0 && pn >= 6) {
            const int slot = (pn == 17) ? 12 + wc : (pn - 6) * 4 + wc;
#pragma unroll
            for (int ai = 0; ai < 2; ++ai)
#pragma unroll
                for (int m = 0; m < 4; ++m) { float q = 0.f;
#pragma unroll
                    for (int bj = 0; bj < 2; ++bj)
#pragma unroll
                        for (int n = 0; n < 2; ++n) { const f32x4 x = acc[ai][bj][m][n]; q += (x[0] * x[0] + x[1] * x[1]) + (x[2] * x[2] + x[3] * x[3]); }
                    { const auto r_ = __builtin_amdgcn_permlane16_swap(__float_as_uint(q), __float_as_uint(q), false, false); q = __uint_as_float(r_[0]) + __uint_as_float(r_[1]); }
                    { const auto r_ = __builtin_amdgcn_permlane32_swap(__float_as_uint(q), __float_as_uint(q), false, false); q = __uint_as_float(r_[0]) + __uint_as_float(r_[1]); }
                    if (fq == 0) PS[(size_t)(row0 + ai * HALF + m * 16) * 16 + slot] = q; }
        }
        const float sc = (mode == 1) ? qscale : 1.f;
#pragma unroll
        for (int ai = 0; ai < 2; ++ai)
#pragma unroll
            for (int m = 0; m < 4; ++m) { bf16_t* rowp = base + (size_t)(row0 + ai * HALF + m * 16) * ldc + col0;
#pragma unroll
                for (int bj = 0; bj < 2; ++bj) *(u32x4*)(rowp + bj * HALF) = pack8(acc[ai][bj][m][0] * sc, acc[ai][bj][m][1] * sc); }
    }
};
struct EpiQup {
    static constexpr bool PERM = true, AFTER_DRAIN = false, SCALES = false;
    bf16_t* Q; const PG8_LAS float* rtab; const float* rope; float sc;
    __device__ __forceinline__ void operator()(const f32x4 (&acc)[2][2][4][2], const Unit& u, int wr, int wc, int fr, int fq) const {
        const int lr0 = wr * 64 + fr;
        const int rb0 = ((8 * u.pn + wc) % 3 == 2), rb1 = ((8 * u.pn + 4 + wc) % 3 == 2);
#pragma unroll
        for (int ai = 0; ai < 2; ++ai) { RopeTab rt[4]; float rrs[4];
#pragma unroll
            for (int m = 0; m < 4; ++m) rrs[m] = rtab[u.slot * BM + lr0 + ai * HALF + m * 16];
            if (rb0 | rb1) {
#pragma unroll
                for (int m = 0; m < 4; ++m) rt[m] = rope_load(rope + (size_t)((u.pm * BM + lr0 + ai * HALF + m * 16) & 8191) * 32, fq);
#pragma unroll
                for (int m = 0; m < 4; ++m) asm volatile("" : "+v"(rt[m].c0), "+v"(rt[m].c1), "+v"(rt[m].c2), "+v"(rt[m].c3));
            }
            EPI_MEMBAR();
#pragma unroll
            for (int m = 0; m < 4; ++m) { const int lr = lr0 + ai * HALF + m * 16, row = u.pm * BM + lr; const float rr = rrs[m];
                bf16_t* rowp = Q + (size_t)row * 768 + u.pn * BM + wc * 32 + 8 * fq;
#pragma unroll
                for (int bj = 0; bj < 2; ++bj) { f32x4 v0 = acc[ai][bj][m][0] * rr, v1 = acc[ai][bj][m][1] * rr;
                    if (bj == 0 ? rb0 : rb1) rope_apply(v0, v1, rt[m], fq);
                    v0 = v0 * sc; v1 = v1 * sc; *(u32x4*)(rowp + bj * HALF) = pack8(v0, v1); } }
            EPI_MEMBAR(); }
    }
};
struct EpiKVup {
    static constexpr bool PERM = true, AFTER_DRAIN = false, SCALES = false;
    bf16_t *KM, *VM; const PG8_LAS float* rtab;
    __device__ __forceinline__ void operator()(const f32x4 (&acc)[2][2][4][2], const Unit& u, int wr, int wc, int fr, int fq) const {
        const int lr0 = wr * 64 + fr;
#pragma unroll
        for (int ai = 0; ai < 2; ++ai)
#pragma unroll
            for (int m = 0; m < 4; ++m) { const int lr = lr0 + ai * HALF + m * 16, row = u.pm * BM + lr; const float rr = rtab[u.slot * BM + lr];
#pragma unroll
                for (int bj = 0; bj < 2; ++bj) { const f32x4 v0 = acc[ai][bj][m][0] * rr, v1 = acc[ai][bj][m][1] * rr;
                    bf16_t* dp;
                    if (u.pn < 2) { const int h = 4 * u.pn + 2 * bj + (wc >> 1); dp = KM + (size_t)row * 768 + 96 * h + 32 * (wc & 1) + 8 * fq; }
                    else { dp = VM + (size_t)row * 512 + (u.pn - 2) * BM + bj * HALF + wc * 32 + 8 * fq; }
                    *(u32x4*)dp = pack8(v0, v1); }
                if (((ai * 4 + m + 1) % EPI_FENCE_GRP) == 0) asm volatile("" ::: "memory"); }
    }
};
struct EpiMerge {
    static constexpr bool PERM = true, AFTER_DRAIN = false, SCALES = false;
    const unsigned char* G; bf16_t* T; int second;
    __device__ __forceinline__ void operator()(const f32x4 (&acc)[2][2][4][2], const Unit& u, int wr, int wc, int fr, int fq) const {
        const int row0 = u.pm * BM + wr * 64 + fr, col0 = u.pn * BM + wc * 32 + 8 * fq;
#pragma unroll
        for (int ai = 0; ai < 2; ++ai) { u32x2 gw[4][2]; u32x4 tw[4][2];
#pragma unroll
            for (int m = 0; m < 4; ++m) { const size_t row = (size_t)(row0 + ai * HALF + m * 16);
#pragma unroll
                for (int bj = 0; bj < 2; ++bj) { const int c = col0 + bj * HALF; gw[m][bj] = *(const u32x2*)(G + row * 2048 + c); if (second) tw[m][bj] = *(const u32x4*)(T + row * 1024 + c); } }
            EPI_MEMBAR();
#pragma unroll
            for (int m = 0; m < 4; ++m) { const size_t row = (size_t)(row0 + ai * HALF + m * 16);
#pragma unroll
                for (int bj = 0; bj < 2; ++bj) { const int c = col0 + bj * HALF; const u32x2 g_ = gw[m][bj];
                    const f32x4 g0 = {(float)(g_.x & 255u), (float)((g_.x >> 8) & 255u), (float)((g_.x >> 16) & 255u), (float)(g_.x >> 24)}, g1 = {(float)(g_.y & 255u), (float)((g_.y >> 8) & 255u), (float)((g_.y >> 16) & 255u), (float)(g_.y >> 24)};
                    f32x4 v0 = acc[ai][bj][m][0] * (g0 * (1.f / 255.f)), v1 = acc[ai][bj][m][1] * (g1 * (1.f / 255.f));
                    if (second) { f32x4 t0, t1; unpack8(tw[m][bj], t0, t1); v0 = v0 + t0; v1 = v1 + t1; }
                    *(u32x4*)(T + row * 1024 + c) = pack8(v0, v1); } }
            EPI_MEMBAR(); }
    }
};
struct EpiPlain {
    static constexpr bool PERM = true, AFTER_DRAIN = false, SCALES = false;
    bf16_t* O; int ldc;
    __device__ __forceinline__ void operator()(const f32x4 (&acc)[2][2][4][2], const Unit& u, int wr, int wc, int fr, int fq) const {
        const int row0 = u.pm * BM + wr * 64 + fr, col0 = u.pn * BM + wc * 32 + 8 * fq;
#pragma unroll
        for (int ai = 0; ai < 2; ++ai)
#pragma unroll
            for (int m = 0; m < 4; ++m) { bf16_t* rowp = O + (size_t)(row0 + ai * HALF + m * 16) * ldc + col0;
#pragma unroll
                for (int bj = 0; bj < 2; ++bj) *(u32x4*)(rowp + bj * HALF) = pack8(acc[ai][bj][m][0], acc[ai][bj][m][1]); }
    }
};
template <int MODE> struct EpiRes {
    static constexpr bool PERM = true, AFTER_DRAIN = false, SCALES = (MODE == 3);
    const bf16_t* xres; bf16_t* Y; bf16_t* P; float alpha; const float* sa; const float* sb; PG8_LAS float* tbl;
    __device__ __forceinline__ void prefetch(const Unit& u, int wid, int) const {
        int lane; asm volatile("v_mbcnt_lo_u32_b32 %0, -1, 0\n\tv_mbcnt_hi_u32_b32 %0, -1, %0" : "=v"(lane));
        const float* src = (wid < 4) ? sa + (size_t)u.pa * BM + wid * 64 + lane : sb + (size_t)u.pb * BM + (wid - 4) * 64 + lane;
        __builtin_amdgcn_global_load_lds((const unsigned*)src, (PG8_LAS unsigned*)(tbl + (u.slot & 1) * 512 + wid * 64), 4, 0, 0);
    }
    __device__ __forceinline__ void operator()(const f32x4 (&acc)[2][2][4][2], const Unit& u, int wr, int wc, int fr, int fq) const {
        const int row0 = u.pm * BM + wr * 64 + fr, col0 = u.pn * BM + wc * 32 + 8 * fq;
        const PG8_LAS float* tb = (MODE == 3) ? tbl + (u.slot & 1) * 512 : nullptr;
        f32x4 sb0[2], sb1[2];
        if (MODE == 3) {
#pragma unroll
            for (int bj = 0; bj < 2; ++bj) { const PG8_LAS float* sbp = tb + 256 + bj * HALF + wc * 32 + 8 * fq; sb0[bj] = *(const PG8_LAS f32x4*)sbp; sb1[bj] = *(const PG8_LAS f32x4*)(sbp + 4); } }
#pragma unroll
        for (int ai = 0; ai < 2; ++ai) { u32x4 lx[4][2], lp[4][2];
#pragma unroll
            for (int m = 0; m < 4; ++m) { const size_t off = (size_t)(row0 + ai * HALF + m * 16) * 1024 + col0;
#pragma unroll
                for (int bj = 0; bj < 2; ++bj) { const size_t o = off + bj * HALF;
                    if (MODE == 0 || MODE == 2) lx[m][bj] = *(const u32x4*)(xres + o);
                    if (MODE != 0) lp[m][bj] = *(const u32x4*)(P + o); } }
            EPI_MEMBAR();
#pragma unroll
            for (int m = 0; m < 4; ++m) { const size_t off = (size_t)(row0 + ai * HALF + m * 16) * 1024 + col0;
#pragma unroll
                for (int bj = 0; bj < 2; ++bj) { const size_t o = off + bj * HALF; f32x4 v0 = acc[ai][bj][m][0], v1 = acc[ai][bj][m][1];
                    if (MODE == 0) { f32x4 x0, x1; unpack8(lx[m][bj], x0, x1); v0 = x0 * alpha + v0; v1 = x1 * alpha + v1; *(u32x4*)(Y + o) = pack8(v0, v1); }
                    else if (MODE == 3) { f32x4 p0, p1; unpack8(lp[m][bj], p0, p1); const float ra = tb[wr * 64 + fr + ai * HALF + m * 16];
                        v0 = i2f4(v0) * (sb0[bj] * ra); v1 = i2f4(v1) * (sb1[bj] * ra);
#pragma unroll
                        for (int j = 0; j < 4; ++j) { v0[j] = sigm(v0[j]) * p0[j]; v1[j] = sigm(v1[j]) * p1[j]; }
                        *(u32x4*)(P + o) = pack8(v0, v1); }
                    else if (MODE == 1) { f32x4 p0, p1; unpack8(lp[m][bj], p0, p1);
#pragma unroll
                        for (int j = 0; j < 4; ++j) { v0[j] = sigm(v0[j]) * p0[j]; v1[j] = sigm(v1[j]) * p1[j]; }
                        *(u32x4*)(P + o) = pack8(v0, v1); }
                    else { f32x4 x0, x1, p0, p1; unpack8(lx[m][bj], x0, x1); unpack8(lp[m][bj], p0, p1);
                        v0 = x0 * alpha + p0 + v0; v1 = x1 * alpha + p1 + v1; *(u32x4*)(Y + o) = pack8(v0, v1); } } }
            EPI_MEMBAR(); }
    }
};
struct EpiGate8 {
    static constexpr bool PERM = true, AFTER_DRAIN = false, SCALES = true;
    unsigned char* G8; const float* sa; const float* sb; PG8_LAS float* tbl;
    __device__ __forceinline__ void prefetch(const Unit& u, int wid, int) const {
        int lane; asm volatile("v_mbcnt_lo_u32_b32 %0, -1, 0\n\tv_mbcnt_hi_u32_b32 %0, -1, %0" : "=v"(lane));
        const float* src = (wid < 4) ? sa + (size_t)u.pa * BM + wid * 64 + lane : sb + (size_t)u.pb * BM + (wid - 4) * 64 + lane;
        __builtin_amdgcn_global_load_lds((const unsigned*)src, (PG8_LAS unsigned*)(tbl + (u.slot & 1) * 512 + wid * 64), 4, 0, 0);
    }
    __device__ __forceinline__ void operator()(const f32x4 (&acc)[2][2][4][2], const Unit& u, int wr, int wc, int fr, int fq) const {
        const int row0 = u.pm * BM + wr * 64 + fr, col0 = u.pn * BM + wc * 32 + 8 * fq;
        const PG8_LAS float* tb = tbl + (u.slot & 1) * 512;
        f32x4 sb0[2], sb1[2];
#pragma unroll
        for (int bj = 0; bj < 2; ++bj) { const PG8_LAS float* sbp = tb + 256 + bj * HALF + wc * 32 + 8 * fq; sb0[bj] = *(const PG8_LAS f32x4*)sbp; sb1[bj] = *(const PG8_LAS f32x4*)(sbp + 4); }
#pragma unroll
        for (int ai = 0; ai < 2; ++ai)
#pragma unroll
            for (int m = 0; m < 4; ++m) { const float ra = tb[wr * 64 + fr + ai * HALF + m * 16]; unsigned char* rowp = G8 + (size_t)(row0 + ai * HALF + m * 16) * 1024 + col0;
#pragma unroll
                for (int bj = 0; bj < 2; ++bj) { const f32x4 v0 = i2f4(acc[ai][bj][m][0]) * (sb0[bj] * ra), v1 = i2f4(acc[ai][bj][m][1]) * (sb1[bj] * ra); u32x2 w = {0u, 0u};
#pragma unroll
                    for (int j = 0; j < 4; ++j) { w.x = __builtin_amdgcn_cvt_pk_u8_f32(sigm(v0[j]) * 255.f, j, w.x); w.y = __builtin_amdgcn_cvt_pk_u8_f32(sigm(v1[j]) * 255.f, j, w.y); }
                    *(u32x2*)(rowp + bj * HALF) = w; } }
    }
};
struct EpiGateMul {
    static constexpr bool PERM = true, AFTER_DRAIN = false, SCALES = false;
    const unsigned char* G8; bf16_t* P;
    __device__ __forceinline__ void operator()(const f32x4 (&acc)[2][2][4][2], const Unit& u, int wr, int wc, int fr, int fq) const {
        const int row0 = u.pm * BM + wr * 64 + fr, col0 = u.pn * BM + wc * 32 + 8 * fq;
        u32x2 gw[8][2];
#pragma unroll
        for (int i = 0; i < 8; ++i)
#pragma unroll
            for (int bj = 0; bj < 2; ++bj) gw[i][bj] = *(const u32x2*)(G8 + (size_t)(row0 + (i >> 2) * HALF + (i & 3) * 16) * 1024 + col0 + bj * HALF);
        EPI_MEMBAR();
#pragma unroll
        for (int i = 0; i < 8; ++i) { const int ai = i >> 2, m = i & 3; bf16_t* rowp = P + (size_t)(row0 + ai * HALF + m * 16) * 1024 + col0;
#pragma unroll
            for (int bj = 0; bj < 2; ++bj) { const u32x2 g_ = gw[i][bj];
                const f32x4 g0 = {(float)(g_.x & 255u), (float)((g_.x >> 8) & 255u), (float)((g_.x >> 16) & 255u), (float)(g_.x >> 24)}, g1 = {(float)(g_.y & 255u), (float)((g_.y >> 8) & 255u), (float)((g_.y >> 16) & 255u), (float)(g_.y >> 24)};
                *(u32x4*)(rowp + bj * HALF) = pack8(acc[ai][bj][m][0] * (g0 * (1.f / 255.f)), acc[ai][bj][m][1] * (g1 * (1.f / 255.f))); } }
    }
};
struct EpiGLU {
    static constexpr bool PERM = true, AFTER_DRAIN = false, SCALES = false;
    bf16_t* H; int ldh;
    __device__ __forceinline__ void operator()(const f32x4 (&acc)[2][2][4][2], const Unit& u, int wr, int wc, int fr, int fq) const {
        const int row0 = u.pm * BM + wr * 64 + fr, col0 = u.pn * HALF + wc * 32 + 8 * fq;
#pragma unroll
        for (int ai = 0; ai < 2; ++ai)
#pragma unroll
            for (int m = 0; m < 4; ++m) { f32x4 h0, h1;
#pragma unroll
                for (int j = 0; j < 4; ++j) { const float a0 = acc[ai][0][m][0][j], a1 = acc[ai][0][m][1][j]; h0[j] = a0 * sigm(a0) * acc[ai][1][m][0][j]; h1[j] = a1 * sigm(a1) * acc[ai][1][m][1][j]; }
                *(u32x4*)(H + (size_t)(row0 + ai * HALF + m * 16) * ldh + col0) = pack8(h0, h1); }
    }
};
struct EpiGLUQ {
    static constexpr bool PERM = true, AFTER_DRAIN = false, SCALES = true;
    bf16_t* H; int ldh; const float* sa; const float* sb; PG8_LAS float* tbl;
    __device__ __forceinline__ void prefetch(const Unit& u, int wid, int) const {
        int lane; asm volatile("v_mbcnt_lo_u32_b32 %0, -1, 0\n\tv_mbcnt_hi_u32_b32 %0, -1, %0" : "=v"(lane));
        const float* src = (wid < 4) ? sa + (size_t)u.pa * BM + wid * 64 + lane : sb + (size_t)u.pb * BM + (wid - 4) * 64 + lane;
        __builtin_amdgcn_global_load_lds((const unsigned*)src, (PG8_LAS unsigned*)(tbl + (u.slot & 1) * 512 + wid * 64), 4, 0, 0);
    }
    __device__ __forceinline__ void operator()(const f32x4 (&acc)[2][2][4][2], const Unit& u, int wr, int wc, int fr, int fq) const {
        const int lrow0 = wr * 64 + fr, row0 = u.pm * BM + lrow0, col0 = u.pn * HALF + wc * 32 + 8 * fq;
        const PG8_LAS float* tb = tbl + (u.slot & 1) * 512; const PG8_LAS float* sbp = tb + 256 + wc * 32 + 8 * fq;
        const f32x4 s10 = *(const PG8_LAS f32x4*)(sbp), s11 = *(const PG8_LAS f32x4*)(sbp + 4), s30 = *(const PG8_LAS f32x4*)(sbp + HALF), s31 = *(const PG8_LAS f32x4*)(sbp + HALF + 4);
#pragma unroll
        for (int ai = 0; ai < 2; ++ai)
#pragma unroll
            for (int m = 0; m < 4; ++m) { const float ra = tb[lrow0 + ai * HALF + m * 16];
                const f32x4 a0 = i2f4(acc[ai][0][m][0]) * (s10 * ra), a1 = i2f4(acc[ai][0][m][1]) * (s11 * ra), b0 = i2f4(acc[ai][1][m][0]) * (s30 * ra), b1 = i2f4(acc[ai][1][m][1]) * (s31 * ra);
                f32x4 h0, h1;
#pragma unroll
                for (int j = 0; j < 4; ++j) { h0[j] = a0[j] * sigm(a0[j]) * b0[j]; h1[j] = a1[j] * sigm(a1[j]) * b1[j]; }
                *(u32x4*)(H + (size_t)(row0 + ai * HALF + m * 16) * ldh + col0) = pack8(h0, h1); }
    }
};
struct EpiMoeDown {
    static constexpr bool PERM = true, AFTER_DRAIN = false, SCALES = false;
    bf16_t* O; const float* SW;
    __device__ __forceinline__ void operator()(const f32x4 (&acc)[2][2][4][2], const Unit& u, int wr, int wc, int fr, int fq) const {
        const int row0 = u.pm * BM + wr * 64 + fr, col0 = u.pn * BM + wc * 32 + 8 * fq;
        float gws[8];
#pragma unroll
        for (int i = 0; i < 8; ++i) gws[i] = SW[row0 + (i >> 2) * HALF + (i & 3) * 16];
        EPI_MEMBAR();
#pragma unroll
        for (int ai = 0; ai < 2; ++ai)
#pragma unroll
            for (int m = 0; m < 4; ++m) { const int row = row0 + ai * HALF + m * 16; const float gw = gws[ai * 4 + m]; bf16_t* rowp = O + (size_t)row * 1024 + col0;
#pragma unroll
                for (int bj = 0; bj < 2; ++bj) *(u32x4*)(rowp + bj * HALF) = pack8(acc[ai][bj][m][0] * gw, acc[ai][bj][m][1] * gw); }
    }
};
template <bool UP> struct MoeOrder {
    int nMc, nN, nwg, G, c, t0; int ts1, ts2, ts3, ts4, ts5, ts6, ts7;
    __device__ __forceinline__ bool next(int i, Unit& u) const {
        const long L = (long)i * G + c; if (L >= nwg) return false;
        int wgid = (int)L; { const int q = nwg / NXCD, r = nwg % NXCD, xcd = wgid % NXCD, off = wgid / NXCD; wgid = (xcd < r ? xcd * (q + 1) : r * (q + 1) + (xcd - r) * q) + off; }
        const int nig = WGM * nN, gid = wgid / nig, fm = gid * WGM, gsz = (nMc - fm) < WGM ? (nMc - fm) : WGM;
        const int pml = fm + ((wgid % nig) % gsz), pn = (wgid % nig) / gsz, t = t0 + pml;
        const int e = (t >= ts1) + (t >= ts2) + (t >= ts3) + (t >= ts4) + (t >= ts5) + (t >= ts6) + (t >= ts7);
        u.pn = pn; u.pb = e * nN + pn; u.slot = i; u.kofs = 0; u.aux = 0;
        if (UP) { u.pa = t; u.pm = pml; } else { u.pa = pml; u.pm = t; }
        return true;
    }
    __device__ __forceinline__ void a_ready(const Unit&) const {}
    __device__ __forceinline__ void done(const Unit&) const {}
};
struct MoeRemOrder {
    int nT, G, c, t0, KQ; int ts1, ts2, ts3, ts4, ts5, ts6, ts7;
    __device__ __forceinline__ bool next(int i, Unit& u) const {
        const int L = i * G + c; if (L >= nT * 16) return false;
        const int tl = L >> 4, pn = (L >> 2) & 3, kq = L & 3, t = t0 + tl;
        const int e = (t >= ts1) + (t >= ts2) + (t >= ts3) + (t >= ts4) + (t >= ts5) + (t >= ts6) + (t >= ts7);
        u.pa = tl; u.pm = tl; u.pn = pn; u.pb = e * 4 + pn; u.slot = i; u.kofs = kq * KQ; u.aux = kq; return true;
    }
    __device__ __forceinline__ void a_ready(const Unit&) const {}
    __device__ __forceinline__ void done(const Unit&) const {}
};
struct EpiMoeRem {
    static constexpr bool PERM = true, AFTER_DRAIN = false, SCALES = false;
    bf16_t* PART; const float* SW; int t0, prows;
    __device__ __forceinline__ void operator()(const f32x4 (&acc)[2][2][4][2], const Unit& u, int wr, int wc, int fr, int fq) const {
        const int row0 = u.pm * BM + wr * 64 + fr, col0 = u.pn * BM + wc * 32 + 8 * fq;
        float gws[8];
#pragma unroll
        for (int i = 0; i < 8; ++i) gws[i] = SW[t0 * BM + row0 + (i >> 2) * HALF + (i & 3) * 16];
        EPI_MEMBAR();
#pragma unroll
        for (int ai = 0; ai < 2; ++ai)
#pragma unroll
            for (int m = 0; m < 4; ++m) { const int row = row0 + ai * HALF + m * 16; const float gw = gws[ai * 4 + m]; bf16_t* rowp = PART + ((size_t)u.aux * prows + row) * 1024 + col0;
#pragma unroll
                for (int bj = 0; bj < 2; ++bj) *(u32x4*)(rowp + bj * HALF) = pack8(acc[ai][bj][m][0] * gw, acc[ai][bj][m][1] * gw); }
    }
};
}
namespace att {
#define ATT_LAS __attribute__((address_space(3)))
typedef unsigned short bf16;
using bf16x8 = __attribute__((ext_vector_type(8))) short;
using s16x4  = __attribute__((ext_vector_type(4))) short;
using f32x16 = __attribute__((ext_vector_type(16))) float;
using u32x4  = __attribute__((ext_vector_type(4))) unsigned;
#define SBAR() __builtin_amdgcn_sched_barrier(0)
__device__ __forceinline__ int crow(int r, int hi) { return (r & 3) + 8 * (r >> 2) + 4 * hi; }
__device__ __forceinline__ unsigned cvtpk(float lo, float hi) { unsigned r; asm volatile("v_cvt_pk_bf16_f32 %0, %1, %2" : "=v"(r) : "v"(lo), "v"(hi)); return r; }
__device__ __forceinline__ unsigned short f2bf(float f) { return (unsigned short)(cvtpk(f, f) & 0xffffu); }
constexpr int OIMG_WAVE = 32 * 144;
__device__ __forceinline__ int crow(int r, int hi);
__device__ __forceinline__ void store_o(const f32x16 (&o)[2], const ATT_LAS float* li_l, bf16* Ow, ATT_LAS char* img, int lane, int r32, int hi) {
  typedef unsigned u32x4_t __attribute__((ext_vector_type(4)));
#pragma unroll
  for (int r = 0; r < 16; ++r) { const int orow = (r & 3) + 8 * (r >> 2) + 4 * hi; const float rl = __builtin_amdgcn_rcpf(li_l[orow]);
    ATT_LAS unsigned short* rp = (ATT_LAS unsigned short*)(img + orow * 144) + r32;
    rp[0] = f2bf(o[0][r] * rl); rp[32] = f2bf(o[1][r] * rl); }
  asm volatile("s_waitcnt lgkmcnt(0)" ::: "memory");
#pragma unroll
  for (int j = 0; j < 4; ++j) { const int pc = j * 64 + lane, row = pc >> 3, c16 = pc & 7;
    const u32x4_t v = *(const ATT_LAS u32x4_t*)(img + row * 144 + c16 * 16);
    *reinterpret_cast<u32x4_t*>(Ow + (long)row * 512 + c16 * 8) = v; }
}
__device__ __forceinline__ int v_st(int k, int c) { const int kk = (k & ~0xC) | ((k & 4) << 1) | ((k & 8) >> 1); return ((kk >> 3) * 2 + (c >> 5)) * 512 + ((kk & 7) * 32 + (c & 31)) * 2; }
__device__ __forceinline__ int v_rd_base(int lane) { return ((lane & 3) << 3) | (((lane >> 2) & 3) << 6) | (((lane >> 4) & 1) << 5) | (((lane >> 5) & 1) << 8); }
constexpr int v_rd_off(int d0, int ks, int half) { return d0 * 512 + ks * 2048 + half * 1024; }
template <int OFF> __device__ __forceinline__ s16x4 tr_read(int vb) { s16x4 r; asm volatile("ds_read_b64_tr_b16 %0, %1 offset:%2" : "=&v"(r) : "v"(vb), "i"(OFF) : "memory"); return r; }
template <int D0> __device__ __forceinline__ void pv_one(f32x16& od, int vb, bf16x8 pa0, bf16x8 pa1, bf16x8 pa2, bf16x8 pa3) {
  const s16x4 l0 = tr_read<v_rd_off(D0, 0, 0)>(vb), h0 = tr_read<v_rd_off(D0, 0, 1)>(vb), l1 = tr_read<v_rd_off(D0, 1, 0)>(vb), h1 = tr_read<v_rd_off(D0, 1, 1)>(vb);
  const s16x4 l2 = tr_read<v_rd_off(D0, 2, 0)>(vb), h2 = tr_read<v_rd_off(D0, 2, 1)>(vb), l3 = tr_read<v_rd_off(D0, 3, 0)>(vb), h3 = tr_read<v_rd_off(D0, 3, 1)>(vb);
  asm volatile("s_waitcnt lgkmcnt(0)" ::: "memory"); SBAR();
#define PK(L, H) (bf16x8){L[0], L[1], L[2], L[3], H[0], H[1], H[2], H[3]}
  od = __builtin_amdgcn_mfma_f32_32x32x16_bf16(pa0, PK(l0, h0), od, 0, 0, 0);
  od = __builtin_amdgcn_mfma_f32_32x32x16_bf16(pa1, PK(l1, h1), od, 0, 0, 0);
  od = __builtin_amdgcn_mfma_f32_32x32x16_bf16(pa2, PK(l2, h2), od, 0, 0, 0);
  od = __builtin_amdgcn_mfma_f32_32x32x16_bf16(pa3, PK(l3, h3), od, 0, 0, 0);
#undef PK
}
__device__ __forceinline__ void pv2(f32x16* o, int vb, bf16x8 pa0, bf16x8 pa1, bf16x8 pa2, bf16x8 pa3) { pv_one<0>(o[0], vb, pa0, pa1, pa2, pa3); pv_one<1>(o[1], vb, pa0, pa1, pa2, pa3); }
template <int NS, int ROWB> __device__ __forceinline__ void qkt(f32x16& p0, f32x16& p1, const ATT_LAS char* Ks, const bf16x8* qr, int r32, int hi) {
  p0 = f32x16{}; p1 = f32x16{};
#pragma unroll
  for (int d0 = 0; d0 < NS; ++d0) { const int cb = d0 * 32 + hi * 16;
    const bf16x8 b0 = *(const ATT_LAS bf16x8*)(Ks + r32 * ROWB + cb);
    const bf16x8 b1 = *(const ATT_LAS bf16x8*)(Ks + (32 + r32) * ROWB + cb);
    p0 = __builtin_amdgcn_mfma_f32_32x32x16_bf16(b0, qr[d0], p0, 0, 0, 0);
    p1 = __builtin_amdgcn_mfma_f32_32x32x16_bf16(b1, qr[d0], p1, 0, 0, 0); }
}
constexpr float THR = 8.f;
__device__ __forceinline__ void partialSM(f32x16& p0, f32x16& p1, float& m_reg, float& alpha) {
  float pmax = p0[0];
#pragma unroll
  for (int r = 1; r < 16; ++r) pmax = fmaxf(pmax, p0[r]);
#pragma unroll
  for (int r = 0; r < 16; ++r) pmax = fmaxf(pmax, p1[r]);
  { auto rr = __builtin_amdgcn_permlane32_swap(__float_as_uint(pmax), __float_as_uint(pmax), false, false); pmax = fmaxf(__uint_as_float(rr[0]), __uint_as_float(rr[1])); }
  float mn;
  if (__builtin_expect(__all(pmax - m_reg <= THR), 1)) { mn = m_reg; alpha = 1.f; }
  else { mn = fmaxf(m_reg, pmax); alpha = __builtin_amdgcn_exp2f(m_reg - mn); m_reg = mn; }
#pragma unroll
  for (int r = 0; r < 16; ++r) p0[r] = p0[r] - mn;
#pragma unroll
  for (int r = 0; r < 16; ++r) p1[r] = p1[r] - mn;
#pragma unroll
  for (int r = 0; r < 16; ++r) p0[r] = __builtin_amdgcn_exp2f(p0[r]);
}
__device__ __forceinline__ void finishSM(f32x16& p0, f32x16& p1, float alpha, float& l_reg, bf16x8& pa0, bf16x8& pa1, bf16x8& pa2, bf16x8& pa3) {
#pragma unroll
  for (int r = 0; r < 16; ++r) p1[r] = __builtin_amdgcn_exp2f(p1[r]);
  float ps = 0;
#pragma unroll
  for (int r = 0; r < 16; ++r) ps += p0[r];
#pragma unroll
  for (int r = 0; r < 16; ++r) ps += p1[r];
  { auto rr = __builtin_amdgcn_permlane32_swap(__float_as_uint(ps), __float_as_uint(ps), false, false); ps = __uint_as_float(rr[0]) + __uint_as_float(rr[1]); }
  l_reg = l_reg * alpha + ps;
#define PK4(P, BASE, OUT) do { unsigned a0 = cvtpk(P[BASE + 0], P[BASE + 1]), a1 = cvtpk(P[BASE + 2], P[BASE + 3]);   \
    unsigned b0 = cvtpk(P[BASE + 4], P[BASE + 5]), b1 = cvtpk(P[BASE + 6], P[BASE + 7]);                              \
    auto r0 = __builtin_amdgcn_permlane32_swap(a0, b0, false, false); auto r1 = __builtin_amdgcn_permlane32_swap(a1, b1, false, false); \
    u32x4 w = {r0[0], r1[0], r0[1], r1[1]}; OUT = *reinterpret_cast<bf16x8*>(&w); } while (0)
  PK4(p0, 0, pa0); PK4(p0, 8, pa1); PK4(p1, 0, pa2); PK4(p1, 8, pa3);
#undef PK4
}

#define MX3(a, b, c) __builtin_fmaxf(__builtin_fmaxf((a), (b)), (c))
__device__ __forceinline__ float rowmax32(const f32x16& p0, const f32x16& p1) {
  float a = MX3(p0[0], p0[1], p1[0]), b = MX3(p0[2], p0[3], p1[1]); a = MX3(a, p1[2], p1[3]);
#pragma unroll
  for (int r = 4; r < 16; r += 4) { a = MX3(a, p0[r], p0[r + 1]); b = MX3(b, p0[r + 2], p0[r + 3]); a = MX3(a, p1[r], p1[r + 1]); b = MX3(b, p1[r + 2], p1[r + 3]); }
  float m = __builtin_fmaxf(a, b);
  { auto rr = __builtin_amdgcn_permlane32_swap(__float_as_uint(m), __float_as_uint(m), false, false); m = __builtin_fmaxf(__uint_as_float(rr[0]), __uint_as_float(rr[1])); }
  return m;
}
template <int NS, int ROWB> __device__ __forceinline__ void qkt_from(f32x16& p0, f32x16& p1, const ATT_LAS char* Ks, const bf16x8* qr, const f32x16& c0, int r32, int hi) {
#pragma unroll
  for (int d0 = 0; d0 < NS; ++d0) { const int cb = d0 * 32 + hi * 16;
    const bf16x8 b0 = *(const ATT_LAS bf16x8*)(Ks + r32 * ROWB + cb);
    const bf16x8 b1 = *(const ATT_LAS bf16x8*)(Ks + (32 + r32) * ROWB + cb);
    if (d0 == 0) { p0 = __builtin_amdgcn_mfma_f32_32x32x16_bf16(b0, qr[0], c0, 0, 0, 0); p1 = __builtin_amdgcn_mfma_f32_32x32x16_bf16(b1, qr[0], c0, 0, 0, 0); }
    else { p0 = __builtin_amdgcn_mfma_f32_32x32x16_bf16(b0, qr[d0], p0, 0, 0, 0); p1 = __builtin_amdgcn_mfma_f32_32x32x16_bf16(b1, qr[d0], p1, 0, 0, 0); } }
}
template <bool FIRST> __device__ __forceinline__ void partialSM2(f32x16& p0, f32x16& p1, float& m_ref, f32x16& negm, float& alpha) {
  const float rm = rowmax32(p0, p1);
  alpha = 1.f;
  if (FIRST || !__builtin_expect(__all(rm <= THR), 1)) {
    const float dl = FIRST ? rm : __builtin_fmaxf(rm, 0.f);
    m_ref += dl;
#pragma unroll
    for (int r = 0; r < 16; ++r) { p0[r] -= dl; p1[r] -= dl; }
#pragma unroll
    for (int r = 0; r < 16; ++r) negm[r] = -m_ref;
    asm volatile("" : "+v"(negm));
    if (!FIRST) alpha = __builtin_amdgcn_exp2f(-dl);
  }
#pragma unroll
  for (int r = 0; r < 16; ++r) p0[r] = __builtin_amdgcn_exp2f(p0[r]);
}
__device__ __forceinline__ void finishSM2(f32x16& p0, f32x16& p1, bf16x8& pa0, bf16x8& pa1, bf16x8& pa2, bf16x8& pa3) {
#pragma unroll
  for (int r = 0; r < 16; ++r) p1[r] = __builtin_amdgcn_exp2f(p1[r]);
#define PK4(P, BASE, OUT) do { unsigned a0 = cvtpk(P[BASE + 0], P[BASE + 1]), a1 = cvtpk(P[BASE + 2], P[BASE + 3]);   \
    unsigned b0 = cvtpk(P[BASE + 4], P[BASE + 5]), b1 = cvtpk(P[BASE + 6], P[BASE + 7]);                              \
    auto r0 = __builtin_amdgcn_permlane32_swap(a0, b0, false, false); auto r1 = __builtin_amdgcn_permlane32_swap(a1, b1, false, false); \
    u32x4 w = {r0[0], r1[0], r0[1], r1[1]}; OUT = *reinterpret_cast<bf16x8*>(&w); } while (0)
  PK4(p0, 0, pa0); PK4(p0, 8, pa1); PK4(p1, 0, pa2); PK4(p1, 8, pa3);
#undef PK4
}
__device__ __forceinline__ void pv3(f32x16* o, f32x16& ol, int vb, bf16x8 pa0, bf16x8 pa1, bf16x8 pa2, bf16x8 pa3) {
  const bf16x8 ones = {0x3F80, 0x3F80, 0x3F80, 0x3F80, 0x3F80, 0x3F80, 0x3F80, 0x3F80};
  pv_one<0>(o[0], vb, pa0, pa1, pa2, pa3);
  ol = __builtin_amdgcn_mfma_f32_32x32x16_bf16(pa0, ones, ol, 0, 0, 0); ol = __builtin_amdgcn_mfma_f32_32x32x16_bf16(pa1, ones, ol, 0, 0, 0);
  pv_one<1>(o[1], vb, pa0, pa1, pa2, pa3);
  ol = __builtin_amdgcn_mfma_f32_32x32x16_bf16(pa2, ones, ol, 0, 0, 0); ol = __builtin_amdgcn_mfma_f32_32x32x16_bf16(pa3, ones, ol, 0, 0, 0);
}
#ifndef MLA_CHK_ODD
#define MLA_CHK_ODD 0
#endif
constexpr int KSLOT = 12288, VSLOT = 8192, NSLOT = 4, MLA_OIMG = NSLOT * (KSLOT + VSLOT) + 8 * 256  , MLA_LDS = MLA_OIMG + 8 * OIMG_WAVE;
__device__ __forceinline__ void glds16(const void* gsrc, unsigned lds_dst) { unsigned keep;
  asm volatile("s_mov_b32 %0, m0\n\ts_mov_b32 m0, %2\n\ts_nop 0\n\tglobal_load_lds_dwordx4 %1, off\n\ts_mov_b32 m0, %0" : "=&s"(keep) : "v"(gsrc), "s"(lds_dst) : "memory"); }
#define BAR_L() asm volatile("s_waitcnt lgkmcnt(0)\n\ts_barrier" ::: "memory")
#define BAR_V(N) asm volatile("s_waitcnt vmcnt(" #N ") lgkmcnt(0)\n\ts_barrier" ::: "memory")
typedef short v4i16_t __attribute__((ext_vector_type(4)));
__device__ __forceinline__ s16x4 vtr(const ATT_LAS char* p) { return __builtin_bit_cast(s16x4, __builtin_amdgcn_ds_read_tr16_b64_v4i16((ATT_LAS v4i16_t*)p)); }
__device__ __forceinline__ void kfetch(bf16x8 (&kf)[12], const ATT_LAS char* Ks, int r32, int hi) {
#pragma unroll
  for (int d0 = 0; d0 < 6; ++d0) { const ATT_LAS char* p = Ks + (2 * d0 + hi) * 1024 + r32 * 16;
    kf[2 * d0] = *(const ATT_LAS bf16x8*)p; kf[2 * d0 + 1] = *(const ATT_LAS bf16x8*)(p + 512); }
}
#define MX3(a, b, c) __builtin_fmaxf(__builtin_fmaxf((a), (b)), (c))
__device__ __forceinline__ void mla_unit(const bf16* __restrict__ Qb, const bf16* __restrict__ Kh, const bf16* __restrict__ Vh, bf16* __restrict__ Ob, int seq, ATT_LAS char* lds, const int wave_id) {
  int lane_; asm volatile("v_mbcnt_lo_u32_b32 %0, -1, 0\n\tv_mbcnt_hi_u32_b32 %0, -1, %0" : "=v"(lane_));
  int w_ = wave_id; asm volatile("" : "+s"(w_));
  const int wid = w_, lane = lane_, r32 = lane & 31, hi = lane >> 5;
  const int half = wid >> 2;
  ATT_LAS char* K_lds = lds; ATT_LAS char* V_lds = lds + NSLOT * KSLOT;
  ATT_LAS float* al_l = (ATT_LAS float*)(lds + NSLOT * (KSLOT + VSLOT)) + wid * 64; ATT_LAS float* li_l = al_l + 32;
  const unsigned lds0 = (unsigned)(uintptr_t)lds;
  const int NT = seq / 64;
  const bf16* ksrc0 = Kh + (long)lane * 768 + wid * 8; const bf16* ksrc1 = ksrc0 + 64;
  const bf16* vsrc = Vh + (long)(16 * (wid & 3) + (lane >> 2)) * 512 + (wid >> 2) * 32 + (lane & 3) * 8;
  const unsigned kdst0 = lds0 + wid * 1024, vdst = lds0 + NSLOT * KSLOT + wid * 1024;
#define DMA_K(tile, slot) do { const int tl_ = (tile) < NT ? (tile) : NT - 1; const unsigned d_ = (unsigned)__builtin_amdgcn_readfirstlane(kdst0 + ((slot) & 3) * KSLOT); \
    glds16(ksrc0 + (long)tl_ * 64 * 768, d_); if (!half) glds16(ksrc1 + (long)tl_ * 64 * 768, d_ + 8192); } while (0)
#define DMA_V(tile, slot) do { const int tl_ = (tile) < NT ? (tile) : NT - 1; glds16(vsrc + (long)tl_ * 64 * 512, (unsigned)__builtin_amdgcn_readfirstlane(vdst + ((slot) & 3) * VSLOT)); } while (0)
#define STEP_BAR() do { SBAR(); if (!half) { BAR_V(6); } else { BAR_V(4); } SBAR(); } while (0)
  DMA_K(0, 0); DMA_K(1, 1); DMA_K(2, 2); DMA_K(3, 3); DMA_V(0, 0); DMA_V(1, 1);
  float m_ref = 0.f, l_reg = 0.f, pend = 0.f; f32x16 o[2] = {}; f32x16 negm = {}; bf16x8 qr[6];
  const bf16* Qw = Qb + (long)(wid * 32 + r32) * 768 + hi * 8;
#pragma unroll
  for (int d0 = 0; d0 < 6; ++d0) qr[d0] = *reinterpret_cast<const bf16x8*>(Qw + d0 * 16);
  const ATT_LAS char* vbp0 = V_lds + ((lane >> 4) & 1) * 32 + (lane & 3) * 8 + (4 * hi + ((lane & 15) >> 2)) * 64; const ATT_LAS char* kb0 = K_lds + hi * 1024 + r32 * 16;
  BAR_V(0);
  f32x16 pA0, pA1, pB0, pB1; bf16x8 paA0, paA1, paA2, paA3, paB0, paB1, paB2, paB3;
  paB0 = paB1 = paB2 = paB3 = (bf16x8){0, 0, 0, 0, 0, 0, 0, 0};
#define KFR(kb, i) (*(const ATT_LAS bf16x8*)((kb) + ((i) >> 1) * 2048 + ((i) & 1) * 512))
#pragma unroll
  for (int i = 0; i < 12; i += 2) { const bf16x8 k0_ = KFR(kb0, i), k1_ = KFR(kb0, i + 1);
    if (i == 0) { pA0 = __builtin_amdgcn_mfma_f32_32x32x16_bf16(k0_, qr[0], negm, 0, 0, 0); pA1 = __builtin_amdgcn_mfma_f32_32x32x16_bf16(k1_, qr[0], negm, 0, 0, 0); }
    else { pA0 = __builtin_amdgcn_mfma_f32_32x32x16_bf16(k0_, qr[i >> 1], pA0, 0, 0, 0); pA1 = __builtin_amdgcn_mfma_f32_32x32x16_bf16(k1_, qr[i >> 1], pA1, 0, 0, 0); } }
#define QKM(i, N0, N1) do { if ((i) == 0) N0 = __builtin_amdgcn_mfma_f32_32x32x16_bf16(kf[0], qr[0], negm, 0, 0, 0); else if ((i) == 1) N1 = __builtin_amdgcn_mfma_f32_32x32x16_bf16(kf[1], qr[0], negm, 0, 0, 0); \
    else if (((i) & 1) == 0) N0 = __builtin_amdgcn_mfma_f32_32x32x16_bf16(kf[i], qr[(i) >> 1], N0, 0, 0, 0); else N1 = __builtin_amdgcn_mfma_f32_32x32x16_bf16(kf[i], qr[(i) >> 1], N1, 0, 0, 0); } while (0)
#define VRDJ(j) do { vl[j] = vtr(vbp + ((j) >> 2) * 4096 + ((j) & 3) * 1024); vh[j] = vtr(vbp + ((j) >> 2) * 4096 + ((j) & 3) * 1024 + 512); } while (0)
#define PKV(i) (bf16x8){vl[i][0], vl[i][1], vl[i][2], vl[i][3], vh[i][0], vh[i][1], vh[i][2], vh[i][3]}
#define EXQ(idx, C0, C1) do { if ((idx) < 16) C0[(idx)] = __builtin_amdgcn_exp2f(C0[(idx)]); else C1[(idx) - 16] = __builtin_amdgcn_exp2f(C1[(idx) - 16]); } while (0)
#define CV(idx, C0, C1) ((idx) < 16 ? C0[(idx)] : C1[(idx) - 16])
#define EX2(k, C0, C1) do { EXQ(2 * (k), C0, C1); EXQ(2 * (k) + 1, C0, C1); ps2 += (f32x2_t){CV(2 * (k), C0, C1), CV(2 * (k) + 1, C0, C1)}; } while (0)
#define PK4(P, BASE, OUT) do { u32x4 w = {cvtpk(P[BASE + 0], P[BASE + 1]), cvtpk(P[BASE + 2], P[BASE + 3]), cvtpk(P[BASE + 4], P[BASE + 5]), cvtpk(P[BASE + 6], P[BASE + 7])}; OUT = *reinterpret_cast<bf16x8*>(&w); } while (0)
#define STEP(t, C0, C1, N0, N1, PC0, PC1, PC2, PC3, PO0, PO1, PO2, PO3, FIRST, CHK) do { \
    typedef float f32x2_t __attribute__((ext_vector_type(2))); \
    STEP_BAR(); \
    DMA_K((t) + 4, (t)); DMA_V((t) + 2, (t) + 2); \
    const ATT_LAS char* kb = kb0 + (((t) + 1) & 3) * KSLOT; const ATT_LAS char* vbp = vbp0 + (((t) - 1) & 3) * VSLOT; \
    bf16x8 kf[12]; s16x4 vl[8], vh[8]; f32x2_t ps2 = {0.f, 0.f}; float al = 1.f; \
    kf[0] = KFR(kb, 0); kf[1] = KFR(kb, 1); kf[2] = KFR(kb, 2); kf[3] = KFR(kb, 3); \
    float a_ = 0.f, b_ = 0.f, rm = 0.f; \
    if (CHK) { a_ = MX3(C0[0], C0[1], C1[0]); b_ = MX3(C0[2], C0[3], C1[1]); a_ = MX3(a_, C1[2], C1[3]); \
    a_ = MX3(a_, C0[4], C0[5]); b_ = MX3(b_, C0[6], C0[7]); a_ = MX3(a_, C1[4], C1[5]); b_ = MX3(b_, C1[6], C1[7]); } SBAR(); \
    QKM(0, N0, N1); kf[4] = KFR(kb, 4); if (CHK) { a_ = MX3(a_, C0[8], C0[9]); b_ = MX3(b_, C0[10], C0[11]); a_ = MX3(a_, C1[8], C1[9]); b_ = MX3(b_, C1[10], C1[11]); } SBAR(); \
    QKM(1, N0, N1); kf[5] = KFR(kb, 5); if (CHK) { a_ = MX3(a_, C0[12], C0[13]); b_ = MX3(b_, C0[14], C0[15]); a_ = MX3(a_, C1[12], C1[13]); b_ = MX3(b_, C1[14], C1[15]); } SBAR(); \
    QKM(2, N0, N1); kf[6] = KFR(kb, 6); if (CHK) { rm = __builtin_fmaxf(a_, b_); { auto rr = __builtin_amdgcn_permlane32_swap(__float_as_uint(rm), __float_as_uint(rm), false, false); rm = __builtin_fmaxf(__uint_as_float(rr[0]), __uint_as_float(rr[1])); } } SBAR(); \
    QKM(3, N0, N1); kf[7] = KFR(kb, 7); SBAR(); \
    if ((CHK) && ((FIRST) || !__builtin_expect(__all(rm <= THR), 1))) { const float dl = (FIRST) ? rm : __builtin_fmaxf(rm, 0.f); m_ref += dl; pend = dl; \
      _Pragma("unroll") for (int r = 0; r < 16; ++r) { C0[r] -= dl; C1[r] -= dl; } \
      _Pragma("unroll") for (int r = 0; r < 16; ++r) negm[r] = -m_ref; \
      asm volatile("" : "+v"(negm)); if (!(FIRST)) al = __builtin_amdgcn_exp2f(-dl); } \
    SBAR(); \
    QKM(4, N0, N1); kf[8] = KFR(kb, 8); EX2(0, C0, C1); SBAR(); \
    QKM(5, N0, N1); kf[9] = KFR(kb, 9); EX2(1, C0, C1); SBAR(); \
    QKM(6, N0, N1); kf[10] = KFR(kb, 10); EX2(2, C0, C1); SBAR(); \
    QKM(7, N0, N1); kf[11] = KFR(kb, 11); EX2(3, C0, C1); SBAR(); \
    QKM(8, N0, N1); EX2(4, C0, C1); PK4(C0, 0, PC0); SBAR(); \
    QKM(9, N0, N1); if (!(FIRST)) { VRDJ(0); } EX2(5, C0, C1); SBAR(); \
    QKM(10, N0, N1); if (!(FIRST)) { VRDJ(4); } EX2(6, C0, C1); SBAR(); \
    QKM(11, N0, N1); if (!(FIRST)) { VRDJ(1); } EX2(7, C0, C1); SBAR(); \
    if (!(FIRST)) o[0] = __builtin_amdgcn_mfma_f32_32x32x16_bf16(PO0, PKV(0), o[0], 0, 0, 0); if (!(FIRST)) { VRDJ(5); } EX2(8, C0, C1); PK4(C0, 8, PC1); SBAR(); \
    if (!(FIRST)) o[1] = __builtin_amdgcn_mfma_f32_32x32x16_bf16(PO0, PKV(4), o[1], 0, 0, 0); if (!(FIRST)) { VRDJ(2); } EX2(9, C0, C1); SBAR(); \
    if (!(FIRST)) o[0] = __builtin_amdgcn_mfma_f32_32x32x16_bf16(PO1, PKV(1), o[0], 0, 0, 0); if (!(FIRST)) { VRDJ(6); } EX2(10, C0, C1); SBAR(); \
    if (!(FIRST)) o[1] = __builtin_amdgcn_mfma_f32_32x32x16_bf16(PO1, PKV(5), o[1], 0, 0, 0); if (!(FIRST)) { VRDJ(3); } EX2(11, C0, C1); SBAR(); \
    if (!(FIRST)) o[0] = __builtin_amdgcn_mfma_f32_32x32x16_bf16(PO2, PKV(2), o[0], 0, 0, 0); if (!(FIRST)) { VRDJ(7); } EX2(12, C0, C1); PK4(C1, 0, PC2); SBAR(); \
    if (!(FIRST)) o[1] = __builtin_amdgcn_mfma_f32_32x32x16_bf16(PO2, PKV(6), o[1], 0, 0, 0); EX2(13, C0, C1); SBAR(); \
    if (!(FIRST)) o[0] = __builtin_amdgcn_mfma_f32_32x32x16_bf16(PO3, PKV(3), o[0], 0, 0, 0); EX2(14, C0, C1); SBAR(); \
    if (!(FIRST)) o[1] = __builtin_amdgcn_mfma_f32_32x32x16_bf16(PO3, PKV(7), o[1], 0, 0, 0); EX2(15, C0, C1); PK4(C1, 8, PC3); SBAR(); \
    l_reg = l_reg * al + (ps2.x + ps2.y); \
    if (__builtin_expect(__any(pend != 0.f), 0)) {       \
      const float f_ = (FIRST) ? 1.f : __builtin_amdgcn_exp2f(-pend); if (hi == 0) al_l[r32] = f_; asm volatile("s_waitcnt lgkmcnt(0)" ::: "memory"); \
      _Pragma("unroll") for (int r = 0; r < 16; ++r) { const float g_ = al_l[crow(r, hi)]; o[0][r] *= g_; o[1][r] *= g_; N0[r] -= pend; N1[r] -= pend; } \
      pend = 0.f; } \
  } while (0)
  STEP(0, pA0, pA1, pB0, pB1, paA0, paA1, paA2, paA3, paB0, paB1, paB2, paB3, true, 1);
  for (int t = 1; t + 1 < NT; t += 2) {
    STEP(t, pB0, pB1, pA0, pA1, paB0, paB1, paB2, paB3, paA0, paA1, paA2, paA3, false, MLA_CHK_ODD);
    STEP(t + 1, pA0, pA1, pB0, pB1, paA0, paA1, paA2, paA3, paB0, paB1, paB2, paB3, false, 1);
  }
  STEP(NT - 1, pB0, pB1, pA0, pA1, paB0, paB1, paB2, paB3, paA0, paA1, paA2, paA3, false, MLA_CHK_ODD);
  STEP_BAR();
  { const ATT_LAS char* vbp = vbp0 + ((NT - 1) & 3) * VSLOT; s16x4 vl[8], vh[8];
#pragma unroll
    for (int j = 0; j < 8; ++j) VRDJ(j);
    o[0] = __builtin_amdgcn_mfma_f32_32x32x16_bf16(paB0, PKV(0), o[0], 0, 0, 0); o[1] = __builtin_amdgcn_mfma_f32_32x32x16_bf16(paB0, PKV(4), o[1], 0, 0, 0);
    o[0] = __builtin_amdgcn_mfma_f32_32x32x16_bf16(paB1, PKV(1), o[0], 0, 0, 0); o[1] = __builtin_amdgcn_mfma_f32_32x32x16_bf16(paB1, PKV(5), o[1], 0, 0, 0);
    o[0] = __builtin_amdgcn_mfma_f32_32x32x16_bf16(paB2, PKV(2), o[0], 0, 0, 0); o[1] = __builtin_amdgcn_mfma_f32_32x32x16_bf16(paB2, PKV(6), o[1], 0, 0, 0);
    o[0] = __builtin_amdgcn_mfma_f32_32x32x16_bf16(paB3, PKV(3), o[0], 0, 0, 0); o[1] = __builtin_amdgcn_mfma_f32_32x32x16_bf16(paB3, PKV(7), o[1], 0, 0, 0); }
  { auto rr = __builtin_amdgcn_permlane32_swap(__float_as_uint(l_reg), __float_as_uint(l_reg), false, false); l_reg = __uint_as_float(rr[0]) + __uint_as_float(rr[1]); }
  if (hi == 0) li_l[r32] = l_reg; asm volatile("s_waitcnt lgkmcnt(0)" ::: "memory");
  store_o(o, li_l, Ob + (long)(wid * 32) * 512, lds + MLA_OIMG + wid * OIMG_WAVE, lane, r32, hi);
  BAR_V(0);
#undef DMA_K
#undef DMA_V
#undef STEP_BAR
#undef KFR
#undef QKM
#undef VRDJ
#undef PKV
#undef EXQ
#undef CV
#undef EX2
#undef PK4
#undef STEP
}
#undef BAR_L
#undef BAR_V

constexpr int NA_KROWB = 144, NA_LDS_K = 64 * NA_KROWB  , NA_SLOT = NA_LDS_K + 8192  , NA_OIMG = 2 * NA_SLOT + 15 * 32 * 4 + 8 * 256  , NA_LDS = NA_OIMG + 8 * OIMG_WAVE;
template <int CH> __device__ __forceinline__ constexpr bool na_live0(int q) { return CH == 0 ? true : q >= 12; }
template <int CH> __device__ __forceinline__ constexpr bool na_live1(int q) { return CH == 0 ? q < 4 : true; }
template <int CH> __device__ __forceinline__ void na_tile(f32x16& p0, f32x16& p1, const ATT_LAS float* trow, int qcol, int wstart, int hi, int r32, bool first,
                                                          float& m_ref, float& l_reg, f32x16& negm, f32x16 (&o)[2], ATT_LAS float* al_l, int vb) {
  float bz0[16], bz1[16];
#pragma unroll
  for (int q = 0; q < 16; ++q) { const int kc0 = crow(q, hi), kc1 = kc0 + 32;
    if (na_live0<CH>(q)) { const int i0 = min(max(kc0 - qcol + 15, 0), 30); bz0[q] = trow[i0]; }
    if (na_live1<CH>(q)) { const int i1 = min(max(kc1 - qcol + 15, 0), 30); bz1[q] = trow[i1]; } }
#pragma unroll
  for (int q = 0; q < 16; ++q) { if (na_live0<CH>(q)) asm volatile("" : "+v"(bz0[q])); if (na_live1<CH>(q)) asm volatile("" : "+v"(bz1[q])); }
#pragma unroll
  for (int q = 0; q < 16; ++q) { const int kc0 = crow(q, hi), kc1 = kc0 + 32;
    if (na_live0<CH>(q)) p0[q] = ((unsigned)(kc0 - wstart) < 16u) ? p0[q] + bz0[q] : -1e30f;
    if (na_live1<CH>(q)) p1[q] = ((unsigned)(kc1 - wstart) < 16u) ? p1[q] + bz1[q] : -1e30f; }
  float rm = -1e30f;
#pragma unroll
  for (int q = 0; q < 16; ++q) { if (na_live0<CH>(q)) rm = __builtin_fmaxf(rm, p0[q]); if (na_live1<CH>(q)) rm = __builtin_fmaxf(rm, p1[q]); }
  { auto rr = __builtin_amdgcn_permlane32_swap(__float_as_uint(rm), __float_as_uint(rm), false, false); rm = __builtin_fmaxf(__uint_as_float(rr[0]), __uint_as_float(rr[1])); }
  float al = 1.f;
  if (first || !__builtin_expect(__all(rm <= THR), 1)) {
    const float dl = first ? rm : __builtin_fmaxf(rm, 0.f); m_ref += dl;
#pragma unroll
    for (int q = 0; q < 16; ++q) { if (na_live0<CH>(q)) p0[q] -= dl; if (na_live1<CH>(q)) p1[q] -= dl; }
#pragma unroll
    for (int q = 0; q < 16; ++q) negm[q] = -m_ref;
    asm volatile("" : "+v"(negm));
    if (!first) al = __builtin_amdgcn_exp2f(-dl);
    if (__any(al < 1.f)) { if (hi == 0) al_l[r32] = al; asm volatile("s_waitcnt lgkmcnt(0)" ::: "memory");
#pragma unroll
      for (int q = 0; q < 16; ++q) { const float f_ = al_l[crow(q, hi)]; o[0][q] *= f_; o[1][q] *= f_; } }
  }
  float ps = 0.f;
#pragma unroll
  for (int q = 0; q < 16; ++q) { if (na_live0<CH>(q)) { p0[q] = __builtin_amdgcn_exp2f(p0[q]); ps += p0[q]; } else p0[q] = 0.f;
    if (na_live1<CH>(q)) { p1[q] = __builtin_amdgcn_exp2f(p1[q]); ps += p1[q]; } else p1[q] = 0.f; }
  l_reg = l_reg * al + ps;
  bf16x8 pa0, pa1, pa2, pa3;
#define PK4(P, BASE, OUT) do { unsigned a0 = cvtpk(P[BASE + 0], P[BASE + 1]), a1 = cvtpk(P[BASE + 2], P[BASE + 3]);   \
    unsigned b0_ = cvtpk(P[BASE + 4], P[BASE + 5]), b1_ = cvtpk(P[BASE + 6], P[BASE + 7]);                              \
    auto r0_ = __builtin_amdgcn_permlane32_swap(a0, b0_, false, false); auto r1_ = __builtin_amdgcn_permlane32_swap(a1, b1_, false, false); \
    u32x4 w = {r0_[0], r1_[0], r0_[1], r1_[1]}; OUT = *reinterpret_cast<bf16x8*>(&w); } while (0)
  if (CH == 1) { PK4(p0, 8, pa1); PK4(p1, 0, pa2); PK4(p1, 8, pa3); } else { PK4(p0, 0, pa0); PK4(p0, 8, pa1); PK4(p1, 0, pa2); }
#undef PK4
  SBAR();
  { const ATT_LAS char* vbp = (const ATT_LAS char*)(unsigned)vb;
#define NA_VF(D0, KS) const s16x4 l##D0##KS = vtr(vbp + v_rd_off(D0, KS, 0)), h##D0##KS = vtr(vbp + v_rd_off(D0, KS, 1))
#define NA_PV(D0, KS, PA) o[D0] = __builtin_amdgcn_mfma_f32_32x32x16_bf16(PA, (bf16x8){l##D0##KS[0], l##D0##KS[1], l##D0##KS[2], l##D0##KS[3], h##D0##KS[0], h##D0##KS[1], h##D0##KS[2], h##D0##KS[3]}, o[D0], 0, 0, 0)
    NA_VF(0, 1); NA_VF(1, 1); NA_VF(0, 2); NA_VF(1, 2);
    if (CH == 0) { NA_VF(0, 0); NA_VF(1, 0); NA_PV(0, 0, pa0); NA_PV(1, 0, pa0); }
    NA_PV(0, 1, pa1); NA_PV(1, 1, pa1); NA_PV(0, 2, pa2); NA_PV(1, 2, pa2);
    if (CH == 1) { NA_VF(0, 3); NA_VF(1, 3); NA_PV(0, 3, pa3); NA_PV(1, 3, pa3); }
#undef NA_VF
#undef NA_PV
  }
}
__device__ __forceinline__ void na_unit(int b, int h, int rg, const bf16* __restrict__ QKV, bf16* __restrict__ O, const float* __restrict__ rpb, ATT_LAS char* lds, const int wave_id) {
  int lane_; asm volatile("v_mbcnt_lo_u32_b32 %0, -1, 0\n\tv_mbcnt_hi_u32_b32 %0, -1, %0" : "=v"(lane_));
  int w_ = wave_id; asm volatile("" : "+s"(w_));
  const int wid = w_, lane = lane_, tid = wid * 64 + lane, r32 = lane & 31, hi = lane >> 5;
  ATT_LAS char* K_lds = lds; ATT_LAS char* V_lds = lds + NA_LDS_K; ATT_LAS float* tab = (ATT_LAS float*)(lds + 2 * NA_SLOT);
  ATT_LAS float* ws = (ATT_LAS float*)(lds + 2 * NA_SLOT + 15 * 32 * 4) + wid * 64; ATT_LAS float* li_l = ws; ATT_LAS float* al_l = ws + 32;
  const int r0 = 4 * rg, r = r0 + (wid >> 1), ch = wid & 1, qcol = 32 * ch + r32;
  const int rs = min(max(r - 4, 0), 120), lo = min(max(r0 - 4, 0), 120), hiR = min(max(r0 + 3 - 4, 0), 120) + 7;
  const int wstart = min(max(qcol - 8, 0), 48);
  const long tok0 = (long)b * 8192;
  if (tid < 15 * 32) { const int dr = tid >> 5, dc = tid & 31; tab[tid] = (dc < 31) ? rpb[(h * 15 + dr) * 31 + dc] * 1.4426950408889634f : 0.f; }
  bf16x8 qr[4];
  { const bf16* Qw = QKV + (tok0 + r * 64 + qcol) * 1536 + h * 64 + hi * 8;
#pragma unroll
    for (int d0 = 0; d0 < 4; ++d0) qr[d0] = *reinterpret_cast<const bf16x8*>(Qw + d0 * 16); }
  const int srow = tid >> 3, sch = tid & 7; const int kst = srow * NA_KROWB + sch * 16, vst = v_st(srow, sch * 8);
  const int vb0 = (int)(unsigned)(uintptr_t)V_lds + v_rd_base(lane);
  const bf16* Ksrc = QKV + (tok0 + srow) * 1536 + 512 + h * 64 + sch * 8; const bf16* Vsrc = Ksrc + 512;
  float m_ref = 0.f, l_reg = 0.f; f32x16 o[2] = {}; f32x16 negm = {};
#define NA_LD(KR, KV, VV) do { const int kk_ = min((KR), hiR); KV = *reinterpret_cast<const bf16x8*>(Ksrc + (long)kk_ * 64 * 1536); VV = *reinterpret_cast<const bf16x8*>(Vsrc + (long)kk_ * 64 * 1536); } while (0)
#define NA_BODY(KR, KN, VN) do { \
    __syncthreads();                                               \
    if ((KR) + 1 <= hiR) { *(ATT_LAS bf16x8*)(K_lds + (par ^ 1) * NA_SLOT + kst) = KN; *(ATT_LAS bf16x8*)(V_lds + (par ^ 1) * NA_SLOT + vst) = VN; NA_LD((KR) + 3, KN, VN); } \
    if ((KR) >= rs && (KR) < rs + 8) {                              \
      f32x16 p0, p1; qkt_from<4, NA_KROWB>(p0, p1, K_lds + par * NA_SLOT, qr, negm, r32, hi); \
      const ATT_LAS float* trow = tab + ((KR) - r + 7) * 32; \
      if (ch == 0) na_tile<0>(p0, p1, trow, qcol, wstart, hi, r32, (KR) == rs, m_ref, l_reg, negm, o, al_l, vb0 + par * NA_SLOT); \
      else         na_tile<1>(p0, p1, trow, qcol, wstart, hi, r32, (KR) == rs, m_ref, l_reg, negm, o, al_l, vb0 + par * NA_SLOT); \
    } \
    par ^= 1; } while (0)
  bf16x8 k0, v0, k1, v1;
  NA_LD(lo, k0, v0); NA_LD(lo + 1, k1, v1);
  *(ATT_LAS bf16x8*)(K_lds + kst) = k0; *(ATT_LAS bf16x8*)(V_lds + vst) = v0; NA_LD(lo + 2, k0, v0);
  int par = 0;
  for (int kr = lo; kr <= hiR; kr += 2) {
    NA_BODY(kr, k1, v1);
    if (kr + 1 > hiR) break;
    NA_BODY(kr + 1, k0, v0);
  }
#undef NA_LD
#undef NA_BODY
  { auto rr = __builtin_amdgcn_permlane32_swap(__float_as_uint(l_reg), __float_as_uint(l_reg), false, false); l_reg = __uint_as_float(rr[0]) + __uint_as_float(rr[1]); }
  if (hi == 0) li_l[r32] = l_reg; asm volatile("s_waitcnt lgkmcnt(0)" ::: "memory");
  store_o(o, li_l, O + (tok0 + r * 64 + 32 * ch) * 512 + h * 64, lds + NA_OIMG + wid * OIMG_WAVE, lane, r32, hi);
  __syncthreads();
}
#undef SBAR
}

constexpr int NWAVES = 8;
constexpr int NB = 8, SEQ = 8192, DM = 1024, MTOK = NB * SEQ;
constexpr int NIN = 4640, NPROJ = 4864;
constexpr int DFF = 2816, DFFE = 3584, NEXP = 8, PLED = 256;
constexpr int QLORA = 768, KVLORA = 256;
constexpr float ALPHA = 1.4142135623730951f;
constexpr float LN_EPS = 1e-5f, RMS_EPS = 1e-6f;
constexpr float LOG2E = 1.4426950408889634f;
constexpr float NA_QSCALE = 0.125f * LOG2E;
constexpr float MLA_QSCALE = 0.10206207261596575f * LOG2E;
constexpr int MOE_CHUNK = 128, MOE_NCHUNK = 5, MOE_MAXT = 520;

constexpr size_t MiB = 1u << 20;
constexpr size_t WS_CTL = 0, CTL_ZERO_BYTES = 64 * 1024;
constexpr size_t WS_ROPE = 1 * MiB;
constexpr size_t WS_W = 2 * MiB;
constexpr size_t W_WIN = 0, W_WUQ = W_WIN + (size_t)NPROJ * 1024 * 2, W_WUKV = W_WUQ + 768 * 768 * 2, W_WNAO = W_WUKV + 1024 * 256 * 2, W_WMLAO = W_WNAO + 1024 * 512 * 2,
                 W_WOUT = W_WMLAO + 1024 * 512 * 2, W_WPG = W_WOUT + 1024 * 1024 * 2, W_WPLE = W_WPG + 1024 * 1024 * 2, W_LAYER = W_WPLE + 1024 * 256 * 2;
constexpr size_t WS_W13 = WS_W + 2 * W_LAYER, WS_W2 = WS_W13 + (size_t)2 * DFF * 1024 * 2, WS_WEND = WS_W2 + (size_t)1024 * DFF * 2;
static_assert(WS_WEND <= 56 * MiB, "weights");
constexpr size_t WS_SX = 54 * MiB, WS_SX1 = WS_SX + 256 * 1024, WS_SXS = WS_SX + 512 * 1024;
constexpr size_t WS_SWIN = 55 * MiB + 256 * 1024, WS_SW13 = WS_SWIN + 64 * 1024, WS_SWM13 = WS_SW13 + 32 * 1024;
constexpr size_t WS_SWPG = WS_SWM13 + 8 * 7168 * 4;
static_assert(WS_WEND <= WS_SX && WS_SWPG + 2 * 1024 * 4 <= 56 * MiB, "scales");
constexpr size_t WS_PB = 56 * MiB;
constexpr size_t WS_TE = 88 * MiB, WS_TP = 88 * MiB + 512 * 1024, WS_TW = 89 * MiB, WS_TPOS = 89 * MiB + 512 * 1024, WS_SW = 90 * MiB, WS_CNT = 91 * MiB;
constexpr size_t WS_PS = 92 * MiB;
constexpr size_t WS_XB = 96 * MiB;
constexpr size_t WS_QMLA = WS_XB;
constexpr size_t WS_GATES = 224 * MiB;
constexpr size_t WS_NAQKV = 480 * MiB;
constexpr size_t WS_MERGED = WS_NAQKV;
constexpr size_t WS_QLAT = 672 * MiB, WS_KVLAT = 768 * MiB;
constexpr size_t WS_ONA = 672 * MiB, WS_OMLA = 736 * MiB;
constexpr size_t WS_KMLA = 800 * MiB, WS_VMLA = 896 * MiB;
constexpr size_t WS_H = 224 * MiB, WS_PP_DENSE = 576 * MiB;
constexpr size_t WS_PP_MOE = 224 * MiB, WS_XS = 352 * MiB, WS_HS = 612 * MiB, WS_WM13 = 856 * MiB, WS_WM2 = 968 * MiB, WS_END = 1024 * MiB;
static_assert(WS_XS + (size_t)MOE_MAXT * 256 * 1024 * 2 <= WS_HS && WS_HS + (size_t)MOE_CHUNK * 256 * DFFE * 2 <= WS_WM13 && WS_WM13 + (size_t)NEXP * 2 * DFFE * 1024 * 2 == WS_WM2 && WS_WM2 + (size_t)NEXP * 1024 * DFFE * 2 == WS_END, "moe map");
static_assert(WS_H + (size_t)MTOK * DFF * 2 <= WS_PP_DENSE, "dense map");
constexpr size_t WS_G8 = 704 * MiB;
constexpr size_t WS_PART = 836 * MiB;
constexpr int MOE_REM_ROWS = 8 * 256, MOE_FULL = 4 * MOE_CHUNK;
static_assert(WS_PART + (size_t)4 * MOE_REM_ROWS * 1024 * 2 <= WS_WM13, "partials");
static_assert(WS_G8 >= WS_PP_DENSE + (size_t)MTOK * 1024 * 2 && WS_G8 >= WS_HS && WS_G8 + (size_t)MTOK * 1024 <= WS_PART, "gate map");
constexpr int CW_BAR = 4096;
constexpr int RING_OFF = 0, RING_BYTES = 131072;
constexpr int LDSCTL_OFF = RING_BYTES;
constexpr int X_LCNT = RING_BYTES + 512, X_OFF = X_LCNT + 64, X_TOT = X_OFF + 64, X_RTAB = X_TOT + 64, X_PRE = X_RTAB + 4 * 256 * 4, X_END = X_PRE + 256 * 8 * 4;
constexpr int X_SCL = 147456;
constexpr int LDS_BYTES = 155648;
static_assert(X_END <= X_SCL && X_SCL + 4096 <= LDS_BYTES, "LDS map");

#include <hip/hip_bf16.h>
#define GAS __attribute__((address_space(1)))
#define LAS __attribute__((address_space(3)))
typedef unsigned short bf16;
typedef unsigned v4u __attribute__((ext_vector_type(4)));
typedef float f32x4 __attribute__((ext_vector_type(4)));
typedef short bf16x8 __attribute__((ext_vector_type(8)));
typedef GAS unsigned gu32;
typedef GAS unsigned long long gu64;
#define RLX_AGENT __ATOMIC_RELAXED, __HIP_MEMORY_SCOPE_AGENT
#define LDS_WAIT() asm volatile("s_waitcnt lgkmcnt(0)" ::: "memory")
#define VM_WAIT() asm volatile("s_waitcnt vmcnt(0)" ::: "memory")
__device__ __forceinline__ unsigned long long rt() { return __builtin_amdgcn_s_memrealtime(); }
__device__ __forceinline__ unsigned f2bf(float f) { unsigned u = __builtin_bit_cast(unsigned, f); return (u + 0x7fffu + ((u >> 16) & 1u)) >> 16; }
__device__ __forceinline__ unsigned pk2(float lo, float hi) { return f2bf(lo) | (f2bf(hi) << 16); }

#define XB_TMO      128
#define XB_XCNT(j)  (256  + 64 * (j))
#define XB_XSUB(j)  (1280 + 64 * (j))
#define XB_XGEN(j)  (2304 + 64 * (j))
#define XB_TOP      3328
#define XB_TOPGEN   3392
#define XCD_BAR_WORDS 3456
#define XB_SPIN_CAP (1u << 18)

__device__ __forceinline__ unsigned xb_ld(unsigned* p)              { return __hip_atomic_load(p, __ATOMIC_RELAXED, __HIP_MEMORY_SCOPE_AGENT); }
__device__ __forceinline__ unsigned xb_add(unsigned* p, unsigned v) { return __hip_atomic_fetch_add(p, v, __ATOMIC_RELAXED, __HIP_MEMORY_SCOPE_AGENT); }
__device__ __forceinline__ unsigned xb_xcc_id() { return (unsigned)__builtin_amdgcn_s_getreg((3 << 11) | 20) & 0xFu; }
#define XB_SPIN(cond, bar) do { unsigned _sp = 0; while (cond) { __builtin_amdgcn_s_sleep(1); \
    if ((++_sp & 255u) == 0u) { if (xb_ld(&(bar)[XB_TMO])) break; if (_sp > XB_SPIN_CAP) { atomicAdd(&(bar)[XB_TMO], 1u); break; } } } } while (0)

struct XcdBarrier {
    unsigned* bar; unsigned x;
    volatile LAS unsigned* st;
    unsigned w0;
};

__device__ __forceinline__ XcdBarrier xcd_barrier_post(unsigned* bar, volatile LAS unsigned* st) {
    XcdBarrier b; b.bar = bar; b.x = xb_xcc_id(); b.st = st; b.w0 = (unsigned)__builtin_amdgcn_readfirstlane(threadIdx.x < 64u ? 1 : 0);
    if (threadIdx.x == 0) (void)xb_add(&bar[XB_XCNT(b.x)], 1u);
    return b;
}
__device__ __forceinline__ void xcd_barrier_complete(unsigned* bar, unsigned x, unsigned& nloc, unsigned& nx) {
    const unsigned G = gridDim.x * gridDim.y * gridDim.z;
    unsigned sum, cnt, mine, sp = 0u;
    for (;;) {
        sum = 0u; cnt = 0u; mine = 0u;
#pragma unroll
        for (unsigned j = 0; j < 16; ++j) { const unsigned c = xb_ld(&bar[XB_XCNT(j)]); sum += c; cnt += (c > 0u) ? 1u : 0u; mine = (j == x) ? c : mine; }
        if (sum == G) break;
        __builtin_amdgcn_s_sleep(1);
        if ((++sp & 255u) == 0u) { if (xb_ld(&bar[XB_TMO])) break; if (sp > XB_SPIN_CAP) { atomicAdd(&bar[XB_TMO], 1u); break; } }
    }
    nloc = mine > 0u ? mine : 1u; nx = cnt > 0u ? cnt : 1u;
}

__device__ __forceinline__ void xcd_barrier(const XcdBarrier& b) {
    asm volatile("s_waitcnt vmcnt(0)" ::: "memory");
    __syncthreads();
    int xl_; asm volatile("v_mbcnt_lo_u32_b32 %0, -1, 0\n\tv_mbcnt_hi_u32_b32 %0, -1, %0" : "=v"(xl_));
    if (b.w0 && xl_ == 0) {
        unsigned* bar = b.bar;
        __builtin_amdgcn_s_waitcnt(0);
        unsigned nloc = b.st[0], nx = b.st[1];
        if (nloc == 0u) { xcd_barrier_complete(bar, b.x, nloc, nx); b.st[0] = nloc; b.st[1] = nx; }
        const unsigned old = xb_add(&bar[XB_XSUB(b.x)], 1u);
        const unsigned gen = old / nloc;
        if (old + 1u == (gen + 1u) * nloc) {
            __builtin_amdgcn_fence(__ATOMIC_RELEASE, "agent");
            asm volatile("s_waitcnt vmcnt(0)" ::: "memory");
            const unsigned og = xb_add(&bar[XB_TOP], 1u);
            const unsigned tg = og / nx;
            if (og + 1u == (tg + 1u) * nx) xb_add(&bar[XB_TOPGEN], 1u);
            else XB_SPIN(xb_ld(&bar[XB_TOPGEN]) == tg, bar);
            __builtin_amdgcn_fence(__ATOMIC_ACQUIRE, "agent");
            xb_add(&bar[XB_XGEN(b.x)], 1u);
            asm volatile("s_waitcnt vmcnt(0)" ::: "memory");
        } else {
            XB_SPIN(xb_ld(&bar[XB_XGEN(b.x)]) == gen, bar);
            __builtin_amdgcn_fence(__ATOMIC_ACQUIRE, "agent");
            asm volatile("s_waitcnt vmcnt(0)" ::: "memory");
        }
    }
    __syncthreads();
}


typedef unsigned v2u __attribute__((ext_vector_type(2)));
struct Args { const float* in[26]; float* out; unsigned char* ws; int ph_lo, ph_hi; };
struct Frame {
    LAS unsigned char* lds;
    int tid, lane, wave, vcu, G;
};
#define WR_DPP(v, ctrl) __int_as_float(__builtin_amdgcn_update_dpp(0, __float_as_int(v), (ctrl), 0xf, 0xf, true))
__device__ __forceinline__ float wave_sum(float v) {
    v += WR_DPP(v, 0xB1); v += WR_DPP(v, 0x4E); v += WR_DPP(v, 0x141); v += WR_DPP(v, 0x140);
    { const auto r = __builtin_amdgcn_permlane16_swap(__float_as_uint(v), __float_as_uint(v), false, false); v = __uint_as_float(r[0]) + __uint_as_float(r[1]); }
    { const auto r = __builtin_amdgcn_permlane32_swap(__float_as_uint(v), __float_as_uint(v), false, false); v = __uint_as_float(r[0]) + __uint_as_float(r[1]); }
    return v;
}
__device__ __forceinline__ float wave_max(float v) {
    v = fmaxf(v, WR_DPP(v, 0xB1)); v = fmaxf(v, WR_DPP(v, 0x4E)); v = fmaxf(v, WR_DPP(v, 0x141)); v = fmaxf(v, WR_DPP(v, 0x140));
    { const auto r = __builtin_amdgcn_permlane16_swap(__float_as_uint(v), __float_as_uint(v), false, false); v = fmaxf(__uint_as_float(r[0]), __uint_as_float(r[1])); }
    { const auto r = __builtin_amdgcn_permlane32_swap(__float_as_uint(v), __float_as_uint(v), false, false); v = fmaxf(__uint_as_float(r[0]), __uint_as_float(r[1])); }
    return v;
}
__device__ __forceinline__ float half_max32(float v) { const auto r = __builtin_amdgcn_permlane32_swap(__float_as_uint(v), __float_as_uint(v), false, false); return fmaxf(__uint_as_float(r[0]), __uint_as_float(r[1])); }
__device__ __forceinline__ float bflo(unsigned w) { return __uint_as_float(w << 16); }
__device__ __forceinline__ float bfhi(unsigned w) { return __uint_as_float(w & 0xffff0000u); }

__device__ __forceinline__ void tr_item(const float* W, int K, int N, bf16* WT, int g, int s0, int ss, int d0, int ds, const float* gs, LAS float* scr, int item, int ncols, int lane) {
    const int nblk = ncols / 32, kb = item / nblk, nb = item % nblk, k0 = 64 * kb, j0 = 32 * nb;
    const int grp = j0 / g, jin = j0 % g, sn0 = s0 + grp * ss + jin, dn0 = d0 + grp * ds + jin;
    float v[32];
#pragma unroll
    for (int i = 0; i < 32; ++i) { const int kk = 2 * i + (lane >> 5); v[i] = W[(size_t)(k0 + kk) * N + sn0 + (lane & 31)]; }
    if (gs) {
#pragma unroll
        for (int i = 0; i < 32; ++i) v[i] *= gs[k0 + 2 * i + (lane >> 5)]; }
#pragma unroll
    for (int i = 0; i < 32; ++i) scr[(2 * i + (lane >> 5)) * 33 + (lane & 31)] = v[i];
    LDS_WAIT(); asm volatile("" ::: "memory");
    const int c = lane & 7;
#pragma unroll
    for (int j = 0; j < 4; ++j) { const int n = (lane >> 3) + 8 * j; const LAS float* s = scr + (8 * c) * 33 + n;
        v4u o; o.x = pk2(s[0 * 33], s[1 * 33]); o.y = pk2(s[2 * 33], s[3 * 33]); o.z = pk2(s[4 * 33], s[5 * 33]); o.w = pk2(s[6 * 33], s[7 * 33]);
        *(GAS v4u*)(WT + (size_t)(dn0 + n) * K + k0 + 8 * c) = o; }
    LDS_WAIT(); asm volatile("" ::: "memory");
}
__device__ __forceinline__ void tr_job(Frame& F, int& rot, const float* W, int K, int N, int ncols, bf16* WT, int g, int s0, int ss, int d0, int ds, const float* gs) {
    LAS float* scr = (LAS float*)(F.lds + RING_OFF + F.wave * 16384);
    const int NGW = F.G * NWAVES, gw = F.vcu * NWAVES + F.wave, nitems = (K / 64) * (ncols / 32);
    int first = (gw - rot) % NGW; if (first < 0) first += NGW;
    for (int it = first; it < nitems; it += NGW) tr_item(W, K, N, WT, g, s0, ss, d0, ds, gs, scr, it, ncols, F.lane);
    rot = (rot + nitems) % NGW;
}
__device__ __forceinline__ void tr_plain(Frame& F, int& rot, const float* W, int K, int N, bf16* WT) { tr_job(F, rot, W, K, N, N, WT, N, 0, 0, 0, 0, nullptr); }
__device__ __forceinline__ void cvt_rows(Frame& F, const float* src, bf16* dst, size_t n8) {
    const size_t NT = (size_t)F.G * NWAVES * 64, t0 = (size_t)(F.vcu * NWAVES + F.wave) * 64 + F.lane;
    size_t i = t0;
    for (; i + 3 * NT < n8; i += 4 * NT) { f32x4 a[4], b[4];
#pragma unroll
        for (int q = 0; q < 4; ++q) { a[q] = *(const GAS f32x4*)(src + (i + q * NT) * 8); b[q] = *(const GAS f32x4*)(src + (i + q * NT) * 8 + 4); }
#pragma unroll
        for (int q = 0; q < 4; ++q) { v4u o; o.x = pk2(a[q].x, a[q].y); o.y = pk2(a[q].z, a[q].w); o.z = pk2(b[q].x, b[q].y); o.w = pk2(b[q].z, b[q].w); *(GAS v4u*)(dst + (i + q * NT) * 8) = o; } }
    for (; i < n8; i += NT) { const f32x4 a = *(const GAS f32x4*)(src + i * 8), b = *(const GAS f32x4*)(src + i * 8 + 4);
        v4u o; o.x = pk2(a.x, a.y); o.y = pk2(a.z, a.w); o.z = pk2(b.x, b.y); o.w = pk2(b.z, b.w); *(GAS v4u*)(dst + i * 8) = o; }
}

__device__ __forceinline__ unsigned pack4i8(float a, float b, float c, float d) {
    const int ia = (int)__builtin_rintf(a), ib = (int)__builtin_rintf(b), ic = (int)__builtin_rintf(c), id = (int)__builtin_rintf(d);
    return (unsigned)(ia & 0xff) | ((unsigned)(ib & 0xff) << 8) | ((unsigned)(ic & 0xff) << 16) | ((unsigned)id << 24);
}
__device__ __forceinline__ void trq_job(Frame& F, int& rot, const float* W, int K, int N, int ncols, signed char* WQ, float* SC, int g, int s0, int ss, int d0, int ds) {
    LAS float* scr = (LAS float*)(F.lds + RING_OFF + F.wave * 16384);
    const int NGW = F.G * NWAVES, gw = F.vcu * NWAVES + F.wave, nitems = ncols / 32, lane = F.lane;
    int first = (gw - rot) % NGW; if (first < 0) first += NGW;
    for (int it = first; it < nitems; it += NGW) {
        const int j0 = 32 * it, grp = j0 / g, jin = j0 % g, sn0 = s0 + grp * ss + jin, dn0 = d0 + grp * ds + jin;
        const float* wp = W + sn0 + (lane & 31) + (size_t)(lane >> 5) * N;
        float mx = 0.f;
        for (int kb = 0; kb < K / 64; ++kb) { float v[32];
#pragma unroll
            for (int i = 0; i < 32; ++i) v[i] = wp[(size_t)(kb * 64 + 2 * i) * N];
#pragma unroll
            for (int i = 0; i < 32; ++i) mx = fmaxf(mx, fabsf(v[i])); }
        mx = half_max32(mx);
        const float inv = mx > 0.f ? 127.f / mx : 0.f;
        if (lane < 32) SC[dn0 + lane] = mx > 0.f ? mx * (1.f / 127.f) : 1.f;
        for (int kb = 0; kb < K / 64; ++kb) { float v[32];
#pragma unroll
            for (int i = 0; i < 32; ++i) v[i] = wp[(size_t)(kb * 64 + 2 * i) * N];
#pragma unroll
            for (int i = 0; i < 32; ++i) scr[(2 * i + (lane >> 5)) * 33 + (lane & 31)] = v[i] * inv;
            LDS_WAIT(); asm volatile("" ::: "memory");
            const int n = lane >> 1, hf = lane & 1; const LAS float* s = scr + (hf * 32) * 33 + n;
            v4u o0, o1;
            o0.x = pack4i8(s[0 * 33], s[1 * 33], s[2 * 33], s[3 * 33]); o0.y = pack4i8(s[4 * 33], s[5 * 33], s[6 * 33], s[7 * 33]); o0.z = pack4i8(s[8 * 33], s[9 * 33], s[10 * 33], s[11 * 33]); o0.w = pack4i8(s[12 * 33], s[13 * 33], s[14 * 33], s[15 * 33]);
            o1.x = pack4i8(s[16 * 33], s[17 * 33], s[18 * 33], s[19 * 33]); o1.y = pack4i8(s[20 * 33], s[21 * 33], s[22 * 33], s[23 * 33]); o1.z = pack4i8(s[24 * 33], s[25 * 33], s[26 * 33], s[27 * 33]); o1.w = pack4i8(s[28 * 33], s[29 * 33], s[30 * 33], s[31 * 33]);
            GAS v4u* dp = (GAS v4u*)(WQ + (size_t)(dn0 + n) * K + kb * 64 + hf * 32); dp[0] = o0; dp[1] = o1;
            LDS_WAIT(); asm volatile("" ::: "memory"); }
    }
    rot = (rot + nitems) % NGW;
}
__device__ __forceinline__ void store_q8(signed char* XQ, float* SX, size_t m, const f32x4 (&v)[4], int lane) {
    float mx = 0.f;
#pragma unroll
    for (int j = 0; j < 4; ++j) mx = fmaxf(fmaxf(mx, fmaxf(fabsf(v[j].x), fabsf(v[j].y))), fmaxf(fabsf(v[j].z), fabsf(v[j].w)));
    mx = wave_max(mx);
    const float inv = mx > 0.f ? 127.f / mx : 0.f;
    GAS unsigned* o4 = (GAS unsigned*)(XQ + m * DM) + lane;
#pragma unroll
    for (int j = 0; j < 4; ++j) o4[64 * j] = pack4i8(v[j].x * inv, v[j].y * inv, v[j].z * inv, v[j].w * inv);
    if (lane == 0) SX[m] = mx > 0.f ? mx * (1.f / 127.f) : 1.f;
}

template <class Sched> __device__ __forceinline__ void rms_prepass(Frame& F, const Sched& S, const float* PS, int p0, int NP, int K) {
    LAS float* rtab = (LAS float*)(F.lds + X_RTAB); pg8::Unit u;
    if (F.tid < 256) {
        for (int i = 0; i < 4 && S.next(i, u); ++i) { const GAS f32x4* pp = (const GAS f32x4*)(PS + (size_t)(u.pa * 256 + F.tid) * 16 + p0);
            float s = 0.f;
            for (int j = 0; j < NP / 4; ++j) { const f32x4 x = pp[j]; s += (x[0] + x[1]) + (x[2] + x[3]); }
            rtab[i * 256 + F.tid] = 1.0f / sqrtf(s / (float)K + RMS_EPS); }
    }
    LDS_WAIT(); __syncthreads();
}

__device__ __forceinline__ void ln_core(f32x4 (&v)[4], const f32x4 (&g)[4], const f32x4 (&bb)[4]) {
    float s = 0.f;
#pragma unroll
    for (int j = 0; j < 4; ++j) s += (v[j].x + v[j].y) + (v[j].z + v[j].w);
    const float mean = wave_sum(s) * (1.f / DM); float s2 = 0.f;
#pragma unroll
    for (int j = 0; j < 4; ++j) { v[j] = v[j] - mean; s2 += (v[j].x * v[j].x + v[j].y * v[j].y) + (v[j].z * v[j].z + v[j].w * v[j].w); }
    const float rstd = 1.f / sqrtf(wave_sum(s2) * (1.f / DM) + LN_EPS);
#pragma unroll
    for (int j = 0; j < 4; ++j) v[j] = v[j] * rstd * g[j] + bb[j];
}
__device__ __forceinline__ void store_row(float* R, bf16* XB, size_t m, const f32x4 (&v)[4], int lane, bool wb) {
    GAS f32x4* o = (GAS f32x4*)(R + m * DM) + lane;
#pragma unroll
    for (int j = 0; j < 4; ++j) o[64 * j] = v[j];
    if (wb) { GAS unsigned long long* o8 = (GAS unsigned long long*)(XB + m * DM) + lane;
#pragma unroll
        for (int j = 0; j < 4; ++j) o8[64 * j] = (unsigned long long)pk2(v[j].x, v[j].y) | ((unsigned long long)pk2(v[j].z, v[j].w) << 32); }
}

__device__ __forceinline__ void load_bf(f32x4 (&v)[4], const bf16* Y, size_t m, int lane) {
    const GAS v2u* p = (const GAS v2u*)(Y + m * DM) + lane;
#pragma unroll
    for (int j = 0; j < 4; ++j) { const v2u w = p[64 * j]; v[j].x = bflo(w.x); v[j].y = bfhi(w.x); v[j].z = bflo(w.y); v[j].w = bfhi(w.y); }
}
__device__ __forceinline__ void store_bf(bf16* XB, size_t m, const f32x4 (&v)[4], int lane) {
    GAS unsigned long long* o8 = (GAS unsigned long long*)(XB + m * DM) + lane;
#pragma unroll
    for (int j = 0; j < 4; ++j) o8[64 * j] = (unsigned long long)pk2(v[j].x, v[j].y) | ((unsigned long long)pk2(v[j].z, v[j].w) << 32);
}
__device__ __forceinline__ void moe_tables(Frame& F, const int* CNT, bool wantPre) {
    LAS int* tot = (LAS int*)(F.lds + X_TOT); LAS int* off = (LAS int*)(F.lds + X_OFF); LAS int* pre = (LAS int*)(F.lds + X_PRE);
    const int e = F.wave;
    int carry = 0;
    for (int b0 = 0; b0 < F.G; b0 += 64) { const int blk = b0 + F.lane; const int v = (blk < F.G) ? CNT[blk * 8 + e] : 0;
        int inc = v;
#pragma unroll
        for (int o = 1; o < 64; o <<= 1) { const int t = __builtin_amdgcn_ds_bpermute(4 * (F.lane - o), inc); if (F.lane >= o) inc += t; }
        if (wantPre && blk < F.G && blk < 256) pre[blk * 8 + e] = carry + inc - v;
        carry += __builtin_amdgcn_readlane(inc, 63); }
    if (F.lane == 0) tot[e] = carry;
    LDS_WAIT(); __syncthreads();
    if (F.tid == 0) { int o = 0; for (int j = 0; j < 8; ++j) { off[j] = o; o += (tot[j] + 255) & ~255; } off[8] = o; }
    LDS_WAIT(); __syncthreads();
}

#ifndef REP_P0
#define REP_P0 1
#endif
#ifndef REP_MC
#define REP_MC 1
#endif
#ifndef REP_A
#define REP_A 1
#endif
#ifndef REP_MU
#define REP_MU 1
#endif
#ifndef REP_MD
#define REP_MD 1
#endif
#ifndef REP_B
#define REP_B 1
#endif
#ifndef REP_D
#define REP_D 1
#endif
#ifndef REP_FU
#define REP_FU 1
#endif
#ifndef REP_PM
#define REP_PM 1
#endif
#ifndef REP_LN
#define REP_LN 1
#endif
#ifndef REP_NA
#define REP_NA 1
#endif
#ifndef REP_MLA
#define REP_MLA 1
#endif
#ifndef EN_P0
#define EN_P0 1
#endif
#ifndef EN_A
#define EN_A 1
#endif
#ifndef EN_B
#define EN_B 1
#endif
#ifndef EN_C
#define EN_C 1
#endif
#ifndef EN_D
#define EN_D 1
#endif
#ifndef EN_E
#define EN_E 1
#endif
#ifndef EN_F
#define EN_F 1
#endif
#ifndef EN_G0
#define EN_G0 1
#endif
#ifndef EN_H0
#define EN_H0 1
#endif
#ifndef EN_G1
#define EN_G1 1
#endif
#ifndef EN_U1
#define EN_U1 1
#endif
#ifndef EN_D1
#define EN_D1 1
#endif
#ifndef EN_I
#define EN_I 1
#endif
__global__ void __launch_bounds__(NWAVES * 64, 2) mk_fwd(Args args) {
    extern __shared__ __attribute__((aligned(16))) unsigned char lds[];
    Frame F;
    F.lds = (LAS unsigned char*)lds;
    volatile LAS unsigned* MISC = (volatile LAS unsigned*)(F.lds + LDSCTL_OFF);
    F.tid = threadIdx.x; F.lane = F.tid & 63; F.wave = __builtin_amdgcn_readfirstlane(F.tid >> 6);
    F.G = gridDim.x; { const int bx = blockIdx.x; F.vcu = (F.G % 8 == 0) ? (bx % 8) * (F.G / 8) + bx / 8 : bx; }
    unsigned char* ws = args.ws; float* R = args.out;
    for (int u = F.tid; u < 128; u += NWAVES * 64) ((LAS unsigned*)(F.lds + LDSCTL_OFF))[u] = 0u;
    __syncthreads();
    const int lo = args.ph_lo, hi = args.ph_hi;
    const bool multi = (hi - lo) > 1;
    XcdBarrier bar; bar.bar = (unsigned*)(ws + WS_CTL) + CW_BAR; bar.x = 0; bar.st = nullptr; bar.w0 = 0;
    if (multi) bar = xcd_barrier_post((unsigned*)(ws + WS_CTL) + CW_BAR, MISC + 8);
    int ph = 0;
#define IN() (lo <= ph && ph < hi)
#define PH_BEGIN() do { int l_; asm volatile("v_mbcnt_lo_u32_b32 %0, -1, 0\n\tv_mbcnt_hi_u32_b32 %0, -1, %0" : "=v"(l_)); F.lane = l_; F.tid = F.wave * 64 + l_; } while (0)
#define SEAM() do { if (lo <= ph && ph + 1 < hi) xcd_barrier(bar); ++ph; } while (0)
    LAS unsigned char* ring = F.lds + RING_OFF;
    bf16* const XB = (bf16*)(ws + WS_XB);
    const float* const ROPE = (const float*)(ws + WS_ROPE);

    if (IN() && EN_P0) { PH_BEGIN();
        int rot = 0;
        for (int rep_ = 0; rep_ < REP_P0; ++rep_)
        for (int L = 0; L < 2; ++L) {
            bf16* WL = (bf16*)(ws + WS_W + (size_t)L * W_LAYER);
            const float* win = args.in[2] + (size_t)L * 1024 * NIN;
            bf16* WIN = (bf16*)((unsigned char*)WL + W_WIN);
            signed char* WINQ = (signed char*)WIN; float* swin = (float*)(ws + WS_SWIN) + L * NPROJ;
            trq_job(F, rot, win, 1024, NIN, 1536, WINQ, swin, 1536, 0, 0, 0, 0);
            trq_job(F, rot, win, 1024, NIN, 768, WINQ, swin, 768, 1536, 0, 1536, 0);
            trq_job(F, rot, win, 1024, NIN, 2048, WINQ, swin, 2048, 2592, 0, 2304, 0);
            trq_job(F, rot, win, 1024, NIN, 256, WINQ, swin, 256, 2304, 0, 4352, 0);
            trq_job(F, rot, win, 1024, NIN, 32, WINQ, swin, 32, 2560, 0, 4608, 0);
            { const size_t n16 = (size_t)(NPROJ - 4640) * 1024 / 16, NT = (size_t)F.G * NWAVES * 64; signed char* z = WINQ + (size_t)4640 * 1024;
              for (size_t i = (size_t)(F.vcu * NWAVES + F.wave) * 64 + F.lane; i < n16; i += NT) *(GAS v4u*)(z + i * 16) = (v4u){0u, 0u, 0u, 0u};
              for (size_t i = (size_t)(F.vcu * NWAVES + F.wave) * 64 + F.lane; i < (size_t)(NPROJ - 4640); i += NT) swin[4640 + i] = 1.f; }
            tr_job(F, rot, args.in[5] + (size_t)L * 768 * 768, 768, 768, 768, (bf16*)((unsigned char*)WL + W_WUQ), 768, 0, 0, 0, 0, args.in[4] + L * 768);
            const float* wukv = args.in[7] + (size_t)L * 256 * 1024; const float* kvg = args.in[6] + L * 256;
            tr_job(F, rot, wukv, 256, 1024, 512, (bf16*)((unsigned char*)WL + W_WUKV), 64, 0, 128, 0, 64, kvg);
            tr_job(F, rot, wukv, 256, 1024, 512, (bf16*)((unsigned char*)WL + W_WUKV), 64, 64, 128, 512, 64, kvg);
            tr_plain(F, rot, args.in[9] + (size_t)L * 512 * 1024, 512, 1024, (bf16*)((unsigned char*)WL + W_WNAO));
            tr_plain(F, rot, args.in[10] + (size_t)L * 512 * 1024, 512, 1024, (bf16*)((unsigned char*)WL + W_WMLAO));
            tr_plain(F, rot, args.in[11] + (size_t)L * 1024 * 1024, 1024, 1024, (bf16*)((unsigned char*)WL + W_WOUT));
            trq_job(F, rot, args.in[22] + (size_t)L * 1024 * 1024, 1024, 1024, 1024, (signed char*)((unsigned char*)WL + W_WPG), (float*)(ws + WS_SWPG) + L * 1024, 1024, 0, 0, 0, 0);
            tr_plain(F, rot, args.in[23] + (size_t)L * 256 * 1024, 256, 1024, (bf16*)((unsigned char*)WL + W_WPLE));
        }
        trq_job(F, rot, args.in[14], 1024, DFF, DFF, (signed char*)(ws + WS_W13), (float*)(ws + WS_SW13), 128, 0, 128, 0, 256);
        trq_job(F, rot, args.in[15], 1024, DFF, DFF, (signed char*)(ws + WS_W13), (float*)(ws + WS_SW13), 128, 0, 128, 128, 256);
        tr_plain(F, rot, args.in[16], DFF, 1024, (bf16*)(ws + WS_W2));
        { const int NT = F.G * NWAVES * 64; float* rt_ = (float*)(ws + WS_ROPE);
          for (int i = (F.vcu * NWAVES + F.wave) * 64 + F.lane; i < SEQ * 16; i += NT) { const int pos = i >> 4, k = i & 15;
              double invf = 1.0; for (int q_ = 0; q_ < k; ++q_) invf *= 0.5623413251903491;
              const double rev = (double)pos * invf * 0.15915494309189535; const float fr_ = (float)(rev - floor(rev));
              rt_[2 * i] = __builtin_amdgcn_cosf(fr_); rt_[2 * i + 1] = __builtin_amdgcn_sinf(fr_); } }
        { const int gw = F.vcu * NWAVES + F.wave, NGW = F.G * NWAVES;
          for (int m = gw; m < MTOK; m += NGW) { f32x4 v[4]; const GAS f32x4* xr = (const GAS f32x4*)(args.in[0] + (size_t)m * DM) + F.lane;
#pragma unroll
              for (int j = 0; j < 4; ++j) v[j] = xr[64 * j];
              store_bf(XB, (size_t)m, v, F.lane); store_q8((signed char*)R + (128u << 20), (float*)(ws + WS_SX), (size_t)m, v, F.lane); } }
    }
    SEAM();

    for (int L = 0; L < 2; ++L) {
        unsigned char* WL = ws + WS_W + (size_t)L * W_LAYER;
        if (IN() && EN_A) { PH_BEGIN();
            pg8::Gemm g{(const pg8::bf16_t*)((const signed char*)R + (128u << 20)), (const pg8::bf16_t*)(WL + W_WIN), MTOK, NPROJ, 512, 0, 0}; pg8::StaticOrder S; S.init(MTOK, NPROJ, F.G, (int)blockIdx.x);
            pg8::EpiProj E{(bf16*)(ws + WS_NAQKV), (bf16*)(ws + WS_QLAT), (bf16*)(ws + WS_GATES), (bf16*)(ws + WS_KVLAT), (bf16*)(ws + WS_KMLA), args.in[3] + L * 2048, ROPE, NA_QSCALE, (float*)(ws + WS_PS), (const float*)(ws + WS_SX), (const float*)(ws + WS_SWIN) + L * NPROJ, (LAS float*)(F.lds + X_SCL)};
            for (int rep_ = 0; rep_ < REP_A; ++rep_) { pg8::gemm_phase<pg8::EpiProj, pg8::StaticOrder, true, true, true>(ring, g, S, E, F.wave); __syncthreads(); }
        }
        SEAM();
        if (IN() && EN_B) { PH_BEGIN();
            for (int rep_ = 0; rep_ < REP_B; ++rep_) {
            { pg8::Gemm g{(const pg8::bf16_t*)(ws + WS_QLAT), (const pg8::bf16_t*)(WL + W_WUQ), MTOK, 768, 768}; pg8::StaticOrder S; S.init(MTOK, 768, F.G, (int)blockIdx.x);
              asm volatile("" : "+s"(S.c), "+s"(S.G)); rms_prepass(F, S, (const float*)(ws + WS_PS), 0, 12, 768); asm volatile("" : "+s"(S.c), "+s"(S.G));
              pg8::EpiQup E{(bf16*)R, (const LAS float*)(F.lds + X_RTAB), ROPE, MLA_QSCALE};
              pg8::gemm_phase<pg8::EpiQup, pg8::StaticOrder, true, true>(ring, g, S, E, F.wave); }
            __syncthreads(); PH_BEGIN();
            { pg8::Gemm g{(const pg8::bf16_t*)(ws + WS_KVLAT), (const pg8::bf16_t*)(WL + W_WUKV), MTOK, 1024, 256}; pg8::StaticOrder S; S.init(MTOK, 1024, F.G, (int)blockIdx.x);
              asm volatile("" : "+s"(S.c), "+s"(S.G)); rms_prepass(F, S, (const float*)(ws + WS_PS), 12, 4, 256); asm volatile("" : "+s"(S.c), "+s"(S.G));
              pg8::EpiKVup E{(bf16*)(ws + WS_KMLA), (bf16*)(ws + WS_VMLA), (const LAS float*)(F.lds + X_RTAB)};
              pg8::gemm_phase<pg8::EpiKVup, pg8::StaticOrder, true, true>(ring, g, S, E, F.wave); }
            __syncthreads(); }
        }
        SEAM();
        if (IN() && EN_C) { PH_BEGIN();
            const float* rpb = args.in[8] + (size_t)L * 8 * 15 * 31;
            for (int rep_ = 0; rep_ < REP_NA; ++rep_)
            for (int uid = F.vcu; uid < 2048; uid += F.G) { const int pair = uid >> 5, rg = uid & 31;
                att::na_unit(pair >> 3, pair & 7, rg, (const att::bf16*)(ws + WS_NAQKV), (att::bf16*)(ws + WS_ONA), rpb, (LAS char*)ring, F.wave); }
            for (int rep_ = 0; rep_ < REP_MLA; ++rep_)
            for (int uid = F.vcu; uid < 2048; uid += F.G) { const int pair = uid >> 5, qb = uid & 31, b = pair >> 3, h = pair & 7;
                const size_t row0 = (size_t)b * SEQ;
                att::mla_unit((const att::bf16*)R + (row0 + qb * 256) * 768 + h * 96, (const att::bf16*)(ws + WS_KMLA) + row0 * 768 + h * 96,
                              (const att::bf16*)(ws + WS_VMLA) + row0 * 512 + h * 64, (att::bf16*)(ws + WS_OMLA) + (row0 + qb * 256) * 512 + h * 64, SEQ, (LAS char*)ring, F.wave); }
        }
        SEAM();
        if (IN() && EN_D) { PH_BEGIN();
            for (int rep_ = 0; rep_ < REP_D; ++rep_) {
            pg8::StaticOrder S; S.init(MTOK, 1024, F.G, (int)blockIdx.x);
            { pg8::Gemm g{(const pg8::bf16_t*)(ws + WS_ONA), (const pg8::bf16_t*)(WL + W_WNAO), MTOK, 1024, 512};
              pg8::EpiMerge E{(const unsigned char*)(ws + WS_GATES), (pg8::bf16_t*)(ws + WS_MERGED), 0};
              pg8::gemm_phase<pg8::EpiMerge, pg8::StaticOrder, true, true>(ring, g, S, E, F.wave); }
            __syncthreads();
            { pg8::Gemm g{(const pg8::bf16_t*)(ws + WS_OMLA), (const pg8::bf16_t*)(WL + W_WMLAO), MTOK, 1024, 512};
              pg8::EpiMerge E{(const unsigned char*)(ws + WS_GATES) + 1024, (pg8::bf16_t*)(ws + WS_MERGED), 1};
              pg8::gemm_phase<pg8::EpiMerge, pg8::StaticOrder, true, true>(ring, g, S, E, F.wave); }
            __syncthreads(); }
        }
        SEAM();
        if (IN() && EN_E) { PH_BEGIN();
            { pg8::Gemm g{(const pg8::bf16_t*)(ws + WS_MERGED), (const pg8::bf16_t*)(WL + W_WOUT), MTOK, 1024, 1024}; pg8::StaticOrder S; S.init(MTOK, 1024, F.G, (int)blockIdx.x);
              pg8::EpiRes<0> E{(const pg8::bf16_t*)XB, (pg8::bf16_t*)R, nullptr, ALPHA};
              pg8::gemm_phase<pg8::EpiRes<0>, pg8::StaticOrder, true, true>(ring, g, S, E, F.wave); }
            if (L == 1) { __syncthreads(); PH_BEGIN(); int rot = 0;
                for (int rep_ = 0; rep_ < REP_MC; ++rep_)
                for (int e = 0; e < NEXP; ++e) {
                    signed char* w13 = (signed char*)(ws + WS_WM13) + (size_t)e * 2 * DFFE * 1024; float* sc13 = (float*)(ws + WS_SWM13) + (size_t)e * 2 * DFFE;
                    trq_job(F, rot, args.in[19] + (size_t)e * 1024 * DFFE, 1024, DFFE, DFFE, w13, sc13, 128, 0, 128, 0, 256);
                    trq_job(F, rot, args.in[20] + (size_t)e * 1024 * DFFE, 1024, DFFE, DFFE, w13, sc13, 128, 0, 128, 128, 256);
                    tr_plain(F, rot, args.in[21] + (size_t)e * DFFE * 1024, DFFE, 1024, (bf16*)(ws + WS_WM2) + (size_t)e * 1024 * DFFE); } }
        }
        SEAM();
        if (IN() && EN_F) { PH_BEGIN();
            f32x4 g[4], bb[4];
            { const GAS f32x4* gp = (const GAS f32x4*)(args.in[12] + L * DM) + F.lane; const GAS f32x4* bp = (const GAS f32x4*)(args.in[13] + L * DM) + F.lane;
#pragma unroll
              for (int j = 0; j < 4; ++j) { g[j] = gp[64 * j]; bb[j] = bp[64 * j]; } }
            LAS float* wrl = (LAS float*)ring; LAS int* lcnt = (LAS int*)(F.lds + X_LCNT);
            if (L == 1) { const float* wr = args.in[17];
                for (int i = F.tid; i < 1024 * 8 / 4; i += NWAVES * 64) ((LAS f32x4*)wrl)[i] = ((const GAS f32x4*)wr)[i];
                if (F.tid < 8) lcnt[F.tid] = 0;
                LDS_WAIT(); __syncthreads(); }
            const int gw = F.vcu * NWAVES + F.wave, NGW = F.G * NWAVES;
            if (REP_LN > 1) for (int m = gw; m < MTOK; m += NGW) {
                f32x4 v[4]; const GAS f32x4* xr = (const GAS f32x4*)(R + (size_t)m * DM) + F.lane;
#pragma unroll
                for (int j = 0; j < 4; ++j) v[j] = xr[64 * j];
                ln_core(v, g, bb);
                store_row((float*)(ws + WS_GATES), XB, (size_t)m, v, F.lane, true); }
            v2u raw[4];
            { const GAS v2u* p_ = (const GAS v2u*)((const bf16*)R + (size_t)gw * DM) + F.lane;
#pragma unroll
              for (int j = 0; j < 4; ++j) raw[j] = p_[64 * j]; }
            for (int m = gw; m < MTOK; m += NGW) {
                f32x4 v[4];
#pragma unroll
                for (int j = 0; j < 4; ++j) { v[j].x = bflo(raw[j].x); v[j].y = bfhi(raw[j].x); v[j].z = bflo(raw[j].y); v[j].w = bfhi(raw[j].y); }
                if (m + NGW < MTOK) { const GAS v2u* p_ = (const GAS v2u*)((const bf16*)R + (size_t)(m + NGW) * DM) + F.lane;
#pragma unroll
                    for (int j = 0; j < 4; ++j) raw[j] = p_[64 * j]; }
                ln_core(v, g, bb);
                store_bf(XB, (size_t)m, v, F.lane);
                store_q8((signed char*)R + (192u << 20), (float*)(ws + WS_SX1), (size_t)m, v, F.lane);
                if (L == 1) {
                    float lg[8];
#pragma unroll
                    for (int e = 0; e < 8; ++e) lg[e] = 0.f;
#pragma unroll
                    for (int j = 0; j < 4; ++j)
#pragma unroll
                        for (int t = 0; t < 4; ++t) { const int k = 4 * F.lane + 256 * j + t; const f32x4 w0 = *(const LAS f32x4*)(wrl + k * 8), w1 = *(const LAS f32x4*)(wrl + k * 8 + 4); const float xv = v[j][t];
                            lg[0] += xv * w0.x; lg[1] += xv * w0.y; lg[2] += xv * w0.z; lg[3] += xv * w0.w; lg[4] += xv * w1.x; lg[5] += xv * w1.y; lg[6] += xv * w1.z; lg[7] += xv * w1.w; }
#pragma unroll
                    for (int e = 0; e < 8; ++e) lg[e] = wave_sum(lg[e]) + args.in[18][e];
                    int i0 = 0; float l0 = lg[0];
#pragma unroll
                    for (int e = 1; e < 8; ++e) if (lg[e] > l0) { l0 = lg[e]; i0 = e; }
                    int i1 = -1; float l1 = -3.0e38f;
#pragma unroll
                    for (int e = 0; e < 8; ++e) if (e != i0 && lg[e] > l1) { l1 = lg[e]; i1 = e; }
                    const float w0 = 1.0f / (1.0f + __expf(l1 - l0)), w1 = 1.0f - w0;
                    if (F.lane == 0) {
                        const int lp0 = __hip_atomic_fetch_add(lcnt + i0, 1, __ATOMIC_RELAXED, __HIP_MEMORY_SCOPE_WORKGROUP), lp1 = __hip_atomic_fetch_add(lcnt + i1, 1, __ATOMIC_RELAXED, __HIP_MEMORY_SCOPE_WORKGROUP);
                        ((int*)(ws + WS_TE))[m] = i0 | (i1 << 4) | ((int)blockIdx.x << 8);
                        ((int2*)(ws + WS_TP))[m] = make_int2(lp0, lp1); ((float2*)(ws + WS_TW))[m] = make_float2(w0, w1); }
                }
            }
            if (L == 1) { LDS_WAIT(); __syncthreads(); if (F.tid < 8) ((int*)(ws + WS_CNT))[blockIdx.x * 8 + F.tid] = lcnt[F.tid]; }
            cvt_rows(F, args.in[1] + (size_t)L * MTOK * PLED, (bf16*)(ws + WS_PB), (size_t)MTOK * PLED / 8);
        }
        SEAM();
        if (L == 0) {
            if (IN() && EN_G0) { PH_BEGIN();
                { pg8::Gemm g{(const pg8::bf16_t*)((const signed char*)R + (192u << 20)), (const pg8::bf16_t*)(ws + WS_W13), MTOK, 2 * DFF, 512, 0, 0}; pg8::StaticOrder S; S.init(MTOK, 2 * DFF, F.G, (int)blockIdx.x);
                  pg8::EpiGLUQ E{(pg8::bf16_t*)(ws + WS_H), DFF, (const float*)(ws + WS_SX1), (const float*)(ws + WS_SW13), (LAS float*)(F.lds + X_SCL)};
                  for (int rep_ = 0; rep_ < REP_FU; ++rep_) { pg8::gemm_phase<pg8::EpiGLUQ, pg8::StaticOrder, true, true, true>(ring, g, S, E, F.wave); __syncthreads(); } }
                __syncthreads();
                pg8::StaticOrder S; S.init(MTOK, 1024, F.G, (int)blockIdx.x);
                { pg8::Gemm g{(const pg8::bf16_t*)((const signed char*)R + (192u << 20)), (const pg8::bf16_t*)(WL + W_WPG), MTOK, 1024, 512, 0, 0};
                  pg8::EpiGate8 E{(unsigned char*)(ws + WS_G8), (const float*)(ws + WS_SX1), (const float*)(ws + WS_SWPG) + L * 1024, (LAS float*)(F.lds + X_SCL)};
                  pg8::gemm_phase<pg8::EpiGate8, pg8::StaticOrder, true, true, true>(ring, g, S, E, F.wave); }
                __syncthreads();
                { pg8::Gemm g{(const pg8::bf16_t*)(ws + WS_PB), (const pg8::bf16_t*)(WL + W_WPLE), MTOK, 1024, 256};
                  pg8::EpiGateMul E{(const unsigned char*)(ws + WS_G8), (pg8::bf16_t*)(ws + WS_PP_DENSE)};
                  pg8::gemm_phase<pg8::EpiGateMul, pg8::StaticOrder, true, true>(ring, g, S, E, F.wave); }
            }
            SEAM();
            if (IN() && EN_H0) { PH_BEGIN();
                pg8::Gemm g{(const pg8::bf16_t*)(ws + WS_H), (const pg8::bf16_t*)(ws + WS_W2), MTOK, 1024, DFF}; pg8::StaticOrder S; S.init(MTOK, 1024, F.G, (int)blockIdx.x);
                pg8::EpiRes<2> E{(const pg8::bf16_t*)XB, (pg8::bf16_t*)R, (pg8::bf16_t*)(ws + WS_PP_DENSE), ALPHA};
                pg8::gemm_phase<pg8::EpiRes<2>, pg8::StaticOrder, true, true>(ring, g, S, E, F.wave);
            }
            SEAM();
        } else {
            if (IN() && EN_G1) { PH_BEGIN();
                moe_tables(F, (const int*)(ws + WS_CNT), true);
                if (blockIdx.x == 0 && F.tid < 9) ((int*)(ws + WS_CNT + 49152))[F.tid] = ((const LAS int*)(F.lds + X_OFF))[F.tid];
                { const LAS int* off = (const LAS int*)(F.lds + X_OFF); const LAS int* pre = (const LAS int*)(F.lds + X_PRE);
                  const int gw = F.vcu * NWAVES + F.wave, NGW = F.G * NWAVES;
                  for (int m0 = gw; m0 < MTOK; m0 += 4 * NGW) {
                      int te[4]; int2 tp[4]; float2 tw[4]; int d0[4], d1[4]; v4u ra[4], rb[4];
#pragma unroll
                      for (int q = 0; q < 4; ++q) { const int m = m0 + q * NGW; te[q] = ((const int*)(ws + WS_TE))[m]; tp[q] = ((const int2*)(ws + WS_TP))[m]; tw[q] = ((const float2*)(ws + WS_TW))[m]; }
#pragma unroll
                      for (int q = 0; q < 4; ++q) { const int m = m0 + q * NGW; ra[q] = ((const GAS v4u*)((const signed char*)R + (192u << 20) + (size_t)m * DM))[F.lane]; rb[q].x = __float_as_uint(((const float*)(ws + WS_SX1))[m]); }
#pragma unroll
                      for (int q = 0; q < 4; ++q) { const int e0 = te[q] & 15, e1 = (te[q] >> 4) & 15, blk = te[q] >> 8;
                          d0[q] = off[e0] + pre[blk * 8 + e0] + tp[q].x; d1[q] = off[e1] + pre[blk * 8 + e1] + tp[q].y; }
#pragma unroll
                      for (int q = 0; q < 4; ++q) { const int m = m0 + q * NGW;
                          ((GAS v4u*)((signed char*)R + (size_t)d0[q] * DM))[F.lane] = ra[q]; ((GAS v4u*)((signed char*)R + (size_t)d1[q] * DM))[F.lane] = ra[q];
                          if (F.lane == 0) { ((float*)(ws + WS_SW))[d0[q]] = tw[q].x; ((float*)(ws + WS_SW))[d1[q]] = tw[q].y; ((int2*)(ws + WS_TPOS))[m] = make_int2(d0[q], d1[q]);
                              ((float*)(ws + WS_SXS))[d0[q]] = __uint_as_float(rb[q].x); ((float*)(ws + WS_SXS))[d1[q]] = __uint_as_float(rb[q].x); } } } }
                __syncthreads();
                pg8::StaticOrder S; S.init(MTOK, 1024, F.G, (int)blockIdx.x);
                { pg8::Gemm g{(const pg8::bf16_t*)((const signed char*)R + (192u << 20)), (const pg8::bf16_t*)(WL + W_WPG), MTOK, 1024, 512, 0, 0};
                  pg8::EpiGate8 E{(unsigned char*)(ws + WS_G8), (const float*)(ws + WS_SX1), (const float*)(ws + WS_SWPG) + L * 1024, (LAS float*)(F.lds + X_SCL)};
                  pg8::gemm_phase<pg8::EpiGate8, pg8::StaticOrder, true, true, true>(ring, g, S, E, F.wave); }
                __syncthreads();
                { pg8::Gemm g{(const pg8::bf16_t*)(ws + WS_PB), (const pg8::bf16_t*)(WL + W_WPLE), MTOK, 1024, 256};
                  pg8::EpiGateMul E{(const unsigned char*)(ws + WS_G8), (pg8::bf16_t*)(ws + WS_PP_MOE)};
                  pg8::gemm_phase<pg8::EpiGateMul, pg8::StaticOrder, true, true>(ring, g, S, E, F.wave); }
            }
            SEAM();
            for (int c = 0; c < MOE_NCHUNK; ++c) {
                if (IN() && EN_U1) { PH_BEGIN();
                    if (F.tid < 9) ((LAS int*)(F.lds + X_OFF))[F.tid] = ((const int*)(ws + WS_CNT + 49152))[F.tid];
                    LDS_WAIT(); __syncthreads();
                    const LAS int* off = (const LAS int*)(F.lds + X_OFF);
                    const int NT = __builtin_amdgcn_readfirstlane(off[8]) >> 8; int nMc = NT - c * MOE_CHUNK; nMc = nMc < 0 ? 0 : (nMc > MOE_CHUNK ? MOE_CHUNK : nMc);
                    pg8::MoeOrder<true> S; S.nMc = nMc; S.nN = 2 * DFFE / 256; S.nwg = nMc * S.nN; S.G = F.G; S.c = (int)blockIdx.x; S.t0 = c * MOE_CHUNK;
                    S.ts1 = __builtin_amdgcn_readfirstlane(off[1]) >> 8; S.ts2 = __builtin_amdgcn_readfirstlane(off[2]) >> 8; S.ts3 = __builtin_amdgcn_readfirstlane(off[3]) >> 8; S.ts4 = __builtin_amdgcn_readfirstlane(off[4]) >> 8;
                    S.ts5 = __builtin_amdgcn_readfirstlane(off[5]) >> 8; S.ts6 = __builtin_amdgcn_readfirstlane(off[6]) >> 8; S.ts7 = __builtin_amdgcn_readfirstlane(off[7]) >> 8;
                    pg8::Gemm g{(const pg8::bf16_t*)R, (const pg8::bf16_t*)(ws + WS_WM13), MOE_MAXT * 256, 2 * DFFE, 512, 0, 0};
                    pg8::EpiGLUQ E{(pg8::bf16_t*)(ws + WS_HS), DFFE, (const float*)(ws + WS_SXS), (const float*)(ws + WS_SWM13), (LAS float*)(F.lds + X_SCL)};
                    for (int rep_ = 0; rep_ < REP_MU; ++rep_) { pg8::gemm_phase<pg8::EpiGLUQ, pg8::MoeOrder<true>, true, true, true>(ring, g, S, E, F.wave); __syncthreads(); }
                }
                SEAM();
                if (IN() && EN_D1) { PH_BEGIN();
                    if (F.tid < 9) ((LAS int*)(F.lds + X_OFF))[F.tid] = ((const int*)(ws + WS_CNT + 49152))[F.tid];
                    LDS_WAIT(); __syncthreads();
                    const LAS int* off = (const LAS int*)(F.lds + X_OFF);
                    const int NT = __builtin_amdgcn_readfirstlane(off[8]) >> 8; int nMc = NT - c * MOE_CHUNK; nMc = nMc < 0 ? 0 : (nMc > MOE_CHUNK ? MOE_CHUNK : nMc);
                    const int t1 = __builtin_amdgcn_readfirstlane(off[1]) >> 8, t2 = __builtin_amdgcn_readfirstlane(off[2]) >> 8, t3 = __builtin_amdgcn_readfirstlane(off[3]) >> 8, t4 = __builtin_amdgcn_readfirstlane(off[4]) >> 8,
                              t5 = __builtin_amdgcn_readfirstlane(off[5]) >> 8, t6 = __builtin_amdgcn_readfirstlane(off[6]) >> 8, t7 = __builtin_amdgcn_readfirstlane(off[7]) >> 8;
                    if (c < MOE_NCHUNK - 1) {
                        pg8::MoeOrder<false> S; S.nMc = nMc; S.nN = 4; S.nwg = nMc * 4; S.G = F.G; S.c = (int)blockIdx.x; S.t0 = c * MOE_CHUNK;
                        S.ts1 = t1; S.ts2 = t2; S.ts3 = t3; S.ts4 = t4; S.ts5 = t5; S.ts6 = t6; S.ts7 = t7;
                        pg8::Gemm g{(const pg8::bf16_t*)(ws + WS_HS), (const pg8::bf16_t*)(ws + WS_WM2), MOE_CHUNK * 256, 1024, DFFE, 0, 0};
                        pg8::EpiMoeDown E{(pg8::bf16_t*)(ws + WS_XS), (const float*)(ws + WS_SW)};
                        for (int rep_ = 0; rep_ < REP_MD; ++rep_) { pg8::gemm_phase<pg8::EpiMoeDown, pg8::MoeOrder<false>, true, true>(ring, g, S, E, F.wave); __syncthreads(); }
                    } else {
                        pg8::MoeRemOrder S; S.nT = nMc; S.G = F.G; S.c = (int)blockIdx.x; S.t0 = c * MOE_CHUNK; S.KQ = DFFE / 4;
                        S.ts1 = t1; S.ts2 = t2; S.ts3 = t3; S.ts4 = t4; S.ts5 = t5; S.ts6 = t6; S.ts7 = t7;
                        pg8::Gemm g{(const pg8::bf16_t*)(ws + WS_HS), (const pg8::bf16_t*)(ws + WS_WM2), MOE_REM_ROWS, 1024, DFFE / 4, DFFE, DFFE};
                        pg8::EpiMoeRem E{(pg8::bf16_t*)(ws + WS_PART), (const float*)(ws + WS_SW), c * MOE_CHUNK, MOE_REM_ROWS};
                        pg8::gemm_phase<pg8::EpiMoeRem, pg8::MoeRemOrder, true, true>(ring, g, S, E, F.wave);
                    }
                }
                SEAM();
            }
        }
        if (L == 1) {
            if (IN() && EN_I) { PH_BEGIN();
                if (F.tid < 9) ((LAS int*)(F.lds + X_OFF))[F.tid] = ((const int*)(ws + WS_CNT + 49152))[F.tid];
                LDS_WAIT(); __syncthreads();
                const int nrem = (__builtin_amdgcn_readfirstlane(((const LAS int*)(F.lds + X_OFF))[8]) >> 8) - MOE_FULL;
                const int gw = F.vcu * NWAVES + F.wave, NGW = F.G * NWAVES;
                for (int r = gw; r < nrem * 256; r += NGW) {
                    const GAS v2u* pp = (const GAS v2u*)((const bf16*)(ws + WS_PART) + (size_t)r * DM) + F.lane; GAS v2u* dst = (GAS v2u*)((bf16*)(ws + WS_XS) + (size_t)(MOE_FULL * 256 + r) * DM) + F.lane;
#pragma unroll
                    for (int j = 0; j < 4; ++j) { float s0 = 0.f, s1 = 0.f, s2 = 0.f, s3 = 0.f;
#pragma unroll
                        for (int q = 0; q < 4; ++q) { const v2u a = pp[(size_t)q * MOE_REM_ROWS * DM / 4 + 64 * j]; s0 += bflo(a.x); s1 += bfhi(a.x); s2 += bflo(a.y); s3 += bfhi(a.y); }
                        v2u o; o.x = pk2(s0, s1); o.y = pk2(s2, s3); dst[64 * j] = o; }
                }
            }
            SEAM();
        }
        if (IN() && EN_I) { PH_BEGIN();
            f32x4 g[4], bb[4];
            { const GAS f32x4* gp = (const GAS f32x4*)(args.in[24] + L * DM) + F.lane; const GAS f32x4* bp = (const GAS f32x4*)(args.in[25] + L * DM) + F.lane;
#pragma unroll
              for (int j = 0; j < 4; ++j) { g[j] = gp[64 * j]; bb[j] = bp[64 * j]; } }
            const int gw = F.vcu * NWAVES + F.wave, NGW = F.G * NWAVES;
            const bool tmo = (L == 1) && (__hip_atomic_load((unsigned*)(ws + WS_CTL) + CW_BAR + XB_TMO, __ATOMIC_RELAXED, __HIP_MEMORY_SCOPE_AGENT) != 0u);
            if (L == 0) {
                v2u rx[4];
                { const GAS v2u* p_ = (const GAS v2u*)((const bf16*)R + (size_t)gw * DM) + F.lane;
#pragma unroll
                  for (int j = 0; j < 4; ++j) rx[j] = p_[64 * j]; }
                for (int m = gw; m < MTOK; m += NGW) {
                    f32x4 v[4];
#pragma unroll
                    for (int j = 0; j < 4; ++j) { v[j].x = bflo(rx[j].x); v[j].y = bfhi(rx[j].x); v[j].z = bflo(rx[j].y); v[j].w = bfhi(rx[j].y); }
                    if (m + NGW < MTOK) { const GAS v2u* p_ = (const GAS v2u*)((const bf16*)R + (size_t)(m + NGW) * DM) + F.lane;
#pragma unroll
                        for (int j = 0; j < 4; ++j) rx[j] = p_[64 * j]; }
                    ln_core(v, g, bb);
                    store_bf(XB, (size_t)m, v, F.lane); store_q8((signed char*)R + (128u << 20), (float*)(ws + WS_SX), (size_t)m, v, F.lane);
                }
            } else {
                v2u rx[4], rp[4], ra[4], rb[4]; int2 tpn = ((const int2*)(ws + WS_TPOS))[gw];
#define LN2_LOAD(mm, tp_) do { const GAS v2u* x1 = (const GAS v2u*)(XB + (size_t)(mm) * DM) + F.lane; const GAS v2u* pl = (const GAS v2u*)((const bf16*)(ws + WS_PP_MOE) + (size_t)(mm) * DM) + F.lane; \
        const GAS v2u* f0 = (const GAS v2u*)((const bf16*)(ws + WS_XS) + (size_t)(tp_).x * DM) + F.lane; const GAS v2u* f1 = (const GAS v2u*)((const bf16*)(ws + WS_XS) + (size_t)(tp_).y * DM) + F.lane; \
        _Pragma("unroll") for (int j = 0; j < 4; ++j) { rx[j] = x1[64 * j]; rp[j] = pl[64 * j]; ra[j] = f0[64 * j]; rb[j] = f1[64 * j]; } } while (0)
                LN2_LOAD(gw, tpn);
                if (gw + NGW < MTOK) tpn = ((const int2*)(ws + WS_TPOS))[gw + NGW];
                for (int m = gw; m < MTOK; m += NGW) {
                    f32x4 v[4];
#pragma unroll
                    for (int j = 0; j < 4; ++j) { const v2u x = rx[j], p = rp[j], a = ra[j], b = rb[j];
                        v[j].x = ALPHA * bflo(x.x) + bflo(p.x) + (bflo(a.x) + bflo(b.x)); v[j].y = ALPHA * bfhi(x.x) + bfhi(p.x) + (bfhi(a.x) + bfhi(b.x));
                        v[j].z = ALPHA * bflo(x.y) + bflo(p.y) + (bflo(a.y) + bflo(b.y)); v[j].w = ALPHA * bfhi(x.y) + bfhi(p.y) + (bfhi(a.y) + bfhi(b.y)); }
                    if (m + NGW < MTOK) { LN2_LOAD(m + NGW, tpn); if (m + 2 * NGW < MTOK) tpn = ((const int2*)(ws + WS_TPOS))[m + 2 * NGW]; }
                    ln_core(v, g, bb);
                    if (tmo) { const float qn = __builtin_nanf("");
#pragma unroll
                        for (int j = 0; j < 4; ++j) v[j] = (f32x4){qn, qn, qn, qn}; }
                    store_row(R, XB, (size_t)m, v, F.lane, false);
                }
            }
        }
        if (L == 0) SEAM();
    }
#undef LN2_LOAD
#undef IN
#undef SEAM
}

constexpr int N_PHASES = 29;
#ifndef MK_ONE_LAUNCH
#define MK_ONE_LAUNCH 1
#endif
extern "C" void kernel_launch(void* const* d_in, const int* in_sizes, int n_in, void* d_out, int out_size, void* d_ws, size_t ws_size, hipStream_t stream) {
    static int grid = 0;
    if (grid == 0) {
        if (n_in != 26 || in_sizes[0] != MTOK * DM || out_size != MTOK * DM || ws_size < WS_END) {
            fprintf(stderr, "kernel_launch: shape mismatch: n_in %d in0 %d out %d ws %zu (need %zu)\n", n_in, n_in > 0 ? in_sizes[0] : -1, out_size, ws_size, (size_t)WS_END); grid = -1; return; }
        int dev = 0, cus = 0, per_cu = 0;
        if (hipGetDevice(&dev) != hipSuccess || hipDeviceGetAttribute(&cus, hipDeviceAttributeMultiprocessorCount, dev) != hipSuccess) { fprintf(stderr, "kernel_launch: device query failed\n"); grid = -1; return; }
        if (hipFuncSetAttribute((const void*)mk_fwd, hipFuncAttributeMaxDynamicSharedMemorySize, LDS_BYTES) != hipSuccess) { fprintf(stderr, "kernel_launch: hipFuncSetAttribute failed\n"); grid = -1; return; }
        if (hipOccupancyMaxActiveBlocksPerMultiprocessor(&per_cu, (const void*)mk_fwd, NWAVES * 64, LDS_BYTES) != hipSuccess || per_cu < 1)
            fprintf(stderr, "kernel_launch: note: occupancy query reports %d workgroups per CU\n", per_cu);
        (void)hipGetLastError();
        grid = cus > 256 ? 256 : cus;
    }
    if (grid < 0) return;
    if (hipMemsetAsync((char*)d_ws + WS_CTL, 0, CTL_ZERO_BYTES, stream) != hipSuccess) { fprintf(stderr, "kernel_launch: memset failed\n"); return; }
    Args a{};
    for (int i = 0; i < 26; ++i) a.in[i] = (const float*)d_in[i];
    a.out = (float*)d_out; a.ws = (unsigned char*)d_ws;
#if MK_ONE_LAUNCH
    a.ph_lo = 0; a.ph_hi = N_PHASES;
    hipLaunchKernelGGL(mk_fwd, dim3(grid), dim3(NWAVES * 64), LDS_BYTES, stream, a);
#else
    for (int p = 0; p < N_PHASES; ++p) { a.ph_lo = p; a.ph_hi = p + 1; hipLaunchKernelGGL(mk_fwd, dim3(grid), dim3(NWAVES * 64), LDS_BYTES, stream, a); }
#endif
    const hipError_t le = hipPeekAtLastError();
    if (le != hipSuccess) fprintf(stderr, "kernel_launch: launch failed: %s (grid %d)\n", hipGetErrorName(le), grid);
}
```

```cpp
#include <hip/hip_runtime.h>
#include <cstdio>
#include <cstdint>
#include <cmath>
#ifndef PG8_WGM
#define PG8_WGM 8
#endif
namespace pg8 {
#define PG8_LAS __attribute__((address_space(3)))
typedef unsigned short bf16_t;
typedef short bf16x8 __attribute__((ext_vector_type(8)));
typedef float f32x4 __attribute__((ext_vector_type(4)));
typedef unsigned u32x4 __attribute__((ext_vector_type(4)));
typedef int i32x4 __attribute__((ext_vector_type(4)));
constexpr int BM = 256, BK = 64, HALF = 128, HTB = HALF * BK * 2  , STAGE_BYTES = 8 * HTB, NXCD = 8, WGM = PG8_WGM;

__host__ __device__ __forceinline__ int lds_byte(int r, int c) { const int st = (r >> 4) * 2 + (c >> 5), rr = r & 15, cc = c & 31, ob = rr * 64 + cc * 2; return st * 1024 + (ob ^ (((ob >> 9) & 1) << 5)); }
__host__ __device__ __forceinline__ void stage_rc(int b, int& R, int& C) { const int st = b / 1024, sb = b % 1024, swz = sb ^ (((sb >> 9) & 1) << 5); R = (st >> 1) * 16 + swz / 64; C = (st & 1) * 32 + (swz % 64) / 2; }
__host__ __device__ __forceinline__ int perm32(int rho) { const int n = rho >> 4, i = rho & 15; return 8 * (i >> 2) + 4 * n + (i & 3); }

struct Unit { int pm, pn, pa, pb, slot, kofs, aux; };
struct Gemm { const bf16_t* A; const bf16_t* Bt; int M, N, K; int lda, ldb; };

struct StaticOrder {
    int nM, nN, nwg, G, c;
    __host__ __device__ void init(int M, int N, int G_, int c_) { nM = M / BM; nN = N / BM; nwg = nM * nN; G = G_; c = c_; }
    __host__ __device__ bool next(int i, Unit& u) const {
        const long L = (long)i * G + c; if (L >= nwg) return false;
        int wgid = (int)L; { const int q = nwg / NXCD, r = nwg % NXCD, xcd = wgid % NXCD, off = wgid / NXCD; wgid = (xcd < r ? xcd * (q + 1) : r * (q + 1) + (xcd - r) * q) + off; }
        const int nig = WGM * nN, gid = wgid / nig, fm = gid * WGM, gsz = (nM - fm) < WGM ? (nM - fm) : WGM;
        u.pm = fm + ((wgid % nig) % gsz); u.pn = (wgid % nig) / gsz; u.pa = u.pm; u.pb = u.pn; u.slot = i; u.kofs = 0; u.aux = 0; return true;
    }
    __device__ __forceinline__ void a_ready(const Unit&) const {}
    __device__ __forceinline__ void done(const Unit&) const {}
};

__device__ __forceinline__ unsigned cvt_pk_bf16(float lo, float hi) { unsigned r; asm volatile("v_cvt_pk_bf16_f32 %0, %1, %2" : "=v"(r) : "v"(lo), "v"(hi)); return r; }
typedef float f32x2 __attribute__((ext_vector_type(2)));
__device__ __forceinline__ f32x2 gelu_pk(f32x2 v) {
    const f32x2 av = __builtin_elementwise_abs(v), d = av * 0.2316418882f + 1.0f;
    f32x2 t; t.x = __builtin_amdgcn_rcpf(d.x); t.y = __builtin_amdgcn_rcpf(d.y);
    f32x2 q = t * 0.5307027145f + (-0.7265760135f); q = q * t + 0.7107068705f; q = q * t + (-0.142248368f); q = q * t + 0.127414796f; q = q * t;
    const f32x2 s = (v * v) * (-0.72134752044f);
    f32x2 e; e.x = __builtin_amdgcn_exp2f(s.x); e.y = __builtin_amdgcn_exp2f(s.y);
    const f32x2 m = v * (q * e), r = v - m;
    f32x2 o; o.x = v.x < 0.f ? m.x : r.x; o.y = v.y < 0.f ? m.y : r.y; return o;
}

template <int ACT  > struct EpiBf16 {
    static constexpr bool PERM = true, AFTER_DRAIN = false, SCALES = false; static_assert(ACT == 0 || ACT == 1, "EpiBf16: ACT is 0 (none) or 1 (gelu_pk)");
    bf16_t* O; int ldc; const float* bias; int split_cols; size_t split_stride; float scale0;
    __device__ __forceinline__ void operator()(const f32x4 (&acc)[2][2][4][2], const Unit& u, int wr, int wc, int fr, int fq) const {
        const int row0 = u.pm * BM + wr * 64 + fr; int colt = u.pn * BM; bf16_t* base = O;
        float sc = 1.f; if (split_cols) { const int t = colt / split_cols; base += (size_t)t * split_stride; colt -= t * split_cols; if (t == 0) sc = scale0; }
        const int col0 = colt + wc * 32 + 8 * fq, bcol0 = u.pn * BM + wc * 32 + 8 * fq;
        f32x4 bv[2][2];
#pragma unroll
        for (int bj = 0; bj < 2; ++bj)
#pragma unroll
            for (int n = 0; n < 2; ++n) bv[bj][n] = bias ? *(const f32x4*)(bias + bcol0 + bj * HALF + 4 * n) : (f32x4){0.f, 0.f, 0.f, 0.f};
#pragma unroll
        for (int ai = 0; ai < 2; ++ai)
#pragma unroll
            for (int m = 0; m < 4; ++m) { bf16_t* rowp = base + (size_t)(row0 + ai * HALF + m * 16) * ldc + col0;
#pragma unroll
                for (int bj = 0; bj < 2; ++bj) { f32x4 v0 = acc[ai][bj][m][0] + bv[bj][0], v1 = acc[ai][bj][m][1] + bv[bj][1];
                    if (ACT == 1) { f32x2 a = gelu_pk((f32x2){v0[0], v0[1]}), b = gelu_pk((f32x2){v0[2], v0[3]}), c = gelu_pk((f32x2){v1[0], v1[1]}), d = gelu_pk((f32x2){v1[2], v1[3]});
                        v0 = (f32x4){a.x, a.y, b.x, b.y}; v1 = (f32x4){c.x, c.y, d.x, d.y}; }
                    v0 = v0 * sc; v1 = v1 * sc; u32x4 w; w.x = cvt_pk_bf16(v0[0], v0[1]); w.y = cvt_pk_bf16(v0[2], v0[3]); w.z = cvt_pk_bf16(v1[0], v1[1]); w.w = cvt_pk_bf16(v1[2], v1[3]);
                    *(u32x4*)(rowp + bj * HALF) = w; } }
    }
};

template <class Epi, class Sched, bool ALIGN_EPI = false, bool SP2 = false, bool I8 = false>
__device__ __forceinline__ void gemm_phase(PG8_LAS unsigned char* lds, const Gemm g, const Sched& S, const Epi& E, const int wave_id) {
    int lane_; asm volatile("v_mbcnt_lo_u32_b32 %0, -1, 0\n\tv_mbcnt_hi_u32_b32 %0, -1, %0" : "=v"(lane_));
    int w_ = wave_id; asm volatile("" : "+s"(w_));
    const int wid = w_, lane = lane_, tid = wid * 64 + lane, wr = wid >> 2, wc = wid & 3, fr = lane & 15, fq = lane >> 4;
    int K_ = g.K; asm volatile("" : "+s"(K_)); const int K = K_, nt = K / BK; int la_ = g.lda ? g.lda : g.K, lb_ = g.ldb ? g.ldb : g.K; asm volatile("" : "+s"(la_), "+s"(lb_)); const int lda = la_, ldb = lb_;
    unsigned voffA[2], voffB[2];
#pragma unroll
    for (int i = 0; i < 2; ++i) { int R, C; stage_rc(tid * 16 + i * 8192, R, C); const int Rb = Epi::PERM ? ((R & ~31) + perm32(R & 31)) : R;
        voffA[i] = (unsigned)(R * lda + C) * 2u; voffB[i] = (unsigned)(Rb * ldb + C) * 2u; }
    const size_t kstep = (size_t)(BK * 2);
    const size_t hstepA = (size_t)HALF * lda * 2, hstepB = (size_t)HALF * ldb * 2;
    const size_t tstepA = 2 * hstepA, tstepB = 2 * hstepB;
    const unsigned ldsw = (unsigned)wid * 1024u;
    const int aoff = lds_byte(wr * 64 + fr, fq * 8), boff = lds_byte(wc * 32 + fr, fq * 8);
#define PG8_SA(b, h) (((b) * 2 + (h)) * HTB)
#define PG8_SB(b, h) ((4 + (b) * 2 + (h)) * HTB)
#define PG8_STAGE(bufoff, gbase, voff) do { _Pragma("unroll") for (int _i = 0; _i < 2; ++_i) \
        __builtin_amdgcn_global_load_lds((const unsigned*)((const char*)(gbase) + (voff)[_i]), (PG8_LAS unsigned*)(lds + (bufoff) + ldsw + _i * 8192), 16, 0, 0); } while (0)
#define PG8_LDA(dst, b, h) do { _Pragma("unroll") for (int m = 0; m < 4; ++m) _Pragma("unroll") for (int k = 0; k < 2; ++k) dst[m][k] = *(const PG8_LAS bf16x8*)(lds + PG8_SA(b, h) + aoff + m * 2048 + k * 1024); } while (0)
#define PG8_LDB(dst, b, h) do { _Pragma("unroll") for (int n = 0; n < 2; ++n) _Pragma("unroll") for (int k = 0; k < 2; ++k) dst[n][k] = *(const PG8_LAS bf16x8*)(lds + PG8_SB(b, h) + boff + n * 2048 + k * 1024); } while (0)
#define PG8_MMA(ai, bj, At, Bt) do { __builtin_amdgcn_s_setprio(1); _Pragma("unroll") for (int m = 0; m < 4; ++m) _Pragma("unroll") for (int n = 0; n < 2; ++n) _Pragma("unroll") for (int k = 0; k < 2; ++k) \
        { if constexpr (I8) acc[ai][bj][m][n] = __builtin_bit_cast(f32x4, __builtin_amdgcn_mfma_i32_16x16x64_i8(__builtin_bit_cast(i32x4, Bt[n][k]), __builtin_bit_cast(i32x4, At[m][k]), __builtin_bit_cast(i32x4, acc[ai][bj][m][n]), 0, 0, 0)); \
          else acc[ai][bj][m][n] = __builtin_amdgcn_mfma_f32_16x16x32_bf16(Bt[n][k], At[m][k], acc[ai][bj][m][n], 0, 0, 0); } __builtin_amdgcn_s_setprio(0); } while (0)
#define PG8_WAIT_V(n) asm volatile("s_waitcnt vmcnt(" #n ")" ::: "memory")
#define PG8_WAIT_L(n) asm volatile("s_waitcnt lgkmcnt(" #n ")" ::: "memory")
#define PG8_BAR __builtin_amdgcn_s_barrier()
#define PG8_SCHED __builtin_amdgcn_sched_barrier(0)
    Unit cur, nxt; int ui = 0;
    if (!S.next(0, cur)) return;
    f32x4 acc[2][2][4][2];
#pragma unroll
    for (int a = 0; a < 2; ++a)
#pragma unroll
        for (int b = 0; b < 2; ++b)
#pragma unroll
            for (int m = 0; m < 4; ++m)
#pragma unroll
                for (int n = 0; n < 2; ++n) acc[a][b][m][n] = (f32x4){0.f, 0.f, 0.f, 0.f};
    bf16x8 At[4][2], B0[2][2], B1[2][2];
    const char* cA = (const char*)g.A + (size_t)cur.pa * tstepA + (size_t)cur.kofs * 2; const char* cB = (const char*)g.Bt + (size_t)cur.pb * tstepB + (size_t)cur.kofs * 2;
    S.a_ready(cur);
    if constexpr (Epi::SCALES) E.prefetch(cur, wid, lane);
    if constexpr (SP2) {
        PG8_STAGE(PG8_SB(0, 0), cB, voffB); PG8_STAGE(PG8_SB(0, 1), cB + hstepB, voffB); PG8_STAGE(PG8_SA(0, 0), cA, voffA); PG8_STAGE(PG8_SA(0, 1), cA + hstepA, voffA);
        if (wr == 1) PG8_BAR;
        PG8_WAIT_V(2); PG8_BAR;
        PG8_STAGE(PG8_SB(1, 0), cB + kstep, voffB); PG8_STAGE(PG8_SA(1, 0), cA + kstep, voffA); PG8_STAGE(PG8_SB(1, 1), cB + hstepB + kstep, voffB);
        PG8_WAIT_V(6); PG8_BAR;
    } else {
        PG8_STAGE(PG8_SB(0, 0), cB, voffB); PG8_STAGE(PG8_SA(0, 0), cA, voffA); PG8_STAGE(PG8_SB(0, 1), cB + hstepB, voffB); PG8_STAGE(PG8_SA(0, 1), cA + hstepA, voffA);
        if (wr == 1) PG8_BAR;
        PG8_WAIT_V(4); PG8_BAR;
        PG8_STAGE(PG8_SB(1, 0), cB + kstep, voffB); PG8_STAGE(PG8_SA(1, 0), cA + kstep, voffA); PG8_STAGE(PG8_SB(1, 1), cB + hstepB + kstep, voffB);
        PG8_WAIT_V(6); PG8_BAR;
    }
    for (;;) {
        const bool has_next = S.next(ui + 1, nxt);
        const char* nA = has_next ? (const char*)g.A + (size_t)nxt.pa * tstepA + (size_t)nxt.kofs * 2 : cA; const char* nB = has_next ? (const char*)g.Bt + (size_t)nxt.pb * tstepB + (size_t)nxt.kofs * 2 : cB;
        for (int t = 0; t < nt; t += 2) {
            const bool last = (t == nt - 2);
            const char* a1 = cA + (size_t)(t + 1) * kstep;
            const char* a2 = last ? nA : cA + (size_t)(t + 2) * kstep; const char* b2 = last ? nB : cB + (size_t)(t + 2) * kstep;
            const char* a3 = a2 + kstep; const char* b3 = b2 + kstep;
            if (last && has_next) { S.a_ready(nxt); if constexpr (Epi::SCALES) E.prefetch(nxt, wid, lane); }
            if constexpr (SP2) {
            PG8_LDB(B0, 0, 0); PG8_LDB(B1, 0, 1); PG8_SCHED; PG8_LDA(At, 0, 0); PG8_STAGE(PG8_SA(1, 1), a1 + hstepA, voffA);
            PG8_WAIT_V(8); PG8_WAIT_L(0); PG8_BAR; PG8_MMA(0, 0, At, B0); PG8_MMA(0, 1, At, B1); PG8_BAR; PG8_SCHED;
            PG8_LDA(At, 0, 1); PG8_STAGE(PG8_SB(0, 0), b2, voffB); PG8_STAGE(PG8_SB(0, 1), b2 + hstepB, voffB); PG8_STAGE(PG8_SA(0, 0), a2, voffA);
            PG8_WAIT_V(8); PG8_WAIT_L(0); PG8_BAR; PG8_MMA(1, 0, At, B0); PG8_MMA(1, 1, At, B1); PG8_BAR; PG8_SCHED;
            PG8_LDB(B0, 1, 0); PG8_LDB(B1, 1, 1); PG8_SCHED; PG8_LDA(At, 1, 0); PG8_STAGE(PG8_SA(0, 1), a2 + hstepA, voffA);
            PG8_WAIT_V(8); PG8_WAIT_L(0); PG8_BAR; PG8_MMA(0, 0, At, B0); PG8_MMA(0, 1, At, B1); PG8_BAR; PG8_SCHED;
            PG8_LDA(At, 1, 1); PG8_STAGE(PG8_SB(1, 0), b3, voffB); PG8_STAGE(PG8_SB(1, 1), b3 + hstepB, voffB); PG8_STAGE(PG8_SA(1, 0), a3, voffA);
            PG8_WAIT_V(8); PG8_WAIT_L(0); PG8_BAR; PG8_MMA(1, 0, At, B0); PG8_MMA(1, 1, At, B1); PG8_BAR; PG8_SCHED;
            } else {
            PG8_LDB(B0, 0, 0); PG8_SCHED; PG8_LDA(At, 0, 0); PG8_STAGE(PG8_SA(1, 1), a1 + hstepA, voffA);
            PG8_WAIT_L(8); PG8_BAR; PG8_WAIT_L(0); PG8_MMA(0, 0, At, B0); PG8_BAR; PG8_SCHED;
            PG8_LDB(B1, 0, 1); PG8_STAGE(PG8_SB(0, 0), b2, voffB);
            PG8_BAR; PG8_WAIT_L(0); PG8_MMA(0, 1, At, B1); PG8_BAR;
            PG8_LDA(At, 0, 1); PG8_STAGE(PG8_SA(0, 0), a2, voffA);
            PG8_BAR; PG8_WAIT_L(0); PG8_MMA(1, 0, At, B0); PG8_BAR; PG8_SCHED;
            PG8_STAGE(PG8_SB(0, 1), b2 + hstepB, voffB);
            PG8_WAIT_V(6); PG8_BAR; PG8_MMA(1, 1, At, B1); PG8_BAR;
            PG8_LDB(B0, 1, 0); PG8_SCHED; PG8_LDA(At, 1, 0); PG8_STAGE(PG8_SA(0, 1), a2 + hstepA, voffA);
            PG8_WAIT_L(8); PG8_BAR; PG8_WAIT_L(0); PG8_MMA(0, 0, At, B0); PG8_BAR; PG8_SCHED;
            PG8_LDB(B1, 1, 1); PG8_STAGE(PG8_SB(1, 0), b3, voffB);
            PG8_BAR; PG8_WAIT_L(0); PG8_MMA(0, 1, At, B1); PG8_BAR;
            PG8_LDA(At, 1, 1); PG8_STAGE(PG8_SA(1, 0), a3, voffA);
            PG8_BAR; PG8_WAIT_L(0); PG8_MMA(1, 0, At, B0); PG8_BAR; PG8_SCHED;
            PG8_STAGE(PG8_SB(1, 1), b3 + hstepB, voffB);
            PG8_WAIT_V(6); PG8_BAR; PG8_MMA(1, 1, At, B1); PG8_BAR;
            }
        }
        if constexpr (ALIGN_EPI) { if (wr == 0) PG8_BAR; }
        if constexpr (!Epi::AFTER_DRAIN) { E(acc, cur, wr, wc, fr, fq); S.done(cur); }
        if (!has_next) break;
#pragma unroll
        for (int a = 0; a < 2; ++a)
#pragma unroll
            for (int b = 0; b < 2; ++b)
#pragma unroll
                for (int m = 0; m < 4; ++m)
#pragma unroll
                    for (int n = 0; n < 2; ++n) acc[a][b][m][n] = (f32x4){0.f, 0.f, 0.f, 0.f};
        cur = nxt; cA = nA; cB = nB; ++ui;
        if constexpr (ALIGN_EPI) { if (wr == 1) PG8_BAR; }
    }
    PG8_WAIT_V(0);
    if constexpr (!ALIGN_EPI) { if (wr == 0) PG8_BAR; }
    PG8_BAR;
    if constexpr (Epi::AFTER_DRAIN) { E.fused(acc, cur, wr, wc, fr, fq, lds, wid, lane); S.done(cur); }
#undef PG8_SA
#undef PG8_SB
#undef PG8_STAGE
#undef PG8_LDA
#undef PG8_LDB
#undef PG8_MMA
#undef PG8_WAIT_V
#undef PG8_WAIT_L
#undef PG8_BAR
#undef PG8_SCHED
}
}
#ifndef EPI_FENCE_GRP
#define EPI_FENCE_GRP 8
#endif
namespace pg8 {
typedef unsigned u32x2 __attribute__((ext_vector_type(2)));
__device__ __forceinline__ float sigm(float x) { return __builtin_amdgcn_rcpf(1.0f + __builtin_amdgcn_exp2f(-1.4426950408889634f * x)); }
__device__ __forceinline__ u32x4 pack8(const f32x4& v0, const f32x4& v1) { u32x4 w; w.x = cvt_pk_bf16(v0[0], v0[1]); w.y = cvt_pk_bf16(v0[2], v0[3]); w.z = cvt_pk_bf16(v1[0], v1[1]); w.w = cvt_pk_bf16(v1[2], v1[3]); return w; }
__device__ __forceinline__ void unpack8(const u32x4& w, f32x4& v0, f32x4& v1) {
    v0[0] = __uint_as_float(w.x << 16); v0[1] = __uint_as_float(w.x & 0xffff0000u); v0[2] = __uint_as_float(w.y << 16); v0[3] = __uint_as_float(w.y & 0xffff0000u);
    v1[0] = __uint_as_float(w.z << 16); v1[1] = __uint_as_float(w.z & 0xffff0000u); v1[2] = __uint_as_float(w.w << 16); v1[3] = __uint_as_float(w.w & 0xffff0000u); }
__device__ __forceinline__ f32x4 i2f4(const f32x4& x) { return __builtin_convertvector(__builtin_bit_cast(i32x4, x), f32x4); }
struct RopeTab { f32x4 c0, c1, c2, c3; };
__device__ __forceinline__ RopeTab rope_load(const float* tab, int fq) { const float* t = tab + 16 * (fq & 1); RopeTab r; r.c0 = *(const f32x4*)(t); r.c1 = *(const f32x4*)(t + 4); r.c2 = *(const f32x4*)(t + 8); r.c3 = *(const f32x4*)(t + 12); return r; }
__device__ __forceinline__ void rope_apply(f32x4& v0, f32x4& v1, const RopeTab& r, int fq) {
    f32x4 p0, p1;
#pragma unroll
    for (int j = 0; j < 4; ++j) { const auto a_ = __builtin_amdgcn_permlane32_swap(__float_as_uint(v0[j]), __float_as_uint(v0[j]), false, false), b_ = __builtin_amdgcn_permlane32_swap(__float_as_uint(v1[j]), __float_as_uint(v1[j]), false, false);
        p0[j] = __uint_as_float(fq < 2 ? a_[1] : a_[0]); p1[j] = __uint_as_float(fq < 2 ? b_[1] : b_[0]); }
    const f32x4 c0 = r.c0, c1 = r.c1, c2 = r.c2, c3 = r.c3;
    const float sg = (fq < 2) ? -1.f : 1.f;
    v0[0] = v0[0] * c0[0] + sg * p0[0] * c0[1]; v0[1] = v0[1] * c0[2] + sg * p0[1] * c0[3];
    v0[2] = v0[2] * c1[0] + sg * p0[2] * c1[1]; v0[3] = v0[3] * c1[2] + sg * p0[3] * c1[3];
    v1[0] = v1[0] * c2[0] + sg * p1[0] * c2[1]; v1[1] = v1[1] * c2[2] + sg * p1[1] * c2[3];
    v1[2] = v1[2] * c3[0] + sg * p1[2] * c3[1]; v1[3] = v1[3] * c3[2] + sg * p1[3] * c3[3];
}
#define EPI_MEMBAR() asm volatile("" ::: "memory")
struct EpiProj {
    static constexpr bool PERM = true, AFTER_DRAIN = false, SCALES = true;
    bf16_t *NAQKV, *QLAT, *GATES, *KVLAT, *KMLA; const float* bgate; const float* rope; float qscale; float* PS; const float* sa; const float* sb; PG8_LAS float* tbl;
    __device__ __forceinline__ void prefetch(const Unit& u, int wid, int) const {
        int lane; asm volatile("v_mbcnt_lo_u32_b32 %0, -1, 0\n\tv_mbcnt_hi_u32_b32 %0, -1, %0" : "=v"(lane));
        const float* src = (wid < 4) ? sa + (size_t)u.pa * BM + wid * 64 + lane : sb + (size_t)u.pb * BM + (wid - 4) * 64 + lane;
        __builtin_amdgcn_global_load_lds((const unsigned*)src, (PG8_LAS unsigned*)(tbl + (u.slot & 1) * 512 + wid * 64), 4, 0, 0);
    }
    __device__ __forceinline__ void operator()(f32x4 (&acc)[2][2][4][2], const Unit& u, int wr, int wc, int fr, int fq) const {
        const int pn = u.pn; const int row0 = u.pm * BM + wr * 64 + fr;
        {
            const PG8_LAS float* tb = tbl + (u.slot & 1) * 512; const PG8_LAS float* sbp = tb + 256 + wc * 32 + 8 * fq;
            const f32x4 s00 = *(const PG8_LAS f32x4*)(sbp), s01 = *(const PG8_LAS f32x4*)(sbp + 4), s10 = *(const PG8_LAS f32x4*)(sbp + HALF), s11 = *(const PG8_LAS f32x4*)(sbp + HALF + 4);
#pragma unroll
            for (int ai = 0; ai < 2; ++ai)
#pragma unroll
                for (int m = 0; m < 4; ++m) { const float ra = tb[wr * 64 + fr + ai * HALF + m * 16];
                    acc[ai][0][m][0] = i2f4(acc[ai][0][m][0]) * (s00 * ra); acc[ai][0][m][1] = i2f4(acc[ai][0][m][1]) * (s01 * ra);
                    acc[ai][1][m][0] = i2f4(acc[ai][1][m][0]) * (s10 * ra); acc[ai][1][m][1] = i2f4(acc[ai][1][m][1]) * (s11 * ra); }
        }
        if (pn == 18) {
            if (wc == 0) {
#pragma unroll
                for (int ai = 0; ai < 2; ++ai) { RopeTab rt[4];
#pragma unroll
                    for (int m = 0; m < 4; ++m) rt[m] = rope_load(rope + (size_t)((row0 + ai * HALF + m * 16) & 8191) * 32, fq);
                    EPI_MEMBAR();
#pragma unroll
                    for (int m = 0; m < 4; ++m) { const int row = row0 + ai * HALF + m * 16; f32x4 v0 = acc[ai][0][m][0], v1 = acc[ai][0][m][1];
                        rope_apply(v0, v1, rt[m], fq); const u32x4 w = pack8(v0, v1); bf16_t* dp = KMLA + (size_t)row * 768 + 64 + 8 * fq;
#pragma unroll
                        for (int h = 0; h < 8; ++h) *(u32x4*)(dp + 96 * h) = w; }
                    EPI_MEMBAR(); }
            }
            return;
        }
        if (pn >= 9 && pn < 17) {
            const int col0 = (pn - 9) * BM + wc * 32 + 8 * fq;
            f32x4 bv[2][2];
#pragma unroll
            for (int bj = 0; bj < 2; ++bj)
#pragma unroll
                for (int n = 0; n < 2; ++n) bv[bj][n] = *(const f32x4*)(bgate + col0 + bj * HALF + 4 * n);
#pragma unroll
            for (int ai = 0; ai < 2; ++ai)
#pragma unroll
                for (int m = 0; m < 4; ++m) { unsigned char* rowp = (unsigned char*)GATES + (size_t)(row0 + ai * HALF + m * 16) * 2048 + col0;
#pragma unroll
                    for (int bj = 0; bj < 2; ++bj) { const f32x4 v0 = acc[ai][bj][m][0] + bv[bj][0], v1 = acc[ai][bj][m][1] + bv[bj][1]; u32x2 w = {0u, 0u};
#pragma unroll
                        for (int j = 0; j < 4; ++j) { w.x = __builtin_amdgcn_cvt_pk_u8_f32(sigm(v0[j]) * 255.f, j, w.x); w.y = __builtin_amdgcn_cvt_pk_u8_f32(sigm(v1[j]) * 255.f, j, w.y); }
                        *(u32x2*)(rowp + bj * HALF) = w; } }
            return;
        }
        bf16_t* base; int ldc, colt, mode = 0;
        if (pn < 6) { base = NAQKV; ldc = 1536; colt = pn * BM; mode = (pn < 2) ? 1 : 0; }
        else if (pn < 9) { base = QLAT; ldc = 768; colt = (pn - 6) * BM; }
        else { base = KVLAT; ldc = 256; colt = 0; }
        const int col0 = colt + wc * 32 + 8 * fq;
        if (mode == 0 && pn >= 6) {
            const int slot = (pn == 17) ? 12 + wc : (pn - 6) * 4 + wc;
#pragma unroll
            for (int ai = 0; ai < 2; ++ai)
#pragma unroll
                for (int m = 0; m < 4; ++m) { float q = 0.f;
#pragma unroll
                    for (int bj = 0; bj < 2; ++bj)
#pragma unroll
                        for (int n = 0; n < 2; ++n) { const f32x4 x = acc[ai][bj][m][n]; q += (x[0] * x[0] + x[1] * x[1]) + (x[2] * x[2] + x[3] * x[3]); }
                    { const auto r_ = __builtin_amdgcn_permlane16_swap(__float_as_uint(q), __float_as_uint(q), false, false); q = __uint_as_float(r_[0]) + __uint_as_float(r_[1]); }
                    { const auto r_ = __builtin_amdgcn_permlane32_swap(__float_as_uint(q), __float_as_uint(q), false, false); q = __uint_as_float(r_[0]) + __uint_as_float(r_[1]); }
                    if (fq == 0) PS[(size_t)(row0 + ai * HALF + m * 16) * 16 + slot] = q; }
        }
        const float sc = (mode == 1) ? qscale : 1.f;
#pragma unroll
        for (int ai = 0; ai < 2; ++ai)
#pragma unroll
            for (int m = 0; m < 4; ++m) { bf16_t* rowp = base + (size_t)(row0 + ai * HALF + m * 16) * ldc + col0;
#pragma unroll
                for (int bj = 0; bj < 2; ++bj) *(u32x4*)(rowp + bj * HALF) = pack8(acc[ai][bj][m][0] * sc, acc[ai][bj][m][1] * sc); }
    }
};
struct EpiQup {
    static constexpr bool PERM = true, AFTER_DRAIN = false, SCALES = false;
    bf16_t* Q; const PG8_LAS float* rtab; const float* rope; float sc;
    __device__ __forceinline__ void operator()(const f32x4 (&acc)[2][2][4][2], const Unit& u, int wr, int wc, int fr, int fq) const {
        const int lr0 = wr * 64 + fr;
        const int rb0 = ((8 * u.pn + wc) % 3 == 2), rb1 = ((8 * u.pn + 4 + wc) % 3 == 2);
#pragma unroll
        for (int ai = 0; ai < 2; ++ai) { RopeTab rt[4]; float rrs[4];
#pragma unroll
            for (int m = 0; m < 4; ++m) rrs[m] = rtab[u.slot * BM + lr0 + ai * HALF + m * 16];
            if (rb0 | rb1) {
#pragma unroll
                for (int m = 0; m < 4; ++m) rt[m] = rope_load(rope + (size_t)((u.pm * BM + lr0 + ai * HALF + m * 16) & 8191) * 32, fq);
#pragma unroll
                for (int m = 0; m < 4; ++m) asm volatile("" : "+v"(rt[m].c0), "+v"(rt[m].c1), "+v"(rt[m].c2), "+v"(rt[m].c3));
            }
            EPI_MEMBAR();
#pragma unroll
            for (int m = 0; m < 4; ++m) { const int lr = lr0 + ai * HALF + m * 16, row = u.pm * BM + lr; const float rr = rrs[m];
                bf16_t* rowp = Q + (size_t)row * 768 + u.pn * BM + wc * 32 + 8 * fq;
#pragma unroll
                for (int bj = 0; bj < 2; ++bj) { f32x4 v0 = acc[ai][bj][m][0] * rr, v1 = acc[ai][bj][m][1] * rr;
                    if (bj == 0 ? rb0 : rb1) rope_apply(v0, v1, rt[m], fq);
                    v0 = v0 * sc; v1 = v1 * sc; *(u32x4*)(rowp + bj * HALF) = pack8(v0, v1); } }
            EPI_MEMBAR(); }
    }
};
struct EpiKVup {
    static constexpr bool PERM = true, AFTER_DRAIN = false, SCALES = false;
    bf16_t *KM, *VM; const PG8_LAS float* rtab;
    __device__ __forceinline__ void operator()(const f32x4 (&acc)[2][2][4][2], const Unit& u, int wr, int wc, int fr, int fq) const {
        const int lr0 = wr * 64 + fr;
#pragma unroll
        for (int ai = 0; ai < 2; ++ai)
#pragma unroll
            for (int m = 0; m < 4; ++m) { const int lr = lr0 + ai * HALF + m * 16, row = u.pm * BM + lr; const float rr = rtab[u.slot * BM + lr];
#pragma unroll
                for (int bj = 0; bj < 2; ++bj) { const f32x4 v0 = acc[ai][bj][m][0] * rr, v1 = acc[ai][bj][m][1] * rr;
                    bf16_t* dp;
                    if (u.pn < 2) { const int h = 4 * u.pn + 2 * bj + (wc >> 1); dp = KM + (size_t)row * 768 + 96 * h + 32 * (wc & 1) + 8 * fq; }
                    else { dp = VM + (size_t)row * 512 + (u.pn - 2) * BM + bj * HALF + wc * 32 + 8 * fq; }
                    *(u32x4*)dp = pack8(v0, v1); }
                if (((ai * 4 + m + 1) % EPI_FENCE_GRP) == 0) asm volatile("" ::: "memory"); }
    }
};
struct EpiMerge {
    static constexpr bool PERM = true, AFTER_DRAIN = false, SCALES = false;
    const unsigned char* G; bf16_t* T; int second;
    __device__ __forceinline__ void operator()(const f32x4 (&acc)[2][2][4][2], const Unit& u, int wr, int wc, int fr, int fq) const {
        const int row0 = u.pm * BM + wr * 64 + fr, col0 = u.pn * BM + wc * 32 + 8 * fq;
#pragma unroll
        for (int ai = 0; ai < 2; ++ai) { u32x2 gw[4][2]; u32x4 tw[4][2];
#pragma unroll
            for (int m = 0; m < 4; ++m) { const size_t row = (size_t)(row0 + ai * HALF + m * 16);
#pragma unroll
                for (int bj = 0; bj < 2; ++bj) { const int c = col0 + bj * HALF; gw[m][bj] = *(const u32x2*)(G + row * 2048 + c); if (second) tw[m][bj] = *(const u32x4*)(T + row * 1024 + c); } }
            EPI_MEMBAR();
#pragma unroll
            for (int m = 0; m < 4; ++m) { const size_t row = (size_t)(row0 + ai * HALF + m * 16);
#pragma unroll
                for (int bj = 0; bj < 2; ++bj) { const int c = col0 + bj * HALF; const u32x2 g_ = gw[m][bj];
                    const f32x4 g0 = {(float)(g_.x & 255u), (float)((g_.x >> 8) & 255u), (float)((g_.x >> 16) & 255u), (float)(g_.x >> 24)}, g1 = {(float)(g_.y & 255u), (float)((g_.y >> 8) & 255u), (float)((g_.y >> 16) & 255u), (float)(g_.y >> 24)};
                    f32x4 v0 = acc[ai][bj][m][0] * (g0 * (1.f / 255.f)), v1 = acc[ai][bj][m][1] * (g1 * (1.f / 255.f));
                    if (second) { f32x4 t0, t1; unpack8(tw[m][bj], t0, t1); v0 = v0 + t0; v1 = v1 + t1; }
                    *(u32x4*)(T + row * 1024 + c) = pack8(v0, v1); } }
            EPI_MEMBAR(); }
    }
};
struct EpiPlain {
    static constexpr bool PERM = true, AFTER_DRAIN = false, SCALES = false;
    bf16_t* O; int ldc;
    __device__ __forceinline__ void operator()(const f32x4 (&acc)[2][2][4][2], const Unit& u, int wr, int wc, int fr, int fq) const {
        const int row0 = u.pm * BM + wr * 64 + fr, col0 = u.pn * BM + wc * 32 + 8 * fq;
#pragma unroll
        for (int ai = 0; ai < 2; ++ai)
#pragma unroll
            for (int m = 0; m < 4; ++m) { bf16_t* rowp = O + (size_t)(row0 + ai * HALF + m * 16) * ldc + col0;
#pragma unroll
                for (int bj = 0; bj < 2; ++bj) *(u32x4*)(rowp + bj * HALF) = pack8(acc[ai][bj][m][0], acc[ai][bj][m][1]); }
    }
};
template <int MODE> struct EpiRes {
    static constexpr bool PERM = true, AFTER_DRAIN = false, SCALES = (MODE == 3);
    const bf16_t* xres; bf16_t* Y; bf16_t* P; float alpha; const float* sa; const float* sb; PG8_LAS float* tbl;
    __device__ __forceinline__ void prefetch(const Unit& u, int wid, int) const {
        int lane; asm volatile("v_mbcnt_lo_u32_b32 %0, -1, 0\n\tv_mbcnt_hi_u32_b32 %0, -1, %0" : "=v"(lane));
        const float* src = (wid < 4) ? sa + (size_t)u.pa * BM + wid * 64 + lane : sb + (size_t)u.pb * BM + (wid - 4) * 64 + lane;
        __builtin_amdgcn_global_load_lds((const unsigned*)src, (PG8_LAS unsigned*)(tbl + (u.slot & 1) * 512 + wid * 64), 4, 0, 0);
    }
    __device__ __forceinline__ void operator()(const f32x4 (&acc)[2][2][4][2], const Unit& u, int wr, int wc, int fr, int fq) const {
        const int row0 = u.pm * BM + wr * 64 + fr, col0 = u.pn * BM + wc * 32 + 8 * fq;
        const PG8_LAS float* tb = (MODE == 3) ? tbl + (u.slot & 1) * 512 : nullptr;
        f32x4 sb0[2], sb1[2];
        if (MODE == 3) {
#pragma unroll
            for (int bj = 0; bj < 2; ++bj) { const PG8_LAS float* sbp = tb + 256 + bj * HALF + wc * 32 + 8 * fq; sb0[bj] = *(const PG8_LAS f32x4*)sbp; sb1[bj] = *(const PG8_LAS f32x4*)(sbp + 4); } }
#pragma unroll
        for (int ai = 0; ai < 2; ++ai) { u32x4 lx[4][2], lp[4][2];
#pragma unroll
            for (int m = 0; m < 4; ++m) { const size_t off = (size_t)(row0 + ai * HALF + m * 16) * 1024 + col0;
#pragma unroll
                for (int bj = 0; bj < 2; ++bj) { const size_t o = off + bj * HALF;
                    if (MODE == 0 || MODE == 2) lx[m][bj] = *(const u32x4*)(xres + o);
                    if (MODE != 0) lp[m][bj] = *(const u32x4*)(P + o); } }
            EPI_MEMBAR();
#pragma unroll
            for (int m = 0; m < 4; ++m) { const size_t off = (size_t)(row0 + ai * HALF + m * 16) * 1024 + col0;
#pragma unroll
                for (int bj = 0; bj < 2; ++bj) { const size_t o = off + bj * HALF; f32x4 v0 = acc[ai][bj][m][0], v1 = acc[ai][bj][m][1];
                    if (MODE == 0) { f32x4 x0, x1; unpack8(lx[m][bj], x0, x1); v0 = x0 * alpha + v0; v1 = x1 * alpha + v1; *(u32x4*)(Y + o) = pack8(v0, v1); }
                    else if (MODE == 3) { f32x4 p0, p1; unpack8(lp[m][bj], p0, p1); const float ra = tb[wr * 64 + fr + ai * HALF + m * 16];
                        v0 = i2f4(v0) * (sb0[bj] * ra); v1 = i2f4(v1) * (sb1[bj] * ra);
#pragma unroll
                        for (int j = 0; j < 4; ++j) { v0[j] = sigm(v0[j]) * p0[j]; v1[j] = sigm(v1[j]) * p1[j]; }
                        *(u32x4*)(P + o) = pack8(v0, v1); }
                    else if (MODE == 1) { f32x4 p0, p1; unpack8(lp[m][bj], p0, p1);
#pragma unroll
                        for (int j = 0; j < 4; ++j) { v0[j] = sigm(v0[j]) * p0[j]; v1[j] = sigm(v1[j]) * p1[j]; }
                        *(u32x4*)(P + o) = pack8(v0, v1); }
                    else { f32x4 x0, x1, p0, p1; unpack8(lx[m][bj], x0, x1); unpack8(lp[m][bj], p0, p1);
                        v0 = x0 * alpha + p0 + v0; v1 = x1 * alpha + p1 + v1; *(u32x4*)(Y + o) = pack8(v0, v1); } } }
            EPI_MEMBAR(); }
    }
};
struct EpiGate8 {
    static constexpr bool PERM = true, AFTER_DRAIN = false, SCALES = true;
    unsigned char* G8; const float* sa; const float* sb; PG8_LAS float* tbl;
    __device__ __forceinline__ void prefetch(const Unit& u, int wid, int) const {
        int lane; asm volatile("v_mbcnt_lo_u32_b32 %0, -1, 0\n\tv_mbcnt_hi_u32_b32 %0, -1, %0" : "=v"(lane));
        const float* src = (wid < 4) ? sa + (size_t)u.pa * BM + wid * 64 + lane : sb + (size_t)u.pb * BM + (wid - 4) * 64 + lane;
        __builtin_amdgcn_global_load_lds((const unsigned*)src, (PG8_LAS unsigned*)(tbl + (u.slot & 1) * 512 + wid * 64), 4, 0, 0);
    }
    __device__ __forceinline__ void operator()(const f32x4 (&acc)[2][2][4][2], const Unit& u, int wr, int wc, int fr, int fq) const {
        const int row0 = u.pm * BM + wr * 64 + fr, col0 = u.pn * BM + wc * 32 + 8 * fq;
        const PG8_LAS float* tb = tbl + (u.slot & 1) * 512;
        f32x4 sb0[2], sb1[2];
#pragma unroll
        for (int bj = 0; bj < 2; ++bj) { const PG8_LAS float* sbp = tb + 256 + bj * HALF + wc * 32 + 8 * fq; sb0[bj] = *(const PG8_LAS f32x4*)sbp; sb1[bj] = *(const PG8_LAS f32x4*)(sbp + 4); }
#pragma unroll
        for (int ai = 0; ai < 2; ++ai)
#pragma unroll
            for (int m = 0; m < 4; ++m) { const float ra = tb[wr * 64 + fr + ai * HALF + m * 16]; unsigned char* rowp = G8 + (size_t)(row0 + ai * HALF + m * 16) * 1024 + col0;
#pragma unroll
                for (int bj = 0; bj < 2; ++bj) { const f32x4 v0 = i2f4(acc[ai][bj][m][0]) * (sb0[bj] * ra), v1 = i2f4(acc[ai][bj][m][1]) * (sb1[bj] * ra); u32x2 w = {0u, 0u};
#pragma unroll
                    for (int j = 0; j < 4; ++j) { w.x = __builtin_amdgcn_cvt_pk_u8_f32(sigm(v0[j]) * 255.f, j, w.x); w.y = __builtin_amdgcn_cvt_pk_u8_f32(sigm(v1[j]) * 255.f, j, w.y); }
                    *(u32x2*)(rowp + bj * HALF) = w; } }
    }
};
struct EpiGateMul {
    static constexpr bool PERM = true, AFTER_DRAIN = false, SCALES = false;
    const unsigned char* G8; bf16_t* P;
    __device__ __forceinline__ void operator()(const f32x4 (&acc)[2][2][4][2], const Unit& u, int wr, int wc, int fr, int fq) const {
        const int row0 = u.pm * BM + wr * 64 + fr, col0 = u.pn * BM + wc * 32 + 8 * fq;
        u32x2 gw[8][2];
#pragma unroll
        for (int i = 0; i < 8; ++i)
#pragma unroll
            for (int bj = 0; bj < 2; ++bj) gw[i][bj] = *(const u32x2*)(G8 + (size_t)(row0 + (i >> 2) * HALF + (i & 3) * 16) * 1024 + col0 + bj * HALF);
        EPI_MEMBAR();
#pragma unroll
        for (int i = 0; i < 8; ++i) { const int ai = i >> 2, m = i & 3; bf16_t* rowp = P + (size_t)(row0 + ai * HALF + m * 16) * 1024 + col0;
#pragma unroll
            for (int bj = 0; bj < 2; ++bj) { const u32x2 g_ = gw[i][bj];
                const f32x4 g0 = {(float)(g_.x & 255u), (float)((g_.x >> 8) & 255u), (float)((g_.x >> 16) & 255u), (float)(g_.x >> 24)}, g1 = {(float)(g_.y & 255u), (float)((g_.y >> 8) & 255u), (float)((g_.y >> 16) & 255u), (float)(g_.y >> 24)};
                *(u32x4*)(rowp + bj * HALF) = pack8(acc[ai][bj][m][0] * (g0 * (1.f / 255.f)), acc[ai][bj][m][1] * (g1 * (1.f / 255.f))); } }
    }
};
struct EpiGLU {
    static constexpr bool PERM = true, AFTER_DRAIN = false, SCALES = false;
    bf16_t* H; int ldh;
    __device__ __forceinline__ void operator()(const f32x4 (&acc)[2][2][4][2], const Unit& u, int wr, int wc, int fr, int fq) const {
        const int row0 = u.pm * BM + wr * 64 + fr, col0 = u.pn * HALF + wc * 32 + 8 * fq;
#pragma unroll
        for (int ai = 0; ai < 2; ++ai)
#pragma unroll
            for (int m = 0; m < 4; ++m) { f32x4 h0, h1;
#pragma unroll
                for (int j = 0; j < 4; ++j) { const float a0 = acc[ai][0][m][0][j], a1 = acc[ai][0][m][1][j]; h0[j] = a0 * sigm(a0) * acc[ai][1][m][0][j]; h1[j] = a1 * sigm(a1) * acc[ai][1][m][1][j]; }
                *(u32x4*)(H + (size_t)(row0 + ai * HALF + m * 16) * ldh + col0) = pack8(h0, h1); }
    }
};
struct EpiGLUQ {
    static constexpr bool PERM = true, AFTER_DRAIN = false, SCALES = true;
    bf16_t* H; int ldh; const float* sa; const float* sb; PG8_LAS float* tbl;
    __device__ __forceinline__ void prefetch(const Unit& u, int wid, int) const {
        int lane; asm volatile("v_mbcnt_lo_u32_b32 %0, -1, 0\n\tv_mbcnt_hi_u32_b32 %0, -1, %0" : "=v"(lane));
        const float* src = (wid < 4) ? sa + (size_t)u.pa * BM + wid * 64 + lane : sb + (size_t)u.pb * BM + (wid - 4) * 64 + lane;
        __builtin_amdgcn_global_load_lds((const unsigned*)src, (PG8_LAS unsigned*)(tbl + (u.slot & 1) * 512 + wid * 64), 4, 0, 0);
    }
    __device__ __forceinline__ void operator()(const f32x4 (&acc)[2][2][4][2], const Unit& u, int wr, int wc, int fr, int fq) const {
        const int lrow0 = wr * 64 + fr, row0 = u.pm * BM + lrow0, col0 = u.pn * HALF + wc * 32 + 8 * fq;
        const PG8_LAS float* tb = tbl + (u.slot & 1) * 512; const PG8_LAS float* sbp = tb + 256 + wc * 32 + 8 * fq;
        const f32x4 s10 = *(const PG8_LAS f32x4*)(sbp), s11 = *(const PG8_LAS f32x4*)(sbp + 4), s30 = *(const PG8_LAS f32x4*)(sbp + HALF), s31 = *(const PG8_LAS f32x4*)(sbp + HALF + 4);
#pragma unroll
        for (int ai = 0; ai < 2; ++ai)
#pragma unroll
            for (int m = 0; m < 4; ++m) { const float ra = tb[lrow0 + ai * HALF + m * 16];
                const f32x4 a0 = i2f4(acc[ai][0][m][0]) * (s10 * ra), a1 = i2f4(acc[ai][0][m][1]) * (s11 * ra), b0 = i2f4(acc[ai][1][m][0]) * (s30 * ra), b1 = i2f4(acc[ai][1][m][1]) * (s31 * ra);
                f32x4 h0, h1;
#pragma unroll
                for (int j = 0; j < 4; ++j) { h0[j] = a0[j] * sigm(a0[j]) * b0[j]; h1[j] = a1[j] * sigm(a1[j]) * b1[j]; }
                *(u32x4*)(H + (size_t)(row0 + ai * HALF + m * 16) * ldh + col0) = pack8(h0, h1); }
    }
};
struct EpiMoeDown {
    static constexpr bool PERM = true, AFTER_DRAIN = false, SCALES = false;
    bf16_t* O; const float* SW;
    __device__ __forceinline__ void operator()(const f32x4 (&acc)[2][2][4][2], const Unit& u, int wr, int wc, int fr, int fq) const {
        const int row0 = u.pm * BM + wr * 64 + fr, col0 = u.pn * BM + wc * 32 + 8 * fq;
        float gws[8];
#pragma unroll
        for (int i = 0; i < 8; ++i) gws[i] = SW[row0 + (i >> 2) * HALF + (i & 3) * 16];
        EPI_MEMBAR();
#pragma unroll
        for (int ai = 0; ai < 2; ++ai)
#pragma unroll
            for (int m = 0; m < 4; ++m) { const int row = row0 + ai * HALF + m * 16; const float gw = gws[ai * 4 + m]; bf16_t* rowp = O + (size_t)row * 1024 + col0;
#pragma unroll
                for (int bj = 0; bj < 2; ++bj) *(u32x4*)(rowp + bj * HALF) = pack8(acc[ai][bj][m][0] * gw, acc[ai][bj][m][1] * gw); }
    }
};
template <bool UP> struct MoeOrder {
    int nMc, nN, nwg, G, c, t0; int ts1, ts2, ts3, ts4, ts5, ts6, ts7;
    __device__ __forceinline__ bool next(int i, Unit& u) const {
        const long L = (long)i * G + c; if (L >= nwg) return false;
        int wgid = (int)L; { const int q = nwg / NXCD, r = nwg % NXCD, xcd = wgid % NXCD, off = wgid / NXCD; wgid = (xcd < r ? xcd * (q + 1) : r * (q + 1) + (xcd - r) * q) + off; }
        const int nig = WGM * nN, gid = wgid / nig, fm = gid * WGM, gsz = (nMc - fm) < WGM ? (nMc - fm) : WGM;
        const int pml = fm + ((wgid % nig) % gsz), pn = (wgid % nig) / gsz, t = t0 + pml;
        const int e = (t >= ts1) + (t >= ts2) + (t >= ts3) + (t >= ts4) + (t >= ts5) + (t >= ts6) + (t >= ts7);
        u.pn = pn; u.pb = e * nN + pn; u.slot = i; u.kofs = 0; u.aux = 0;
        if (UP) { u.pa = t; u.pm = pml; } else { u.pa = pml; u.pm = t; }
        return true;
    }
    __device__ __forceinline__ void a_ready(const Unit&) const {}
    __device__ __forceinline__ void done(const Unit&) const {}
};
struct MoeRemOrder {
    int nT, G, c, t0, KQ, pa0; int ts1, ts2, ts3, ts4, ts5, ts6, ts7;
    __device__ __forceinline__ bool next(int i, Unit& u) const {
        const int L = i * G + c; if (L >= nT * 16) return false;
        const int tl = L >> 4, pn = (L >> 2) & 3, kq = L & 3, t = t0 + tl;
        const int e = (t >= ts1) + (t >= ts2) + (t >= ts3) + (t >= ts4) + (t >= ts5) + (t >= ts6) + (t >= ts7);
        u.pa = pa0 + tl; u.pm = tl; u.pn = pn; u.pb = e * 4 + pn; u.slot = i; u.kofs = kq * KQ; u.aux = kq; return true;
    }
    __device__ __forceinline__ void a_ready(const Unit&) const {}
    __device__ __forceinline__ void done(const Unit&) const {}
};
struct EpiMoeRem {
    static constexpr bool PERM = true, AFTER_DRAIN = false, SCALES = false;
    bf16_t* PART; const float* SW; int t0, prows;
    __device__ __forceinline__ void operator()(const f32x4 (&acc)[2][2][4][2], const Unit& u, int wr, int wc, int fr, int fq) const {
        const int row0 = u.pm * BM + wr * 64 + fr, col0 = u.pn * BM + wc * 32 + 8 * fq;
        float gws[8];
#pragma unroll
        for (int i = 0; i < 8; ++i) gws[i] = SW[t0 * BM + row0 + (i >> 2) * HALF + (i & 3) * 16];
        EPI_MEMBAR();
#pragma unroll
        for (int ai = 0; ai < 2; ++ai)
#pragma unroll
            for (int m = 0; m < 4; ++m) { const int row = row0 + ai * HALF + m * 16; const float gw = gws[ai * 4 + m]; bf16_t* rowp = PART + ((size_t)u.aux * prows + row) * 1024 + col0;
#pragma unroll
                for (int bj = 0; bj < 2; ++bj) *(u32x4*)(rowp + bj * HALF) = pack8(acc[ai][bj][m][0] * gw, acc[ai][bj][m][1] * gw); }
    }
};
}
namespace att {
#define ATT_LAS __attribute__((address_space(3)))
typedef unsigned short bf16;
using bf16x8 = __attribute__((ext_vector_type(8))) short;
using s16x4  = __attribute__((ext_vector_type(4))) short;
using f32x16 = __attribute__((ext_vector_type(16))) float;
using u32x4  = __attribute__((ext_vector_type(4))) unsigned;
#define SBAR() __builtin_amdgcn_sched_barrier(0)
__device__ __forceinline__ int crow(int r, int hi) { return (r & 3) + 8 * (r >> 2) + 4 * hi; }
__device__ __forceinline__ unsigned cvtpk(float lo, float hi) { unsigned r; asm volatile("v_cvt_pk_bf16_f32 %0, %1, %2" : "=v"(r) : "v"(lo), "v"(hi)); return r; }
__device__ __forceinline__ unsigned short f2bf(float f) { return (unsigned short)(cvtpk(f, f) & 0xffffu); }
constexpr int OIMG_WAVE = 32 * 144;
__device__ __forceinline__ int crow(int r, int hi);
__device__ __forceinline__ void store_o(const f32x16 (&o)[2], const ATT_LAS float* li_l, bf16* Ow, ATT_LAS char* img, int lane, int r32, int hi) {
  typedef unsigned u32x4_t __attribute__((ext_vector_type(4)));
#pragma unroll
  for (int r = 0; r < 16; ++r) { const int orow = (r & 3) + 8 * (r >> 2) + 4 * hi; const float rl = __builtin_amdgcn_rcpf(li_l[orow]);
    ATT_LAS unsigned short* rp = (ATT_LAS unsigned short*)(img + orow * 144) + r32;
    rp[0] = f2bf(o[0][r] * rl); rp[32] = f2bf(o[1][r] * rl); }
  asm volatile("s_waitcnt lgkmcnt(0)" ::: "memory");
#pragma unroll
  for (int j = 0; j < 4; ++j) { const int pc = j * 64 + lane, row = pc >> 3, c16 = pc & 7;
    const u32x4_t v = *(const ATT_LAS u32x4_t*)(img + row * 144 + c16 * 16);
    *reinterpret_cast<u32x4_t*>(Ow + (long)row * 512 + c16 * 8) = v; }
}
__device__ __forceinline__ int v_st(int k, int c) { const int kk = (k & ~0xC) | ((k & 4) << 1) | ((k & 8) >> 1); return ((kk >> 3) * 2 + (c >> 5)) * 512 + ((kk & 7) * 32 + (c & 31)) * 2; }
__device__ __forceinline__ int v_rd_base(int lane) { return ((lane & 3) << 3) | (((lane >> 2) & 3) << 6) | (((lane >> 4) & 1) << 5) | (((lane >> 5) & 1) << 8); }
constexpr int v_rd_off(int d0, int ks, int half) { return d0 * 512 + ks * 2048 + half * 1024; }
template <int OFF> __device__ __forceinline__ s16x4 tr_read(int vb) { s16x4 r; asm volatile("ds_read_b64_tr_b16 %0, %1 offset:%2" : "=&v"(r) : "v"(vb), "i"(OFF) : "memory"); return r; }
template <int D0> __device__ __forceinline__ void pv_one(f32x16& od, int vb, bf16x8 pa0, bf16x8 pa1, bf16x8 pa2, bf16x8 pa3) {
  const s16x4 l0 = tr_read<v_rd_off(D0, 0, 0)>(vb), h0 = tr_read<v_rd_off(D0, 0, 1)>(vb), l1 = tr_read<v_rd_off(D0, 1, 0)>(vb), h1 = tr_read<v_rd_off(D0, 1, 1)>(vb);
  const s16x4 l2 = tr_read<v_rd_off(D0, 2, 0)>(vb), h2 = tr_read<v_rd_off(D0, 2, 1)>(vb), l3 = tr_read<v_rd_off(D0, 3, 0)>(vb), h3 = tr_read<v_rd_off(D0, 3, 1)>(vb);
  asm volatile("s_waitcnt lgkmcnt(0)" ::: "memory"); SBAR();
#define PK(L, H) (bf16x8){L[0], L[1], L[2], L[3], H[0], H[1], H[2], H[3]}
  od = __builtin_amdgcn_mfma_f32_32x32x16_bf16(pa0, PK(l0, h0), od, 0, 0, 0);
  od = __builtin_amdgcn_mfma_f32_32x32x16_bf16(pa1, PK(l1, h1), od, 0, 0, 0);
  od = __builtin_amdgcn_mfma_f32_32x32x16_bf16(pa2, PK(l2, h2), od, 0, 0, 0);
  od = __builtin_amdgcn_mfma_f32_32x32x16_bf16(pa3, PK(l3, h3), od, 0, 0, 0);
#undef PK
}
__device__ __forceinline__ void pv2(f32x16* o, int vb, bf16x8 pa0, bf16x8 pa1, bf16x8 pa2, bf16x8 pa3) { pv_one<0>(o[0], vb, pa0, pa1, pa2, pa3); pv_one<1>(o[1], vb, pa0, pa1, pa2, pa3); }
template <int NS, int ROWB> __device__ __forceinline__ void qkt(f32x16& p0, f32x16& p1, const ATT_LAS char* Ks, const bf16x8* qr, int r32, int hi) {
  p0 = f32x16{}; p1 = f32x16{};
#pragma unroll
  for (int d0 = 0; d0 < NS; ++d0) { const int cb = d0 * 32 + hi * 16;
    const bf16x8 b0 = *(const ATT_LAS bf16x8*)(Ks + r32 * ROWB + cb);
    const bf16x8 b1 = *(const ATT_LAS bf16x8*)(Ks + (32 + r32) * ROWB + cb);
    p0 = __builtin_amdgcn_mfma_f32_32x32x16_bf16(b0, qr[d0], p0, 0, 0, 0);
    p1 = __builtin_amdgcn_mfma_f32_32x32x16_bf16(b1, qr[d0], p1, 0, 0, 0); }
}
constexpr float THR = 8.f;
__device__ __forceinline__ void partialSM(f32x16& p0, f32x16& p1, float& m_reg, float& alpha) {
  float pmax = p0[0];
#pragma unroll
  for (int r = 1; r < 16; ++r) pmax = fmaxf(pmax, p0[r]);
#pragma unroll
  for (int r = 0; r < 16; ++r) pmax = fmaxf(pmax, p1[r]);
  { auto rr = __builtin_amdgcn_permlane32_swap(__float_as_uint(pmax), __float_as_uint(pmax), false, false); pmax = fmaxf(__uint_as_float(rr[0]), __uint_as_float(rr[1])); }
  float mn;
  if (__builtin_expect(__all(pmax - m_reg <= THR), 1)) { mn = m_reg; alpha = 1.f; }
  else { mn = fmaxf(m_reg, pmax); alpha = __builtin_amdgcn_exp2f(m_reg - mn); m_reg = mn; }
#pragma unroll
  for (int r = 0; r < 16; ++r) p0[r] = p0[r] - mn;
#pragma unroll
  for (int r = 0; r < 16; ++r) p1[r] = p1[r] - mn;
#pragma unroll
  for (int r = 0; r < 16; ++r) p0[r] = __builtin_amdgcn_exp2f(p0[r]);
}
__device__ __forceinline__ void finishSM(f32x16& p0, f32x16& p1, float alpha, float& l_reg, bf16x8& pa0, bf16x8& pa1, bf16x8& pa2, bf16x8& pa3) {
#pragma unroll
  for (int r = 0; r < 16; ++r) p1[r] = __builtin_amdgcn_exp2f(p1[r]);
  float ps = 0;
#pragma unroll
  for (int r = 0; r < 16; ++r) ps += p0[r];
#pragma unroll
  for (int r = 0; r < 16; ++r) ps += p1[r];
  { auto rr = __builtin_amdgcn_permlane32_swap(__float_as_uint(ps), __float_as_uint(ps), false, false); ps = __uint_as_float(rr[0]) + __uint_as_float(rr[1]); }
  l_reg = l_reg * alpha + ps;
#define PK4(P, BASE, OUT) do { unsigned a0 = cvtpk(P[BASE + 0], P[BASE + 1]), a1 = cvtpk(P[BASE + 2], P[BASE + 3]);   \
    unsigned b0 = cvtpk(P[BASE + 4], P[BASE + 5]), b1 = cvtpk(P[BASE + 6], P[BASE + 7]);                              \
    auto r0 = __builtin_amdgcn_permlane32_swap(a0, b0, false, false); auto r1 = __builtin_amdgcn_permlane32_swap(a1, b1, false, false); \
    u32x4 w = {r0[0], r1[0], r0[1], r1[1]}; OUT = *reinterpret_cast<bf16x8*>(&w); } while (0)
  PK4(p0, 0, pa0); PK4(p0, 8, pa1); PK4(p1, 0, pa2); PK4(p1, 8, pa3);
#undef PK4
}

#define MX3(a, b, c) __builtin_fmaxf(__builtin_fmaxf((a), (b)), (c))
__device__ __forceinline__ float rowmax32(const f32x16& p0, const f32x16& p1) {
  float a = MX3(p0[0], p0[1], p1[0]), b = MX3(p0[2], p0[3], p1[1]); a = MX3(a, p1[2], p1[3]);
#pragma unroll
  for (int r = 4; r < 16; r += 4) { a = MX3(a, p0[r], p0[r + 1]); b = MX3(b, p0[r + 2], p0[r + 3]); a = MX3(a, p1[r], p1[r + 1]); b = MX3(b, p1[r + 2], p1[r + 3]); }
  float m = __builtin_fmaxf(a, b);
  { auto rr = __builtin_amdgcn_permlane32_swap(__float_as_uint(m), __float_as_uint(m), false, false); m = __builtin_fmaxf(__uint_as_float(rr[0]), __uint_as_float(rr[1])); }
  return m;
}
template <int NS, int ROWB> __device__ __forceinline__ void qkt_from(f32x16& p0, f32x16& p1, const ATT_LAS char* Ks, const bf16x8* qr, const f32x16& c0, int r32, int hi) {
#pragma unroll
  for (int d0 = 0; d0 < NS; ++d0) { const int cb = d0 * 32 + hi * 16;
    const bf16x8 b0 = *(const ATT_LAS bf16x8*)(Ks + r32 * ROWB + cb);
    const bf16x8 b1 = *(const ATT_LAS bf16x8*)(Ks + (32 + r32) * ROWB + cb);
    if (d0 == 0) { p0 = __builtin_amdgcn_mfma_f32_32x32x16_bf16(b0, qr[0], c0, 0, 0, 0); p1 = __builtin_amdgcn_mfma_f32_32x32x16_bf16(b1, qr[0], c0, 0, 0, 0); }
    else { p0 = __builtin_amdgcn_mfma_f32_32x32x16_bf16(b0, qr[d0], p0, 0, 0, 0); p1 = __builtin_amdgcn_mfma_f32_32x32x16_bf16(b1, qr[d0], p1, 0, 0, 0); } }
}
template <bool FIRST> __device__ __forceinline__ void partialSM2(f32x16& p0, f32x16& p1, float& m_ref, f32x16& negm, float& alpha) {
  const float rm = rowmax32(p0, p1);
  alpha = 1.f;
  if (FIRST || !__builtin_expect(__all(rm <= THR), 1)) {
    const float dl = FIRST ? rm : __builtin_fmaxf(rm, 0.f);
    m_ref += dl;
#pragma unroll
    for (int r = 0; r < 16; ++r) { p0[r] -= dl; p1[r] -= dl; }
#pragma unroll
    for (int r = 0; r < 16; ++r) negm[r] = -m_ref;
    asm volatile("" : "+v"(negm));
    if (!FIRST) alpha = __builtin_amdgcn_exp2f(-dl);
  }
#pragma unroll
  for (int r = 0; r < 16; ++r) p0[r] = __builtin_amdgcn_exp2f(p0[r]);
}
__device__ __forceinline__ void finishSM2(f32x16& p0, f32x16& p1, bf16x8& pa0, bf16x8& pa1, bf16x8& pa2, bf16x8& pa3) {
#pragma unroll
  for (int r = 0; r < 16; ++r) p1[r] = __builtin_amdgcn_exp2f(p1[r]);
#define PK4(P, BASE, OUT) do { unsigned a0 = cvtpk(P[BASE + 0], P[BASE + 1]), a1 = cvtpk(P[BASE + 2], P[BASE + 3]);   \
    unsigned b0 = cvtpk(P[BASE + 4], P[BASE + 5]), b1 = cvtpk(P[BASE + 6], P[BASE + 7]);                              \
    auto r0 = __builtin_amdgcn_permlane32_swap(a0, b0, false, false); auto r1 = __builtin_amdgcn_permlane32_swap(a1, b1, false, false); \
    u32x4 w = {r0[0], r1[0], r0[1], r1[1]}; OUT = *reinterpret_cast<bf16x8*>(&w); } while (0)
  PK4(p0, 0, pa0); PK4(p0, 8, pa1); PK4(p1, 0, pa2); PK4(p1, 8, pa3);
#undef PK4
}
__device__ __forceinline__ void pv3(f32x16* o, f32x16& ol, int vb, bf16x8 pa0, bf16x8 pa1, bf16x8 pa2, bf16x8 pa3) {
  const bf16x8 ones = {0x3F80, 0x3F80, 0x3F80, 0x3F80, 0x3F80, 0x3F80, 0x3F80, 0x3F80};
  pv_one<0>(o[0], vb, pa0, pa1, pa2, pa3);
  ol = __builtin_amdgcn_mfma_f32_32x32x16_bf16(pa0, ones, ol, 0, 0, 0); ol = __builtin_amdgcn_mfma_f32_32x32x16_bf16(pa1, ones, ol, 0, 0, 0);
  pv_one<1>(o[1], vb, pa0, pa1, pa2, pa3);
  ol = __builtin_amdgcn_mfma_f32_32x32x16_bf16(pa2, ones, ol, 0, 0, 0); ol = __builtin_amdgcn_mfma_f32_32x32x16_bf16(pa3, ones, ol, 0, 0, 0);
}
#ifndef MLA_CHK_ODD
#define MLA_CHK_ODD 0
#endif
constexpr int KSLOT = 12288, VSLOT = 8192, NSLOT = 4, MLA_OIMG = NSLOT * (KSLOT + VSLOT) + 8 * 256  , MLA_LDS = MLA_OIMG + 8 * OIMG_WAVE;
__device__ __forceinline__ void glds16(const void* gsrc, unsigned lds_dst) { unsigned keep;
  asm volatile("s_mov_b32 %0, m0\n\ts_mov_b32 m0, %2\n\ts_nop 0\n\tglobal_load_lds_dwordx4 %1, off\n\ts_mov_b32 m0, %0" : "=&s"(keep) : "v"(gsrc), "s"(lds_dst) : "memory"); }
#define BAR_L() asm volatile("s_waitcnt lgkmcnt(0)\n\ts_barrier" ::: "memory")
#define BAR_V(N) asm volatile("s_waitcnt vmcnt(" #N ") lgkmcnt(0)\n\ts_barrier" ::: "memory")
typedef short v4i16_t __attribute__((ext_vector_type(4)));
__device__ __forceinline__ s16x4 vtr(const ATT_LAS char* p) { return __builtin_bit_cast(s16x4, __builtin_amdgcn_ds_read_tr16_b64_v4i16((ATT_LAS v4i16_t*)p)); }
__device__ __forceinline__ void kfetch(bf16x8 (&kf)[12], const ATT_LAS char* Ks, int r32, int hi) {
#pragma unroll
  for (int d0 = 0; d0 < 6; ++d0) { const ATT_LAS char* p = Ks + (2 * d0 + hi) * 1024 + r32 * 16;
    kf[2 * d0] = *(const ATT_LAS bf16x8*)p; kf[2 * d0 + 1] = *(const ATT_LAS bf16x8*)(p + 512); }
}
#define MX3(a, b, c) __builtin_fmaxf(__builtin_fmaxf((a), (b)), (c))
__device__ __forceinline__ void mla_unit(const bf16* __restrict__ Qb, const bf16* __restrict__ Kh, const bf16* __restrict__ Vh, bf16* __restrict__ Ob, int seq, ATT_LAS char* lds, const int wave_id) {
  int lane_; asm volatile("v_mbcnt_lo_u32_b32 %0, -1, 0\n\tv_mbcnt_hi_u32_b32 %0, -1, %0" : "=v"(lane_));
  int w_ = wave_id; asm volatile("" : "+s"(w_));
  const int wid = w_, lane = lane_, r32 = lane & 31, hi = lane >> 5;
  const int half = wid >> 2;
  ATT_LAS char* K_lds = lds; ATT_LAS char* V_lds = lds + NSLOT * KSLOT;
  ATT_LAS float* al_l = (ATT_LAS float*)(lds + NSLOT * (KSLOT + VSLOT)) + wid * 64; ATT_LAS float* li_l = al_l + 32;
  const unsigned lds0 = (unsigned)(uintptr_t)lds;
  const int NT = seq / 64;
  const bf16* ksrc0 = Kh + (long)lane * 768 + wid * 8; const bf16* ksrc1 = ksrc0 + 64;
  const bf16* vsrc = Vh + (long)(16 * (wid & 3) + (lane >> 2)) * 512 + (wid >> 2) * 32 + (lane & 3) * 8;
  const unsigned kdst0 = lds0 + wid * 1024, vdst = lds0 + NSLOT * KSLOT + wid * 1024;
#define DMA_K(tile, slot) do { const int tl_ = (tile) < NT ? (tile) : NT - 1; const unsigned d_ = (unsigned)__builtin_amdgcn_readfirstlane(kdst0 + ((slot) & 3) * KSLOT); \
    glds16(ksrc0 + (long)tl_ * 64 * 768, d_); if (!half) glds16(ksrc1 + (long)tl_ * 64 * 768, d_ + 8192); } while (0)
#define DMA_V(tile, slot) do { const int tl_ = (tile) < NT ? (tile) : NT - 1; glds16(vsrc + (long)tl_ * 64 * 512, (unsigned)__builtin_amdgcn_readfirstlane(vdst + ((slot) & 3) * VSLOT)); } while (0)
#define STEP_BAR() do { SBAR(); if (!half) { BAR_V(6); } else { BAR_V(4); } SBAR(); } while (0)
  DMA_K(0, 0); DMA_K(1, 1); DMA_K(2, 2); DMA_K(3, 3); DMA_V(0, 0); DMA_V(1, 1);
  float m_ref = 0.f, l_reg = 0.f, pend = 0.f; f32x16 o[2] = {}; f32x16 negm = {}; bf16x8 qr[6];
  const bf16* Qw = Qb + (long)(wid * 32 + r32) * 768 + hi * 8;
#pragma unroll
  for (int d0 = 0; d0 < 6; ++d0) qr[d0] = *reinterpret_cast<const bf16x8*>(Qw + d0 * 16);
  const ATT_LAS char* vbp0 = V_lds + ((lane >> 4) & 1) * 32 + (lane & 3) * 8 + (4 * hi + ((lane & 15) >> 2)) * 64; const ATT_LAS char* kb0 = K_lds + hi * 1024 + r32 * 16;
  BAR_V(0);
  f32x16 pA0, pA1, pB0, pB1; bf16x8 paA0, paA1, paA2, paA3, paB0, paB1, paB2, paB3;
  paB0 = paB1 = paB2 = paB3 = (bf16x8){0, 0, 0, 0, 0, 0, 0, 0};
#define KFR(kb, i) (*(const ATT_LAS bf16x8*)((kb) + ((i) >> 1) * 2048 + ((i) & 1) * 512))
#pragma unroll
  for (int i = 0; i < 12; i += 2) { const bf16x8 k0_ = KFR(kb0, i), k1_ = KFR(kb0, i + 1);
    if (i == 0) { pA0 = __builtin_amdgcn_mfma_f32_32x32x16_bf16(k0_, qr[0], negm, 0, 0, 0); pA1 = __builtin_amdgcn_mfma_f32_32x32x16_bf16(k1_, qr[0], negm, 0, 0, 0); }
    else { pA0 = __builtin_amdgcn_mfma_f32_32x32x16_bf16(k0_, qr[i >> 1], pA0, 0, 0, 0); pA1 = __builtin_amdgcn_mfma_f32_32x32x16_bf16(k1_, qr[i >> 1], pA1, 0, 0, 0); } }
#define QKM(i, N0, N1) do { if ((i) == 0) N0 = __builtin_amdgcn_mfma_f32_32x32x16_bf16(kf[0], qr[0], negm, 0, 0, 0); else if ((i) == 1) N1 = __builtin_amdgcn_mfma_f32_32x32x16_bf16(kf[1], qr[0], negm, 0, 0, 0); \
    else if (((i) & 1) == 0) N0 = __builtin_amdgcn_mfma_f32_32x32x16_bf16(kf[i], qr[(i) >> 1], N0, 0, 0, 0); else N1 = __builtin_amdgcn_mfma_f32_32x32x16_bf16(kf[i], qr[(i) >> 1], N1, 0, 0, 0); } while (0)
#define VRDJ(j) do { vl[j] = vtr(vbp + ((j) >> 2) * 4096 + ((j) & 3) * 1024); vh[j] = vtr(vbp + ((j) >> 2) * 4096 + ((j) & 3) * 1024 + 512); } while (0)
#define PKV(i) (bf16x8){vl[i][0], vl[i][1], vl[i][2], vl[i][3], vh[i][0], vh[i][1], vh[i][2], vh[i][3]}
#define EXQ(idx, C0, C1) do { if ((idx) < 16) C0[(idx)] = __builtin_amdgcn_exp2f(C0[(idx)]); else C1[(idx) - 16] = __builtin_amdgcn_exp2f(C1[(idx) - 16]); } while (0)
#define CV(idx, C0, C1) ((idx) < 16 ? C0[(idx)] : C1[(idx) - 16])
#define EX2(k, C0, C1) do { EXQ(2 * (k), C0, C1); EXQ(2 * (k) + 1, C0, C1); ps2 += (f32x2_t){CV(2 * (k), C0, C1), CV(2 * (k) + 1, C0, C1)}; } while (0)
#define PK4(P, BASE, OUT) do { u32x4 w = {cvtpk(P[BASE + 0], P[BASE + 1]), cvtpk(P[BASE + 2], P[BASE + 3]), cvtpk(P[BASE + 4], P[BASE + 5]), cvtpk(P[BASE + 6], P[BASE + 7])}; OUT = *reinterpret_cast<bf16x8*>(&w); } while (0)
#define STEP(t, C0, C1, N0, N1, PC0, PC1, PC2, PC3, PO0, PO1, PO2, PO3, FIRST, CHK) do { \
    typedef float f32x2_t __attribute__((ext_vector_type(2))); \
    STEP_BAR(); \
    DMA_K((t) + 4, (t)); DMA_V((t) + 2, (t) + 2); \
    const ATT_LAS char* kb = kb0 + (((t) + 1) & 3) * KSLOT; const ATT_LAS char* vbp = vbp0 + (((t) - 1) & 3) * VSLOT; \
    bf16x8 kf[12]; s16x4 vl[8], vh[8]; f32x2_t ps2 = {0.f, 0.f}; float al = 1.f; \
    kf[0] = KFR(kb, 0); kf[1] = KFR(kb, 1); kf[2] = KFR(kb, 2); kf[3] = KFR(kb, 3); \
    float a_ = 0.f, b_ = 0.f, rm = 0.f; \
    if (CHK) { a_ = MX3(C0[0], C0[1], C1[0]); b_ = MX3(C0[2], C0[3], C1[1]); a_ = MX3(a_, C1[2], C1[3]); \
    a_ = MX3(a_, C0[4], C0[5]); b_ = MX3(b_, C0[6], C0[7]); a_ = MX3(a_, C1[4], C1[5]); b_ = MX3(b_, C1[6], C1[7]); } SBAR(); \
    QKM(0, N0, N1); kf[4] = KFR(kb, 4); if (CHK) { a_ = MX3(a_, C0[8], C0[9]); b_ = MX3(b_, C0[10], C0[11]); a_ = MX3(a_, C1[8], C1[9]); b_ = MX3(b_, C1[10], C1[11]); } SBAR(); \
    QKM(1, N0, N1); kf[5] = KFR(kb, 5); if (CHK) { a_ = MX3(a_, C0[12], C0[13]); b_ = MX3(b_, C0[14], C0[15]); a_ = MX3(a_, C1[12], C1[13]); b_ = MX3(b_, C1[14], C1[15]); } SBAR(); \
    QKM(2, N0, N1); kf[6] = KFR(kb, 6); if (CHK) { rm = __builtin_fmaxf(a_, b_); { auto rr = __builtin_amdgcn_permlane32_swap(__float_as_uint(rm), __float_as_uint(rm), false, false); rm = __builtin_fmaxf(__uint_as_float(rr[0]), __uint_as_float(rr[1])); } } SBAR(); \
    QKM(3, N0, N1); kf[7] = KFR(kb, 7); SBAR(); \
    if ((CHK) && ((FIRST) || !__builtin_expect(__all(rm <= THR), 1))) { const float dl = (FIRST) ? rm : __builtin_fmaxf(rm, 0.f); m_ref += dl; pend = dl; \
      _Pragma("unroll") for (int r = 0; r < 16; ++r) { C0[r] -= dl; C1[r] -= dl; } \
      _Pragma("unroll") for (int r = 0; r < 16; ++r) negm[r] = -m_ref; \
      asm volatile("" : "+v"(negm)); if (!(FIRST)) al = __builtin_amdgcn_exp2f(-dl); } \
    SBAR(); \
    QKM(4, N0, N1); kf[8] = KFR(kb, 8); EX2(0, C0, C1); SBAR(); \
    QKM(5, N0, N1); kf[9] = KFR(kb, 9); EX2(1, C0, C1); SBAR(); \
    QKM(6, N0, N1); kf[10] = KFR(kb, 10); EX2(2, C0, C1); SBAR(); \
    QKM(7, N0, N1); kf[11] = KFR(kb, 11); EX2(3, C0, C1); SBAR(); \
    QKM(8, N0, N1); EX2(4, C0, C1); PK4(C0, 0, PC0); SBAR(); \
    QKM(9, N0, N1); if (!(FIRST)) { VRDJ(0); } EX2(5, C0, C1); SBAR(); \
    QKM(10, N0, N1); if (!(FIRST)) { VRDJ(4); } EX2(6, C0, C1); SBAR(); \
    QKM(11, N0, N1); if (!(FIRST)) { VRDJ(1); } EX2(7, C0, C1); SBAR(); \
    if (!(FIRST)) o[0] = __builtin_amdgcn_mfma_f32_32x32x16_bf16(PO0, PKV(0), o[0], 0, 0, 0); if (!(FIRST)) { VRDJ(5); } EX2(8, C0, C1); PK4(C0, 8, PC1); SBAR(); \
    if (!(FIRST)) o[1] = __builtin_amdgcn_mfma_f32_32x32x16_bf16(PO0, PKV(4), o[1], 0, 0, 0); if (!(FIRST)) { VRDJ(2); } EX2(9, C0, C1); SBAR(); \
    if (!(FIRST)) o[0] = __builtin_amdgcn_mfma_f32_32x32x16_bf16(PO1, PKV(1), o[0], 0, 0, 0); if (!(FIRST)) { VRDJ(6); } EX2(10, C0, C1); SBAR(); \
    if (!(FIRST)) o[1] = __builtin_amdgcn_mfma_f32_32x32x16_bf16(PO1, PKV(5), o[1], 0, 0, 0); if (!(FIRST)) { VRDJ(3); } EX2(11, C0, C1); SBAR(); \
    if (!(FIRST)) o[0] = __builtin_amdgcn_mfma_f32_32x32x16_bf16(PO2, PKV(2), o[0], 0, 0, 0); if (!(FIRST)) { VRDJ(7); } EX2(12, C0, C1); PK4(C1, 0, PC2); SBAR(); \
    if (!(FIRST)) o[1] = __builtin_amdgcn_mfma_f32_32x32x16_bf16(PO2, PKV(6), o[1], 0, 0, 0); EX2(13, C0, C1); SBAR(); \
    if (!(FIRST)) o[0] = __builtin_amdgcn_mfma_f32_32x32x16_bf16(PO3, PKV(3), o[0], 0, 0, 0); EX2(14, C0, C1); SBAR(); \
    if (!(FIRST)) o[1] = __builtin_amdgcn_mfma_f32_32x32x16_bf16(PO3, PKV(7), o[1], 0, 0, 0); EX2(15, C0, C1); PK4(C1, 8, PC3); SBAR(); \
    l_reg = l_reg * al + (ps2.x + ps2.y); \
    if (__builtin_expect(__any(pend != 0.f), 0)) {       \
      const float f_ = (FIRST) ? 1.f : __builtin_amdgcn_exp2f(-pend); if (hi == 0) al_l[r32] = f_; asm volatile("s_waitcnt lgkmcnt(0)" ::: "memory"); \
      _Pragma("unroll") for (int r = 0; r < 16; ++r) { const float g_ = al_l[crow(r, hi)]; o[0][r] *= g_; o[1][r] *= g_; N0[r] -= pend; N1[r] -= pend; } \
      pend = 0.f; } \
  } while (0)
  STEP(0, pA0, pA1, pB0, pB1, paA0, paA1, paA2, paA3, paB0, paB1, paB2, paB3, true, 1);
  for (int t = 1; t + 1 < NT; t += 2) {
    STEP(t, pB0, pB1, pA0, pA1, paB0, paB1, paB2, paB3, paA0, paA1, paA2, paA3, false, MLA_CHK_ODD);
    STEP(t + 1, pA0, pA1, pB0, pB1, paA0, paA1, paA2, paA3, paB0, paB1, paB2, paB3, false, 1);
  }
  STEP(NT - 1, pB0, pB1, pA0, pA1, paB0, paB1, paB2, paB3, paA0, paA1, paA2, paA3, false, MLA_CHK_ODD);
  STEP_BAR();
  { const ATT_LAS char* vbp = vbp0 + ((NT - 1) & 3) * VSLOT; s16x4 vl[8], vh[8];
#pragma unroll
    for (int j = 0; j < 8; ++j) VRDJ(j);
    o[0] = __builtin_amdgcn_mfma_f32_32x32x16_bf16(paB0, PKV(0), o[0], 0, 0, 0); o[1] = __builtin_amdgcn_mfma_f32_32x32x16_bf16(paB0, PKV(4), o[1], 0, 0, 0);
    o[0] = __builtin_amdgcn_mfma_f32_32x32x16_bf16(paB1, PKV(1), o[0], 0, 0, 0); o[1] = __builtin_amdgcn_mfma_f32_32x32x16_bf16(paB1, PKV(5), o[1], 0, 0, 0);
    o[0] = __builtin_amdgcn_mfma_f32_32x32x16_bf16(paB2, PKV(2), o[0], 0, 0, 0); o[1] = __builtin_amdgcn_mfma_f32_32x32x16_bf16(paB2, PKV(6), o[1], 0, 0, 0);
    o[0] = __builtin_amdgcn_mfma_f32_32x32x16_bf16(paB3, PKV(3), o[0], 0, 0, 0); o[1] = __builtin_amdgcn_mfma_f32_32x32x16_bf16(paB3, PKV(7), o[1], 0, 0, 0); }
  { auto rr = __builtin_amdgcn_permlane32_swap(__float_as_uint(l_reg), __float_as_uint(l_reg), false, false); l_reg = __uint_as_float(rr[0]) + __uint_as_float(rr[1]); }
  if (hi == 0) li_l[r32] = l_reg; asm volatile("s_waitcnt lgkmcnt(0)" ::: "memory");
  store_o(o, li_l, Ob + (long)(wid * 32) * 512, lds + MLA_OIMG + wid * OIMG_WAVE, lane, r32, hi);
  BAR_V(0);
#undef DMA_K
#undef DMA_V
#undef STEP_BAR
#undef KFR
#undef QKM
#undef VRDJ
#undef PKV
#undef EXQ
#undef CV
#undef EX2
#undef PK4
#undef STEP
}
#undef BAR_L
#undef BAR_V

constexpr int NA_KROWB = 144, NA_LDS_K = 64 * NA_KROWB  , NA_SLOT = NA_LDS_K + 8192  , NA_OIMG = 2 * NA_SLOT + 15 * 32 * 4 + 8 * 256  , NA_LDS = NA_OIMG + 8 * OIMG_WAVE;
template <int CH> __device__ __forceinline__ constexpr bool na_live0(int q) { return CH == 0 ? true : q >= 12; }
template <int CH> __device__ __forceinline__ constexpr bool na_live1(int q) { return CH == 0 ? q < 4 : true; }
template <int CH> __device__ __forceinline__ void na_tile(f32x16& p0, f32x16& p1, const ATT_LAS float* trow, int qcol, int wstart, int hi, int r32, bool first,
                                                          float& m_ref, float& l_reg, f32x16& negm, f32x16 (&o)[2], ATT_LAS float* al_l, int vb) {
  float bz0[16], bz1[16];
#pragma unroll
  for (int q = 0; q < 16; ++q) { const int kc0 = crow(q, hi), kc1 = kc0 + 32;
    if (na_live0<CH>(q)) { const int i0 = min(max(kc0 - qcol + 15, 0), 30); bz0[q] = trow[i0]; }
    if (na_live1<CH>(q)) { const int i1 = min(max(kc1 - qcol + 15, 0), 30); bz1[q] = trow[i1]; } }
#pragma unroll
  for (int q = 0; q < 16; ++q) { if (na_live0<CH>(q)) asm volatile("" : "+v"(bz0[q])); if (na_live1<CH>(q)) asm volatile("" : "+v"(bz1[q])); }
#pragma unroll
  for (int q = 0; q < 16; ++q) { const int kc0 = crow(q, hi), kc1 = kc0 + 32;
    if (na_live0<CH>(q)) p0[q] = ((unsigned)(kc0 - wstart) < 16u) ? p0[q] + bz0[q] : -1e30f;
    if (na_live1<CH>(q)) p1[q] = ((unsigned)(kc1 - wstart) < 16u) ? p1[q] + bz1[q] : -1e30f; }
  float rm = -1e30f;
#pragma unroll
  for (int q = 0; q < 16; ++q) { if (na_live0<CH>(q)) rm = __builtin_fmaxf(rm, p0[q]); if (na_live1<CH>(q)) rm = __builtin_fmaxf(rm, p1[q]); }
  { auto rr = __builtin_amdgcn_permlane32_swap(__float_as_uint(rm), __float_as_uint(rm), false, false); rm = __builtin_fmaxf(__uint_as_float(rr[0]), __uint_as_float(rr[1])); }
  float al = 1.f;
  if (first || !__builtin_expect(__all(rm <= THR), 1)) {
    const float dl = first ? rm : __builtin_fmaxf(rm, 0.f); m_ref += dl;
#pragma unroll
    for (int q = 0; q < 16; ++q) { if (na_live0<CH>(q)) p0[q] -= dl; if (na_live1<CH>(q)) p1[q] -= dl; }
#pragma unroll
    for (int q = 0; q < 16; ++q) negm[q] = -m_ref;
    asm volatile("" : "+v"(negm));
    if (!first) al = __builtin_amdgcn_exp2f(-dl);
    if (__any(al < 1.f)) { if (hi == 0) al_l[r32] = al; asm volatile("s_waitcnt lgkmcnt(0)" ::: "memory");
#pragma unroll
      for (int q = 0; q < 16; ++q) { const float f_ = al_l[crow(q, hi)]; o[0][q] *= f_; o[1][q] *= f_; } }
  }
  float ps = 0.f;
#pragma unroll
  for (int q = 0; q < 16; ++q) { if (na_live0<CH>(q)) { p0[q] = __builtin_amdgcn_exp2f(p0[q]); ps += p0[q]; } else p0[q] = 0.f;
    if (na_live1<CH>(q)) { p1[q] = __builtin_amdgcn_exp2f(p1[q]); ps += p1[q]; } else p1[q] = 0.f; }
  l_reg = l_reg * al + ps;
  bf16x8 pa0, pa1, pa2, pa3;
#define PK4(P, BASE, OUT) do { unsigned a0 = cvtpk(P[BASE + 0], P[BASE + 1]), a1 = cvtpk(P[BASE + 2], P[BASE + 3]);   \
    unsigned b0_ = cvtpk(P[BASE + 4], P[BASE + 5]), b1_ = cvtpk(P[BASE + 6], P[BASE + 7]);                              \
    auto r0_ = __builtin_amdgcn_permlane32_swap(a0, b0_, false, false); auto r1_ = __builtin_amdgcn_permlane32_swap(a1, b1_, false, false); \
    u32x4 w = {r0_[0], r1_[0], r0_[1], r1_[1]}; OUT = *reinterpret_cast<bf16x8*>(&w); } while (0)
  if (CH == 1) { PK4(p0, 8, pa1); PK4(p1, 0, pa2); PK4(p1, 8, pa3); } else { PK4(p0, 0, pa0); PK4(p0, 8, pa1); PK4(p1, 0, pa2); }
#undef PK4
  SBAR();
  { const ATT_LAS char* vbp = (const ATT_LAS char*)(unsigned)vb;
#define NA_VF(D0, KS) const s16x4 l##D0##KS = vtr(vbp + v_rd_off(D0, KS, 0)), h##D0##KS = vtr(vbp + v_rd_off(D0, KS, 1))
#define NA_PV(D0, KS, PA) o[D0] = __builtin_amdgcn_mfma_f32_32x32x16_bf16(PA, (bf16x8){l##D0##KS[0], l##D0##KS[1], l##D0##KS[2], l##D0##KS[3], h##D0##KS[0], h##D0##KS[1], h##D0##KS[2], h##D0##KS[3]}, o[D0], 0, 0, 0)
    NA_VF(0, 1); NA_VF(1, 1); NA_VF(0, 2); NA_VF(1, 2);
    if (CH == 0) { NA_VF(0, 0); NA_VF(1, 0); NA_PV(0, 0, pa0); NA_PV(1, 0, pa0); }
    NA_PV(0, 1, pa1); NA_PV(1, 1, pa1); NA_PV(0, 2, pa2); NA_PV(1, 2, pa2);
    if (CH == 1) { NA_VF(0, 3); NA_VF(1, 3); NA_PV(0, 3, pa3); NA_PV(1, 3, pa3); }
#undef NA_VF
#undef NA_PV
  }
}
__device__ __forceinline__ void na_unit(int b, int h, int rg, const bf16* __restrict__ QKV, bf16* __restrict__ O, const float* __restrict__ rpb, ATT_LAS char* lds, const int wave_id) {
  int lane_; asm volatile("v_mbcnt_lo_u32_b32 %0, -1, 0\n\tv_mbcnt_hi_u32_b32 %0, -1, %0" : "=v"(lane_));
  int w_ = wave_id; asm volatile("" : "+s"(w_));
  const int wid = w_, lane = lane_, tid = wid * 64 + lane, r32 = lane & 31, hi = lane >> 5;
  ATT_LAS char* K_lds = lds; ATT_LAS char* V_lds = lds + NA_LDS_K; ATT_LAS float* tab = (ATT_LAS float*)(lds + 2 * NA_SLOT);
  ATT_LAS float* ws = (ATT_LAS float*)(lds + 2 * NA_SLOT + 15 * 32 * 4) + wid * 64; ATT_LAS float* li_l = ws; ATT_LAS float* al_l = ws + 32;
  const int r0 = 4 * rg, r = r0 + (wid >> 1), ch = wid & 1, qcol = 32 * ch + r32;
  const int rs = min(max(r - 4, 0), 120), lo = min(max(r0 - 4, 0), 120), hiR = min(max(r0 + 3 - 4, 0), 120) + 7;
  const int wstart = min(max(qcol - 8, 0), 48);
  const long tok0 = (long)b * 8192;
  if (tid < 15 * 32) { const int dr = tid >> 5, dc = tid & 31; tab[tid] = (dc < 31) ? rpb[(h * 15 + dr) * 31 + dc] * 1.4426950408889634f : 0.f; }
  bf16x8 qr[4];
  { const bf16* Qw = QKV + (tok0 + r * 64 + qcol) * 1536 + h * 64 + hi * 8;
#pragma unroll
    for (int d0 = 0; d0 < 4; ++d0) qr[d0] = *reinterpret_cast<const bf16x8*>(Qw + d0 * 16); }
  const int srow = tid >> 3, sch = tid & 7; const int kst = srow * NA_KROWB + sch * 16, vst = v_st(srow, sch * 8);
  const int vb0 = (int)(unsigned)(uintptr_t)V_lds + v_rd_base(lane);
  const bf16* Ksrc = QKV + (tok0 + srow) * 1536 + 512 + h * 64 + sch * 8; const bf16* Vsrc = Ksrc + 512;
  float m_ref = 0.f, l_reg = 0.f; f32x16 o[2] = {}; f32x16 negm = {};
#define NA_LD(KR, KV, VV) do { const int kk_ = min((KR), hiR); KV = *reinterpret_cast<const bf16x8*>(Ksrc + (long)kk_ * 64 * 1536); VV = *reinterpret_cast<const bf16x8*>(Vsrc + (long)kk_ * 64 * 1536); } while (0)
#define NA_BODY(KR, KN, VN) do { \
    __syncthreads();                                               \
    if ((KR) + 1 <= hiR) { *(ATT_LAS bf16x8*)(K_lds + (par ^ 1) * NA_SLOT + kst) = KN; *(ATT_LAS bf16x8*)(V_lds + (par ^ 1) * NA_SLOT + vst) = VN; NA_LD((KR) + 3, KN, VN); } \
    if ((KR) >= rs && (KR) < rs + 8) {                              \
      f32x16 p0, p1; qkt_from<4, NA_KROWB>(p0, p1, K_lds + par * NA_SLOT, qr, negm, r32, hi); \
      const ATT_LAS float* trow = tab + ((KR) - r + 7) * 32; \
      if (ch == 0) na_tile<0>(p0, p1, trow, qcol, wstart, hi, r32, (KR) == rs, m_ref, l_reg, negm, o, al_l, vb0 + par * NA_SLOT); \
      else         na_tile<1>(p0, p1, trow, qcol, wstart, hi, r32, (KR) == rs, m_ref, l_reg, negm, o, al_l, vb0 + par * NA_SLOT); \
    } \
    par ^= 1; } while (0)
  bf16x8 k0, v0, k1, v1;
  NA_LD(lo, k0, v0); NA_LD(lo + 1, k1, v1);
  *(ATT_LAS bf16x8*)(K_lds + kst) = k0; *(ATT_LAS bf16x8*)(V_lds + vst) = v0; NA_LD(lo + 2, k0, v0);
  int par = 0;
  for (int kr = lo; kr <= hiR; kr += 2) {
    NA_BODY(kr, k1, v1);
    if (kr + 1 > hiR) break;
    NA_BODY(kr + 1, k0, v0);
  }
#undef NA_LD
#undef NA_BODY
  { auto rr = __builtin_amdgcn_permlane32_swap(__float_as_uint(l_reg), __float_as_uint(l_reg), false, false); l_reg = __uint_as_float(rr[0]) + __uint_as_float(rr[1]); }
  if (hi == 0) li_l[r32] = l_reg; asm volatile("s_waitcnt lgkmcnt(0)" ::: "memory");
  store_o(o, li_l, O + (tok0 + r * 64 + 32 * ch) * 512 + h * 64, lds + NA_OIMG + wid * OIMG_WAVE, lane, r32, hi);
  __syncthreads();
}
#undef SBAR
}

constexpr int NWAVES = 8;
constexpr int NB = 8, SEQ = 8192, DM = 1024, MTOK = NB * SEQ;
constexpr int NIN = 4640, NPROJ = 4864;
constexpr int DFF = 2816, DFFE = 3584, NEXP = 8, PLED = 256;
constexpr int QLORA = 768, KVLORA = 256;
constexpr float ALPHA = 1.4142135623730951f;
constexpr float LN_EPS = 1e-5f, RMS_EPS = 1e-6f;
constexpr float LOG2E = 1.4426950408889634f;
constexpr float NA_QSCALE = 0.125f * LOG2E;
constexpr float MLA_QSCALE = 0.10206207261596575f * LOG2E;
constexpr int MOE_CHUNK = 128, MOE_NCHUNK = 4, MOE_REMT = 8, MOE_MAXT = 520;

constexpr size_t MiB = 1u << 20;
constexpr size_t WS_CTL = 0, CTL_ZERO_BYTES = 64 * 1024;
constexpr size_t WS_ROPE = 1 * MiB;
constexpr size_t WS_W = 2 * MiB;
constexpr size_t W_WIN = 0, W_WUQ = W_WIN + (size_t)NPROJ * 1024 * 2, W_WUKV = W_WUQ + 768 * 768 * 2, W_WNAO = W_WUKV + 1024 * 256 * 2, W_WMLAO = W_WNAO + 1024 * 512 * 2,
                 W_WOUT = W_WMLAO + 1024 * 512 * 2, W_WPG = W_WOUT + 1024 * 1024 * 2, W_WPLE = W_WPG + 1024 * 1024 * 2, W_LAYER = W_WPLE + 1024 * 256 * 2;
constexpr size_t WS_W13 = WS_W + 2 * W_LAYER, WS_W2 = WS_W13 + (size_t)2 * DFF * 1024 * 2, WS_WEND = WS_W2 + (size_t)1024 * DFF * 2;
static_assert(WS_WEND <= 56 * MiB, "weights");
constexpr size_t WS_SX = 54 * MiB, WS_SX1 = WS_SX + 256 * 1024, WS_SXS = WS_SX + 512 * 1024;
constexpr size_t WS_SWIN = 55 * MiB + 256 * 1024, WS_SW13 = WS_SWIN + 64 * 1024, WS_SWM13 = WS_SW13 + 32 * 1024;
constexpr size_t WS_SWPG = WS_SWM13 + 8 * 7168 * 4;
static_assert(WS_WEND <= WS_SX && WS_SWPG + 2 * 1024 * 4 <= 56 * MiB, "scales");
constexpr size_t WS_PB = 56 * MiB;
constexpr size_t WS_TE = 88 * MiB, WS_TP = 88 * MiB + 512 * 1024, WS_TW = 89 * MiB, WS_TPOS = 89 * MiB + 512 * 1024, WS_SW = 90 * MiB, WS_CNT = 91 * MiB;
constexpr size_t WS_PS = 92 * MiB;
constexpr size_t WS_XB = 96 * MiB;
constexpr size_t WS_QMLA = WS_XB;
constexpr size_t WS_GATES = 224 * MiB;
constexpr size_t WS_NAQKV = 480 * MiB;
constexpr size_t WS_MERGED = WS_NAQKV;
constexpr size_t WS_QLAT = 672 * MiB, WS_KVLAT = 768 * MiB;
constexpr size_t WS_ONA = 672 * MiB, WS_OMLA = 736 * MiB;
constexpr size_t WS_KMLA = 800 * MiB, WS_VMLA = 896 * MiB;
constexpr size_t WS_H = 224 * MiB, WS_PP_DENSE = 576 * MiB;
constexpr size_t WS_PP_MOE = 224 * MiB, WS_XS = 352 * MiB, WS_HS = 612 * MiB, WS_WM13 = 856 * MiB, WS_WM2 = 968 * MiB, WS_END = 1024 * MiB;
static_assert(WS_XS + (size_t)MOE_MAXT * 256 * 1024 * 2 <= WS_HS && WS_HS + (size_t)(MOE_CHUNK + MOE_REMT) * 256 * DFFE * 2 <= WS_WM13 && WS_WM13 + (size_t)NEXP * 2 * DFFE * 1024 * 2 == WS_WM2 && WS_WM2 + (size_t)NEXP * 1024 * DFFE * 2 == WS_END, "moe map");
static_assert(WS_H + (size_t)MTOK * DFF * 2 <= WS_PP_DENSE, "dense map");
constexpr size_t WS_G8 = 704 * MiB;
constexpr size_t WS_PART = 912 * MiB;
constexpr int MOE_REM_ROWS = MOE_REMT * 256, MOE_FULL = MOE_NCHUNK * MOE_CHUNK;
static_assert(WS_PART >= WS_WM13 + (size_t)NEXP * 2 * DFFE * 1024 && WS_PART + (size_t)4 * MOE_REM_ROWS * 1024 * 2 <= WS_WM2, "partials");
static_assert(WS_G8 >= WS_PP_DENSE + (size_t)MTOK * 1024 * 2 && WS_G8 >= WS_HS && WS_G8 + (size_t)MTOK * 1024 <= WS_WM13, "gate map");
constexpr int CW_BAR = 4096;
constexpr int RING_OFF = 0, RING_BYTES = 131072;
constexpr int LDSCTL_OFF = RING_BYTES;
constexpr int X_LCNT = RING_BYTES + 512, X_OFF = X_LCNT + 64, X_TOT = X_OFF + 64, X_RTAB = X_TOT + 64, X_PRE = X_RTAB + 4 * 256 * 4, X_END = X_PRE + 256 * 8 * 4;
constexpr int X_SCL = 147456;
constexpr int LDS_BYTES = 155648;
static_assert(X_END <= X_SCL && X_SCL + 4096 <= LDS_BYTES, "LDS map");

#include <hip/hip_bf16.h>
#define GAS __attribute__((address_space(1)))
#define LAS __attribute__((address_space(3)))
typedef unsigned short bf16;
typedef unsigned v4u __attribute__((ext_vector_type(4)));
typedef float f32x4 __attribute__((ext_vector_type(4)));
typedef short bf16x8 __attribute__((ext_vector_type(8)));
typedef GAS unsigned gu32;
typedef GAS unsigned long long gu64;
#define RLX_AGENT __ATOMIC_RELAXED, __HIP_MEMORY_SCOPE_AGENT
#define LDS_WAIT() asm volatile("s_waitcnt lgkmcnt(0)" ::: "memory")
#define VM_WAIT() asm volatile("s_waitcnt vmcnt(0)" ::: "memory")
__device__ __forceinline__ unsigned long long rt() { return __builtin_amdgcn_s_memrealtime(); }
__device__ __forceinline__ unsigned f2bf(float f) { unsigned u = __builtin_bit_cast(unsigned, f); return (u + 0x7fffu + ((u >> 16) & 1u)) >> 16; }
__device__ __forceinline__ unsigned pk2(float lo, float hi) { return f2bf(lo) | (f2bf(hi) << 16); }

#define XB_TMO      128
#define XB_XCNT(j)  (256  + 64 * (j))
#define XB_XSUB(j)  (1280 + 64 * (j))
#define XB_XGEN(j)  (2304 + 64 * (j))
#define XB_TOP      3328
#define XB_TOPGEN   3392
#define XCD_BAR_WORDS 3456
#define XB_SPIN_CAP (1u << 18)

__device__ __forceinline__ unsigned xb_ld(unsigned* p)              { return __hip_atomic_load(p, __ATOMIC_RELAXED, __HIP_MEMORY_SCOPE_AGENT); }
__device__ __forceinline__ unsigned xb_add(unsigned* p, unsigned v) { return __hip_atomic_fetch_add(p, v, __ATOMIC_RELAXED, __HIP_MEMORY_SCOPE_AGENT); }
__device__ __forceinline__ unsigned xb_xcc_id() { return (unsigned)__builtin_amdgcn_s_getreg((3 << 11) | 20) & 0xFu; }
#define XB_SPIN(cond, bar) do { unsigned _sp = 0; while (cond) { __builtin_amdgcn_s_sleep(1); \
    if ((++_sp & 255u) == 0u) { if (xb_ld(&(bar)[XB_TMO])) break; if (_sp > XB_SPIN_CAP) { atomicAdd(&(bar)[XB_TMO], 1u); break; } } } } while (0)

struct XcdBarrier {
    unsigned* bar; unsigned x;
    volatile LAS unsigned* st;
    unsigned w0;
};

__device__ __forceinline__ XcdBarrier xcd_barrier_post(unsigned* bar, volatile LAS unsigned* st) {
    XcdBarrier b; b.bar = bar; b.x = xb_xcc_id(); b.st = st; b.w0 = (unsigned)__builtin_amdgcn_readfirstlane(threadIdx.x < 64u ? 1 : 0);
    if (threadIdx.x == 0) (void)xb_add(&bar[XB_XCNT(b.x)], 1u);
    return b;
}
__device__ __forceinline__ void xcd_barrier_complete(unsigned* bar, unsigned x, unsigned& nloc, unsigned& nx) {
    const unsigned G = gridDim.x * gridDim.y * gridDim.z;
    unsigned sum, cnt, mine, sp = 0u;
    for (;;) {
        sum = 0u; cnt = 0u; mine = 0u;
#pragma unroll
        for (unsigned j = 0; j < 16; ++j) { const unsigned c = xb_ld(&bar[XB_XCNT(j)]); sum += c; cnt += (c > 0u) ? 1u : 0u; mine = (j == x) ? c : mine; }
        if (sum == G) break;
        __builtin_amdgcn_s_sleep(1);
        if ((++sp & 255u) == 0u) { if (xb_ld(&bar[XB_TMO])) break; if (sp > XB_SPIN_CAP) { atomicAdd(&bar[XB_TMO], 1u); break; } }
    }
    nloc = mine > 0u ? mine : 1u; nx = cnt > 0u ? cnt : 1u;
}

__device__ __forceinline__ void xcd_barrier(const XcdBarrier& b) {
    asm volatile("s_waitcnt vmcnt(0)" ::: "memory");
    __syncthreads();
    int xl_; asm volatile("v_mbcnt_lo_u32_b32 %0, -1, 0\n\tv_mbcnt_hi_u32_b32 %0, -1, %0" : "=v"(xl_));
    if (b.w0 && xl_ == 0) {
        unsigned* bar = b.bar;
        __builtin_amdgcn_s_waitcnt(0);
        unsigned nloc = b.st[0], nx = b.st[1];
        if (nloc == 0u) { xcd_barrier_complete(bar, b.x, nloc, nx); b.st[0] = nloc; b.st[1] = nx; }
        const unsigned old = xb_add(&bar[XB_XSUB(b.x)], 1u);
        const unsigned gen = old / nloc;
        if (old + 1u == (gen + 1u) * nloc) {
            __builtin_amdgcn_fence(__ATOMIC_RELEASE, "agent");
            asm volatile("s_waitcnt vmcnt(0)" ::: "memory");
            const unsigned og = xb_add(&bar[XB_TOP], 1u);
            const unsigned tg = og / nx;
            if (og + 1u == (tg + 1u) * nx) xb_add(&bar[XB_TOPGEN], 1u);
            else XB_SPIN(xb_ld(&bar[XB_TOPGEN]) == tg, bar);
            __builtin_amdgcn_fence(__ATOMIC_ACQUIRE, "agent");
            xb_add(&bar[XB_XGEN(b.x)], 1u);
            asm volatile("s_waitcnt vmcnt(0)" ::: "memory");
        } else {
            XB_SPIN(xb_ld(&bar[XB_XGEN(b.x)]) == gen, bar);
            __builtin_amdgcn_fence(__ATOMIC_ACQUIRE, "agent");
            asm volatile("s_waitcnt vmcnt(0)" ::: "memory");
        }
    }
    __syncthreads();
}


typedef unsigned v2u __attribute__((ext_vector_type(2)));
struct Args { const float* in[26]; float* out; unsigned char* ws; int ph_lo, ph_hi; };
struct Frame {
    LAS unsigned char* lds;
    int tid, lane, wave, vcu, G;
};
#define WR_DPP(v, ctrl) __int_as_float(__builtin_amdgcn_update_dpp(0, __float_as_int(v), (ctrl), 0xf, 0xf, true))
__device__ __forceinline__ float wave_sum(float v) {
    v += WR_DPP(v, 0xB1); v += WR_DPP(v, 0x4E); v += WR_DPP(v, 0x141); v += WR_DPP(v, 0x140);
    { const auto r = __builtin_amdgcn_permlane16_swap(__float_as_uint(v), __float_as_uint(v), false, false); v = __uint_as_float(r[0]) + __uint_as_float(r[1]); }
    { const auto r = __builtin_amdgcn_permlane32_swap(__float_as_uint(v), __float_as_uint(v), false, false); v = __uint_as_float(r[0]) + __uint_as_float(r[1]); }
    return v;
}
__device__ __forceinline__ float wave_max(float v) {
    v = fmaxf(v, WR_DPP(v, 0xB1)); v = fmaxf(v, WR_DPP(v, 0x4E)); v = fmaxf(v, WR_DPP(v, 0x141)); v = fmaxf(v, WR_DPP(v, 0x140));
    { const auto r = __builtin_amdgcn_permlane16_swap(__float_as_uint(v), __float_as_uint(v), false, false); v = fmaxf(__uint_as_float(r[0]), __uint_as_float(r[1])); }
    { const auto r = __builtin_amdgcn_permlane32_swap(__float_as_uint(v), __float_as_uint(v), false, false); v = fmaxf(__uint_as_float(r[0]), __uint_as_float(r[1])); }
    return v;
}
__device__ __forceinline__ float half_max32(float v) { const auto r = __builtin_amdgcn_permlane32_swap(__float_as_uint(v), __float_as_uint(v), false, false); return fmaxf(__uint_as_float(r[0]), __uint_as_float(r[1])); }
__device__ __forceinline__ float bflo(unsigned w) { return __uint_as_float(w << 16); }
__device__ __forceinline__ float bfhi(unsigned w) { return __uint_as_float(w & 0xffff0000u); }

__device__ __forceinline__ void tr_item(const float* W, int K, int N, bf16* WT, int g, int s0, int ss, int d0, int ds, const float* gs, LAS float* scr, int item, int ncols, int lane) {
    const int nblk = ncols / 32, kb = item / nblk, nb = item % nblk, k0 = 64 * kb, j0 = 32 * nb;
    const int grp = j0 / g, jin = j0 % g, sn0 = s0 + grp * ss + jin, dn0 = d0 + grp * ds + jin;
    float v[32];
#pragma unroll
    for (int i = 0; i < 32; ++i) { const int kk = 2 * i + (lane >> 5); v[i] = W[(size_t)(k0 + kk) * N + sn0 + (lane & 31)]; }
    if (gs) {
#pragma unroll
        for (int i = 0; i < 32; ++i) v[i] *= gs[k0 + 2 * i + (lane >> 5)]; }
#pragma unroll
    for (int i = 0; i < 32; ++i) scr[(2 * i + (lane >> 5)) * 33 + (lane & 31)] = v[i];
    LDS_WAIT(); asm volatile("" ::: "memory");
    const int c = lane & 7;
#pragma unroll
    for (int j = 0; j < 4; ++j) { const int n = (lane >> 3) + 8 * j; const LAS float* s = scr + (8 * c) * 33 + n;
        v4u o; o.x = pk2(s[0 * 33], s[1 * 33]); o.y = pk2(s[2 * 33], s[3 * 33]); o.z = pk2(s[4 * 33], s[5 * 33]); o.w = pk2(s[6 * 33], s[7 * 33]);
        *(GAS v4u*)(WT + (size_t)(dn0 + n) * K + k0 + 8 * c) = o; }
    LDS_WAIT(); asm volatile("" ::: "memory");
}
__device__ __forceinline__ void tr_job(Frame& F, int& rot, const float* W, int K, int N, int ncols, bf16* WT, int g, int s0, int ss, int d0, int ds, const float* gs) {
    LAS float* scr = (LAS float*)(F.lds + RING_OFF + F.wave * 16384);
    const int NGW = F.G * NWAVES, gw = F.vcu * NWAVES + F.wave, nitems = (K / 64) * (ncols / 32);
    int first = (gw - rot) % NGW; if (first < 0) first += NGW;
    for (int it = first; it < nitems; it += NGW) tr_item(W, K, N, WT, g, s0, ss, d0, ds, gs, scr, it, ncols, F.lane);
    rot = (rot + nitems) % NGW;
}
__device__ __forceinline__ void tr_plain(Frame& F, int& rot, const float* W, int K, int N, bf16* WT) { tr_job(F, rot, W, K, N, N, WT, N, 0, 0, 0, 0, nullptr); }
__device__ __forceinline__ void cvt_rows(Frame& F, const float* src, bf16* dst, size_t n8) {
    const size_t NT = (size_t)F.G * NWAVES * 64, t0 = (size_t)(F.vcu * NWAVES + F.wave) * 64 + F.lane;
    size_t i = t0;
    for (; i + 3 * NT < n8; i += 4 * NT) { f32x4 a[4], b[4];
#pragma unroll
        for (int q = 0; q < 4; ++q) { a[q] = *(const GAS f32x4*)(src + (i + q * NT) * 8); b[q] = *(const GAS f32x4*)(src + (i + q * NT) * 8 + 4); }
#pragma unroll
        for (int q = 0; q < 4; ++q) { v4u o; o.x = pk2(a[q].x, a[q].y); o.y = pk2(a[q].z, a[q].w); o.z = pk2(b[q].x, b[q].y); o.w = pk2(b[q].z, b[q].w); *(GAS v4u*)(dst + (i + q * NT) * 8) = o; } }
    for (; i < n8; i += NT) { const f32x4 a = *(const GAS f32x4*)(src + i * 8), b = *(const GAS f32x4*)(src + i * 8 + 4);
        v4u o; o.x = pk2(a.x, a.y); o.y = pk2(a.z, a.w); o.z = pk2(b.x, b.y); o.w = pk2(b.z, b.w); *(GAS v4u*)(dst + i * 8) = o; }
}

__device__ __forceinline__ unsigned pack4i8(float a, float b, float c, float d) {
    const int ia = (int)__builtin_rintf(a), ib = (int)__builtin_rintf(b), ic = (int)__builtin_rintf(c), id = (int)__builtin_rintf(d);
    return (unsigned)(ia & 0xff) | ((unsigned)(ib & 0xff) << 8) | ((unsigned)(ic & 0xff) << 16) | ((unsigned)id << 24);
}
__device__ __forceinline__ void trq_job(Frame& F, int& rot, const float* W, int K, int N, int ncols, signed char* WQ, float* SC, int g, int s0, int ss, int d0, int ds) {
    LAS float* scr = (LAS float*)(F.lds + RING_OFF + F.wave * 16384);
    const int NGW = F.G * NWAVES, gw = F.vcu * NWAVES + F.wave, nitems = ncols / 32, lane = F.lane;
    int first = (gw - rot) % NGW; if (first < 0) first += NGW;
    for (int it = first; it < nitems; it += NGW) {
        const int j0 = 32 * it, grp = j0 / g, jin = j0 % g, sn0 = s0 + grp * ss + jin, dn0 = d0 + grp * ds + jin;
        const float* wp = W + sn0 + (lane & 31) + (size_t)(lane >> 5) * N;
        float mx = 0.f;
        for (int kb = 0; kb < K / 64; ++kb) { float v[32];
#pragma unroll
            for (int i = 0; i < 32; ++i) v[i] = wp[(size_t)(kb * 64 + 2 * i) * N];
#pragma unroll
            for (int i = 0; i < 32; ++i) mx = fmaxf(mx, fabsf(v[i])); }
        mx = half_max32(mx);
        const float inv = mx > 0.f ? 127.f / mx : 0.f;
        if (lane < 32) SC[dn0 + lane] = mx > 0.f ? mx * (1.f / 127.f) : 1.f;
        for (int kb = 0; kb < K / 64; ++kb) { float v[32];
#pragma unroll
            for (int i = 0; i < 32; ++i) v[i] = wp[(size_t)(kb * 64 + 2 * i) * N];
#pragma unroll
            for (int i = 0; i < 32; ++i) scr[(2 * i + (lane >> 5)) * 33 + (lane & 31)] = v[i] * inv;
            LDS_WAIT(); asm volatile("" ::: "memory");
            const int n = lane >> 1, hf = lane & 1; const LAS float* s = scr + (hf * 32) * 33 + n;
            v4u o0, o1;
            o0.x = pack4i8(s[0 * 33], s[1 * 33], s[2 * 33], s[3 * 33]); o0.y = pack4i8(s[4 * 33], s[5 * 33], s[6 * 33], s[7 * 33]); o0.z = pack4i8(s[8 * 33], s[9 * 33], s[10 * 33], s[11 * 33]); o0.w = pack4i8(s[12 * 33], s[13 * 33], s[14 * 33], s[15 * 33]);
            o1.x = pack4i8(s[16 * 33], s[17 * 33], s[18 * 33], s[19 * 33]); o1.y = pack4i8(s[20 * 33], s[21 * 33], s[22 * 33], s[23 * 33]); o1.z = pack4i8(s[24 * 33], s[25 * 33], s[26 * 33], s[27 * 33]); o1.w = pack4i8(s[28 * 33], s[29 * 33], s[30 * 33], s[31 * 33]);
            GAS v4u* dp = (GAS v4u*)(WQ + (size_t)(dn0 + n) * K + kb * 64 + hf * 32); dp[0] = o0; dp[1] = o1;
            LDS_WAIT(); asm volatile("" ::: "memory"); }
    }
    rot = (rot + nitems) % NGW;
}
__device__ __forceinline__ void store_q8(signed char* XQ, float* SX, size_t m, const f32x4 (&v)[4], int lane) {
    float mx = 0.f;
#pragma unroll
    for (int j = 0; j < 4; ++j) mx = fmaxf(fmaxf(mx, fmaxf(fabsf(v[j].x), fabsf(v[j].y))), fmaxf(fabsf(v[j].z), fabsf(v[j].w)));
    mx = wave_max(mx);
    const float inv = mx > 0.f ? 127.f / mx : 0.f;
    GAS unsigned* o4 = (GAS unsigned*)(XQ + m * DM) + lane;
#pragma unroll
    for (int j = 0; j < 4; ++j) o4[64 * j] = pack4i8(v[j].x * inv, v[j].y * inv, v[j].z * inv, v[j].w * inv);
    if (lane == 0) SX[m] = mx > 0.f ? mx * (1.f / 127.f) : 1.f;
}

template <class Sched> __device__ __forceinline__ void rms_prepass(Frame& F, const Sched& S, const float* PS, int p0, int NP, int K) {
    LAS float* rtab = (LAS float*)(F.lds + X_RTAB); pg8::Unit u;
    if (F.tid < 256) {
        for (int i = 0; i < 4 && S.next(i, u); ++i) { const GAS f32x4* pp = (const GAS f32x4*)(PS + (size_t)(u.pa * 256 + F.tid) * 16 + p0);
            float s = 0.f;
            for (int j = 0; j < NP / 4; ++j) { const f32x4 x = pp[j]; s += (x[0] + x[1]) + (x[2] + x[3]); }
            rtab[i * 256 + F.tid] = 1.0f / sqrtf(s / (float)K + RMS_EPS); }
    }
    LDS_WAIT(); __syncthreads();
}

__device__ __forceinline__ void ln_core(f32x4 (&v)[4], const f32x4 (&g)[4], const f32x4 (&bb)[4]) {
    float s = 0.f;
#pragma unroll
    for (int j = 0; j < 4; ++j) s += (v[j].x + v[j].y) + (v[j].z + v[j].w);
    const float mean = wave_sum(s) * (1.f / DM); float s2 = 0.f;
#pragma unroll
    for (int j = 0; j < 4; ++j) { v[j] = v[j] - mean; s2 += (v[j].x * v[j].x + v[j].y * v[j].y) + (v[j].z * v[j].z + v[j].w * v[j].w); }
    const float rstd = 1.f / sqrtf(wave_sum(s2) * (1.f / DM) + LN_EPS);
#pragma unroll
    for (int j = 0; j < 4; ++j) v[j] = v[j] * rstd * g[j] + bb[j];
}
__device__ __forceinline__ void store_row(float* R, bf16* XB, size_t m, const f32x4 (&v)[4], int lane, bool wb) {
    GAS f32x4* o = (GAS f32x4*)(R + m * DM) + lane;
#pragma unroll
    for (int j = 0; j < 4; ++j) o[64 * j] = v[j];
    if (wb) { GAS unsigned long long* o8 = (GAS unsigned long long*)(XB + m * DM) + lane;
#pragma unroll
        for (int j = 0; j < 4; ++j) o8[64 * j] = (unsigned long long)pk2(v[j].x, v[j].y) | ((unsigned long long)pk2(v[j].z, v[j].w) << 32); }
}

__device__ __forceinline__ void load_bf(f32x4 (&v)[4], const bf16* Y, size_t m, int lane) {
    const GAS v2u* p = (const GAS v2u*)(Y + m * DM) + lane;
#pragma unroll
    for (int j = 0; j < 4; ++j) { const v2u w = p[64 * j]; v[j].x = bflo(w.x); v[j].y = bfhi(w.x); v[j].z = bflo(w.y); v[j].w = bfhi(w.y); }
}
__device__ __forceinline__ void store_bf(bf16* XB, size_t m, const f32x4 (&v)[4], int lane) {
    GAS unsigned long long* o8 = (GAS unsigned long long*)(XB + m * DM) + lane;
#pragma unroll
    for (int j = 0; j < 4; ++j) o8[64 * j] = (unsigned long long)pk2(v[j].x, v[j].y) | ((unsigned long long)pk2(v[j].z, v[j].w) << 32);
}
__device__ __forceinline__ void moe_tables(Frame& F, const int* CNT, bool wantPre) {
    LAS int* tot = (LAS int*)(F.lds + X_TOT); LAS int* off = (LAS int*)(F.lds + X_OFF); LAS int* pre = (LAS int*)(F.lds + X_PRE);
    const int e = F.wave;
    int carry = 0;
    for (int b0 = 0; b0 < F.G; b0 += 64) { const int blk = b0 + F.lane; const int v = (blk < F.G) ? CNT[blk * 8 + e] : 0;
        int inc = v;
#pragma unroll
        for (int o = 1; o < 64; o <<= 1) { const int t = __builtin_amdgcn_ds_bpermute(4 * (F.lane - o), inc); if (F.lane >= o) inc += t; }
        if (wantPre && blk < F.G && blk < 256) pre[blk * 8 + e] = carry + inc - v;
        carry += __builtin_amdgcn_readlane(inc, 63); }
    if (F.lane == 0) tot[e] = carry;
    LDS_WAIT(); __syncthreads();
    if (F.tid == 0) { int o = 0; for (int j = 0; j < 8; ++j) { off[j] = o; o += (tot[j] + 255) & ~255; } off[8] = o; }
    LDS_WAIT(); __syncthreads();
}

#ifndef REP_P0
#define REP_P0 1
#endif
#ifndef REP_MC
#define REP_MC 1
#endif
#ifndef REP_A
#define REP_A 1
#endif
#ifndef REP_MU
#define REP_MU 1
#endif
#ifndef REP_MD
#define REP_MD 1
#endif
#ifndef REP_B
#define REP_B 1
#endif
#ifndef REP_D
#define REP_D 1
#endif
#ifndef REP_FU
#define REP_FU 1
#endif
#ifndef REP_PM
#define REP_PM 1
#endif
#ifndef REP_LN
#define REP_LN 1
#endif
#ifndef REP_NA
#define REP_NA 1
#endif
#ifndef REP_MLA
#define REP_MLA 1
#endif
#ifndef EN_P0
#define EN_P0 1
#endif
#ifndef EN_A
#define EN_A 1
#endif
#ifndef EN_B
#define EN_B 1
#endif
#ifndef EN_C
#define EN_C 1
#endif
#ifndef EN_D
#define EN_D 1
#endif
#ifndef EN_E
#define EN_E 1
#endif
#ifndef EN_F
#define EN_F 1
#endif
#ifndef EN_G0
#define EN_G0 1
#endif
#ifndef EN_H0
#define EN_H0 1
#endif
#ifndef EN_G1
#define EN_G1 1
#endif
#ifndef EN_U1
#define EN_U1 1
#endif
#ifndef EN_D1
#define EN_D1 1
#endif
#ifndef EN_I
#define EN_I 1
#endif
__global__ void __launch_bounds__(NWAVES * 64, 2) mk_fwd(Args args) {
    extern __shared__ __attribute__((aligned(16))) unsigned char lds[];
    Frame F;
    F.lds = (LAS unsigned char*)lds;
    volatile LAS unsigned* MISC = (volatile LAS unsigned*)(F.lds + LDSCTL_OFF);
    F.tid = threadIdx.x; F.lane = F.tid & 63; F.wave = __builtin_amdgcn_readfirstlane(F.tid >> 6);
    F.G = gridDim.x; { const int bx = blockIdx.x; F.vcu = (F.G % 8 == 0) ? (bx % 8) * (F.G / 8) + bx / 8 : bx; }
    unsigned char* ws = args.ws; float* R = args.out;
    for (int u = F.tid; u < 128; u += NWAVES * 64) ((LAS unsigned*)(F.lds + LDSCTL_OFF))[u] = 0u;
    __syncthreads();
    const int lo = args.ph_lo, hi = args.ph_hi;
    const bool multi = (hi - lo) > 1;
    XcdBarrier bar; bar.bar = (unsigned*)(ws + WS_CTL) + CW_BAR; bar.x = 0; bar.st = nullptr; bar.w0 = 0;
    if (multi) bar = xcd_barrier_post((unsigned*)(ws + WS_CTL) + CW_BAR, MISC + 8);
    int ph = 0;
#define IN() (lo <= ph && ph < hi)
#define PH_BEGIN() do { int l_; asm volatile("v_mbcnt_lo_u32_b32 %0, -1, 0\n\tv_mbcnt_hi_u32_b32 %0, -1, %0" : "=v"(l_)); F.lane = l_; F.tid = F.wave * 64 + l_; } while (0)
#define SEAM() do { if (lo <= ph && ph + 1 < hi) xcd_barrier(bar); ++ph; } while (0)
    LAS unsigned char* ring = F.lds + RING_OFF;
    bf16* const XB = (bf16*)(ws + WS_XB);
    const float* const ROPE = (const float*)(ws + WS_ROPE);

    if (IN() && EN_P0) { PH_BEGIN();
        int rot = 0;
        for (int rep_ = 0; rep_ < REP_P0; ++rep_)
        for (int L = 0; L < 2; ++L) {
            bf16* WL = (bf16*)(ws + WS_W + (size_t)L * W_LAYER);
            const float* win = args.in[2] + (size_t)L * 1024 * NIN;
            bf16* WIN = (bf16*)((unsigned char*)WL + W_WIN);
            signed char* WINQ = (signed char*)WIN; float* swin = (float*)(ws + WS_SWIN) + L * NPROJ;
            trq_job(F, rot, win, 1024, NIN, 1536, WINQ, swin, 1536, 0, 0, 0, 0);
            trq_job(F, rot, win, 1024, NIN, 768, WINQ, swin, 768, 1536, 0, 1536, 0);
            trq_job(F, rot, win, 1024, NIN, 2048, WINQ, swin, 2048, 2592, 0, 2304, 0);
            trq_job(F, rot, win, 1024, NIN, 256, WINQ, swin, 256, 2304, 0, 4352, 0);
            trq_job(F, rot, win, 1024, NIN, 32, WINQ, swin, 32, 2560, 0, 4608, 0);
            { const size_t n16 = (size_t)(NPROJ - 4640) * 1024 / 16, NT = (size_t)F.G * NWAVES * 64; signed char* z = WINQ + (size_t)4640 * 1024;
              for (size_t i = (size_t)(F.vcu * NWAVES + F.wave) * 64 + F.lane; i < n16; i += NT) *(GAS v4u*)(z + i * 16) = (v4u){0u, 0u, 0u, 0u};
              for (size_t i = (size_t)(F.vcu * NWAVES + F.wave) * 64 + F.lane; i < (size_t)(NPROJ - 4640); i += NT) swin[4640 + i] = 1.f; }
            tr_job(F, rot, args.in[5] + (size_t)L * 768 * 768, 768, 768, 768, (bf16*)((unsigned char*)WL + W_WUQ), 768, 0, 0, 0, 0, args.in[4] + L * 768);
            const float* wukv = args.in[7] + (size_t)L * 256 * 1024; const float* kvg = args.in[6] + L * 256;
            tr_job(F, rot, wukv, 256, 1024, 512, (bf16*)((unsigned char*)WL + W_WUKV), 64, 0, 128, 0, 64, kvg);
            tr_job(F, rot, wukv, 256, 1024, 512, (bf16*)((unsigned char*)WL + W_WUKV), 64, 64, 128, 512, 64, kvg);
            tr_plain(F, rot, args.in[9] + (size_t)L * 512 * 1024, 512, 1024, (bf16*)((unsigned char*)WL + W_WNAO));
            tr_plain(F, rot, args.in[10] + (size_t)L * 512 * 1024, 512, 1024, (bf16*)((unsigned char*)WL + W_WMLAO));
            tr_plain(F, rot, args.in[11] + (size_t)L * 1024 * 1024, 1024, 1024, (bf16*)((unsigned char*)WL + W_WOUT));
            trq_job(F, rot, args.in[22] + (size_t)L * 1024 * 1024, 1024, 1024, 1024, (signed char*)((unsigned char*)WL + W_WPG), (float*)(ws + WS_SWPG) + L * 1024, 1024, 0, 0, 0, 0);
            tr_plain(F, rot, args.in[23] + (size_t)L * 256 * 1024, 256, 1024, (bf16*)((unsigned char*)WL + W_WPLE));
        }
        trq_job(F, rot, args.in[14], 1024, DFF, DFF, (signed char*)(ws + WS_W13), (float*)(ws + WS_SW13), 128, 0, 128, 0, 256);
        trq_job(F, rot, args.in[15], 1024, DFF, DFF, (signed char*)(ws + WS_W13), (float*)(ws + WS_SW13), 128, 0, 128, 128, 256);
        tr_plain(F, rot, args.in[16], DFF, 1024, (bf16*)(ws + WS_W2));
        { const int NT = F.G * NWAVES * 64; float* rt_ = (float*)(ws + WS_ROPE);
          for (int i = (F.vcu * NWAVES + F.wave) * 64 + F.lane; i < SEQ * 16; i += NT) { const int pos = i >> 4, k = i & 15;
              double invf = 1.0; for (int q_ = 0; q_ < k; ++q_) invf *= 0.5623413251903491;
              const double rev = (double)pos * invf * 0.15915494309189535; const float fr_ = (float)(rev - floor(rev));
              rt_[2 * i] = __builtin_amdgcn_cosf(fr_); rt_[2 * i + 1] = __builtin_amdgcn_sinf(fr_); } }
        { const int gw = F.vcu * NWAVES + F.wave, NGW = F.G * NWAVES;
          for (int m = gw; m < MTOK; m += NGW) { f32x4 v[4]; const GAS f32x4* xr = (const GAS f32x4*)(args.in[0] + (size_t)m * DM) + F.lane;
#pragma unroll
              for (int j = 0; j < 4; ++j) v[j] = xr[64 * j];
              store_bf(XB, (size_t)m, v, F.lane); store_q8((signed char*)R + (128u << 20), (float*)(ws + WS_SX), (size_t)m, v, F.lane); } }
    }
    SEAM();

    for (int L = 0; L < 2; ++L) {
        unsigned char* WL = ws + WS_W + (size_t)L * W_LAYER;
        if (IN() && EN_A) { PH_BEGIN();
            pg8::Gemm g{(const pg8::bf16_t*)((const signed char*)R + (128u << 20)), (const pg8::bf16_t*)(WL + W_WIN), MTOK, NPROJ, 512, 0, 0}; pg8::StaticOrder S; S.init(MTOK, NPROJ, F.G, (int)blockIdx.x);
            pg8::EpiProj E{(bf16*)(ws + WS_NAQKV), (bf16*)(ws + WS_QLAT), (bf16*)(ws + WS_GATES), (bf16*)(ws + WS_KVLAT), (bf16*)(ws + WS_KMLA), args.in[3] + L * 2048, ROPE, NA_QSCALE, (float*)(ws + WS_PS), (const float*)(ws + WS_SX), (const float*)(ws + WS_SWIN) + L * NPROJ, (LAS float*)(F.lds + X_SCL)};
            for (int rep_ = 0; rep_ < REP_A; ++rep_) { pg8::gemm_phase<pg8::EpiProj, pg8::StaticOrder, true, true, true>(ring, g, S, E, F.wave); __syncthreads(); }
        }
        SEAM();
        if (IN() && EN_B) { PH_BEGIN();
            for (int rep_ = 0; rep_ < REP_B; ++rep_) {
            { pg8::Gemm g{(const pg8::bf16_t*)(ws + WS_QLAT), (const pg8::bf16_t*)(WL + W_WUQ), MTOK, 768, 768}; pg8::StaticOrder S; S.init(MTOK, 768, F.G, (int)blockIdx.x);
              asm volatile("" : "+s"(S.c), "+s"(S.G)); rms_prepass(F, S, (const float*)(ws + WS_PS), 0, 12, 768); asm volatile("" : "+s"(S.c), "+s"(S.G));
              pg8::EpiQup E{(bf16*)R, (const LAS float*)(F.lds + X_RTAB), ROPE, MLA_QSCALE};
              pg8::gemm_phase<pg8::EpiQup, pg8::StaticOrder, true, true>(ring, g, S, E, F.wave); }
            __syncthreads(); PH_BEGIN();
            { pg8::Gemm g{(const pg8::bf16_t*)(ws + WS_KVLAT), (const pg8::bf16_t*)(WL + W_WUKV), MTOK, 1024, 256}; pg8::StaticOrder S; S.init(MTOK, 1024, F.G, (int)blockIdx.x);
              asm volatile("" : "+s"(S.c), "+s"(S.G)); rms_prepass(F, S, (const float*)(ws + WS_PS), 12, 4, 256); asm volatile("" : "+s"(S.c), "+s"(S.G));
              pg8::EpiKVup E{(bf16*)(ws + WS_KMLA), (bf16*)(ws + WS_VMLA), (const LAS float*)(F.lds + X_RTAB)};
              pg8::gemm_phase<pg8::EpiKVup, pg8::StaticOrder, true, true>(ring, g, S, E, F.wave); }
            __syncthreads(); }
        }
        SEAM();
        if (IN() && EN_C) { PH_BEGIN();
            const float* rpb = args.in[8] + (size_t)L * 8 * 15 * 31;
            for (int rep_ = 0; rep_ < REP_NA; ++rep_)
            for (int uid = F.vcu; uid < 2048; uid += F.G) { const int pair = uid >> 5, rg = uid & 31;
                att::na_unit(pair >> 3, pair & 7, rg, (const att::bf16*)(ws + WS_NAQKV), (att::bf16*)(ws + WS_ONA), rpb, (LAS char*)ring, F.wave); }
            for (int rep_ = 0; rep_ < REP_MLA; ++rep_)
            for (int uid = F.vcu; uid < 2048; uid += F.G) { const int pair = uid >> 5, qb = uid & 31, b = pair >> 3, h = pair & 7;
                const size_t row0 = (size_t)b * SEQ;
                att::mla_unit((const att::bf16*)R + (row0 + qb * 256) * 768 + h * 96, (const att::bf16*)(ws + WS_KMLA) + row0 * 768 + h * 96,
                              (const att::bf16*)(ws + WS_VMLA) + row0 * 512 + h * 64, (att::bf16*)(ws + WS_OMLA) + (row0 + qb * 256) * 512 + h * 64, SEQ, (LAS char*)ring, F.wave); }
        }
        SEAM();
        if (IN() && EN_D) { PH_BEGIN();
            for (int rep_ = 0; rep_ < REP_D; ++rep_) {
            pg8::StaticOrder S; S.init(MTOK, 1024, F.G, (int)blockIdx.x);
            { pg8::Gemm g{(const pg8::bf16_t*)(ws + WS_ONA), (const pg8::bf16_t*)(WL + W_WNAO), MTOK, 1024, 512};
              pg8::EpiMerge E{(const unsigned char*)(ws + WS_GATES), (pg8::bf16_t*)(ws + WS_MERGED), 0};
              pg8::gemm_phase<pg8::EpiMerge, pg8::StaticOrder, true, true>(ring, g, S, E, F.wave); }
            __syncthreads();
            { pg8::Gemm g{(const pg8::bf16_t*)(ws + WS_OMLA), (const pg8::bf16_t*)(WL + W_WMLAO), MTOK, 1024, 512};
              pg8::EpiMerge E{(const unsigned char*)(ws + WS_GATES) + 1024, (pg8::bf16_t*)(ws + WS_MERGED), 1};
              pg8::gemm_phase<pg8::EpiMerge, pg8::StaticOrder, true, true>(ring, g, S, E, F.wave); }
            __syncthreads(); }
        }
        SEAM();
        if (IN() && EN_E) { PH_BEGIN();
            { pg8::Gemm g{(const pg8::bf16_t*)(ws + WS_MERGED), (const pg8::bf16_t*)(WL + W_WOUT), MTOK, 1024, 1024}; pg8::StaticOrder S; S.init(MTOK, 1024, F.G, (int)blockIdx.x);
              pg8::EpiRes<0> E{(const pg8::bf16_t*)XB, (pg8::bf16_t*)R, nullptr, ALPHA};
              pg8::gemm_phase<pg8::EpiRes<0>, pg8::StaticOrder, true, true>(ring, g, S, E, F.wave); }
            if (L == 1) { __syncthreads(); PH_BEGIN(); int rot = 0;
                for (int rep_ = 0; rep_ < REP_MC; ++rep_)
                for (int e = 0; e < NEXP; ++e) {
                    signed char* w13 = (signed char*)(ws + WS_WM13) + (size_t)e * 2 * DFFE * 1024; float* sc13 = (float*)(ws + WS_SWM13) + (size_t)e * 2 * DFFE;
                    trq_job(F, rot, args.in[19] + (size_t)e * 1024 * DFFE, 1024, DFFE, DFFE, w13, sc13, 128, 0, 128, 0, 256);
                    trq_job(F, rot, args.in[20] + (size_t)e * 1024 * DFFE, 1024, DFFE, DFFE, w13, sc13, 128, 0, 128, 128, 256);
                    tr_plain(F, rot, args.in[21] + (size_t)e * DFFE * 1024, DFFE, 1024, (bf16*)(ws + WS_WM2) + (size_t)e * 1024 * DFFE); } }
        }
        SEAM();
        if (IN() && EN_F) { PH_BEGIN();
            f32x4 g[4], bb[4];
            { const GAS f32x4* gp = (const GAS f32x4*)(args.in[12] + L * DM) + F.lane; const GAS f32x4* bp = (const GAS f32x4*)(args.in[13] + L * DM) + F.lane;
#pragma unroll
              for (int j = 0; j < 4; ++j) { g[j] = gp[64 * j]; bb[j] = bp[64 * j]; } }
            LAS float* wrl = (LAS float*)ring; LAS int* lcnt = (LAS int*)(F.lds + X_LCNT);
            if (L == 1) { const float* wr = args.in[17];
                for (int i = F.tid; i < 1024 * 8 / 4; i += NWAVES * 64) ((LAS f32x4*)wrl)[i] = ((const GAS f32x4*)wr)[i];
                if (F.tid < 8) lcnt[F.tid] = 0;
                LDS_WAIT(); __syncthreads(); }
            const int gw = F.vcu * NWAVES + F.wave, NGW = F.G * NWAVES;
            if (REP_LN > 1) for (int m = gw; m < MTOK; m += NGW) {
                f32x4 v[4]; const GAS f32x4* xr = (const GAS f32x4*)(R + (size_t)m * DM) + F.lane;
#pragma unroll
                for (int j = 0; j < 4; ++j) v[j] = xr[64 * j];
                ln_core(v, g, bb);
                store_row((float*)(ws + WS_GATES), XB, (size_t)m, v, F.lane, true); }
            v2u raw[4];
            { const GAS v2u* p_ = (const GAS v2u*)((const bf16*)R + (size_t)gw * DM) + F.lane;
#pragma unroll
              for (int j = 0; j < 4; ++j) raw[j] = p_[64 * j]; }
            for (int m = gw; m < MTOK; m += NGW) {
                f32x4 v[4];
#pragma unroll
                for (int j = 0; j < 4; ++j) { v[j].x = bflo(raw[j].x); v[j].y = bfhi(raw[j].x); v[j].z = bflo(raw[j].y); v[j].w = bfhi(raw[j].y); }
                if (m + NGW < MTOK) { const GAS v2u* p_ = (const GAS v2u*)((const bf16*)R + (size_t)(m + NGW) * DM) + F.lane;
#pragma unroll
                    for (int j = 0; j < 4; ++j) raw[j] = p_[64 * j]; }
                ln_core(v, g, bb);
                store_bf(XB, (size_t)m, v, F.lane);
                store_q8((signed char*)R + (192u << 20), (float*)(ws + WS_SX1), (size_t)m, v, F.lane);
                if (L == 1) {
                    float lg[8];
#pragma unroll
                    for (int e = 0; e < 8; ++e) lg[e] = 0.f;
#pragma unroll
                    for (int j = 0; j < 4; ++j)
#pragma unroll
                        for (int t = 0; t < 4; ++t) { const int k = 4 * F.lane + 256 * j + t; const f32x4 w0 = *(const LAS f32x4*)(wrl + k * 8), w1 = *(const LAS f32x4*)(wrl + k * 8 + 4); const float xv = v[j][t];
                            lg[0] += xv * w0.x; lg[1] += xv * w0.y; lg[2] += xv * w0.z; lg[3] += xv * w0.w; lg[4] += xv * w1.x; lg[5] += xv * w1.y; lg[6] += xv * w1.z; lg[7] += xv * w1.w; }
#pragma unroll
                    for (int e = 0; e < 8; ++e) lg[e] = wave_sum(lg[e]) + args.in[18][e];
                    int i0 = 0; float l0 = lg[0];
#pragma unroll
                    for (int e = 1; e < 8; ++e) if (lg[e] > l0) { l0 = lg[e]; i0 = e; }
                    int i1 = -1; float l1 = -3.0e38f;
#pragma unroll
                    for (int e = 0; e < 8; ++e) if (e != i0 && lg[e] > l1) { l1 = lg[e]; i1 = e; }
                    const float w0 = 1.0f / (1.0f + __expf(l1 - l0)), w1 = 1.0f - w0;
                    if (F.lane == 0) {
                        const int lp0 = __hip_atomic_fetch_add(lcnt + i0, 1, __ATOMIC_RELAXED, __HIP_MEMORY_SCOPE_WORKGROUP), lp1 = __hip_atomic_fetch_add(lcnt + i1, 1, __ATOMIC_RELAXED, __HIP_MEMORY_SCOPE_WORKGROUP);
                        ((int*)(ws + WS_TE))[m] = i0 | (i1 << 4) | ((int)blockIdx.x << 8);
                        ((int2*)(ws + WS_TP))[m] = make_int2(lp0, lp1); ((float2*)(ws + WS_TW))[m] = make_float2(w0, w1); }
                }
            }
            if (L == 1) { LDS_WAIT(); __syncthreads(); if (F.tid < 8) ((int*)(ws + WS_CNT))[blockIdx.x * 8 + F.tid] = lcnt[F.tid]; }
            cvt_rows(F, args.in[1] + (size_t)L * MTOK * PLED, (bf16*)(ws + WS_PB), (size_t)MTOK * PLED / 8);
        }
        SEAM();
        if (L == 0) {
            if (IN() && EN_G0) { PH_BEGIN();
                { pg8::Gemm g{(const pg8::bf16_t*)((const signed char*)R + (192u << 20)), (const pg8::bf16_t*)(ws + WS_W13), MTOK, 2 * DFF, 512, 0, 0}; pg8::StaticOrder S; S.init(MTOK, 2 * DFF, F.G, (int)blockIdx.x);
                  pg8::EpiGLUQ E{(pg8::bf16_t*)(ws + WS_H), DFF, (const float*)(ws + WS_SX1), (const float*)(ws + WS_SW13), (LAS float*)(F.lds + X_SCL)};
                  for (int rep_ = 0; rep_ < REP_FU; ++rep_) { pg8::gemm_phase<pg8::EpiGLUQ, pg8::StaticOrder, true, true, true>(ring, g, S, E, F.wave); __syncthreads(); } }
                __syncthreads();
                pg8::StaticOrder S; S.init(MTOK, 1024, F.G, (int)blockIdx.x);
                { pg8::Gemm g{(const pg8::bf16_t*)((const signed char*)R + (192u << 20)), (const pg8::bf16_t*)(WL + W_WPG), MTOK, 1024, 512, 0, 0};
                  pg8::EpiGate8 E{(unsigned char*)(ws + WS_G8), (const float*)(ws + WS_SX1), (const float*)(ws + WS_SWPG) + L * 1024, (LAS float*)(F.lds + X_SCL)};
                  pg8::gemm_phase<pg8::EpiGate8, pg8::StaticOrder, true, true, true>(ring, g, S, E, F.wave); }
                __syncthreads();
                { pg8::Gemm g{(const pg8::bf16_t*)(ws + WS_PB), (const pg8::bf16_t*)(WL + W_WPLE), MTOK, 1024, 256};
                  pg8::EpiGateMul E{(const unsigned char*)(ws + WS_G8), (pg8::bf16_t*)(ws + WS_PP_DENSE)};
                  pg8::gemm_phase<pg8::EpiGateMul, pg8::StaticOrder, true, true>(ring, g, S, E, F.wave); }
            }
            SEAM();
            if (IN() && EN_H0) { PH_BEGIN();
                pg8::Gemm g{(const pg8::bf16_t*)(ws + WS_H), (const pg8::bf16_t*)(ws + WS_W2), MTOK, 1024, DFF}; pg8::StaticOrder S; S.init(MTOK, 1024, F.G, (int)blockIdx.x);
                pg8::EpiRes<2> E{(const pg8::bf16_t*)XB, (pg8::bf16_t*)R, (pg8::bf16_t*)(ws + WS_PP_DENSE), ALPHA};
                pg8::gemm_phase<pg8::EpiRes<2>, pg8::StaticOrder, true, true>(ring, g, S, E, F.wave);
            }
            SEAM();
        } else {
            if (IN() && EN_G1) { PH_BEGIN();
                moe_tables(F, (const int*)(ws + WS_CNT), true);
                if (blockIdx.x == 0 && F.tid < 9) ((int*)(ws + WS_CNT + 49152))[F.tid] = ((const LAS int*)(F.lds + X_OFF))[F.tid];
                { const LAS int* off = (const LAS int*)(F.lds + X_OFF); const LAS int* pre = (const LAS int*)(F.lds + X_PRE);
                  const int gw = F.vcu * NWAVES + F.wave, NGW = F.G * NWAVES;
                  for (int m0 = gw; m0 < MTOK; m0 += 4 * NGW) {
                      int te[4]; int2 tp[4]; float2 tw[4]; int d0[4], d1[4]; v4u ra[4], rb[4];
#pragma unroll
                      for (int q = 0; q < 4; ++q) { const int m = m0 + q * NGW; te[q] = ((const int*)(ws + WS_TE))[m]; tp[q] = ((const int2*)(ws + WS_TP))[m]; tw[q] = ((const float2*)(ws + WS_TW))[m]; }
#pragma unroll
                      for (int q = 0; q < 4; ++q) { const int m = m0 + q * NGW; ra[q] = ((const GAS v4u*)((const signed char*)R + (192u << 20) + (size_t)m * DM))[F.lane]; rb[q].x = __float_as_uint(((const float*)(ws + WS_SX1))[m]); }
#pragma unroll
                      for (int q = 0; q < 4; ++q) { const int e0 = te[q] & 15, e1 = (te[q] >> 4) & 15, blk = te[q] >> 8;
                          d0[q] = off[e0] + pre[blk * 8 + e0] + tp[q].x; d1[q] = off[e1] + pre[blk * 8 + e1] + tp[q].y; }
#pragma unroll
                      for (int q = 0; q < 4; ++q) { const int m = m0 + q * NGW;
                          ((GAS v4u*)((signed char*)R + (size_t)d0[q] * DM))[F.lane] = ra[q]; ((GAS v4u*)((signed char*)R + (size_t)d1[q] * DM))[F.lane] = ra[q];
                          if (F.lane == 0) { ((float*)(ws + WS_SW))[d0[q]] = tw[q].x; ((float*)(ws + WS_SW))[d1[q]] = tw[q].y; ((int2*)(ws + WS_TPOS))[m] = make_int2(d0[q], d1[q]);
                              ((float*)(ws + WS_SXS))[d0[q]] = __uint_as_float(rb[q].x); ((float*)(ws + WS_SXS))[d1[q]] = __uint_as_float(rb[q].x); } } } }
                __syncthreads();
                pg8::StaticOrder S; S.init(MTOK, 1024, F.G, (int)blockIdx.x);
                { pg8::Gemm g{(const pg8::bf16_t*)((const signed char*)R + (192u << 20)), (const pg8::bf16_t*)(WL + W_WPG), MTOK, 1024, 512, 0, 0};
                  pg8::EpiGate8 E{(unsigned char*)(ws + WS_G8), (const float*)(ws + WS_SX1), (const float*)(ws + WS_SWPG) + L * 1024, (LAS float*)(F.lds + X_SCL)};
                  pg8::gemm_phase<pg8::EpiGate8, pg8::StaticOrder, true, true, true>(ring, g, S, E, F.wave); }
                __syncthreads();
                { pg8::Gemm g{(const pg8::bf16_t*)(ws + WS_PB), (const pg8::bf16_t*)(WL + W_WPLE), MTOK, 1024, 256};
                  pg8::EpiGateMul E{(const unsigned char*)(ws + WS_G8), (pg8::bf16_t*)(ws + WS_PP_MOE)};
                  pg8::gemm_phase<pg8::EpiGateMul, pg8::StaticOrder, true, true>(ring, g, S, E, F.wave); }
            }
            SEAM();
            for (int c = 0; c < MOE_NCHUNK; ++c) {
                if (IN() && EN_U1) { PH_BEGIN();
                    if (F.tid < 9) ((LAS int*)(F.lds + X_OFF))[F.tid] = ((const int*)(ws + WS_CNT + 49152))[F.tid];
                    LDS_WAIT(); __syncthreads();
                    const LAS int* off = (const LAS int*)(F.lds + X_OFF);
                    const int NT = __builtin_amdgcn_readfirstlane(off[8]) >> 8; const int capU = (c == MOE_NCHUNK - 1) ? MOE_CHUNK + MOE_REMT : MOE_CHUNK;
                    int nMc = NT - c * MOE_CHUNK; nMc = nMc < 0 ? 0 : (nMc > capU ? capU : nMc);
                    pg8::MoeOrder<true> S; S.nMc = nMc; S.nN = 2 * DFFE / 256; S.nwg = nMc * S.nN; S.G = F.G; S.c = (int)blockIdx.x; S.t0 = c * MOE_CHUNK;
                    S.ts1 = __builtin_amdgcn_readfirstlane(off[1]) >> 8; S.ts2 = __builtin_amdgcn_readfirstlane(off[2]) >> 8; S.ts3 = __builtin_amdgcn_readfirstlane(off[3]) >> 8; S.ts4 = __builtin_amdgcn_readfirstlane(off[4]) >> 8;
                    S.ts5 = __builtin_amdgcn_readfirstlane(off[5]) >> 8; S.ts6 = __builtin_amdgcn_readfirstlane(off[6]) >> 8; S.ts7 = __builtin_amdgcn_readfirstlane(off[7]) >> 8;
                    pg8::Gemm g{(const pg8::bf16_t*)R, (const pg8::bf16_t*)(ws + WS_WM13), MOE_MAXT * 256, 2 * DFFE, 512, 0, 0};
                    pg8::EpiGLUQ E{(pg8::bf16_t*)(ws + WS_HS), DFFE, (const float*)(ws + WS_SXS), (const float*)(ws + WS_SWM13), (LAS float*)(F.lds + X_SCL)};
                    for (int rep_ = 0; rep_ < REP_MU; ++rep_) { pg8::gemm_phase<pg8::EpiGLUQ, pg8::MoeOrder<true>, true, true, true>(ring, g, S, E, F.wave); __syncthreads(); }
                }
                SEAM();
                if (IN() && EN_D1) { PH_BEGIN();
                    if (F.tid < 9) ((LAS int*)(F.lds + X_OFF))[F.tid] = ((const int*)(ws + WS_CNT + 49152))[F.tid];
                    LDS_WAIT(); __syncthreads();
                    const LAS int* off = (const LAS int*)(F.lds + X_OFF);
                    const int NT = __builtin_amdgcn_readfirstlane(off[8]) >> 8; int nMc = NT - c * MOE_CHUNK; nMc = nMc < 0 ? 0 : (nMc > MOE_CHUNK ? MOE_CHUNK : nMc);
                    const int t1 = __builtin_amdgcn_readfirstlane(off[1]) >> 8, t2 = __builtin_amdgcn_readfirstlane(off[2]) >> 8, t3 = __builtin_amdgcn_readfirstlane(off[3]) >> 8, t4 = __builtin_amdgcn_readfirstlane(off[4]) >> 8,
                              t5 = __builtin_amdgcn_readfirstlane(off[5]) >> 8, t6 = __builtin_amdgcn_readfirstlane(off[6]) >> 8, t7 = __builtin_amdgcn_readfirstlane(off[7]) >> 8;
                    {
                        pg8::MoeOrder<false> S; S.nMc = nMc; S.nN = 4; S.nwg = nMc * 4; S.G = F.G; S.c = (int)blockIdx.x; S.t0 = c * MOE_CHUNK;
                        S.ts1 = t1; S.ts2 = t2; S.ts3 = t3; S.ts4 = t4; S.ts5 = t5; S.ts6 = t6; S.ts7 = t7;
                        pg8::Gemm g{(const pg8::bf16_t*)(ws + WS_HS), (const pg8::bf16_t*)(ws + WS_WM2), MOE_CHUNK * 256, 1024, DFFE, 0, 0};
                        pg8::EpiMoeDown E{(pg8::bf16_t*)(ws + WS_XS), (const float*)(ws + WS_SW)};
                        for (int rep_ = 0; rep_ < REP_MD; ++rep_) { pg8::gemm_phase<pg8::EpiMoeDown, pg8::MoeOrder<false>, true, true>(ring, g, S, E, F.wave); __syncthreads(); }
                    }
                    if (c == MOE_NCHUNK - 1) {
                        PH_BEGIN();
                        pg8::MoeRemOrder S; S.nT = NT - MOE_FULL; S.G = F.G; S.c = (int)blockIdx.x; S.t0 = MOE_FULL; S.KQ = DFFE / 4; S.pa0 = MOE_CHUNK;
                        S.ts1 = t1; S.ts2 = t2; S.ts3 = t3; S.ts4 = t4; S.ts5 = t5; S.ts6 = t6; S.ts7 = t7;
                        pg8::Gemm g{(const pg8::bf16_t*)(ws + WS_HS), (const pg8::bf16_t*)(ws + WS_WM2), MOE_REM_ROWS, 1024, DFFE / 4, DFFE, DFFE};
                        pg8::EpiMoeRem E{(pg8::bf16_t*)(ws + WS_PART), (const float*)(ws + WS_SW), MOE_FULL, MOE_REM_ROWS};
                        pg8::gemm_phase<pg8::EpiMoeRem, pg8::MoeRemOrder, true, true>(ring, g, S, E, F.wave);
                    }
                }
                SEAM();
            }
        }
        if (L == 1) {
            if (IN() && EN_I) { PH_BEGIN();
                if (F.tid < 9) ((LAS int*)(F.lds + X_OFF))[F.tid] = ((const int*)(ws + WS_CNT + 49152))[F.tid];
                LDS_WAIT(); __syncthreads();
                const int nrem = (__builtin_amdgcn_readfirstlane(((const LAS int*)(F.lds + X_OFF))[8]) >> 8) - MOE_FULL;
                const int gw = F.vcu * NWAVES + F.wave, NGW = F.G * NWAVES;
                for (int r = gw; r < nrem * 256; r += NGW) {
                    const GAS v2u* pp = (const GAS v2u*)((const bf16*)(ws + WS_PART) + (size_t)r * DM) + F.lane; GAS v2u* dst = (GAS v2u*)((bf16*)(ws + WS_XS) + (size_t)(MOE_FULL * 256 + r) * DM) + F.lane;
#pragma unroll
                    for (int j = 0; j < 4; ++j) { float s0 = 0.f, s1 = 0.f, s2 = 0.f, s3 = 0.f;
#pragma unroll
                        for (int q = 0; q < 4; ++q) { const v2u a = pp[(size_t)q * MOE_REM_ROWS * DM / 4 + 64 * j]; s0 += bflo(a.x); s1 += bfhi(a.x); s2 += bflo(a.y); s3 += bfhi(a.y); }
                        v2u o; o.x = pk2(s0, s1); o.y = pk2(s2, s3); dst[64 * j] = o; }
                }
            }
            SEAM();
        }
        if (IN() && EN_I) { PH_BEGIN();
            f32x4 g[4], bb[4];
            { const GAS f32x4* gp = (const GAS f32x4*)(args.in[24] + L * DM) + F.lane; const GAS f32x4* bp = (const GAS f32x4*)(args.in[25] + L * DM) + F.lane;
#pragma unroll
              for (int j = 0; j < 4; ++j) { g[j] = gp[64 * j]; bb[j] = bp[64 * j]; } }
            const int gw = F.vcu * NWAVES + F.wave, NGW = F.G * NWAVES;
            const bool tmo = (L == 1) && (__hip_atomic_load((unsigned*)(ws + WS_CTL) + CW_BAR + XB_TMO, __ATOMIC_RELAXED, __HIP_MEMORY_SCOPE_AGENT) != 0u);
            if (L == 0) {
                v2u rx[4];
                { const GAS v2u* p_ = (const GAS v2u*)((const bf16*)R + (size_t)gw * DM) + F.lane;
#pragma unroll
                  for (int j = 0; j < 4; ++j) rx[j] = p_[64 * j]; }
                for (int m = gw; m < MTOK; m += NGW) {
                    f32x4 v[4];
#pragma unroll
                    for (int j = 0; j < 4; ++j) { v[j].x = bflo(rx[j].x); v[j].y = bfhi(rx[j].x); v[j].z = bflo(rx[j].y); v[j].w = bfhi(rx[j].y); }
                    if (m + NGW < MTOK) { const GAS v2u* p_ = (const GAS v2u*)((const bf16*)R + (size_t)(m + NGW) * DM) + F.lane;
#pragma unroll
                        for (int j = 0; j < 4; ++j) rx[j] = p_[64 * j]; }
                    ln_core(v, g, bb);
                    store_bf(XB, (size_t)m, v, F.lane); store_q8((signed char*)R + (128u << 20), (float*)(ws + WS_SX), (size_t)m, v, F.lane);
                }
            } else {
                v2u rx[4], rp[4], ra[4], rb[4]; int2 tpn = ((const int2*)(ws + WS_TPOS))[gw];
#define LN2_LOAD(mm, tp_) do { const GAS v2u* x1 = (const GAS v2u*)(XB + (size_t)(mm) * DM) + F.lane; const GAS v2u* pl = (const GAS v2u*)((const bf16*)(ws + WS_PP_MOE) + (size_t)(mm) * DM) + F.lane; \
        const GAS v2u* f0 = (const GAS v2u*)((const bf16*)(ws + WS_XS) + (size_t)(tp_).x * DM) + F.lane; const GAS v2u* f1 = (const GAS v2u*)((const bf16*)(ws + WS_XS) + (size_t)(tp_).y * DM) + F.lane; \
        _Pragma("unroll") for (int j = 0; j < 4; ++j) { rx[j] = x1[64 * j]; rp[j] = pl[64 * j]; ra[j] = f0[64 * j]; rb[j] = f1[64 * j]; } } while (0)
                LN2_LOAD(gw, tpn);
                if (gw + NGW < MTOK) tpn = ((const int2*)(ws + WS_TPOS))[gw + NGW];
                for (int m = gw; m < MTOK; m += NGW) {
                    f32x4 v[4];
#pragma unroll
                    for (int j = 0; j < 4; ++j) { const v2u x = rx[j], p = rp[j], a = ra[j], b = rb[j];
                        v[j].x = ALPHA * bflo(x.x) + bflo(p.x) + (bflo(a.x) + bflo(b.x)); v[j].y = ALPHA * bfhi(x.x) + bfhi(p.x) + (bfhi(a.x) + bfhi(b.x));
                        v[j].z = ALPHA * bflo(x.y) + bflo(p.y) + (bflo(a.y) + bflo(b.y)); v[j].w = ALPHA * bfhi(x.y) + bfhi(p.y) + (bfhi(a.y) + bfhi(b.y)); }
                    if (m + NGW < MTOK) { LN2_LOAD(m + NGW, tpn); if (m + 2 * NGW < MTOK) tpn = ((const int2*)(ws + WS_TPOS))[m + 2 * NGW]; }
                    ln_core(v, g, bb);
                    if (tmo) { const float qn = __builtin_nanf("");
#pragma unroll
                        for (int j = 0; j < 4; ++j) v[j] = (f32x4){qn, qn, qn, qn}; }
                    store_row(R, XB, (size_t)m, v, F.lane, false);
                }
            }
        }
        if (L == 0) SEAM();
    }
#undef LN2_LOAD
#undef IN
#undef SEAM
}

constexpr int N_PHASES = 27;
#ifndef MK_ONE_LAUNCH
#define MK_ONE_LAUNCH 1
#endif
extern "C" void kernel_launch(void* const* d_in, const int* in_sizes, int n_in, void* d_out, int out_size, void* d_ws, size_t ws_size, hipStream_t stream) {
    static int grid = 0;
    if (grid == 0) {
        if (n_in != 26 || in_sizes[0] != MTOK * DM || out_size != MTOK * DM || ws_size < WS_END) {
            fprintf(stderr, "kernel_launch: shape mismatch: n_in %d in0 %d out %d ws %zu (need %zu)\n", n_in, n_in > 0 ? in_sizes[0] : -1, out_size, ws_size, (size_t)WS_END); grid = -1; return; }
        int dev = 0, cus = 0, per_cu = 0;
        if (hipGetDevice(&dev) != hipSuccess || hipDeviceGetAttribute(&cus, hipDeviceAttributeMultiprocessorCount, dev) != hipSuccess) { fprintf(stderr, "kernel_launch: device query failed\n"); grid = -1; return; }
        if (hipFuncSetAttribute((const void*)mk_fwd, hipFuncAttributeMaxDynamicSharedMemorySize, LDS_BYTES) != hipSuccess) { fprintf(stderr, "kernel_launch: hipFuncSetAttribute failed\n"); grid = -1; return; }
        if (hipOccupancyMaxActiveBlocksPerMultiprocessor(&per_cu, (const void*)mk_fwd, NWAVES * 64, LDS_BYTES) != hipSuccess || per_cu < 1)
            fprintf(stderr, "kernel_launch: note: occupancy query reports %d workgroups per CU\n", per_cu);
        (void)hipGetLastError();
        grid = cus > 256 ? 256 : cus;
    }
    if (grid < 0) return;
    if (hipMemsetAsync((char*)d_ws + WS_CTL, 0, CTL_ZERO_BYTES, stream) != hipSuccess) { fprintf(stderr, "kernel_launch: memset failed\n"); return; }
    Args a{};
    for (int i = 0; i < 26; ++i) a.in[i] = (const float*)d_in[i];
    a.out = (float*)d_out; a.ws = (unsigned char*)d_ws;
#if MK_ONE_LAUNCH
    a.ph_lo = 0; a.ph_hi = N_PHASES;
    hipLaunchKernelGGL(mk_fwd, dim3(grid), dim3(NWAVES * 64), LDS_BYTES, stream, a);
#else
    for (int p = 0; p < N_PHASES; ++p) { a.ph_lo = p; a.ph_hi = p + 1; hipLaunchKernelGGL(mk_fwd, dim3(grid), dim3(NWAVES * 64), LDS_BYTES, stream, a); }
#endif
    const hipError_t le = hipPeekAtLastError();
    if (le != hipSuccess) fprintf(stderr, "kernel_launch: launch failed: %s (grid %d)\n", hipGetErrorName(le), grid);
}
```

```cpp
#include <hip/hip_runtime.h>
#include <cstdio>
#include <cstdint>
#include <cmath>
#ifndef PG8_WGM
#define PG8_WGM 8
#endif
namespace pg8 {
#define PG8_LAS __attribute__((address_space(3)))
typedef unsigned short bf16_t;
typedef short bf16x8 __attribute__((ext_vector_type(8)));
typedef float f32x4 __attribute__((ext_vector_type(4)));
typedef unsigned u32x4 __attribute__((ext_vector_type(4)));
typedef int i32x4 __attribute__((ext_vector_type(4)));
constexpr int BM = 256, BK = 64, HALF = 128, HTB = HALF * BK * 2  , STAGE_BYTES = 8 * HTB, NXCD = 8, WGM = PG8_WGM;

__host__ __device__ __forceinline__ int lds_byte(int r, int c) { const int st = (r >> 4) * 2 + (c >> 5), rr = r & 15, cc = c & 31, ob = rr * 64 + cc * 2; return st * 1024 + (ob ^ (((ob >> 9) & 1) << 5)); }
__host__ __device__ __forceinline__ void stage_rc(int b, int& R, int& C) { const int st = b / 1024, sb = b % 1024, swz = sb ^ (((sb >> 9) & 1) << 5); R = (st >> 1) * 16 + swz / 64; C = (st & 1) * 32 + (swz % 64) / 2; }
__host__ __device__ __forceinline__ int perm32(int rho) { const int n = rho >> 4, i = rho & 15; return 8 * (i >> 2) + 4 * n + (i & 3); }

struct Unit { int pm, pn, pa, pb, slot, kofs, aux; };
struct Gemm { const bf16_t* A; const bf16_t* Bt; int M, N, K; int lda, ldb; };

struct StaticOrder {
    int nM, nN, nwg, G, c;
    __host__ __device__ void init(int M, int N, int G_, int c_) { nM = M / BM; nN = N / BM; nwg = nM * nN; G = G_; c = c_; }
    __host__ __device__ bool next(int i, Unit& u) const {
        const long L = (long)i * G + c; if (L >= nwg) return false;
        int wgid = (int)L; { const int q = nwg / NXCD, r = nwg % NXCD, xcd = wgid % NXCD, off = wgid / NXCD; wgid = (xcd < r ? xcd * (q + 1) : r * (q + 1) + (xcd - r) * q) + off; }
        const int nig = WGM * nN, gid = wgid / nig, fm = gid * WGM, gsz = (nM - fm) < WGM ? (nM - fm) : WGM;
        u.pm = fm + ((wgid % nig) % gsz); u.pn = (wgid % nig) / gsz; u.pa = u.pm; u.pb = u.pn; u.slot = i; u.kofs = 0; u.aux = 0; return true;
    }
    __device__ __forceinline__ void a_ready(const Unit&) const {}
    __device__ __forceinline__ void done(const Unit&) const {}
};

__device__ __forceinline__ unsigned cvt_pk_bf16(float lo, float hi) { unsigned r; asm volatile("v_cvt_pk_bf16_f32 %0, %1, %2" : "=v"(r) : "v"(lo), "v"(hi)); return r; }
typedef float f32x2 __attribute__((ext_vector_type(2)));
__device__ __forceinline__ f32x2 gelu_pk(f32x2 v) {
    const f32x2 av = __builtin_elementwise_abs(v), d = av * 0.2316418882f + 1.0f;
    f32x2 t; t.x = __builtin_amdgcn_rcpf(d.x); t.y = __builtin_amdgcn_rcpf(d.y);
    f32x2 q = t * 0.5307027145f + (-0.7265760135f); q = q * t + 0.7107068705f; q = q * t + (-0.142248368f); q = q * t + 0.127414796f; q = q * t;
    const f32x2 s = (v * v) * (-0.72134752044f);
    f32x2 e; e.x = __builtin_amdgcn_exp2f(s.x); e.y = __builtin_amdgcn_exp2f(s.y);
    const f32x2 m = v * (q * e), r = v - m;
    f32x2 o; o.x = v.x < 0.f ? m.x : r.x; o.y = v.y < 0.f ? m.y : r.y; return o;
}

template <int ACT  > struct EpiBf16 {
    static constexpr bool PERM = true, AFTER_DRAIN = false, SCALES = false; static_assert(ACT == 0 || ACT == 1, "EpiBf16: ACT is 0 (none) or 1 (gelu_pk)");
    bf16_t* O; int ldc; const float* bias; int split_cols; size_t split_stride; float scale0;
    __device__ __forceinline__ void operator()(const f32x4 (&acc)[2][2][4][2], const Unit& u, int wr, int wc, int fr, int fq) const {
        const int row0 = u.pm * BM + wr * 64 + fr; int colt = u.pn * BM; bf16_t* base = O;
        float sc = 1.f; if (split_cols) { const int t = colt / split_cols; base += (size_t)t * split_stride; colt -= t * split_cols; if (t == 0) sc = scale0; }
        const int col0 = colt + wc * 32 + 8 * fq, bcol0 = u.pn * BM + wc * 32 + 8 * fq;
        f32x4 bv[2][2];
#pragma unroll
        for (int bj = 0; bj < 2; ++bj)
#pragma unroll
            for (int n = 0; n < 2; ++n) bv[bj][n] = bias ? *(const f32x4*)(bias + bcol0 + bj * HALF + 4 * n) : (f32x4){0.f, 0.f, 0.f, 0.f};
#pragma unroll
        for (int ai = 0; ai < 2; ++ai)
#pragma unroll
            for (int m = 0; m < 4; ++m) { bf16_t* rowp = base + (size_t)(row0 + ai * HALF + m * 16) * ldc + col0;
#pragma unroll
                for (int bj = 0; bj < 2; ++bj) { f32x4 v0 = acc[ai][bj][m][0] + bv[bj][0], v1 = acc[ai][bj][m][1] + bv[bj][1];
                    if (ACT == 1) { f32x2 a = gelu_pk((f32x2){v0[0], v0[1]}), b = gelu_pk((f32x2){v0[2], v0[3]}), c = gelu_pk((f32x2){v1[0], v1[1]}), d = gelu_pk((f32x2){v1[2], v1[3]});
                        v0 = (f32x4){a.x, a.y, b.x, b.y}; v1 = (f32x4){c.x, c.y, d.x, d.y}; }
                    v0 = v0 * sc; v1 = v1 * sc; u32x4 w; w.x = cvt_pk_bf16(v0[0], v0[1]); w.y = cvt_pk_bf16(v0[2], v0[3]); w.z = cvt_pk_bf16(v1[0], v1[1]); w.w = cvt_pk_bf16(v1[2], v1[3]);
                    *(u32x4*)(rowp + bj * HALF) = w; } }
    }
};

template <class Epi, class Sched, bool ALIGN_EPI = false, bool SP2 = false, bool I8 = false>
__device__ __forceinline__ void gemm_phase(PG8_LAS unsigned char* lds, const Gemm g, const Sched& S, const Epi& E, const int wave_id) {
    int lane_; asm volatile("v_mbcnt_lo_u32_b32 %0, -1, 0\n\tv_mbcnt_hi_u32_b32 %0, -1, %0" : "=v"(lane_));
    int w_ = wave_id; asm volatile("" : "+s"(w_));
    const int wid = w_, lane = lane_, tid = wid * 64 + lane, wr = wid >> 2, wc = wid & 3, fr = lane & 15, fq = lane >> 4;
    int K_ = g.K; asm volatile("" : "+s"(K_)); const int K = K_, nt = K / BK; int la_ = g.lda ? g.lda : g.K, lb_ = g.ldb ? g.ldb : g.K; asm volatile("" : "+s"(la_), "+s"(lb_)); const int lda = la_, ldb = lb_;
    unsigned voffA[2], voffB[2];
#pragma unroll
    for (int i = 0; i < 2; ++i) { int R, C; stage_rc(tid * 16 + i * 8192, R, C); const int Rb = Epi::PERM ? ((R & ~31) + perm32(R & 31)) : R;
        voffA[i] = (unsigned)(R * lda + C) * 2u; voffB[i] = (unsigned)(Rb * ldb + C) * 2u; }
    const size_t kstep = (size_t)(BK * 2);
    const size_t hstepA = (size_t)HALF * lda * 2, hstepB = (size_t)HALF * ldb * 2;
    const size_t tstepA = 2 * hstepA, tstepB = 2 * hstepB;
    const unsigned ldsw = (unsigned)wid * 1024u;
    const int aoff = lds_byte(wr * 64 + fr, fq * 8), boff = lds_byte(wc * 32 + fr, fq * 8);
#define PG8_SA(b, h) (((b) * 2 + (h)) * HTB)
#define PG8_SB(b, h) ((4 + (b) * 2 + (h)) * HTB)
#define PG8_STAGE(bufoff, gbase, voff) do { _Pragma("unroll") for (int _i = 0; _i < 2; ++_i) \
        __builtin_amdgcn_global_load_lds((const unsigned*)((const char*)(gbase) + (voff)[_i]), (PG8_LAS unsigned*)(lds + (bufoff) + ldsw + _i * 8192), 16, 0, 0); } while (0)
#define PG8_LDA(dst, b, h) do { _Pragma("unroll") for (int m = 0; m < 4; ++m) _Pragma("unroll") for (int k = 0; k < 2; ++k) dst[m][k] = *(const PG8_LAS bf16x8*)(lds + PG8_SA(b, h) + aoff + m * 2048 + k * 1024); } while (0)
#define PG8_LDB(dst, b, h) do { _Pragma("unroll") for (int n = 0; n < 2; ++n) _Pragma("unroll") for (int k = 0; k < 2; ++k) dst[n][k] = *(const PG8_LAS bf16x8*)(lds + PG8_SB(b, h) + boff + n * 2048 + k * 1024); } while (0)
#define PG8_MMA(ai, bj, At, Bt) do { __builtin_amdgcn_s_setprio(1); _Pragma("unroll") for (int m = 0; m < 4; ++m) _Pragma("unroll") for (int n = 0; n < 2; ++n) _Pragma("unroll") for (int k = 0; k < 2; ++k) \
        { if constexpr (I8) acc[ai][bj][m][n] = __builtin_bit_cast(f32x4, __builtin_amdgcn_mfma_i32_16x16x64_i8(__builtin_bit_cast(i32x4, Bt[n][k]), __builtin_bit_cast(i32x4, At[m][k]), __builtin_bit_cast(i32x4, acc[ai][bj][m][n]), 0, 0, 0)); \
          else acc[ai][bj][m][n] = __builtin_amdgcn_mfma_f32_16x16x32_bf16(Bt[n][k], At[m][k], acc[ai][bj][m][n], 0, 0, 0); } __builtin_amdgcn_s_setprio(0); } while (0)
#define PG8_WAIT_V(n) asm volatile("s_waitcnt vmcnt(" #n ")" ::: "memory")
#define PG8_WAIT_L(n) asm volatile("s_waitcnt lgkmcnt(" #n ")" ::: "memory")
#define PG8_BAR __builtin_amdgcn_s_barrier()
#define PG8_SCHED __builtin_amdgcn_sched_barrier(0)
    Unit cur, nxt; int ui = 0;
    if (!S.next(0, cur)) return;
    f32x4 acc[2][2][4][2];
#pragma unroll
    for (int a = 0; a < 2; ++a)
#pragma unroll
        for (int b = 0; b < 2; ++b)
#pragma unroll
            for (int m = 0; m < 4; ++m)
#pragma unroll
                for (int n = 0; n < 2; ++n) acc[a][b][m][n] = (f32x4){0.f, 0.f, 0.f, 0.f};
    bf16x8 At[4][2], B0[2][2], B1[2][2];
    const char* cA = (const char*)g.A + (size_t)cur.pa * tstepA + (size_t)cur.kofs * 2; const char* cB = (const char*)g.Bt + (size_t)cur.pb * tstepB + (size_t)cur.kofs * 2;
    S.a_ready(cur);
    if constexpr (Epi::SCALES) E.prefetch(cur, wid, lane);
    if constexpr (SP2) {
        PG8_STAGE(PG8_SB(0, 0), cB, voffB); PG8_STAGE(PG8_SB(0, 1), cB + hstepB, voffB); PG8_STAGE(PG8_SA(0, 0), cA, voffA); PG8_STAGE(PG8_SA(0, 1), cA + hstepA, voffA);
        if (wr == 1) PG8_BAR;
        PG8_WAIT_V(2); PG8_BAR;
        PG8_STAGE(PG8_SB(1, 0), cB + kstep, voffB); PG8_STAGE(PG8_SA(1, 0), cA + kstep, voffA); PG8_STAGE(PG8_SB(1, 1), cB + hstepB + kstep, voffB);
        PG8_WAIT_V(6); PG8_BAR;
    } else {
        PG8_STAGE(PG8_SB(0, 0), cB, voffB); PG8_STAGE(PG8_SA(0, 0), cA, voffA); PG8_STAGE(PG8_SB(0, 1), cB + hstepB, voffB); PG8_STAGE(PG8_SA(0, 1), cA + hstepA, voffA);
        if (wr == 1) PG8_BAR;
        PG8_WAIT_V(4); PG8_BAR;
        PG8_STAGE(PG8_SB(1, 0), cB + kstep, voffB); PG8_STAGE(PG8_SA(1, 0), cA + kstep, voffA); PG8_STAGE(PG8_SB(1, 1), cB + hstepB + kstep, voffB);
        PG8_WAIT_V(6); PG8_BAR;
    }
    for (;;) {
        const bool has_next = S.next(ui + 1, nxt);
        const char* nA = has_next ? (const char*)g.A + (size_t)nxt.pa * tstepA + (size_t)nxt.kofs * 2 : cA; const char* nB = has_next ? (const char*)g.Bt + (size_t)nxt.pb * tstepB + (size_t)nxt.kofs * 2 : cB;
        for (int t = 0; t < nt; t += 2) {
            const bool last = (t == nt - 2);
            const char* a1 = cA + (size_t)(t + 1) * kstep;
            const char* a2 = last ? nA : cA + (size_t)(t + 2) * kstep; const char* b2 = last ? nB : cB + (size_t)(t + 2) * kstep;
            const char* a3 = a2 + kstep; const char* b3 = b2 + kstep;
            if (last && has_next) { S.a_ready(nxt); if constexpr (Epi::SCALES) E.prefetch(nxt, wid, lane); }
            if constexpr (SP2) {
            PG8_LDB(B0, 0, 0); PG8_LDB(B1, 0, 1); PG8_SCHED; PG8_LDA(At, 0, 0); PG8_STAGE(PG8_SA(1, 1), a1 + hstepA, voffA);
            PG8_WAIT_V(8); PG8_WAIT_L(0); PG8_BAR; PG8_MMA(0, 0, At, B0); PG8_MMA(0, 1, At, B1); PG8_BAR; PG8_SCHED;
            PG8_LDA(At, 0, 1); PG8_STAGE(PG8_SB(0, 0), b2, voffB); PG8_STAGE(PG8_SB(0, 1), b2 + hstepB, voffB); PG8_STAGE(PG8_SA(0, 0), a2, voffA);
            PG8_WAIT_V(8); PG8_WAIT_L(0); PG8_BAR; PG8_MMA(1, 0, At, B0); PG8_MMA(1, 1, At, B1); PG8_BAR; PG8_SCHED;
            PG8_LDB(B0, 1, 0); PG8_LDB(B1, 1, 1); PG8_SCHED; PG8_LDA(At, 1, 0); PG8_STAGE(PG8_SA(0, 1), a2 + hstepA, voffA);
            PG8_WAIT_V(8); PG8_WAIT_L(0); PG8_BAR; PG8_MMA(0, 0, At, B0); PG8_MMA(0, 1, At, B1); PG8_BAR; PG8_SCHED;
            PG8_LDA(At, 1, 1); PG8_STAGE(PG8_SB(1, 0), b3, voffB); PG8_STAGE(PG8_SB(1, 1), b3 + hstepB, voffB); PG8_STAGE(PG8_SA(1, 0), a3, voffA);
            PG8_WAIT_V(8); PG8_WAIT_L(0); PG8_BAR; PG8_MMA(1, 0, At, B0); PG8_MMA(1, 1, At, B1); PG8_BAR; PG8_SCHED;
            } else {
            PG8_LDB(B0, 0, 0); PG8_SCHED; PG8_LDA(At, 0, 0); PG8_STAGE(PG8_SA(1, 1), a1 + hstepA, voffA);
            PG8_WAIT_L(8); PG8_BAR; PG8_WAIT_L(0); PG8_MMA(0, 0, At, B0); PG8_BAR; PG8_SCHED;
            PG8_LDB(B1, 0, 1); PG8_STAGE(PG8_SB(0, 0), b2, voffB);
            PG8_BAR; PG8_WAIT_L(0); PG8_MMA(0, 1, At, B1); PG8_BAR;
            PG8_LDA(At, 0, 1); PG8_STAGE(PG8_SA(0, 0), a2, voffA);
            PG8_BAR; PG8_WAIT_L(0); PG8_MMA(1, 0, At, B0); PG8_BAR; PG8_SCHED;
            PG8_STAGE(PG8_SB(0, 1), b2 + hstepB, voffB);
            PG8_WAIT_V(6); PG8_BAR; PG8_MMA(1, 1, At, B1); PG8_BAR;
            PG8_LDB(B0, 1, 0); PG8_SCHED; PG8_LDA(At, 1, 0); PG8_STAGE(PG8_SA(0, 1), a2 + hstepA, voffA);
            PG8_WAIT_L(8); PG8_BAR; PG8_WAIT_L(0); PG8_MMA(0, 0, At, B0); PG8_BAR; PG8_SCHED;
            PG8_LDB(B1, 1, 1); PG8_STAGE(PG8_SB(1, 0), b3, voffB);
            PG8_BAR; PG8_WAIT_L(0); PG8_MMA(0, 1, At, B1); PG8_BAR;
            PG8_LDA(At, 1, 1); PG8_STAGE(PG8_SA(1, 0), a3, voffA);
            PG8_BAR; PG8_WAIT_L(0); PG8_MMA(1, 0, At, B0); PG8_BAR; PG8_SCHED;
            PG8_STAGE(PG8_SB(1, 1), b3 + hstepB, voffB);
            PG8_WAIT_V(6); PG8_BAR; PG8_MMA(1, 1, At, B1); PG8_BAR;
            }
        }
        if constexpr (ALIGN_EPI) { if (wr == 0) PG8_BAR; }
        if constexpr (!Epi::AFTER_DRAIN) { E(acc, cur, wr, wc, fr, fq); S.done(cur); }
        if (!has_next) break;
#pragma unroll
        for (int a = 0; a < 2; ++a)
#pragma unroll
            for (int b = 0; b < 2; ++b)
#pragma unroll
                for (int m = 0; m < 4; ++m)
#pragma unroll
                    for (int n = 0; n < 2; ++n) acc[a][b][m][n] = (f32x4){0.f, 0.f, 0.f, 0.f};
        cur = nxt; cA = nA; cB = nB; ++ui;
        if constexpr (ALIGN_EPI) { if (wr == 1) PG8_BAR; }
    }
    PG8_WAIT_V(0);
    if constexpr (!ALIGN_EPI) { if (wr == 0) PG8_BAR; }
    PG8_BAR;
    if constexpr (Epi::AFTER_DRAIN) { E.fused(acc, cur, wr, wc, fr, fq, lds, wid, lane); S.done(cur); }
#undef PG8_SA
#undef PG8_SB
#undef PG8_STAGE
#undef PG8_LDA
#undef PG8_LDB
#undef PG8_MMA
#undef PG8_WAIT_V
#undef PG8_WAIT_L
#undef PG8_BAR
#undef PG8_SCHED
}
}
#ifndef EPI_FENCE_GRP
#define EPI_FENCE_GRP 8
#endif
namespace pg8 {
typedef unsigned u32x2 __attribute__((ext_vector_type(2)));
__device__ __forceinline__ float sigm(float x) { return __builtin_amdgcn_rcpf(1.0f + __builtin_amdgcn_exp2f(-1.4426950408889634f * x)); }
__device__ __forceinline__ u32x4 pack8(const f32x4& v0, const f32x4& v1) { u32x4 w; w.x = cvt_pk_bf16(v0[0], v0[1]); w.y = cvt_pk_bf16(v0[2], v0[3]); w.z = cvt_pk_bf16(v1[0], v1[1]); w.w = cvt_pk_bf16(v1[2], v1[3]); return w; }
__device__ __forceinline__ void unpack8(const u32x4& w, f32x4& v0, f32x4& v1) {
    v0[0] = __uint_as_float(w.x << 16); v0[1] = __uint_as_float(w.x & 0xffff0000u); v0[2] = __uint_as_float(w.y << 16); v0[3] = __uint_as_float(w.y & 0xffff0000u);
    v1[0] = __uint_as_float(w.z << 16); v1[1] = __uint_as_float(w.z & 0xffff0000u); v1[2] = __uint_as_float(w.w << 16); v1[3] = __uint_as_float(w.w & 0xffff0000u); }
__device__ __forceinline__ f32x4 i2f4(const f32x4& x) { return __builtin_convertvector(__builtin_bit_cast(i32x4, x), f32x4); }
struct RopeTab { f32x4 c0, c1, c2, c3; };
__device__ __forceinline__ RopeTab rope_load(const float* tab, int fq) { const float* t = tab + 16 * (fq & 1); RopeTab r; r.c0 = *(const f32x4*)(t); r.c1 = *(const f32x4*)(t + 4); r.c2 = *(const f32x4*)(t + 8); r.c3 = *(const f32x4*)(t + 12); return r; }
__device__ __forceinline__ void rope_apply(f32x4& v0, f32x4& v1, const RopeTab& r, int fq) {
    f32x4 p0, p1;
#pragma unroll
    for (int j = 0; j < 4; ++j) { const auto a_ = __builtin_amdgcn_permlane32_swap(__float_as_uint(v0[j]), __float_as_uint(v0[j]), false, false), b_ = __builtin_amdgcn_permlane32_swap(__float_as_uint(v1[j]), __float_as_uint(v1[j]), false, false);
        p0[j] = __uint_as_float(fq < 2 ? a_[1] : a_[0]); p1[j] = __uint_as_float(fq < 2 ? b_[1] : b_[0]); }
    const f32x4 c0 = r.c0, c1 = r.c1, c2 = r.c2, c3 = r.c3;
    const float sg = (fq < 2) ? -1.f : 1.f;
    v0[0] = v0[0] * c0[0] + sg * p0[0] * c0[1]; v0[1] = v0[1] * c0[2] + sg * p0[1] * c0[3];
    v0[2] = v0[2] * c1[0] + sg * p0[2] * c1[1]; v0[3] = v0[3] * c1[2] + sg * p0[3] * c1[3];
    v1[0] = v1[0] * c2[0] + sg * p1[0] * c2[1]; v1[1] = v1[1] * c2[2] + sg * p1[1] * c2[3];
    v1[2] = v1[2] * c3[0] + sg * p1[2] * c3[1]; v1[3] = v1[3] * c3[2] + sg * p1[3] * c3[3];
}
#define EPI_MEMBAR() asm volatile("" ::: "memory")
struct EpiProj {
    static constexpr bool PERM = true, AFTER_DRAIN = false, SCALES = true;
    bf16_t *NAQKV, *QLAT, *GATES, *KVLAT, *KMLA; const float* bgate; const float* rope; float qscale; float* PS; const float* sa; const float* sb; PG8_LAS float* tbl;
    __device__ __forceinline__ void prefetch(const Unit& u, int wid, int) const {
        int lane; asm volatile("v_mbcnt_lo_u32_b32 %0, -1, 0\n\tv_mbcnt_hi_u32_b32 %0, -1, %0" : "=v"(lane));
        const float* src = (wid < 4) ? sa + (size_t)u.pa * BM + wid * 64 + lane : sb + (size_t)u.pb * BM + (wid - 4) * 64 + lane;
        __builtin_amdgcn_global_load_lds((const unsigned*)src, (PG8_LAS unsigned*)(tbl + (u.slot & 1) * 512 + wid * 64), 4, 0, 0);
    }
    __device__ __forceinline__ void operator()(f32x4 (&acc)[2][2][4][2], const Unit& u, int wr, int wc, int fr, int fq) const {
        const int pn = u.pn; const int row0 = u.pm * BM + wr * 64 + fr;
        {
            const PG8_LAS float* tb = tbl + (u.slot & 1) * 512; const PG8_LAS float* sbp = tb + 256 + wc * 32 + 8 * fq;
            const f32x4 s00 = *(const PG8_LAS f32x4*)(sbp), s01 = *(const PG8_LAS f32x4*)(sbp + 4), s10 = *(const PG8_LAS f32x4*)(sbp + HALF), s11 = *(const PG8_LAS f32x4*)(sbp + HALF + 4);
#pragma unroll
            for (int ai = 0; ai < 2; ++ai)
#pragma unroll
                for (int m = 0; m < 4; ++m) { const float ra = tb[wr * 64 + fr + ai * HALF + m * 16];
                    acc[ai][0][m][0] = i2f4(acc[ai][0][m][0]) * (s00 * ra); acc[ai][0][m][1] = i2f4(acc[ai][0][m][1]) * (s01 * ra);
                    acc[ai][1][m][0] = i2f4(acc[ai][1][m][0]) * (s10 * ra); acc[ai][1][m][1] = i2f4(acc[ai][1][m][1]) * (s11 * ra); }
        }
        if (pn == 18) {
            if (wc == 0) {
#pragma unroll
                for (int ai = 0; ai < 2; ++ai) { RopeTab rt[4];
#pragma unroll
                    for (int m = 0; m < 4; ++m) rt[m] = rope_load(rope + (size_t)((row0 + ai * HALF + m * 16) & 8191) * 32, fq);
                    EPI_MEMBAR();
#pragma unroll
                    for (int m = 0; m < 4; ++m) { const int row = row0 + ai * HALF + m * 16; f32x4 v0 = acc[ai][0][m][0], v1 = acc[ai][0][m][1];
                        rope_apply(v0, v1, rt[m], fq); const u32x4 w = pack8(v0, v1); bf16_t* dp = KMLA + (size_t)row * 768 + 64 + 8 * fq;
#pragma unroll
                        for (int h = 0; h < 8; ++h) *(u32x4*)(dp + 96 * h) = w; }
                    EPI_MEMBAR(); }
            }
            return;
        }
        if (pn >= 9 && pn < 17) {
            const int col0 = (pn - 9) * BM + wc * 32 + 8 * fq;
            f32x4 bv[2][2];
#pragma unroll
            for (int bj = 0; bj < 2; ++bj)
#pragma unroll
                for (int n = 0; n < 2; ++n) bv[bj][n] = *(const f32x4*)(bgate + col0 + bj * HALF + 4 * n);
#pragma unroll
            for (int ai = 0; ai < 2; ++ai)
#pragma unroll
                for (int m = 0; m < 4; ++m) { unsigned char* rowp = (unsigned char*)GATES + (size_t)(row0 + ai * HALF + m * 16) * 2048 + col0;
#pragma unroll
                    for (int bj = 0; bj < 2; ++bj) { const f32x4 v0 = acc[ai][bj][m][0] + bv[bj][0], v1 = acc[ai][bj][m][1] + bv[bj][1]; u32x2 w = {0u, 0u};
#pragma unroll
                        for (int j = 0; j < 4; ++j) { w.x = __builtin_amdgcn_cvt_pk_u8_f32(sigm(v0[j]) * 255.f, j, w.x); w.y = __builtin_amdgcn_cvt_pk_u8_f32(sigm(v1[j]) * 255.f, j, w.y); }
                        *(u32x2*)(rowp + bj * HALF) = w; } }
            return;
        }
        bf16_t* base; int ldc, colt, mode = 0;
        if (pn < 6) { base = NAQKV; ldc = 1536; colt = pn * BM; mode = (pn < 2) ? 1 : 0; }
        else if (pn < 9) { base = QLAT; ldc = 768; colt = (pn - 6) * BM; }
        else { base = KVLAT; ldc = 256; colt = 0; }
        const int col0 = colt + wc * 32 + 8 * fq;
        if (mode == 0 && pn >= 6) {
            const int slot = (pn == 17) ? 12 + wc : (pn - 6) * 4 + wc;
#pragma unroll
            for (int ai = 0; ai < 2; ++ai)
#pragma unroll
                for (int m = 0; m < 4; ++m) { float q = 0.f;
#pragma unroll
                    for (int bj = 0; bj < 2; ++bj)
#pragma unroll
                        for (int n = 0; n < 2; ++n) { const f32x4 x = acc[ai][bj][m][n]; q += (x[0] * x[0] + x[1] * x[1]) + (x[2] * x[2] + x[3] * x[3]); }
                    { const auto r_ = __builtin_amdgcn_permlane16_swap(__float_as_uint(q), __float_as_uint(q), false, false); q = __uint_as_float(r_[0]) + __uint_as_float(r_[1]); }
                    { const auto r_ = __builtin_amdgcn_permlane32_swap(__float_as_uint(q), __float_as_uint(q), false, false); q = __uint_as_float(r_[0]) + __uint_as_float(r_[1]); }
                    if (fq == 0) PS[(size_t)(row0 + ai * HALF + m * 16) * 16 + slot] = q; }
        }
        const float sc = (mode == 1) ? qscale : 1.f;
#pragma unroll
        for (int ai = 0; ai < 2; ++ai)
#pragma unroll
            for (int m = 0; m < 4; ++m) { bf16_t* rowp = base + (size_t)(row0 + ai * HALF + m * 16) * ldc + col0;
#pragma unroll
                for (int bj = 0; bj < 2; ++bj) *(u32x4*)(rowp + bj * HALF) = pack8(acc[ai][bj][m][0] * sc, acc[ai][bj][m][1] * sc); }
    }
};
struct EpiQup {
    static constexpr bool PERM = true, AFTER_DRAIN = false, SCALES = false;
    bf16_t* Q; const PG8_LAS float* rtab; const float* rope; float sc;
    __device__ __forceinline__ void operator()(const f32x4 (&acc)[2][2][4][2], const Unit& u, int wr, int wc, int fr, int fq) const {
        const int lr0 = wr * 64 + fr;
        const int rb0 = ((8 * u.pn + wc) % 3 == 2), rb1 = ((8 * u.pn + 4 + wc) % 3 == 2);
#pragma unroll
        for (int ai = 0; ai < 2; ++ai) { RopeTab rt[4]; float rrs[4];
#pragma unroll
            for (int m = 0; m < 4; ++m) rrs[m] = rtab[u.slot * BM + lr0 + ai * HALF + m * 16];
            if (rb0 | rb1) {
#pragma unroll
                for (int m = 0; m < 4; ++m) rt[m] = rope_load(rope + (size_t)((u.pm * BM + lr0 + ai * HALF + m * 16) & 8191) * 32, fq);
#pragma unroll
                for (int m = 0; m < 4; ++m) asm volatile("" : "+v"(rt[m].c0), "+v"(rt[m].c1), "+v"(rt[m].c2), "+v"(rt[m].c3));
            }
            EPI_MEMBAR();
#pragma unroll
            for (int m = 0; m < 4; ++m) { const int lr = lr0 + ai * HALF + m * 16, row = u.pm * BM + lr; const float rr = rrs[m];
                bf16_t* rowp = Q + (size_t)row * 768 + u.pn * BM + wc * 32 + 8 * fq;
#pragma unroll
                for (int bj = 0; bj < 2; ++bj) { f32x4 v0 = acc[ai][bj][m][0] * rr, v1 = acc[ai][bj][m][1] * rr;
                    if (bj == 0 ? rb0 : rb1) rope_apply(v0, v1, rt[m], fq);
                    v0 = v0 * sc; v1 = v1 * sc; *(u32x4*)(rowp + bj * HALF) = pack8(v0, v1); } }
            EPI_MEMBAR(); }
    }
};
struct EpiKVup {
    static constexpr bool PERM = true, AFTER_DRAIN = false, SCALES = false;
    bf16_t *KM, *VM; const PG8_LAS float* rtab;
    __device__ __forceinline__ void operator()(const f32x4 (&acc)[2][2][4][2], const Unit& u, int wr, int wc, int fr, int fq) const {
        const int lr0 = wr * 64 + fr;
#pragma unroll
        for (int ai = 0; ai < 2; ++ai)
#pragma unroll
            for (int m = 0; m < 4; ++m) { const int lr = lr0 + ai * HALF + m * 16, row = u.pm * BM + lr; const float rr = rtab[u.slot * BM + lr];
#pragma unroll
                for (int bj = 0; bj < 2; ++bj) { const f32x4 v0 = acc[ai][bj][m][0] * rr, v1 = acc[ai][bj][m][1] * rr;
                    bf16_t* dp;
                    if (u.pn < 2) { const int h = 4 * u.pn + 2 * bj + (wc >> 1); dp = KM + (size_t)row * 768 + 96 * h + 32 * (wc & 1) + 8 * fq; }
                    else { dp = VM + (size_t)row * 512 + (u.pn - 2) * BM + bj * HALF + wc * 32 + 8 * fq; }
                    *(u32x4*)dp = pack8(v0, v1); }
                if (((ai * 4 + m + 1) % EPI_FENCE_GRP) == 0) asm volatile("" ::: "memory"); }
    }
};
struct EpiMerge {
    static constexpr bool PERM = true, AFTER_DRAIN = false, SCALES = false;
    const unsigned char* G; bf16_t* T; int second;
    __device__ __forceinline__ void operator()(const f32x4 (&acc)[2][2][4][2], const Unit& u, int wr, int wc, int fr, int fq) const {
        const int row0 = u.pm * BM + wr * 64 + fr, col0 = u.pn * BM + wc * 32 + 8 * fq;
#pragma unroll
        for (int ai = 0; ai < 2; ++ai) { u32x2 gw[4][2]; u32x4 tw[4][2];
#pragma unroll
            for (int m = 0; m < 4; ++m) { const size_t row = (size_t)(row0 + ai * HALF + m * 16);
#pragma unroll
                for (int bj = 0; bj < 2; ++bj) { const int c = col0 + bj * HALF; gw[m][bj] = *(const u32x2*)(G + row * 2048 + c); if (second) tw[m][bj] = *(const u32x4*)(T + row * 1024 + c); } }
            EPI_MEMBAR();
#pragma unroll
            for (int m = 0; m < 4; ++m) { const size_t row = (size_t)(row0 + ai * HALF + m * 16);
#pragma unroll
                for (int bj = 0; bj < 2; ++bj) { const int c = col0 + bj * HALF; const u32x2 g_ = gw[m][bj];
                    const f32x4 g0 = {(float)(g_.x & 255u), (float)((g_.x >> 8) & 255u), (float)((g_.x >> 16) & 255u), (float)(g_.x >> 24)}, g1 = {(float)(g_.y & 255u), (float)((g_.y >> 8) & 255u), (float)((g_.y >> 16) & 255u), (float)(g_.y >> 24)};
                    f32x4 v0 = acc[ai][bj][m][0] * (g0 * (1.f / 255.f)), v1 = acc[ai][bj][m][1] * (g1 * (1.f / 255.f));
                    if (second) { f32x4 t0, t1; unpack8(tw[m][bj], t0, t1); v0 = v0 + t0; v1 = v1 + t1; }
                    *(u32x4*)(T + row * 1024 + c) = pack8(v0, v1); } }
            EPI_MEMBAR(); }
    }
};
struct EpiPlain {
    static constexpr bool PERM = true, AFTER_DRAIN = false, SCALES = false;
    bf16_t* O; int ldc;
    __device__ __forceinline__ void operator()(const f32x4 (&acc)[2][2][4][2], const Unit& u, int wr, int wc, int fr, int fq) const {
        const int row0 = u.pm * BM + wr * 64 + fr, col0 = u.pn * BM + wc * 32 + 8 * fq;
#pragma unroll
        for (int ai = 0; ai < 2; ++ai)
#pragma unroll
            for (int m = 0; m < 4; ++m) { bf16_t* rowp = O + (size_t)(row0 + ai * HALF + m * 16) * ldc + col0;
#pragma unroll
                for (int bj = 0; bj < 2; ++bj) *(u32x4*)(rowp + bj * HALF) = pack8(acc[ai][bj][m][0], acc[ai][bj][m][1]); }
    }
};
template <int MODE> struct EpiRes {
    static constexpr bool PERM = true, AFTER_DRAIN = false, SCALES = (MODE == 3);
    const bf16_t* xres; bf16_t* Y; bf16_t* P; float alpha; const float* sa; const float* sb; PG8_LAS float* tbl;
    __device__ __forceinline__ void prefetch(const Unit& u, int wid, int) const {
        int lane; asm volatile("v_mbcnt_lo_u32_b32 %0, -1, 0\n\tv_mbcnt_hi_u32_b32 %0, -1, %0" : "=v"(lane));
        const float* src = (wid < 4) ? sa + (size_t)u.pa * BM + wid * 64 + lane : sb + (size_t)u.pb * BM + (wid - 4) * 64 + lane;
        __builtin_amdgcn_global_load_lds((const unsigned*)src, (PG8_LAS unsigned*)(tbl + (u.slot & 1) * 512 + wid * 64), 4, 0, 0);
    }
    __device__ __forceinline__ void operator()(const f32x4 (&acc)[2][2][4][2], const Unit& u, int wr, int wc, int fr, int fq) const {
        const int row0 = u.pm * BM + wr * 64 + fr, col0 = u.pn * BM + wc * 32 + 8 * fq;
        const PG8_LAS float* tb = (MODE == 3) ? tbl + (u.slot & 1) * 512 : nullptr;
        f32x4 sb0[2], sb1[2];
        if (MODE == 3) {
#pragma unroll
            for (int bj = 0; bj < 2; ++bj) { const PG8_LAS float* sbp = tb + 256 + bj * HALF + wc * 32 + 8 * fq; sb0[bj] = *(const PG8_LAS f32x4*)sbp; sb1[bj] = *(const PG8_LAS f32x4*)(sbp + 4); } }
#pragma unroll
        for (int ai = 0; ai < 2; ++ai) { u32x4 lx[4][2], lp[4][2];
#pragma unroll
            for (int m = 0; m < 4; ++m) { const size_t off = (size_t)(row0 + ai * HALF + m * 16) * 1024 + col0;
#pragma unroll
                for (int bj = 0; bj < 2; ++bj) { const size_t o = off + bj * HALF;
                    if (MODE == 0 || MODE == 2) lx[m][bj] = *(const u32x4*)(xres + o);
                    if (MODE != 0) lp[m][bj] = *(const u32x4*)(P + o); } }
            EPI_MEMBAR();
#pragma unroll
            for (int m = 0; m < 4; ++m) { const size_t off = (size_t)(row0 + ai * HALF + m * 16) * 1024 + col0;
#pragma unroll
                for (int bj = 0; bj < 2; ++bj) { const size_t o = off + bj * HALF; f32x4 v0 = acc[ai][bj][m][0], v1 = acc[ai][bj][m][1];
                    if (MODE == 0) { f32x4 x0, x1; unpack8(lx[m][bj], x0, x1); v0 = x0 * alpha + v0; v1 = x1 * alpha + v1; *(u32x4*)(Y + o) = pack8(v0, v1); }
                    else if (MODE == 3) { f32x4 p0, p1; unpack8(lp[m][bj], p0, p1); const float ra = tb[wr * 64 + fr + ai * HALF + m * 16];
                        v0 = i2f4(v0) * (sb0[bj] * ra); v1 = i2f4(v1) * (sb1[bj] * ra);
#pragma unroll
                        for (int j = 0; j < 4; ++j) { v0[j] = sigm(v0[j]) * p0[j]; v1[j] = sigm(v1[j]) * p1[j]; }
                        *(u32x4*)(P + o) = pack8(v0, v1); }
                    else if (MODE == 1) { f32x4 p0, p1; unpack8(lp[m][bj], p0, p1);
#pragma unroll
                        for (int j = 0; j < 4; ++j) { v0[j] = sigm(v0[j]) * p0[j]; v1[j] = sigm(v1[j]) * p1[j]; }
                        *(u32x4*)(P + o) = pack8(v0, v1); }
                    else { f32x4 x0, x1, p0, p1; unpack8(lx[m][bj], x0, x1); unpack8(lp[m][bj], p0, p1);
                        v0 = x0 * alpha + p0 + v0; v1 = x1 * alpha + p1 + v1; *(u32x4*)(Y + o) = pack8(v0, v1); } } }
            EPI_MEMBAR(); }
    }
};
struct EpiGate8 {
    static constexpr bool PERM = true, AFTER_DRAIN = false, SCALES = true;
    unsigned char* G8; const float* sa; const float* sb; PG8_LAS float* tbl;
    __device__ __forceinline__ void prefetch(const Unit& u, int wid, int) const {
        int lane; asm volatile("v_mbcnt_lo_u32_b32 %0, -1, 0\n\tv_mbcnt_hi_u32_b32 %0, -1, %0" : "=v"(lane));
        const float* src = (wid < 4) ? sa + (size_t)u.pa * BM + wid * 64 + lane : sb + (size_t)u.pb * BM + (wid - 4) * 64 + lane;
        __builtin_amdgcn_global_load_lds((const unsigned*)src, (PG8_LAS unsigned*)(tbl + (u.slot & 1) * 512 + wid * 64), 4, 0, 0);
    }
    __device__ __forceinline__ void operator()(const f32x4 (&acc)[2][2][4][2], const Unit& u, int wr, int wc, int fr, int fq) const {
        const int row0 = u.pm * BM + wr * 64 + fr, col0 = u.pn * BM + wc * 32 + 8 * fq;
        const PG8_LAS float* tb = tbl + (u.slot & 1) * 512;
        f32x4 sb0[2], sb1[2];
#pragma unroll
        for (int bj = 0; bj < 2; ++bj) { const PG8_LAS float* sbp = tb + 256 + bj * HALF + wc * 32 + 8 * fq; sb0[bj] = *(const PG8_LAS f32x4*)sbp; sb1[bj] = *(const PG8_LAS f32x4*)(sbp + 4); }
#pragma unroll
        for (int ai = 0; ai < 2; ++ai)
#pragma unroll
            for (int m = 0; m < 4; ++m) { const float ra = tb[wr * 64 + fr + ai * HALF + m * 16]; unsigned char* rowp = G8 + (size_t)(row0 + ai * HALF + m * 16) * 1024 + col0;
#pragma unroll
                for (int bj = 0; bj < 2; ++bj) { const f32x4 v0 = i2f4(acc[ai][bj][m][0]) * (sb0[bj] * ra), v1 = i2f4(acc[ai][bj][m][1]) * (sb1[bj] * ra); u32x2 w = {0u, 0u};
#pragma unroll
                    for (int j = 0; j < 4; ++j) { w.x = __builtin_amdgcn_cvt_pk_u8_f32(sigm(v0[j]) * 255.f, j, w.x); w.y = __builtin_amdgcn_cvt_pk_u8_f32(sigm(v1[j]) * 255.f, j, w.y); }
                    *(u32x2*)(rowp + bj * HALF) = w; } }
    }
};
struct EpiGateMul {
    static constexpr bool PERM = true, AFTER_DRAIN = false, SCALES = false;
    const unsigned char* G8; bf16_t* P;
    __device__ __forceinline__ void operator()(const f32x4 (&acc)[2][2][4][2], const Unit& u, int wr, int wc, int fr, int fq) const {
        const int row0 = u.pm * BM + wr * 64 + fr, col0 = u.pn * BM + wc * 32 + 8 * fq;
        u32x2 gw[8][2];
#pragma unroll
        for (int i = 0; i < 8; ++i)
#pragma unroll
            for (int bj = 0; bj < 2; ++bj) gw[i][bj] = *(const u32x2*)(G8 + (size_t)(row0 + (i >> 2) * HALF + (i & 3) * 16) * 1024 + col0 + bj * HALF);
        EPI_MEMBAR();
#pragma unroll
        for (int i = 0; i < 8; ++i) { const int ai = i >> 2, m = i & 3; bf16_t* rowp = P + (size_t)(row0 + ai * HALF + m * 16) * 1024 + col0;
#pragma unroll
            for (int bj = 0; bj < 2; ++bj) { const u32x2 g_ = gw[i][bj];
                const f32x4 g0 = {(float)(g_.x & 255u), (float)((g_.x >> 8) & 255u), (float)((g_.x >> 16) & 255u), (float)(g_.x >> 24)}, g1 = {(float)(g_.y & 255u), (float)((g_.y >> 8) & 255u), (float)((g_.y >> 16) & 255u), (float)(g_.y >> 24)};
                *(u32x4*)(rowp + bj * HALF) = pack8(acc[ai][bj][m][0] * (g0 * (1.f / 255.f)), acc[ai][bj][m][1] * (g1 * (1.f / 255.f))); } }
    }
};
struct EpiGLU {
    static constexpr bool PERM = true, AFTER_DRAIN = false, SCALES = false;
    bf16_t* H; int ldh;
    __device__ __forceinline__ void operator()(const f32x4 (&acc)[2][2][4][2], const Unit& u, int wr, int wc, int fr, int fq) const {
        const int row0 = u.pm * BM + wr * 64 + fr, col0 = u.pn * HALF + wc * 32 + 8 * fq;
#pragma unroll
        for (int ai = 0; ai < 2; ++ai)
#pragma unroll
            for (int m = 0; m < 4; ++m) { f32x4 h0, h1;
#pragma unroll
                for (int j = 0; j < 4; ++j) { const float a0 = acc[ai][0][m][0][j], a1 = acc[ai][0][m][1][j]; h0[j] = a0 * sigm(a0) * acc[ai][1][m][0][j]; h1[j] = a1 * sigm(a1) * acc[ai][1][m][1][j]; }
                *(u32x4*)(H + (size_t)(row0 + ai * HALF + m * 16) * ldh + col0) = pack8(h0, h1); }
    }
};
struct EpiGLUQ {
    static constexpr bool PERM = true, AFTER_DRAIN = false, SCALES = true;
    bf16_t* H; int ldh; const float* sa; const float* sb; PG8_LAS float* tbl;
    __device__ __forceinline__ void prefetch(const Unit& u, int wid, int) const {
        int lane; asm volatile("v_mbcnt_lo_u32_b32 %0, -1, 0\n\tv_mbcnt_hi_u32_b32 %0, -1, %0" : "=v"(lane));
        const float* src = (wid < 4) ? sa + (size_t)u.pa * BM + wid * 64 + lane : sb + (size_t)u.pb * BM + (wid - 4) * 64 + lane;
        __builtin_amdgcn_global_load_lds((const unsigned*)src, (PG8_LAS unsigned*)(tbl + (u.slot & 1) * 512 + wid * 64), 4, 0, 0);
    }
    __device__ __forceinline__ void operator()(const f32x4 (&acc)[2][2][4][2], const Unit& u, int wr, int wc, int fr, int fq) const {
        const int lrow0 = wr * 64 + fr, row0 = u.pm * BM + lrow0, col0 = u.pn * HALF + wc * 32 + 8 * fq;
        const PG8_LAS float* tb = tbl + (u.slot & 1) * 512; const PG8_LAS float* sbp = tb + 256 + wc * 32 + 8 * fq;
        const f32x4 s10 = *(const PG8_LAS f32x4*)(sbp), s11 = *(const PG8_LAS f32x4*)(sbp + 4), s30 = *(const PG8_LAS f32x4*)(sbp + HALF), s31 = *(const PG8_LAS f32x4*)(sbp + HALF + 4);
#pragma unroll
        for (int ai = 0; ai < 2; ++ai)
#pragma unroll
            for (int m = 0; m < 4; ++m) { const float ra = tb[lrow0 + ai * HALF + m * 16];
                const f32x4 a0 = i2f4(acc[ai][0][m][0]) * (s10 * ra), a1 = i2f4(acc[ai][0][m][1]) * (s11 * ra), b0 = i2f4(acc[ai][1][m][0]) * (s30 * ra), b1 = i2f4(acc[ai][1][m][1]) * (s31 * ra);
                f32x4 h0, h1;
#pragma unroll
                for (int j = 0; j < 4; ++j) { h0[j] = a0[j] * sigm(a0[j]) * b0[j]; h1[j] = a1[j] * sigm(a1[j]) * b1[j]; }
                *(u32x4*)(H + (size_t)(row0 + ai * HALF + m * 16) * ldh + col0) = pack8(h0, h1); }
    }
};
struct EpiMoeDown {
    static constexpr bool PERM = true, AFTER_DRAIN = false, SCALES = false;
    bf16_t* O; const float* SW;
    __device__ __forceinline__ void operator()(const f32x4 (&acc)[2][2][4][2], const Unit& u, int wr, int wc, int fr, int fq) const {
        const int row0 = u.pm * BM + wr * 64 + fr, col0 = u.pn * BM + wc * 32 + 8 * fq;
        float gws[8];
#pragma unroll
        for (int i = 0; i < 8; ++i) gws[i] = SW[row0 + (i >> 2) * HALF + (i & 3) * 16];
        EPI_MEMBAR();
#pragma unroll
        for (int ai = 0; ai < 2; ++ai)
#pragma unroll
            for (int m = 0; m < 4; ++m) { const int row = row0 + ai * HALF + m * 16; const float gw = gws[ai * 4 + m]; bf16_t* rowp = O + (size_t)row * 1024 + col0;
#pragma unroll
                for (int bj = 0; bj < 2; ++bj) *(u32x4*)(rowp + bj * HALF) = pack8(acc[ai][bj][m][0] * gw, acc[ai][bj][m][1] * gw); }
    }
};
template <bool UP> struct MoeOrder {
    int nMc, nN, nwg, G, c, t0; int ts1, ts2, ts3, ts4, ts5, ts6, ts7;
    __device__ __forceinline__ bool next(int i, Unit& u) const {
        const long L = (long)i * G + c; if (L >= nwg) return false;
        int wgid = (int)L; { const int q = nwg / NXCD, r = nwg % NXCD, xcd = wgid % NXCD, off = wgid / NXCD; wgid = (xcd < r ? xcd * (q + 1) : r * (q + 1) + (xcd - r) * q) + off; }
        const int nig = WGM * nN, gid = wgid / nig, fm = gid * WGM, gsz = (nMc - fm) < WGM ? (nMc - fm) : WGM;
        const int pml = fm + ((wgid % nig) % gsz), pn = (wgid % nig) / gsz, t = t0 + pml;
        const int e = (t >= ts1) + (t >= ts2) + (t >= ts3) + (t >= ts4) + (t >= ts5) + (t >= ts6) + (t >= ts7);
        u.pn = pn; u.pb = e * nN + pn; u.slot = i; u.kofs = 0; u.aux = 0;
        if (UP) { u.pa = t; u.pm = pml; } else { u.pa = pml; u.pm = t; }
        return true;
    }
    __device__ __forceinline__ void a_ready(const Unit&) const {}
    __device__ __forceinline__ void done(const Unit&) const {}
};
struct MoeRemOrder {
    int nT, G, c, t0, KQ, pa0; int ts1, ts2, ts3, ts4, ts5, ts6, ts7;
    __device__ __forceinline__ bool next(int i, Unit& u) const {
        const int L = i * G + c; if (L >= nT * 16) return false;
        const int tl = L >> 4, pn = (L >> 2) & 3, kq = L & 3, t = t0 + tl;
        const int e = (t >= ts1) + (t >= ts2) + (t >= ts3) + (t >= ts4) + (t >= ts5) + (t >= ts6) + (t >= ts7);
        u.pa = pa0 + tl; u.pm = tl; u.pn = pn; u.pb = e * 4 + pn; u.slot = i; u.kofs = kq * KQ; u.aux = kq; return true;
    }
    __device__ __forceinline__ void a_ready(const Unit&) const {}
    __device__ __forceinline__ void done(const Unit&) const {}
};
struct EpiMoeRem {
    static constexpr bool PERM = true, AFTER_DRAIN = false, SCALES = false;
    bf16_t* PART; const float* SW; int t0, prows;
    __device__ __forceinline__ void operator()(const f32x4 (&acc)[2][2][4][2], const Unit& u, int wr, int wc, int fr, int fq) const {
        const int row0 = u.pm * BM + wr * 64 + fr, col0 = u.pn * BM + wc * 32 + 8 * fq;
        float gws[8];
#pragma unroll
        for (int i = 0; i < 8; ++i) gws[i] = SW[t0 * BM + row0 + (i >> 2) * HALF + (i & 3) * 16];
        EPI_MEMBAR();
#pragma unroll
        for (int ai = 0; ai < 2; ++ai)
#pragma unroll
            for (int m = 0; m < 4; ++m) { const int row = row0 + ai * HALF + m * 16; const float gw = gws[ai * 4 + m]; bf16_t* rowp = PART + ((size_t)u.aux * prows + row) * 1024 + col0;
#pragma unroll
                for (int bj = 0; bj < 2; ++bj) *(u32x4*)(rowp + bj * HALF) = pack8(acc[ai][bj][m][0] * gw, acc[ai][bj][m][1] * gw); }
    }
};
}
namespace att {
#define ATT_LAS __attribute__((address_space(3)))
typedef unsigned short bf16;
using bf16x8 = __attribute__((ext_vector_type(8))) short;
using s16x4  = __attribute__((ext_vector_type(4))) short;
using f32x16 = __attribute__((ext_vector_type(16))) float;
using u32x4  = __attribute__((ext_vector_type(4))) unsigned;
#define SBAR() __builtin_amdgcn_sched_barrier(0)
__device__ __forceinline__ int crow(int r, int hi) { return (r & 3) + 8 * (r >> 2) + 4 * hi; }
__device__ __forceinline__ unsigned cvtpk(float lo, float hi) { unsigned r; asm volatile("v_cvt_pk_bf16_f32 %0, %1, %2" : "=v"(r) : "v"(lo), "v"(hi)); return r; }
__device__ __forceinline__ unsigned short f2bf(float f) { return (unsigned short)(cvtpk(f, f) & 0xffffu); }
constexpr int OIMG_WAVE = 32 * 144;
__device__ __forceinline__ int crow(int r, int hi);
__device__ __forceinline__ void store_o(const f32x16 (&o)[2], const ATT_LAS float* li_l, bf16* Ow, ATT_LAS char* img, int lane, int r32, int hi) {
  typedef unsigned u32x4_t __attribute__((ext_vector_type(4)));
#pragma unroll
  for (int r = 0; r < 16; ++r) { const int orow = (r & 3) + 8 * (r >> 2) + 4 * hi; const float rl = __builtin_amdgcn_rcpf(li_l[orow]);
    ATT_LAS unsigned short* rp = (ATT_LAS unsigned short*)(img + orow * 144) + r32;
    rp[0] = f2bf(o[0][r] * rl); rp[32] = f2bf(o[1][r] * rl); }
  asm volatile("s_waitcnt lgkmcnt(0)" ::: "memory");
#pragma unroll
  for (int j = 0; j < 4; ++j) { const int pc = j * 64 + lane, row = pc >> 3, c16 = pc & 7;
    const u32x4_t v = *(const ATT_LAS u32x4_t*)(img + row * 144 + c16 * 16);
    *reinterpret_cast<u32x4_t*>(Ow + (long)row * 512 + c16 * 8) = v; }
}
__device__ __forceinline__ int v_st(int k, int c) { const int kk = (k & ~0xC) | ((k & 4) << 1) | ((k & 8) >> 1); return ((kk >> 3) * 2 + (c >> 5)) * 512 + ((kk & 7) * 32 + (c & 31)) * 2; }
__device__ __forceinline__ int v_rd_base(int lane) { return ((lane & 3) << 3) | (((lane >> 2) & 3) << 6) | (((lane >> 4) & 1) << 5) | (((lane >> 5) & 1) << 8); }
constexpr int v_rd_off(int d0, int ks, int half) { return d0 * 512 + ks * 2048 + half * 1024; }
template <int OFF> __device__ __forceinline__ s16x4 tr_read(int vb) { s16x4 r; asm volatile("ds_read_b64_tr_b16 %0, %1 offset:%2" : "=&v"(r) : "v"(vb), "i"(OFF) : "memory"); return r; }
template <int D0> __device__ __forceinline__ void pv_one(f32x16& od, int vb, bf16x8 pa0, bf16x8 pa1, bf16x8 pa2, bf16x8 pa3) {
  const s16x4 l0 = tr_read<v_rd_off(D0, 0, 0)>(vb), h0 = tr_read<v_rd_off(D0, 0, 1)>(vb), l1 = tr_read<v_rd_off(D0, 1, 0)>(vb), h1 = tr_read<v_rd_off(D0, 1, 1)>(vb);
  const s16x4 l2 = tr_read<v_rd_off(D0, 2, 0)>(vb), h2 = tr_read<v_rd_off(D0, 2, 1)>(vb), l3 = tr_read<v_rd_off(D0, 3, 0)>(vb), h3 = tr_read<v_rd_off(D0, 3, 1)>(vb);
  asm volatile("s_waitcnt lgkmcnt(0)" ::: "memory"); SBAR();
#define PK(L, H) (bf16x8){L[0], L[1], L[2], L[3], H[0], H[1], H[2], H[3]}
  od = __builtin_amdgcn_mfma_f32_32x32x16_bf16(pa0, PK(l0, h0), od, 0, 0, 0);
  od = __builtin_amdgcn_mfma_f32_32x32x16_bf16(pa1, PK(l1, h1), od, 0, 0, 0);
  od = __builtin_amdgcn_mfma_f32_32x32x16_bf16(pa2, PK(l2, h2), od, 0, 0, 0);
  od = __builtin_amdgcn_mfma_f32_32x32x16_bf16(pa3, PK(l3, h3), od, 0, 0, 0);
#undef PK
}
__device__ __forceinline__ void pv2(f32x16* o, int vb, bf16x8 pa0, bf16x8 pa1, bf16x8 pa2, bf16x8 pa3) { pv_one<0>(o[0], vb, pa0, pa1, pa2, pa3); pv_one<1>(o[1], vb, pa0, pa1, pa2, pa3); }
template <int NS, int ROWB> __device__ __forceinline__ void qkt(f32x16& p0, f32x16& p1, const ATT_LAS char* Ks, const bf16x8* qr, int r32, int hi) {
  p0 = f32x16{}; p1 = f32x16{};
#pragma unroll
  for (int d0 = 0; d0 < NS; ++d0) { const int cb = d0 * 32 + hi * 16;
    const bf16x8 b0 = *(const ATT_LAS bf16x8*)(Ks + r32 * ROWB + cb);
    const bf16x8 b1 = *(const ATT_LAS bf16x8*)(Ks + (32 + r32) * ROWB + cb);
    p0 = __builtin_amdgcn_mfma_f32_32x32x16_bf16(b0, qr[d0], p0, 0, 0, 0);
    p1 = __builtin_amdgcn_mfma_f32_32x32x16_bf16(b1, qr[d0], p1, 0, 0, 0); }
}
constexpr float THR = 8.f;
__device__ __forceinline__ void partialSM(f32x16& p0, f32x16& p1, float& m_reg, float& alpha) {
  float pmax = p0[0];
#pragma unroll
  for (int r = 1; r < 16; ++r) pmax = fmaxf(pmax, p0[r]);
#pragma unroll
  for (int r = 0; r < 16; ++r) pmax = fmaxf(pmax, p1[r]);
  { auto rr = __builtin_amdgcn_permlane32_swap(__float_as_uint(pmax), __float_as_uint(pmax), false, false); pmax = fmaxf(__uint_as_float(rr[0]), __uint_as_float(rr[1])); }
  float mn;
  if (__builtin_expect(__all(pmax - m_reg <= THR), 1)) { mn = m_reg; alpha = 1.f; }
  else { mn = fmaxf(m_reg, pmax); alpha = __builtin_amdgcn_exp2f(m_reg - mn); m_reg = mn; }
#pragma unroll
  for (int r = 0; r < 16; ++r) p0[r] = p0[r] - mn;
#pragma unroll
  for (int r = 0; r < 16; ++r) p1[r] = p1[r] - mn;
#pragma unroll
  for (int r = 0; r < 16; ++r) p0[r] = __builtin_amdgcn_exp2f(p0[r]);
}
__device__ __forceinline__ void finishSM(f32x16& p0, f32x16& p1, float alpha, float& l_reg, bf16x8& pa0, bf16x8& pa1, bf16x8& pa2, bf16x8& pa3) {
#pragma unroll
  for (int r = 0; r < 16; ++r) p1[r] = __builtin_amdgcn_exp2f(p1[r]);
  float ps = 0;
#pragma unroll
  for (int r = 0; r < 16; ++r) ps += p0[r];
#pragma unroll
  for (int r = 0; r < 16; ++r) ps += p1[r];
  { auto rr = __builtin_amdgcn_permlane32_swap(__float_as_uint(ps), __float_as_uint(ps), false, false); ps = __uint_as_float(rr[0]) + __uint_as_float(rr[1]); }
  l_reg = l_reg * alpha + ps;
#define PK4(P, BASE, OUT) do { unsigned a0 = cvtpk(P[BASE + 0], P[BASE + 1]), a1 = cvtpk(P[BASE + 2], P[BASE + 3]);   \
    unsigned b0 = cvtpk(P[BASE + 4], P[BASE + 5]), b1 = cvtpk(P[BASE + 6], P[BASE + 7]);                              \
    auto r0 = __builtin_amdgcn_permlane32_swap(a0, b0, false, false); auto r1 = __builtin_amdgcn_permlane32_swap(a1, b1, false, false); \
    u32x4 w = {r0[0], r1[0], r0[1], r1[1]}; OUT = *reinterpret_cast<bf16x8*>(&w); } while (0)
  PK4(p0, 0, pa0); PK4(p0, 8, pa1); PK4(p1, 0, pa2); PK4(p1, 8, pa3);
#undef PK4
}

#define MX3(a, b, c) __builtin_fmaxf(__builtin_fmaxf((a), (b)), (c))
__device__ __forceinline__ float rowmax32(const f32x16& p0, const f32x16& p1) {
  float a = MX3(p0[0], p0[1], p1[0]), b = MX3(p0[2], p0[3], p1[1]); a = MX3(a, p1[2], p1[3]);
#pragma unroll
  for (int r = 4; r < 16; r += 4) { a = MX3(a, p0[r], p0[r + 1]); b = MX3(b, p0[r + 2], p0[r + 3]); a = MX3(a, p1[r], p1[r + 1]); b = MX3(b, p1[r + 2], p1[r + 3]); }
  float m = __builtin_fmaxf(a, b);
  { auto rr = __builtin_amdgcn_permlane32_swap(__float_as_uint(m), __float_as_uint(m), false, false); m = __builtin_fmaxf(__uint_as_float(rr[0]), __uint_as_float(rr[1])); }
  return m;
}
template <int NS, int ROWB> __device__ __forceinline__ void qkt_from(f32x16& p0, f32x16& p1, const ATT_LAS char* Ks, const bf16x8* qr, const f32x16& c0, int r32, int hi) {
#pragma unroll
  for (int d0 = 0; d0 < NS; ++d0) { const int cb = d0 * 32 + hi * 16;
    const bf16x8 b0 = *(const ATT_LAS bf16x8*)(Ks + r32 * ROWB + cb);
    const bf16x8 b1 = *(const ATT_LAS bf16x8*)(Ks + (32 + r32) * ROWB + cb);
    if (d0 == 0) { p0 = __builtin_amdgcn_mfma_f32_32x32x16_bf16(b0, qr[0], c0, 0, 0, 0); p1 = __builtin_amdgcn_mfma_f32_32x32x16_bf16(b1, qr[0], c0, 0, 0, 0); }
    else { p0 = __builtin_amdgcn_mfma_f32_32x32x16_bf16(b0, qr[d0], p0, 0, 0, 0); p1 = __builtin_amdgcn_mfma_f32_32x32x16_bf16(b1, qr[d0], p1, 0, 0, 0); } }
}
template <bool FIRST> __device__ __forceinline__ void partialSM2(f32x16& p0, f32x16& p1, float& m_ref, f32x16& negm, float& alpha) {
  const float rm = rowmax32(p0, p1);
  alpha = 1.f;
  if (FIRST || !__builtin_expect(__all(rm <= THR), 1)) {
    const float dl = FIRST ? rm : __builtin_fmaxf(rm, 0.f);
    m_ref += dl;
#pragma unroll
    for (int r = 0; r < 16; ++r) { p0[r] -= dl; p1[r] -= dl; }
#pragma unroll
    for (int r = 0; r < 16; ++r) negm[r] = -m_ref;
    asm volatile("" : "+v"(negm));
    if (!FIRST) alpha = __builtin_amdgcn_exp2f(-dl);
  }
#pragma unroll
  for (int r = 0; r < 16; ++r) p0[r] = __builtin_amdgcn_exp2f(p0[r]);
}
__device__ __forceinline__ void finishSM2(f32x16& p0, f32x16& p1, bf16x8& pa0, bf16x8& pa1, bf16x8& pa2, bf16x8& pa3) {
#pragma unroll
  for (int r = 0; r < 16; ++r) p1[r] = __builtin_amdgcn_exp2f(p1[r]);
#define PK4(P, BASE, OUT) do { unsigned a0 = cvtpk(P[BASE + 0], P[BASE + 1]), a1 = cvtpk(P[BASE + 2], P[BASE + 3]);   \
    unsigned b0 = cvtpk(P[BASE + 4], P[BASE + 5]), b1 = cvtpk(P[BASE + 6], P[BASE + 7]);                              \
    auto r0 = __builtin_amdgcn_permlane32_swap(a0, b0, false, false); auto r1 = __builtin_amdgcn_permlane32_swap(a1, b1, false, false); \
    u32x4 w = {r0[0], r1[0], r0[1], r1[1]}; OUT = *reinterpret_cast<bf16x8*>(&w); } while (0)
  PK4(p0, 0, pa0); PK4(p0, 8, pa1); PK4(p1, 0, pa2); PK4(p1, 8, pa3);
#undef PK4
}
__device__ __forceinline__ void pv3(f32x16* o, f32x16& ol, int vb, bf16x8 pa0, bf16x8 pa1, bf16x8 pa2, bf16x8 pa3) {
  const bf16x8 ones = {0x3F80, 0x3F80, 0x3F80, 0x3F80, 0x3F80, 0x3F80, 0x3F80, 0x3F80};
  pv_one<0>(o[0], vb, pa0, pa1, pa2, pa3);
  ol = __builtin_amdgcn_mfma_f32_32x32x16_bf16(pa0, ones, ol, 0, 0, 0); ol = __builtin_amdgcn_mfma_f32_32x32x16_bf16(pa1, ones, ol, 0, 0, 0);
  pv_one<1>(o[1], vb, pa0, pa1, pa2, pa3);
  ol = __builtin_amdgcn_mfma_f32_32x32x16_bf16(pa2, ones, ol, 0, 0, 0); ol = __builtin_amdgcn_mfma_f32_32x32x16_bf16(pa3, ones, ol, 0, 0, 0);
}
#ifndef MLA_CHK_ODD
#define MLA_CHK_ODD 0
#endif
constexpr int KSLOT = 12288, VSLOT = 8192, NSLOT = 4, MLA_OIMG = NSLOT * (KSLOT + VSLOT) + 8 * 256  , MLA_LDS = MLA_OIMG + 8 * OIMG_WAVE;
__device__ __forceinline__ void glds16(const void* gsrc, unsigned lds_dst) { unsigned keep;
  asm volatile("s_mov_b32 %0, m0\n\ts_mov_b32 m0, %2\n\ts_nop 0\n\tglobal_load_lds_dwordx4 %1, off\n\ts_mov_b32 m0, %0" : "=&s"(keep) : "v"(gsrc), "s"(lds_dst) : "memory"); }
#define BAR_L() asm volatile("s_waitcnt lgkmcnt(0)\n\ts_barrier" ::: "memory")
#define BAR_V(N) asm volatile("s_waitcnt vmcnt(" #N ") lgkmcnt(0)\n\ts_barrier" ::: "memory")
typedef short v4i16_t __attribute__((ext_vector_type(4)));
__device__ __forceinline__ s16x4 vtr(const ATT_LAS char* p) { return __builtin_bit_cast(s16x4, __builtin_amdgcn_ds_read_tr16_b64_v4i16((ATT_LAS v4i16_t*)p)); }
__device__ __forceinline__ void kfetch(bf16x8 (&kf)[12], const ATT_LAS char* Ks, int r32, int hi) {
#pragma unroll
  for (int d0 = 0; d0 < 6; ++d0) { const ATT_LAS char* p = Ks + (2 * d0 + hi) * 1024 + r32 * 16;
    kf[2 * d0] = *(const ATT_LAS bf16x8*)p; kf[2 * d0 + 1] = *(const ATT_LAS bf16x8*)(p + 512); }
}
#define MX3(a, b, c) __builtin_fmaxf(__builtin_fmaxf((a), (b)), (c))
__device__ __forceinline__ void mla_unit(const bf16* __restrict__ Qb, const bf16* __restrict__ Kh, const bf16* __restrict__ Vh, bf16* __restrict__ Ob, int seq, ATT_LAS char* lds, const int wave_id) {
  int lane_; asm volatile("v_mbcnt_lo_u32_b32 %0, -1, 0\n\tv_mbcnt_hi_u32_b32 %0, -1, %0" : "=v"(lane_));
  int w_ = wave_id; asm volatile("" : "+s"(w_));
  const int wid = w_, lane = lane_, r32 = lane & 31, hi = lane >> 5;
  const int half = wid >> 2;
  ATT_LAS char* K_lds = lds; ATT_LAS char* V_lds = lds + NSLOT * KSLOT;
  ATT_LAS float* al_l = (ATT_LAS float*)(lds + NSLOT * (KSLOT + VSLOT)) + wid * 64; ATT_LAS float* li_l = al_l + 32;
  const unsigned lds0 = (unsigned)(uintptr_t)lds;
  const int NT = seq / 64;
  const bf16* ksrc0 = Kh + (long)lane * 768 + wid * 8; const bf16* ksrc1 = ksrc0 + 64;
  const bf16* vsrc = Vh + (long)(16 * (wid & 3) + (lane >> 2)) * 512 + (wid >> 2) * 32 + (lane & 3) * 8;
  const unsigned kdst0 = lds0 + wid * 1024, vdst = lds0 + NSLOT * KSLOT + wid * 1024;
#define DMA_K(tile, slot) do { const int tl_ = (tile) < NT ? (tile) : NT - 1; const unsigned d_ = (unsigned)__builtin_amdgcn_readfirstlane(kdst0 + ((slot) & 3) * KSLOT); \
    glds16(ksrc0 + (long)tl_ * 64 * 768, d_); if (!half) glds16(ksrc1 + (long)tl_ * 64 * 768, d_ + 8192); } while (0)
#define DMA_V(tile, slot) do { const int tl_ = (tile) < NT ? (tile) : NT - 1; glds16(vsrc + (long)tl_ * 64 * 512, (unsigned)__builtin_amdgcn_readfirstlane(vdst + ((slot) & 3) * VSLOT)); } while (0)
#define STEP_BAR() do { SBAR(); if (!half) { BAR_V(6); } else { BAR_V(4); } SBAR(); } while (0)
  DMA_K(0, 0); DMA_K(1, 1); DMA_K(2, 2); DMA_K(3, 3); DMA_V(0, 0); DMA_V(1, 1);
  float m_ref = 0.f, l_reg = 0.f, pend = 0.f; f32x16 o[2] = {}; f32x16 negm = {}; bf16x8 qr[6];
  const bf16* Qw = Qb + (long)(wid * 32 + r32) * 768 + hi * 8;
#pragma unroll
  for (int d0 = 0; d0 < 6; ++d0) qr[d0] = *reinterpret_cast<const bf16x8*>(Qw + d0 * 16);
  const ATT_LAS char* vbp0 = V_lds + ((lane >> 4) & 1) * 32 + (lane & 3) * 8 + (4 * hi + ((lane & 15) >> 2)) * 64; const ATT_LAS char* kb0 = K_lds + hi * 1024 + r32 * 16;
  BAR_V(0);
  f32x16 pA0, pA1, pB0, pB1; bf16x8 paA0, paA1, paA2, paA3, paB0, paB1, paB2, paB3;
  paB0 = paB1 = paB2 = paB3 = (bf16x8){0, 0, 0, 0, 0, 0, 0, 0};
#define KFR(kb, i) (*(const ATT_LAS bf16x8*)((kb) + ((i) >> 1) * 2048 + ((i) & 1) * 512))
#pragma unroll
  for (int i = 0; i < 12; i += 2) { const bf16x8 k0_ = KFR(kb0, i), k1_ = KFR(kb0, i + 1);
    if (i == 0) { pA0 = __builtin_amdgcn_mfma_f32_32x32x16_bf16(k0_, qr[0], negm, 0, 0, 0); pA1 = __builtin_amdgcn_mfma_f32_32x32x16_bf16(k1_, qr[0], negm, 0, 0, 0); }
    else { pA0 = __builtin_amdgcn_mfma_f32_32x32x16_bf16(k0_, qr[i >> 1], pA0, 0, 0, 0); pA1 = __builtin_amdgcn_mfma_f32_32x32x16_bf16(k1_, qr[i >> 1], pA1, 0, 0, 0); } }
#define QKM(i, N0, N1) do { if ((i) == 0) N0 = __builtin_amdgcn_mfma_f32_32x32x16_bf16(kf[0], qr[0], negm, 0, 0, 0); else if ((i) == 1) N1 = __builtin_amdgcn_mfma_f32_32x32x16_bf16(kf[1], qr[0], negm, 0, 0, 0); \
    else if (((i) & 1) == 0) N0 = __builtin_amdgcn_mfma_f32_32x32x16_bf16(kf[i], qr[(i) >> 1], N0, 0, 0, 0); else N1 = __builtin_amdgcn_mfma_f32_32x32x16_bf16(kf[i], qr[(i) >> 1], N1, 0, 0, 0); } while (0)
#define VRDJ(j) do { vl[j] = vtr(vbp + ((j) >> 2) * 4096 + ((j) & 3) * 1024); vh[j] = vtr(vbp + ((j) >> 2) * 4096 + ((j) & 3) * 1024 + 512); } while (0)
#define PKV(i) (bf16x8){vl[i][0], vl[i][1], vl[i][2], vl[i][3], vh[i][0], vh[i][1], vh[i][2], vh[i][3]}
#define EXQ(idx, C0, C1) do { if ((idx) < 16) C0[(idx)] = __builtin_amdgcn_exp2f(C0[(idx)]); else C1[(idx) - 16] = __builtin_amdgcn_exp2f(C1[(idx) - 16]); } while (0)
#define CV(idx, C0, C1) ((idx) < 16 ? C0[(idx)] : C1[(idx) - 16])
#define EX2(k, C0, C1) do { EXQ(2 * (k), C0, C1); EXQ(2 * (k) + 1, C0, C1); ps2 += (f32x2_t){CV(2 * (k), C0, C1), CV(2 * (k) + 1, C0, C1)}; } while (0)
#define PK4(P, BASE, OUT) do { u32x4 w = {cvtpk(P[BASE + 0], P[BASE + 1]), cvtpk(P[BASE + 2], P[BASE + 3]), cvtpk(P[BASE + 4], P[BASE + 5]), cvtpk(P[BASE + 6], P[BASE + 7])}; OUT = *reinterpret_cast<bf16x8*>(&w); } while (0)
#define STEP(t, C0, C1, N0, N1, PC0, PC1, PC2, PC3, PO0, PO1, PO2, PO3, FIRST, CHK) do { \
    typedef float f32x2_t __attribute__((ext_vector_type(2))); \
    STEP_BAR(); \
    DMA_K((t) + 4, (t)); DMA_V((t) + 2, (t) + 2); \
    const ATT_LAS char* kb = kb0 + (((t) + 1) & 3) * KSLOT; const ATT_LAS char* vbp = vbp0 + (((t) - 1) & 3) * VSLOT; \
    bf16x8 kf[12]; s16x4 vl[8], vh[8]; f32x2_t ps2 = {0.f, 0.f}; float al = 1.f; \
    kf[0] = KFR(kb, 0); kf[1] = KFR(kb, 1); kf[2] = KFR(kb, 2); kf[3] = KFR(kb, 3); \
    float a_ = 0.f, b_ = 0.f, rm = 0.f; \
    if (CHK) { a_ = MX3(C0[0], C0[1], C1[0]); b_ = MX3(C0[2], C0[3], C1[1]); a_ = MX3(a_, C1[2], C1[3]); \
    a_ = MX3(a_, C0[4], C0[5]); b_ = MX3(b_, C0[6], C0[7]); a_ = MX3(a_, C1[4], C1[5]); b_ = MX3(b_, C1[6], C1[7]); } SBAR(); \
    QKM(0, N0, N1); kf[4] = KFR(kb, 4); if (CHK) { a_ = MX3(a_, C0[8], C0[9]); b_ = MX3(b_, C0[10], C0[11]); a_ = MX3(a_, C1[8], C1[9]); b_ = MX3(b_, C1[10], C1[11]); } SBAR(); \
    QKM(1, N0, N1); kf[5] = KFR(kb, 5); if (CHK) { a_ = MX3(a_, C0[12], C0[13]); b_ = MX3(b_, C0[14], C0[15]); a_ = MX3(a_, C1[12], C1[13]); b_ = MX3(b_, C1[14], C1[15]); } SBAR(); \
    QKM(2, N0, N1); kf[6] = KFR(kb, 6); if (CHK) { rm = __builtin_fmaxf(a_, b_); { auto rr = __builtin_amdgcn_permlane32_swap(__float_as_uint(rm), __float_as_uint(rm), false, false); rm = __builtin_fmaxf(__uint_as_float(rr[0]), __uint_as_float(rr[1])); } } SBAR(); \
    QKM(3, N0, N1); kf[7] = KFR(kb, 7); SBAR(); \
    if ((CHK) && ((FIRST) || !__builtin_expect(__all(rm <= THR), 1))) { const float dl = (FIRST) ? rm : __builtin_fmaxf(rm, 0.f); m_ref += dl; pend = dl; \
      _Pragma("unroll") for (int r = 0; r < 16; ++r) { C0[r] -= dl; C1[r] -= dl; } \
      _Pragma("unroll") for (int r = 0; r < 16; ++r) negm[r] = -m_ref; \
      asm volatile("" : "+v"(negm)); if (!(FIRST)) al = __builtin_amdgcn_exp2f(-dl); } \
    SBAR(); \
    QKM(4, N0, N1); kf[8] = KFR(kb, 8); EX2(0, C0, C1); SBAR(); \
    QKM(5, N0, N1); kf[9] = KFR(kb, 9); EX2(1, C0, C1); SBAR(); \
    QKM(6, N0, N1); kf[10] = KFR(kb, 10); EX2(2, C0, C1); SBAR(); \
    QKM(7, N0, N1); kf[11] = KFR(kb, 11); EX2(3, C0, C1); SBAR(); \
    QKM(8, N0, N1); EX2(4, C0, C1); PK4(C0, 0, PC0); SBAR(); \
    QKM(9, N0, N1); if (!(FIRST)) { VRDJ(0); } EX2(5, C0, C1); SBAR(); \
    QKM(10, N0, N1); if (!(FIRST)) { VRDJ(4); } EX2(6, C0, C1); SBAR(); \
    QKM(11, N0, N1); if (!(FIRST)) { VRDJ(1); } EX2(7, C0, C1); SBAR(); \
    if (!(FIRST)) o[0] = __builtin_amdgcn_mfma_f32_32x32x16_bf16(PO0, PKV(0), o[0], 0, 0, 0); if (!(FIRST)) { VRDJ(5); } EX2(8, C0, C1); PK4(C0, 8, PC1); SBAR(); \
    if (!(FIRST)) o[1] = __builtin_amdgcn_mfma_f32_32x32x16_bf16(PO0, PKV(4), o[1], 0, 0, 0); if (!(FIRST)) { VRDJ(2); } EX2(9, C0, C1); SBAR(); \
    if (!(FIRST)) o[0] = __builtin_amdgcn_mfma_f32_32x32x16_bf16(PO1, PKV(1), o[0], 0, 0, 0); if (!(FIRST)) { VRDJ(6); } EX2(10, C0, C1); SBAR(); \
    if (!(FIRST)) o[1] = __builtin_amdgcn_mfma_f32_32x32x16_bf16(PO1, PKV(5), o[1], 0, 0, 0); if (!(FIRST)) { VRDJ(3); } EX2(11, C0, C1); SBAR(); \
    if (!(FIRST)) o[0] = __builtin_amdgcn_mfma_f32_32x32x16_bf16(PO2, PKV(2), o[0], 0, 0, 0); if (!(FIRST)) { VRDJ(7); } EX2(12, C0, C1); PK4(C1, 0, PC2); SBAR(); \
    if (!(FIRST)) o[1] = __builtin_amdgcn_mfma_f32_32x32x16_bf16(PO2, PKV(6), o[1], 0, 0, 0); EX2(13, C0, C1); SBAR(); \
    if (!(FIRST)) o[0] = __builtin_amdgcn_mfma_f32_32x32x16_bf16(PO3, PKV(3), o[0], 0, 0, 0); EX2(14, C0, C1); SBAR(); \
    if (!(FIRST)) o[1] = __builtin_amdgcn_mfma_f32_32x32x16_bf16(PO3, PKV(7), o[1], 0, 0, 0); EX2(15, C0, C1); PK4(C1, 8, PC3); SBAR(); \
    l_reg = l_reg * al + (ps2.x + ps2.y); \
    if (__builtin_expect(__any(pend != 0.f), 0)) {       \
      const float f_ = (FIRST) ? 1.f : __builtin_amdgcn_exp2f(-pend); if (hi == 0) al_l[r32] = f_; asm volatile("s_waitcnt lgkmcnt(0)" ::: "memory"); \
      _Pragma("unroll") for (int r = 0; r < 16; ++r) { const float g_ = al_l[crow(r, hi)]; o[0][r] *= g_; o[1][r] *= g_; N0[r] -= pend; N1[r] -= pend; } \
      pend = 0.f; } \
  } while (0)
  STEP(0, pA0, pA1, pB0, pB1, paA0, paA1, paA2, paA3, paB0, paB1, paB2, paB3, true, 1);
  for (int t = 1; t + 1 < NT; t += 2) {
    STEP(t, pB0, pB1, pA0, pA1, paB0, paB1, paB2, paB3, paA0, paA1, paA2, paA3, false, MLA_CHK_ODD);
    STEP(t + 1, pA0, pA1, pB0, pB1, paA0, paA1, paA2, paA3, paB0, paB1, paB2, paB3, false, 1);
  }
  STEP(NT - 1, pB0, pB1, pA0, pA1, paB0, paB1, paB2, paB3, paA0, paA1, paA2, paA3, false, MLA_CHK_ODD);
  STEP_BAR();
  { const ATT_LAS char* vbp = vbp0 + ((NT - 1) & 3) * VSLOT; s16x4 vl[8], vh[8];
#pragma unroll
    for (int j = 0; j < 8; ++j) VRDJ(j);
    o[0] = __builtin_amdgcn_mfma_f32_32x32x16_bf16(paB0, PKV(0), o[0], 0, 0, 0); o[1] = __builtin_amdgcn_mfma_f32_32x32x16_bf16(paB0, PKV(4), o[1], 0, 0, 0);
    o[0] = __builtin_amdgcn_mfma_f32_32x32x16_bf16(paB1, PKV(1), o[0], 0, 0, 0); o[1] = __builtin_amdgcn_mfma_f32_32x32x16_bf16(paB1, PKV(5), o[1], 0, 0, 0);
    o[0] = __builtin_amdgcn_mfma_f32_32x32x16_bf16(paB2, PKV(2), o[0], 0, 0, 0); o[1] = __builtin_amdgcn_mfma_f32_32x32x16_bf16(paB2, PKV(6), o[1], 0, 0, 0);
    o[0] = __builtin_amdgcn_mfma_f32_32x32x16_bf16(paB3, PKV(3), o[0], 0, 0, 0); o[1] = __builtin_amdgcn_mfma_f32_32x32x16_bf16(paB3, PKV(7), o[1], 0, 0, 0); }
  { auto rr = __builtin_amdgcn_permlane32_swap(__float_as_uint(l_reg), __float_as_uint(l_reg), false, false); l_reg = __uint_as_float(rr[0]) + __uint_as_float(rr[1]); }
  if (hi == 0) li_l[r32] = l_reg; asm volatile("s_waitcnt lgkmcnt(0)" ::: "memory");
  store_o(o, li_l, Ob + (long)(wid * 32) * 512, lds + MLA_OIMG + wid * OIMG_WAVE, lane, r32, hi);
  BAR_V(0);
#undef DMA_K
#undef DMA_V
#undef STEP_BAR
#undef KFR
#undef QKM
#undef VRDJ
#undef PKV
#undef EXQ
#undef CV
#undef EX2
#undef PK4
#undef STEP
}
#undef BAR_L
#undef BAR_V

constexpr int NA_KROWB = 144, NA_LDS_K = 64 * NA_KROWB  , NA_SLOT = NA_LDS_K + 8192  , NA_OIMG = 2 * NA_SLOT + 15 * 32 * 4 + 8 * 256  , NA_LDS = NA_OIMG + 8 * OIMG_WAVE;
template <int CH> __device__ __forceinline__ constexpr bool na_live0(int q) { return CH == 0 ? true : q >= 12; }
template <int CH> __device__ __forceinline__ constexpr bool na_live1(int q) { return CH == 0 ? q < 4 : true; }
template <int CH> __device__ __forceinline__ void na_tile(f32x16& p0, f32x16& p1, const ATT_LAS float* trow, int qcol, int wstart, int hi, int r32, bool first,
                                                          float& m_ref, float& l_reg, f32x16& negm, f32x16 (&o)[2], ATT_LAS float* al_l, int vb) {
  float bz0[16], bz1[16];
#pragma unroll
  for (int q = 0; q < 16; ++q) { const int kc0 = crow(q, hi), kc1 = kc0 + 32;
    if (na_live0<CH>(q)) { const int i0 = min(max(kc0 - qcol + 15, 0), 30); bz0[q] = trow[i0]; }
    if (na_live1<CH>(q)) { const int i1 = min(max(kc1 - qcol + 15, 0), 30); bz1[q] = trow[i1]; } }
#pragma unroll
  for (int q = 0; q < 16; ++q) { if (na_live0<CH>(q)) asm volatile("" : "+v"(bz0[q])); if (na_live1<CH>(q)) asm volatile("" : "+v"(bz1[q])); }
#pragma unroll
  for (int q = 0; q < 16; ++q) { const int kc0 = crow(q, hi), kc1 = kc0 + 32;
    if (na_live0<CH>(q)) p0[q] = ((unsigned)(kc0 - wstart) < 16u) ? p0[q] + bz0[q] : -1e30f;
    if (na_live1<CH>(q)) p1[q] = ((unsigned)(kc1 - wstart) < 16u) ? p1[q] + bz1[q] : -1e30f; }
  float rm = -1e30f;
#pragma unroll
  for (int q = 0; q < 16; ++q) { if (na_live0<CH>(q)) rm = __builtin_fmaxf(rm, p0[q]); if (na_live1<CH>(q)) rm = __builtin_fmaxf(rm, p1[q]); }
  { auto rr = __builtin_amdgcn_permlane32_swap(__float_as_uint(rm), __float_as_uint(rm), false, false); rm = __builtin_fmaxf(__uint_as_float(rr[0]), __uint_as_float(rr[1])); }
  float al = 1.f;
  if (first || !__builtin_expect(__all(rm <= THR), 1)) {
    const float dl = first ? rm : __builtin_fmaxf(rm, 0.f); m_ref += dl;
#pragma unroll
    for (int q = 0; q < 16; ++q) { if (na_live0<CH>(q)) p0[q] -= dl; if (na_live1<CH>(q)) p1[q] -= dl; }
#pragma unroll
    for (int q = 0; q < 16; ++q) negm[q] = -m_ref;
    asm volatile("" : "+v"(negm));
    if (!first) al = __builtin_amdgcn_exp2f(-dl);
    if (__any(al < 1.f)) { if (hi == 0) al_l[r32] = al; asm volatile("s_waitcnt lgkmcnt(0)" ::: "memory");
#pragma unroll
      for (int q = 0; q < 16; ++q) { const float f_ = al_l[crow(q, hi)]; o[0][q] *= f_; o[1][q] *= f_; } }
  }
  float ps = 0.f;
#pragma unroll
  for (int q = 0; q < 16; ++q) { if (na_live0<CH>(q)) { p0[q] = __builtin_amdgcn_exp2f(p0[q]); ps += p0[q]; } else p0[q] = 0.f;
    if (na_live1<CH>(q)) { p1[q] = __builtin_amdgcn_exp2f(p1[q]); ps += p1[q]; } else p1[q] = 0.f; }
  l_reg = l_reg * al + ps;
  bf16x8 pa0, pa1, pa2, pa3;
#define PK4(P, BASE, OUT) do { unsigned a0 = cvtpk(P[BASE + 0], P[BASE + 1]), a1 = cvtpk(P[BASE + 2], P[BASE + 3]);   \
    unsigned b0_ = cvtpk(P[BASE + 4], P[BASE + 5]), b1_ = cvtpk(P[BASE + 6], P[BASE + 7]);                              \
    auto r0_ = __builtin_amdgcn_permlane32_swap(a0, b0_, false, false); auto r1_ = __builtin_amdgcn_permlane32_swap(a1, b1_, false, false); \
    u32x4 w = {r0_[0], r1_[0], r0_[1], r1_[1]}; OUT = *reinterpret_cast<bf16x8*>(&w); } while (0)
  if (CH == 1) { PK4(p0, 8, pa1); PK4(p1, 0, pa2); PK4(p1, 8, pa3); } else { PK4(p0, 0, pa0); PK4(p0, 8, pa1); PK4(p1, 0, pa2); }
#undef PK4
  SBAR();
  { const ATT_LAS char* vbp = (const ATT_LAS char*)(unsigned)vb;
#define NA_VF(D0, KS) const s16x4 l##D0##KS = vtr(vbp + v_rd_off(D0, KS, 0)), h##D0##KS = vtr(vbp + v_rd_off(D0, KS, 1))
#define NA_PV(D0, KS, PA) o[D0] = __builtin_amdgcn_mfma_f32_32x32x16_bf16(PA, (bf16x8){l##D0##KS[0], l##D0##KS[1], l##D0##KS[2], l##D0##KS[3], h##D0##KS[0], h##D0##KS[1], h##D0##KS[2], h##D0##KS[3]}, o[D0], 0, 0, 0)
    NA_VF(0, 1); NA_VF(1, 1); NA_VF(0, 2); NA_VF(1, 2);
    if (CH == 0) { NA_VF(0, 0); NA_VF(1, 0); NA_PV(0, 0, pa0); NA_PV(1, 0, pa0); }
    NA_PV(0, 1, pa1); NA_PV(1, 1, pa1); NA_PV(0, 2, pa2); NA_PV(1, 2, pa2);
    if (CH == 1) { NA_VF(0, 3); NA_VF(1, 3); NA_PV(0, 3, pa3); NA_PV(1, 3, pa3); }
#undef NA_VF
#undef NA_PV
  }
}
__device__ __forceinline__ void na_unit(int b, int h, int rg, const bf16* __restrict__ QKV, bf16* __restrict__ O, const float* __restrict__ rpb, ATT_LAS char* lds, const int wave_id) {
  int lane_; asm volatile("v_mbcnt_lo_u32_b32 %0, -1, 0\n\tv_mbcnt_hi_u32_b32 %0, -1, %0" : "=v"(lane_));
  int w_ = wave_id; asm volatile("" : "+s"(w_));
  const int wid = w_, lane = lane_, tid = wid * 64 + lane, r32 = lane & 31, hi = lane >> 5;
  ATT_LAS char* K_lds = lds; ATT_LAS char* V_lds = lds + NA_LDS_K; ATT_LAS float* tab = (ATT_LAS float*)(lds + 2 * NA_SLOT);
  ATT_LAS float* ws = (ATT_LAS float*)(lds + 2 * NA_SLOT + 15 * 32 * 4) + wid * 64; ATT_LAS float* li_l = ws; ATT_LAS float* al_l = ws + 32;
  const int r0 = 4 * rg, r = r0 + (wid >> 1), ch = wid & 1, qcol = 32 * ch + r32;
  const int rs = min(max(r - 4, 0), 120), lo = min(max(r0 - 4, 0), 120), hiR = min(max(r0 + 3 - 4, 0), 120) + 7;
  const int wstart = min(max(qcol - 8, 0), 48);
  const long tok0 = (long)b * 8192;
  if (tid < 15 * 32) { const int dr = tid >> 5, dc = tid & 31; tab[tid] = (dc < 31) ? rpb[(h * 15 + dr) * 31 + dc] * 1.4426950408889634f : 0.f; }
  bf16x8 qr[4];
  { const bf16* Qw = QKV + (tok0 + r * 64 + qcol) * 1536 + h * 64 + hi * 8;
#pragma unroll
    for (int d0 = 0; d0 < 4; ++d0) qr[d0] = *reinterpret_cast<const bf16x8*>(Qw + d0 * 16); }
  const int srow = tid >> 3, sch = tid & 7; const int kst = srow * NA_KROWB + sch * 16, vst = v_st(srow, sch * 8);
  const int vb0 = (int)(unsigned)(uintptr_t)V_lds + v_rd_base(lane);
  const bf16* Ksrc = QKV + (tok0 + srow) * 1536 + 512 + h * 64 + sch * 8; const bf16* Vsrc = Ksrc + 512;
  float m_ref = 0.f, l_reg = 0.f; f32x16 o[2] = {}; f32x16 negm = {};
#define NA_LD(KR, KV, VV) do { const int kk_ = min((KR), hiR); KV = *reinterpret_cast<const bf16x8*>(Ksrc + (long)kk_ * 64 * 1536); VV = *reinterpret_cast<const bf16x8*>(Vsrc + (long)kk_ * 64 * 1536); } while (0)
#define NA_BODY(KR, KN, VN, CHV) do { \
    __syncthreads();                                               \
    if ((KR) + 1 <= hiR) { *(ATT_LAS bf16x8*)(K_lds + (par ^ 1) * NA_SLOT + kst) = KN; *(ATT_LAS bf16x8*)(V_lds + (par ^ 1) * NA_SLOT + vst) = VN; NA_LD((KR) + 3, KN, VN); } \
    if ((KR) >= rs && (KR) < rs + 8) {                              \
      f32x16 p0, p1; qkt_from<4, NA_KROWB>(p0, p1, K_lds + par * NA_SLOT, qr, negm, r32, hi); \
      const ATT_LAS float* trow = tab + ((KR) - r + 7) * 32; \
      na_tile<CHV>(p0, p1, trow, qcol, wstart, hi, r32, (KR) == rs, m_ref, l_reg, negm, o, al_l, vb0 + par * NA_SLOT); \
    } \
    par ^= 1; } while (0)
  bf16x8 k0, v0, k1, v1;
  NA_LD(lo, k0, v0); NA_LD(lo + 1, k1, v1);
  *(ATT_LAS bf16x8*)(K_lds + kst) = k0; *(ATT_LAS bf16x8*)(V_lds + vst) = v0; NA_LD(lo + 2, k0, v0);
  int par = 0;
  if (ch == 0) {
    for (int kr = lo; kr <= hiR; kr += 2) {
      NA_BODY(kr, k1, v1, 0);
      if (kr + 1 > hiR) break;
      NA_BODY(kr + 1, k0, v0, 0);
    }
  } else {
    for (int kr = lo; kr <= hiR; kr += 2) {
      NA_BODY(kr, k1, v1, 1);
      if (kr + 1 > hiR) break;
      NA_BODY(kr + 1, k0, v0, 1);
    }
  }
#undef NA_LD
#undef NA_BODY
  { auto rr = __builtin_amdgcn_permlane32_swap(__float_as_uint(l_reg), __float_as_uint(l_reg), false, false); l_reg = __uint_as_float(rr[0]) + __uint_as_float(rr[1]); }
  if (hi == 0) li_l[r32] = l_reg; asm volatile("s_waitcnt lgkmcnt(0)" ::: "memory");
  store_o(o, li_l, O + (tok0 + r * 64 + 32 * ch) * 512 + h * 64, lds + NA_OIMG + wid * OIMG_WAVE, lane, r32, hi);
  __syncthreads();
}
#undef SBAR
}

constexpr int NWAVES = 8;
constexpr int NB = 8, SEQ = 8192, DM = 1024, MTOK = NB * SEQ;
constexpr int NIN = 4640, NPROJ = 4864;
constexpr int DFF = 2816, DFFE = 3584, NEXP = 8, PLED = 256;
constexpr int QLORA = 768, KVLORA = 256;
constexpr float ALPHA = 1.4142135623730951f;
constexpr float LN_EPS = 1e-5f, RMS_EPS = 1e-6f;
constexpr float LOG2E = 1.4426950408889634f;
constexpr float NA_QSCALE = 0.125f * LOG2E;
constexpr float MLA_QSCALE = 0.10206207261596575f * LOG2E;
constexpr int MOE_CHUNK = 128, MOE_NCHUNK = 4, MOE_REMT = 8, MOE_MAXT = 520;

constexpr size_t MiB = 1u << 20;
constexpr size_t WS_CTL = 0, CTL_ZERO_BYTES = 64 * 1024;
constexpr size_t WS_ROPE = 1 * MiB;
constexpr size_t WS_W = 2 * MiB;
constexpr size_t W_WIN = 0, W_WUQ = W_WIN + (size_t)NPROJ * 1024 * 2, W_WUKV = W_WUQ + 768 * 768 * 2, W_WNAO = W_WUKV + 1024 * 256 * 2, W_WMLAO = W_WNAO + 1024 * 512 * 2,
                 W_WOUT = W_WMLAO + 1024 * 512 * 2, W_WPG = W_WOUT + 1024 * 1024 * 2, W_WPLE = W_WPG + 1024 * 1024 * 2, W_LAYER = W_WPLE + 1024 * 256 * 2;
constexpr size_t WS_W13 = WS_W + 2 * W_LAYER, WS_W2 = WS_W13 + (size_t)2 * DFF * 1024 * 2, WS_WEND = WS_W2 + (size_t)1024 * DFF * 2;
static_assert(WS_WEND <= 56 * MiB, "weights");
constexpr size_t WS_SX = 54 * MiB, WS_SX1 = WS_SX + 256 * 1024, WS_SXS = WS_SX + 512 * 1024;
constexpr size_t WS_SWIN = 55 * MiB + 256 * 1024, WS_SW13 = WS_SWIN + 64 * 1024, WS_SWM13 = WS_SW13 + 32 * 1024;
constexpr size_t WS_SWPG = WS_SWM13 + 8 * 7168 * 4;
static_assert(WS_WEND <= WS_SX && WS_SWPG + 2 * 1024 * 4 <= 56 * MiB, "scales");
constexpr size_t WS_PB = 56 * MiB;
constexpr size_t WS_TE = 88 * MiB, WS_TP = 88 * MiB + 512 * 1024, WS_TW = 89 * MiB, WS_TPOS = 89 * MiB + 512 * 1024, WS_SW = 90 * MiB, WS_CNT = 91 * MiB;
constexpr size_t WS_PS = 92 * MiB;
constexpr size_t WS_XB = 96 * MiB;
constexpr size_t WS_QMLA = WS_XB;
constexpr size_t WS_GATES = 224 * MiB;
constexpr size_t WS_NAQKV = 480 * MiB;
constexpr size_t WS_MERGED = WS_NAQKV;
constexpr size_t WS_QLAT = 672 * MiB, WS_KVLAT = 768 * MiB;
constexpr size_t WS_ONA = 672 * MiB, WS_OMLA = 736 * MiB;
constexpr size_t WS_KMLA = 800 * MiB, WS_VMLA = 896 * MiB;
constexpr size_t WS_H = 224 * MiB, WS_PP_DENSE = 576 * MiB;
constexpr size_t WS_PP_MOE = 224 * MiB, WS_XS = 352 * MiB, WS_HS = 612 * MiB, WS_WM13 = 856 * MiB, WS_WM2 = 968 * MiB, WS_END = 1024 * MiB;
static_assert(WS_XS + (size_t)MOE_MAXT * 256 * 1024 * 2 <= WS_HS && WS_HS + (size_t)(MOE_CHUNK + MOE_REMT) * 256 * DFFE * 2 <= WS_WM13 && WS_WM13 + (size_t)NEXP * 2 * DFFE * 1024 * 2 == WS_WM2 && WS_WM2 + (size_t)NEXP * 1024 * DFFE * 2 == WS_END, "moe map");
static_assert(WS_H + (size_t)MTOK * DFF * 2 <= WS_PP_DENSE, "dense map");
constexpr size_t WS_G8 = 704 * MiB;
constexpr size_t WS_PART = 912 * MiB;
constexpr int MOE_REM_ROWS = MOE_REMT * 256, MOE_FULL = MOE_NCHUNK * MOE_CHUNK;
static_assert(WS_PART >= WS_WM13 + (size_t)NEXP * 2 * DFFE * 1024 && WS_PART + (size_t)4 * MOE_REM_ROWS * 1024 * 2 <= WS_WM2, "partials");
static_assert(WS_G8 >= WS_PP_DENSE + (size_t)MTOK * 1024 * 2 && WS_G8 >= WS_HS && WS_G8 + (size_t)MTOK * 1024 <= WS_WM13, "gate map");
constexpr int CW_BAR = 4096;
constexpr int RING_OFF = 0, RING_BYTES = 131072;
constexpr int LDSCTL_OFF = RING_BYTES;
constexpr int X_LCNT = RING_BYTES + 512, X_OFF = X_LCNT + 64, X_TOT = X_OFF + 64, X_RTAB = X_TOT + 64, X_PRE = X_RTAB + 4 * 256 * 4, X_END = X_PRE + 256 * 8 * 4;
constexpr int X_SCL = 147456;
constexpr int LDS_BYTES = 155648;
static_assert(X_END <= X_SCL && X_SCL + 4096 <= LDS_BYTES, "LDS map");

#include <hip/hip_bf16.h>
#define GAS __attribute__((address_space(1)))
#define LAS __attribute__((address_space(3)))
typedef unsigned short bf16;
typedef unsigned v4u __attribute__((ext_vector_type(4)));
typedef float f32x4 __attribute__((ext_vector_type(4)));
typedef short bf16x8 __attribute__((ext_vector_type(8)));
typedef GAS unsigned gu32;
typedef GAS unsigned long long gu64;
#define RLX_AGENT __ATOMIC_RELAXED, __HIP_MEMORY_SCOPE_AGENT
#define LDS_WAIT() asm volatile("s_waitcnt lgkmcnt(0)" ::: "memory")
#define VM_WAIT() asm volatile("s_waitcnt vmcnt(0)" ::: "memory")
__device__ __forceinline__ unsigned long long rt() { return __builtin_amdgcn_s_memrealtime(); }
__device__ __forceinline__ unsigned f2bf(float f) { unsigned u = __builtin_bit_cast(unsigned, f); return (u + 0x7fffu + ((u >> 16) & 1u)) >> 16; }
__device__ __forceinline__ unsigned pk2(float lo, float hi) { return f2bf(lo) | (f2bf(hi) << 16); }

#define XB_TMO      128
#define XB_XCNT(j)  (256  + 64 * (j))
#define XB_XSUB(j)  (1280 + 64 * (j))
#define XB_XGEN(j)  (2304 + 64 * (j))
#define XB_TOP      3328
#define XB_TOPGEN   3392
#define XCD_BAR_WORDS 3456
#define XB_SPIN_CAP (1u << 18)

__device__ __forceinline__ unsigned xb_ld(unsigned* p)              { return __hip_atomic_load(p, __ATOMIC_RELAXED, __HIP_MEMORY_SCOPE_AGENT); }
__device__ __forceinline__ unsigned xb_add(unsigned* p, unsigned v) { return __hip_atomic_fetch_add(p, v, __ATOMIC_RELAXED, __HIP_MEMORY_SCOPE_AGENT); }
__device__ __forceinline__ unsigned xb_xcc_id() { return (unsigned)__builtin_amdgcn_s_getreg((3 << 11) | 20) & 0xFu; }
#define XB_SPIN(cond, bar) do { unsigned _sp = 0; while (cond) { __builtin_amdgcn_s_sleep(1); \
    if ((++_sp & 255u) == 0u) { if (xb_ld(&(bar)[XB_TMO])) break; if (_sp > XB_SPIN_CAP) { atomicAdd(&(bar)[XB_TMO], 1u); break; } } } } while (0)

struct XcdBarrier {
    unsigned* bar; unsigned x;
    volatile LAS unsigned* st;
    unsigned w0;
};

__device__ __forceinline__ XcdBarrier xcd_barrier_post(unsigned* bar, volatile LAS unsigned* st) {
    XcdBarrier b; b.bar = bar; b.x = xb_xcc_id(); b.st = st; b.w0 = (unsigned)__builtin_amdgcn_readfirstlane(threadIdx.x < 64u ? 1 : 0);
    if (threadIdx.x == 0) (void)xb_add(&bar[XB_XCNT(b.x)], 1u);
    return b;
}
__device__ __forceinline__ void xcd_barrier_complete(unsigned* bar, unsigned x, unsigned& nloc, unsigned& nx) {
    const unsigned G = gridDim.x * gridDim.y * gridDim.z;
    unsigned sum, cnt, mine, sp = 0u;
    for (;;) {
        sum = 0u; cnt = 0u; mine = 0u;
#pragma unroll
        for (unsigned j = 0; j < 16; ++j) { const unsigned c = xb_ld(&bar[XB_XCNT(j)]); sum += c; cnt += (c > 0u) ? 1u : 0u; mine = (j == x) ? c : mine; }
        if (sum == G) break;
        __builtin_amdgcn_s_sleep(1);
        if ((++sp & 255u) == 0u) { if (xb_ld(&bar[XB_TMO])) break; if (sp > XB_SPIN_CAP) { atomicAdd(&bar[XB_TMO], 1u); break; } }
    }
    nloc = mine > 0u ? mine : 1u; nx = cnt > 0u ? cnt : 1u;
}

__device__ __forceinline__ void xcd_barrier(const XcdBarrier& b) {
    asm volatile("s_waitcnt vmcnt(0)" ::: "memory");
    __syncthreads();
    int xl_; asm volatile("v_mbcnt_lo_u32_b32 %0, -1, 0\n\tv_mbcnt_hi_u32_b32 %0, -1, %0" : "=v"(xl_));
    if (b.w0 && xl_ == 0) {
        unsigned* bar = b.bar;
        __builtin_amdgcn_s_waitcnt(0);
        unsigned nloc = b.st[0], nx = b.st[1];
        if (nloc == 0u) { xcd_barrier_complete(bar, b.x, nloc, nx); b.st[0] = nloc; b.st[1] = nx; }
        const unsigned old = xb_add(&bar[XB_XSUB(b.x)], 1u);
        const unsigned gen = old / nloc;
        if (old + 1u == (gen + 1u) * nloc) {
            __builtin_amdgcn_fence(__ATOMIC_RELEASE, "agent");
            asm volatile("s_waitcnt vmcnt(0)" ::: "memory");
            const unsigned og = xb_add(&bar[XB_TOP], 1u);
            const unsigned tg = og / nx;
            if (og + 1u == (tg + 1u) * nx) xb_add(&bar[XB_TOPGEN], 1u);
            else XB_SPIN(xb_ld(&bar[XB_TOPGEN]) == tg, bar);
            __builtin_amdgcn_fence(__ATOMIC_ACQUIRE, "agent");
            xb_add(&bar[XB_XGEN(b.x)], 1u);
            asm volatile("s_waitcnt vmcnt(0)" ::: "memory");
        } else {
            XB_SPIN(xb_ld(&bar[XB_XGEN(b.x)]) == gen, bar);
            __builtin_amdgcn_fence(__ATOMIC_ACQUIRE, "agent");
            asm volatile("s_waitcnt vmcnt(0)" ::: "memory");
        }
    }
    __syncthreads();
}


typedef unsigned v2u __attribute__((ext_vector_type(2)));
struct Args { const float* in[26]; float* out; unsigned char* ws; int ph_lo, ph_hi; };
struct Frame {
    LAS unsigned char* lds;
    int tid, lane, wave, vcu, G;
};
#define WR_DPP(v, ctrl) __int_as_float(__builtin_amdgcn_update_dpp(0, __float_as_int(v), (ctrl), 0xf, 0xf, true))
__device__ __forceinline__ float wave_sum(float v) {
    v += WR_DPP(v, 0xB1); v += WR_DPP(v, 0x4E); v += WR_DPP(v, 0x141); v += WR_DPP(v, 0x140);
    { const auto r = __builtin_amdgcn_permlane16_swap(__float_as_uint(v), __float_as_uint(v), false, false); v = __uint_as_float(r[0]) + __uint_as_float(r[1]); }
    { const auto r = __builtin_amdgcn_permlane32_swap(__float_as_uint(v), __float_as_uint(v), false, false); v = __uint_as_float(r[0]) + __uint_as_float(r[1]); }
    return v;
}
__device__ __forceinline__ float wave_max(float v) {
    v = fmaxf(v, WR_DPP(v, 0xB1)); v = fmaxf(v, WR_DPP(v, 0x4E)); v = fmaxf(v, WR_DPP(v, 0x141)); v = fmaxf(v, WR_DPP(v, 0x140));
    { const auto r = __builtin_amdgcn_permlane16_swap(__float_as_uint(v), __float_as_uint(v), false, false); v = fmaxf(__uint_as_float(r[0]), __uint_as_float(r[1])); }
    { const auto r = __builtin_amdgcn_permlane32_swap(__float_as_uint(v), __float_as_uint(v), false, false); v = fmaxf(__uint_as_float(r[0]), __uint_as_float(r[1])); }
    return v;
}
__device__ __forceinline__ float half_max32(float v) { const auto r = __builtin_amdgcn_permlane32_swap(__float_as_uint(v), __float_as_uint(v), false, false); return fmaxf(__uint_as_float(r[0]), __uint_as_float(r[1])); }
__device__ __forceinline__ float bflo(unsigned w) { return __uint_as_float(w << 16); }
__device__ __forceinline__ float bfhi(unsigned w) { return __uint_as_float(w & 0xffff0000u); }

__device__ __forceinline__ void tr_item(const float* W, int K, int N, bf16* WT, int g, int s0, int ss, int d0, int ds, const float* gs, LAS float* scr, int item, int ncols, int lane) {
    const int nblk = ncols / 32, kb = item / nblk, nb = item % nblk, k0 = 64 * kb, j0 = 32 * nb;
    const int grp = j0 / g, jin = j0 % g, sn0 = s0 + grp * ss + jin, dn0 = d0 + grp * ds + jin;
    float v[32];
#pragma unroll
    for (int i = 0; i < 32; ++i) { const int kk = 2 * i + (lane >> 5); v[i] = W[(size_t)(k0 + kk) * N + sn0 + (lane & 31)]; }
    if (gs) {
#pragma unroll
        for (int i = 0; i < 32; ++i) v[i] *= gs[k0 + 2 * i + (lane >> 5)]; }
#pragma unroll
    for (int i = 0; i < 32; ++i) scr[(2 * i + (lane >> 5)) * 33 + (lane & 31)] = v[i];
    LDS_WAIT(); asm volatile("" ::: "memory");
    const int c = lane & 7;
#pragma unroll
    for (int j = 0; j < 4; ++j) { const int n = (lane >> 3) + 8 * j; const LAS float* s = scr + (8 * c) * 33 + n;
        v4u o; o.x = pk2(s[0 * 33], s[1 * 33]); o.y = pk2(s[2 * 33], s[3 * 33]); o.z = pk2(s[4 * 33], s[5 * 33]); o.w = pk2(s[6 * 33], s[7 * 33]);
        *(GAS v4u*)(WT + (size_t)(dn0 + n) * K + k0 + 8 * c) = o; }
    LDS_WAIT(); asm volatile("" ::: "memory");
}
__device__ __forceinline__ void tr_job(Frame& F, int& rot, const float* W, int K, int N, int ncols, bf16* WT, int g, int s0, int ss, int d0, int ds, const float* gs) {
    LAS float* scr = (LAS float*)(F.lds + RING_OFF + F.wave * 16384);
    const int NGW = F.G * NWAVES, gw = F.vcu * NWAVES + F.wave, nitems = (K / 64) * (ncols / 32);
    int first = (gw - rot) % NGW; if (first < 0) first += NGW;
    for (int it = first; it < nitems; it += NGW) tr_item(W, K, N, WT, g, s0, ss, d0, ds, gs, scr, it, ncols, F.lane);
    rot = (rot + nitems) % NGW;
}
__device__ __forceinline__ void tr_plain(Frame& F, int& rot, const float* W, int K, int N, bf16* WT) { tr_job(F, rot, W, K, N, N, WT, N, 0, 0, 0, 0, nullptr); }
__device__ __forceinline__ void cvt_rows(Frame& F, const float* src, bf16* dst, size_t n8) {
    const size_t NT = (size_t)F.G * NWAVES * 64, t0 = (size_t)(F.vcu * NWAVES + F.wave) * 64 + F.lane;
    size_t i = t0;
    for (; i + 3 * NT < n8; i += 4 * NT) { f32x4 a[4], b[4];
#pragma unroll
        for (int q = 0; q < 4; ++q) { a[q] = *(const GAS f32x4*)(src + (i + q * NT) * 8); b[q] = *(const GAS f32x4*)(src + (i + q * NT) * 8 + 4); }
#pragma unroll
        for (int q = 0; q < 4; ++q) { v4u o; o.x = pk2(a[q].x, a[q].y); o.y = pk2(a[q].z, a[q].w); o.z = pk2(b[q].x, b[q].y); o.w = pk2(b[q].z, b[q].w); *(GAS v4u*)(dst + (i + q * NT) * 8) = o; } }
    for (; i < n8; i += NT) { const f32x4 a = *(const GAS f32x4*)(src + i * 8), b = *(const GAS f32x4*)(src + i * 8 + 4);
        v4u o; o.x = pk2(a.x, a.y); o.y = pk2(a.z, a.w); o.z = pk2(b.x, b.y); o.w = pk2(b.z, b.w); *(GAS v4u*)(dst + i * 8) = o; }
}

__device__ __forceinline__ unsigned pack4i8(float a, float b, float c, float d) {
    const int ia = (int)__builtin_rintf(a), ib = (int)__builtin_rintf(b), ic = (int)__builtin_rintf(c), id = (int)__builtin_rintf(d);
    return (unsigned)(ia & 0xff) | ((unsigned)(ib & 0xff) << 8) | ((unsigned)(ic & 0xff) << 16) | ((unsigned)id << 24);
}
__device__ __forceinline__ void trq_job(Frame& F, int& rot, const float* W, int K, int N, int ncols, signed char* WQ, float* SC, int g, int s0, int ss, int d0, int ds) {
    LAS float* scr = (LAS float*)(F.lds + RING_OFF + F.wave * 16384);
    const int NGW = F.G * NWAVES, gw = F.vcu * NWAVES + F.wave, nitems = ncols / 32, lane = F.lane;
    int first = (gw - rot) % NGW; if (first < 0) first += NGW;
    for (int it = first; it < nitems; it += NGW) {
        const int j0 = 32 * it, grp = j0 / g, jin = j0 % g, sn0 = s0 + grp * ss + jin, dn0 = d0 + grp * ds + jin;
        const float* wp = W + sn0 + (lane & 31) + (size_t)(lane >> 5) * N;
        float mx = 0.f;
        for (int kb = 0; kb < K / 64; ++kb) { float v[32];
#pragma unroll
            for (int i = 0; i < 32; ++i) v[i] = wp[(size_t)(kb * 64 + 2 * i) * N];
#pragma unroll
            for (int i = 0; i < 32; ++i) mx = fmaxf(mx, fabsf(v[i])); }
        mx = half_max32(mx);
        const float inv = mx > 0.f ? 127.f / mx : 0.f;
        if (lane < 32) SC[dn0 + lane] = mx > 0.f ? mx * (1.f / 127.f) : 1.f;
        for (int kb = 0; kb < K / 64; ++kb) { float v[32];
#pragma unroll
            for (int i = 0; i < 32; ++i) v[i] = wp[(size_t)(kb * 64 + 2 * i) * N];
#pragma unroll
            for (int i = 0; i < 32; ++i) scr[(2 * i + (lane >> 5)) * 33 + (lane & 31)] = v[i] * inv;
            LDS_WAIT(); asm volatile("" ::: "memory");
            const int n = lane >> 1, hf = lane & 1; const LAS float* s = scr + (hf * 32) * 33 + n;
            v4u o0, o1;
            o0.x = pack4i8(s[0 * 33], s[1 * 33], s[2 * 33], s[3 * 33]); o0.y = pack4i8(s[4 * 33], s[5 * 33], s[6 * 33], s[7 * 33]); o0.z = pack4i8(s[8 * 33], s[9 * 33], s[10 * 33], s[11 * 33]); o0.w = pack4i8(s[12 * 33], s[13 * 33], s[14 * 33], s[15 * 33]);
            o1.x = pack4i8(s[16 * 33], s[17 * 33], s[18 * 33], s[19 * 33]); o1.y = pack4i8(s[20 * 33], s[21 * 33], s[22 * 33], s[23 * 33]); o1.z = pack4i8(s[24 * 33], s[25 * 33], s[26 * 33], s[27 * 33]); o1.w = pack4i8(s[28 * 33], s[29 * 33], s[30 * 33], s[31 * 33]);
            GAS v4u* dp = (GAS v4u*)(WQ + (size_t)(dn0 + n) * K + kb * 64 + hf * 32); dp[0] = o0; dp[1] = o1;
            LDS_WAIT(); asm volatile("" ::: "memory"); }
    }
    rot = (rot + nitems) % NGW;
}
__device__ __forceinline__ void store_q8(signed char* XQ, float* SX, size_t m, const f32x4 (&v)[4], int lane) {
    float mx = 0.f;
#pragma unroll
    for (int j = 0; j < 4; ++j) mx = fmaxf(fmaxf(mx, fmaxf(fabsf(v[j].x), fabsf(v[j].y))), fmaxf(fabsf(v[j].z), fabsf(v[j].w)));
    mx = wave_max(mx);
    const float inv = mx > 0.f ? 127.f / mx : 0.f;
    GAS unsigned* o4 = (GAS unsigned*)(XQ + m * DM) + lane;
#pragma unroll
    for (int j = 0; j < 4; ++j) o4[64 * j] = pack4i8(v[j].x * inv, v[j].y * inv, v[j].z * inv, v[j].w * inv);
    if (lane == 0) SX[m] = mx > 0.f ? mx * (1.f / 127.f) : 1.f;
}

template <class Sched> __device__ __forceinline__ void rms_prepass(Frame& F, const Sched& S, const float* PS, int p0, int NP, int K) {
    LAS float* rtab = (LAS float*)(F.lds + X_RTAB); pg8::Unit u;
    if (F.tid < 256) {
        for (int i = 0; i < 4 && S.next(i, u); ++i) { const GAS f32x4* pp = (const GAS f32x4*)(PS + (size_t)(u.pa * 256 + F.tid) * 16 + p0);
            float s = 0.f;
            for (int j = 0; j < NP / 4; ++j) { const f32x4 x = pp[j]; s += (x[0] + x[1]) + (x[2] + x[3]); }
            rtab[i * 256 + F.tid] = 1.0f / sqrtf(s / (float)K + RMS_EPS); }
    }
    LDS_WAIT(); __syncthreads();
}

__device__ __forceinline__ void ln_core(f32x4 (&v)[4], const f32x4 (&g)[4], const f32x4 (&bb)[4]) {
    float s = 0.f;
#pragma unroll
    for (int j = 0; j < 4; ++j) s += (v[j].x + v[j].y) + (v[j].z + v[j].w);
    const float mean = wave_sum(s) * (1.f / DM); float s2 = 0.f;
#pragma unroll
    for (int j = 0; j < 4; ++j) { v[j] = v[j] - mean; s2 += (v[j].x * v[j].x + v[j].y * v[j].y) + (v[j].z * v[j].z + v[j].w * v[j].w); }
    const float rstd = 1.f / sqrtf(wave_sum(s2) * (1.f / DM) + LN_EPS);
#pragma unroll
    for (int j = 0; j < 4; ++j) v[j] = v[j] * rstd * g[j] + bb[j];
}
__device__ __forceinline__ void store_row(float* R, bf16* XB, size_t m, const f32x4 (&v)[4], int lane, bool wb) {
    GAS f32x4* o = (GAS f32x4*)(R + m * DM) + lane;
#pragma unroll
    for (int j = 0; j < 4; ++j) o[64 * j] = v[j];
    if (wb) { GAS unsigned long long* o8 = (GAS unsigned long long*)(XB + m * DM) + lane;
#pragma unroll
        for (int j = 0; j < 4; ++j) o8[64 * j] = (unsigned long long)pk2(v[j].x, v[j].y) | ((unsigned long long)pk2(v[j].z, v[j].w) << 32); }
}

__device__ __forceinline__ void load_bf(f32x4 (&v)[4], const bf16* Y, size_t m, int lane) {
    const GAS v2u* p = (const GAS v2u*)(Y + m * DM) + lane;
#pragma unroll
    for (int j = 0; j < 4; ++j) { const v2u w = p[64 * j]; v[j].x = bflo(w.x); v[j].y = bfhi(w.x); v[j].z = bflo(w.y); v[j].w = bfhi(w.y); }
}
__device__ __forceinline__ void store_bf(bf16* XB, size_t m, const f32x4 (&v)[4], int lane) {
    GAS unsigned long long* o8 = (GAS unsigned long long*)(XB + m * DM) + lane;
#pragma unroll
    for (int j = 0; j < 4; ++j) o8[64 * j] = (unsigned long long)pk2(v[j].x, v[j].y) | ((unsigned long long)pk2(v[j].z, v[j].w) << 32);
}
__device__ __forceinline__ void moe_tables(Frame& F, const int* CNT, bool wantPre) {
    LAS int* tot = (LAS int*)(F.lds + X_TOT); LAS int* off = (LAS int*)(F.lds + X_OFF); LAS int* pre = (LAS int*)(F.lds + X_PRE);
    const int e = F.wave;
    int carry = 0;
    for (int b0 = 0; b0 < F.G; b0 += 64) { const int blk = b0 + F.lane; const int v = (blk < F.G) ? CNT[blk * 8 + e] : 0;
        int inc = v;
#pragma unroll
        for (int o = 1; o < 64; o <<= 1) { const int t = __builtin_amdgcn_ds_bpermute(4 * (F.lane - o), inc); if (F.lane >= o) inc += t; }
        if (wantPre && blk < F.G && blk < 256) pre[blk * 8 + e] = carry + inc - v;
        carry += __builtin_amdgcn_readlane(inc, 63); }
    if (F.lane == 0) tot[e] = carry;
    LDS_WAIT(); __syncthreads();
    if (F.tid == 0) { int o = 0; for (int j = 0; j < 8; ++j) { off[j] = o; o += (tot[j] + 255) & ~255; } off[8] = o; }
    LDS_WAIT(); __syncthreads();
}

#ifndef REP_P0
#define REP_P0 1
#endif
#ifndef REP_MC
#define REP_MC 1
#endif
#ifndef REP_A
#define REP_A 1
#endif
#ifndef REP_MU
#define REP_MU 1
#endif
#ifndef REP_MD
#define REP_MD 1
#endif
#ifndef REP_B
#define REP_B 1
#endif
#ifndef REP_D
#define REP_D 1
#endif
#ifndef REP_FU
#define REP_FU 1
#endif
#ifndef REP_PM
#define REP_PM 1
#endif
#ifndef REP_LN
#define REP_LN 1
#endif
#ifndef REP_NA
#define REP_NA 1
#endif
#ifndef REP_MLA
#define REP_MLA 1
#endif
#ifndef EN_P0
#define EN_P0 1
#endif
#ifndef EN_A
#define EN_A 1
#endif
#ifndef EN_B
#define EN_B 1
#endif
#ifndef EN_C
#define EN_C 1
#endif
#ifndef EN_D
#define EN_D 1
#endif
#ifndef EN_E
#define EN_E 1
#endif
#ifndef EN_F
#define EN_F 1
#endif
#ifndef EN_G0
#define EN_G0 1
#endif
#ifndef EN_H0
#define EN_H0 1
#endif
#ifndef EN_G1
#define EN_G1 1
#endif
#ifndef EN_U1
#define EN_U1 1
#endif
#ifndef EN_D1
#define EN_D1 1
#endif
#ifndef EN_I
#define EN_I 1
#endif
__global__ void __launch_bounds__(NWAVES * 64, 2) mk_fwd(Args args) {
    extern __shared__ __attribute__((aligned(16))) unsigned char lds[];
    Frame F;
    F.lds = (LAS unsigned char*)lds;
    volatile LAS unsigned* MISC = (volatile LAS unsigned*)(F.lds + LDSCTL_OFF);
    F.tid = threadIdx.x; F.lane = F.tid & 63; F.wave = __builtin_amdgcn_readfirstlane(F.tid >> 6);
    F.G = gridDim.x; { const int bx = blockIdx.x; F.vcu = (F.G % 8 == 0) ? (bx % 8) * (F.G / 8) + bx / 8 : bx; }
    unsigned char* ws = args.ws; float* R = args.out;
    for (int u = F.tid; u < 128; u += NWAVES * 64) ((LAS unsigned*)(F.lds + LDSCTL_OFF))[u] = 0u;
    __syncthreads();
    const int lo = args.ph_lo, hi = args.ph_hi;
    const bool multi = (hi - lo) > 1;
    XcdBarrier bar; bar.bar = (unsigned*)(ws + WS_CTL) + CW_BAR; bar.x = 0; bar.st = nullptr; bar.w0 = 0;
    if (multi) bar = xcd_barrier_post((unsigned*)(ws + WS_CTL) + CW_BAR, MISC + 8);
    int ph = 0;
#define IN() (lo <= ph && ph < hi)
#define PH_BEGIN() do { int l_; asm volatile("v_mbcnt_lo_u32_b32 %0, -1, 0\n\tv_mbcnt_hi_u32_b32 %0, -1, %0" : "=v"(l_)); F.lane = l_; F.tid = F.wave * 64 + l_; } while (0)
#define SEAM() do { if (lo <= ph && ph + 1 < hi) xcd_barrier(bar); ++ph; } while (0)
    LAS unsigned char* ring = F.lds + RING_OFF;
    bf16* const XB = (bf16*)(ws + WS_XB);
    const float* const ROPE = (const float*)(ws + WS_ROPE);

    if (IN() && EN_P0) { PH_BEGIN();
        int rot = 0;
        for (int rep_ = 0; rep_ < REP_P0; ++rep_)
        for (int L = 0; L < 2; ++L) {
            bf16* WL = (bf16*)(ws + WS_W + (size_t)L * W_LAYER);
            const float* win = args.in[2] + (size_t)L * 1024 * NIN;
            bf16* WIN = (bf16*)((unsigned char*)WL + W_WIN);
            signed char* WINQ = (signed char*)WIN; float* swin = (float*)(ws + WS_SWIN) + L * NPROJ;
            trq_job(F, rot, win, 1024, NIN, 1536, WINQ, swin, 1536, 0, 0, 0, 0);
            trq_job(F, rot, win, 1024, NIN, 768, WINQ, swin, 768, 1536, 0, 1536, 0);
            trq_job(F, rot, win, 1024, NIN, 2048, WINQ, swin, 2048, 2592, 0, 2304, 0);
            trq_job(F, rot, win, 1024, NIN, 256, WINQ, swin, 256, 2304, 0, 4352, 0);
            trq_job(F, rot, win, 1024, NIN, 32, WINQ, swin, 32, 2560, 0, 4608, 0);
            { const size_t n16 = (size_t)(NPROJ - 4640) * 1024 / 16, NT = (size_t)F.G * NWAVES * 64; signed char* z = WINQ + (size_t)4640 * 1024;
              for (size_t i = (size_t)(F.vcu * NWAVES + F.wave) * 64 + F.lane; i < n16; i += NT) *(GAS v4u*)(z + i * 16) = (v4u){0u, 0u, 0u, 0u};
              for (size_t i = (size_t)(F.vcu * NWAVES + F.wave) * 64 + F.lane; i < (size_t)(NPROJ - 4640); i += NT) swin[4640 + i] = 1.f; }
            tr_job(F, rot, args.in[5] + (size_t)L * 768 * 768, 768, 768, 768, (bf16*)((unsigned char*)WL + W_WUQ), 768, 0, 0, 0, 0, args.in[4] + L * 768);
            const float* wukv = args.in[7] + (size_t)L * 256 * 1024; const float* kvg = args.in[6] + L * 256;
            tr_job(F, rot, wukv, 256, 1024, 512, (bf16*)((unsigned char*)WL + W_WUKV), 64, 0, 128, 0, 64, kvg);
            tr_job(F, rot, wukv, 256, 1024, 512, (bf16*)((unsigned char*)WL + W_WUKV), 64, 64, 128, 512, 64, kvg);
            tr_plain(F, rot, args.in[9] + (size_t)L * 512 * 1024, 512, 1024, (bf16*)((unsigned char*)WL + W_WNAO));
            tr_plain(F, rot, args.in[10] + (size_t)L * 512 * 1024, 512, 1024, (bf16*)((unsigned char*)WL + W_WMLAO));
            tr_plain(F, rot, args.in[11] + (size_t)L * 1024 * 1024, 1024, 1024, (bf16*)((unsigned char*)WL + W_WOUT));
            trq_job(F, rot, args.in[22] + (size_t)L * 1024 * 1024, 1024, 1024, 1024, (signed char*)((unsigned char*)WL + W_WPG), (float*)(ws + WS_SWPG) + L * 1024, 1024, 0, 0, 0, 0);
            tr_plain(F, rot, args.in[23] + (size_t)L * 256 * 1024, 256, 1024, (bf16*)((unsigned char*)WL + W_WPLE));
        }
        trq_job(F, rot, args.in[14], 1024, DFF, DFF, (signed char*)(ws + WS_W13), (float*)(ws + WS_SW13), 128, 0, 128, 0, 256);
        trq_job(F, rot, args.in[15], 1024, DFF, DFF, (signed char*)(ws + WS_W13), (float*)(ws + WS_SW13), 128, 0, 128, 128, 256);
        tr_plain(F, rot, args.in[16], DFF, 1024, (bf16*)(ws + WS_W2));
        { const int NT = F.G * NWAVES * 64; float* rt_ = (float*)(ws + WS_ROPE);
          for (int i = (F.vcu * NWAVES + F.wave) * 64 + F.lane; i < SEQ * 16; i += NT) { const int pos = i >> 4, k = i & 15;
              double invf = 1.0; for (int q_ = 0; q_ < k; ++q_) invf *= 0.5623413251903491;
              const double rev = (double)pos * invf * 0.15915494309189535; const float fr_ = (float)(rev - floor(rev));
              rt_[2 * i] = __builtin_amdgcn_cosf(fr_); rt_[2 * i + 1] = __builtin_amdgcn_sinf(fr_); } }
        { const int gw = F.vcu * NWAVES + F.wave, NGW = F.G * NWAVES;
          for (int m = gw; m < MTOK; m += NGW) { f32x4 v[4]; const GAS f32x4* xr = (const GAS f32x4*)(args.in[0] + (size_t)m * DM) + F.lane;
#pragma unroll
              for (int j = 0; j < 4; ++j) v[j] = xr[64 * j];
              store_bf(XB, (size_t)m, v, F.lane); store_q8((signed char*)R + (128u << 20), (float*)(ws + WS_SX), (size_t)m, v, F.lane); } }
    }
    SEAM();

    for (int L = 0; L < 2; ++L) {
        unsigned char* WL = ws + WS_W + (size_t)L * W_LAYER;
        if (IN() && EN_A) { PH_BEGIN();
            pg8::Gemm g{(const pg8::bf16_t*)((const signed char*)R + (128u << 20)), (const pg8::bf16_t*)(WL + W_WIN), MTOK, NPROJ, 512, 0, 0}; pg8::StaticOrder S; S.init(MTOK, NPROJ, F.G, (int)blockIdx.x);
            pg8::EpiProj E{(bf16*)(ws + WS_NAQKV), (bf16*)(ws + WS_QLAT), (bf16*)(ws + WS_GATES), (bf16*)(ws + WS_KVLAT), (bf16*)(ws + WS_KMLA), args.in[3] + L * 2048, ROPE, NA_QSCALE, (float*)(ws + WS_PS), (const float*)(ws + WS_SX), (const float*)(ws + WS_SWIN) + L * NPROJ, (LAS float*)(F.lds + X_SCL)};
            for (int rep_ = 0; rep_ < REP_A; ++rep_) { pg8::gemm_phase<pg8::EpiProj, pg8::StaticOrder, true, true, true>(ring, g, S, E, F.wave); __syncthreads(); }
        }
        SEAM();
        if (IN() && EN_B) { PH_BEGIN();
            for (int rep_ = 0; rep_ < REP_B; ++rep_) {
            { pg8::Gemm g{(const pg8::bf16_t*)(ws + WS_QLAT), (const pg8::bf16_t*)(WL + W_WUQ), MTOK, 768, 768}; pg8::StaticOrder S; S.init(MTOK, 768, F.G, (int)blockIdx.x);
              asm volatile("" : "+s"(S.c), "+s"(S.G)); rms_prepass(F, S, (const float*)(ws + WS_PS), 0, 12, 768); asm volatile("" : "+s"(S.c), "+s"(S.G));
              pg8::EpiQup E{(bf16*)R, (const LAS float*)(F.lds + X_RTAB), ROPE, MLA_QSCALE};
              pg8::gemm_phase<pg8::EpiQup, pg8::StaticOrder, true, true>(ring, g, S, E, F.wave); }
            __syncthreads(); PH_BEGIN();
            { pg8::Gemm g{(const pg8::bf16_t*)(ws + WS_KVLAT), (const pg8::bf16_t*)(WL + W_WUKV), MTOK, 1024, 256}; pg8::StaticOrder S; S.init(MTOK, 1024, F.G, (int)blockIdx.x);
              asm volatile("" : "+s"(S.c), "+s"(S.G)); rms_prepass(F, S, (const float*)(ws + WS_PS), 12, 4, 256); asm volatile("" : "+s"(S.c), "+s"(S.G));
              pg8::EpiKVup E{(bf16*)(ws + WS_KMLA), (bf16*)(ws + WS_VMLA), (const LAS float*)(F.lds + X_RTAB)};
              pg8::gemm_phase<pg8::EpiKVup, pg8::StaticOrder, true, true>(ring, g, S, E, F.wave); }
            __syncthreads(); }
        }
        SEAM();
        if (IN() && EN_C) { PH_BEGIN();
            const float* rpb = args.in[8] + (size_t)L * 8 * 15 * 31;
            for (int rep_ = 0; rep_ < REP_NA; ++rep_)
            for (int uid = F.vcu; uid < 2048; uid += F.G) { const int pair = uid >> 5, rg = uid & 31;
                att::na_unit(pair >> 3, pair & 7, rg, (const att::bf16*)(ws + WS_NAQKV), (att::bf16*)(ws + WS_ONA), rpb, (LAS char*)ring, F.wave); }
            for (int rep_ = 0; rep_ < REP_MLA; ++rep_)
            for (int uid = F.vcu; uid < 2048; uid += F.G) { const int pair = uid >> 5, qb = uid & 31, b = pair >> 3, h = pair & 7;
                const size_t row0 = (size_t)b * SEQ;
                att::mla_unit((const att::bf16*)R + (row0 + qb * 256) * 768 + h * 96, (const att::bf16*)(ws + WS_KMLA) + row0 * 768 + h * 96,
                              (const att::bf16*)(ws + WS_VMLA) + row0 * 512 + h * 64, (att::bf16*)(ws + WS_OMLA) + (row0 + qb * 256) * 512 + h * 64, SEQ, (LAS char*)ring, F.wave); }
        }
        SEAM();
        if (IN() && EN_D) { PH_BEGIN();
            for (int rep_ = 0; rep_ < REP_D; ++rep_) {
            pg8::StaticOrder S; S.init(MTOK, 1024, F.G, (int)blockIdx.x);
            { pg8::Gemm g{(const pg8::bf16_t*)(ws + WS_ONA), (const pg8::bf16_t*)(WL + W_WNAO), MTOK, 1024, 512};
              pg8::EpiMerge E{(const unsigned char*)(ws + WS_GATES), (pg8::bf16_t*)(ws + WS_MERGED), 0};
              pg8::gemm_phase<pg8::EpiMerge, pg8::StaticOrder, true, true>(ring, g, S, E, F.wave); }
            __syncthreads();
            { pg8::Gemm g{(const pg8::bf16_t*)(ws + WS_OMLA), (const pg8::bf16_t*)(WL + W_WMLAO), MTOK, 1024, 512};
              pg8::EpiMerge E{(const unsigned char*)(ws + WS_GATES) + 1024, (pg8::bf16_t*)(ws + WS_MERGED), 1};
              pg8::gemm_phase<pg8::EpiMerge, pg8::StaticOrder, true, true>(ring, g, S, E, F.wave); }
            __syncthreads(); }
        }
        SEAM();
        if (IN() && EN_E) { PH_BEGIN();
            { pg8::Gemm g{(const pg8::bf16_t*)(ws + WS_MERGED), (const pg8::bf16_t*)(WL + W_WOUT), MTOK, 1024, 1024}; pg8::StaticOrder S; S.init(MTOK, 1024, F.G, (int)blockIdx.x);
              pg8::EpiRes<0> E{(const pg8::bf16_t*)XB, (pg8::bf16_t*)R, nullptr, ALPHA};
              pg8::gemm_phase<pg8::EpiRes<0>, pg8::StaticOrder, true, true>(ring, g, S, E, F.wave); }
            if (L == 1) { __syncthreads(); PH_BEGIN(); int rot = 0;
                for (int rep_ = 0; rep_ < REP_MC; ++rep_)
                for (int e = 0; e < NEXP; ++e) {
                    signed char* w13 = (signed char*)(ws + WS_WM13) + (size_t)e * 2 * DFFE * 1024; float* sc13 = (float*)(ws + WS_SWM13) + (size_t)e * 2 * DFFE;
                    trq_job(F, rot, args.in[19] + (size_t)e * 1024 * DFFE, 1024, DFFE, DFFE, w13, sc13, 128, 0, 128, 0, 256);
                    trq_job(F, rot, args.in[20] + (size_t)e * 1024 * DFFE, 1024, DFFE, DFFE, w13, sc13, 128, 0, 128, 128, 256);
                    tr_plain(F, rot, args.in[21] + (size_t)e * DFFE * 1024, DFFE, 1024, (bf16*)(ws + WS_WM2) + (size_t)e * 1024 * DFFE); } }
        }
        SEAM();
        if (IN() && EN_F) { PH_BEGIN();
            f32x4 g[4], bb[4];
            { const GAS f32x4* gp = (const GAS f32x4*)(args.in[12] + L * DM) + F.lane; const GAS f32x4* bp = (const GAS f32x4*)(args.in[13] + L * DM) + F.lane;
#pragma unroll
              for (int j = 0; j < 4; ++j) { g[j] = gp[64 * j]; bb[j] = bp[64 * j]; } }
            LAS float* wrl = (LAS float*)ring; LAS int* lcnt = (LAS int*)(F.lds + X_LCNT);
            if (L == 1) { const float* wr = args.in[17];
                for (int i = F.tid; i < 1024 * 8 / 4; i += NWAVES * 64) ((LAS f32x4*)wrl)[i] = ((const GAS f32x4*)wr)[i];
                if (F.tid < 8) lcnt[F.tid] = 0;
                LDS_WAIT(); __syncthreads(); }
            const int gw = F.vcu * NWAVES + F.wave, NGW = F.G * NWAVES;
            if (REP_LN > 1) for (int m = gw; m < MTOK; m += NGW) {
                f32x4 v[4]; const GAS f32x4* xr = (const GAS f32x4*)(R + (size_t)m * DM) + F.lane;
#pragma unroll
                for (int j = 0; j < 4; ++j) v[j] = xr[64 * j];
                ln_core(v, g, bb);
                store_row((float*)(ws + WS_GATES), XB, (size_t)m, v, F.lane, true); }
            v2u raw[4];
            { const GAS v2u* p_ = (const GAS v2u*)((const bf16*)R + (size_t)gw * DM) + F.lane;
#pragma unroll
              for (int j = 0; j < 4; ++j) raw[j] = p_[64 * j]; }
            for (int m = gw; m < MTOK; m += NGW) {
                f32x4 v[4];
#pragma unroll
                for (int j = 0; j < 4; ++j) { v[j].x = bflo(raw[j].x); v[j].y = bfhi(raw[j].x); v[j].z = bflo(raw[j].y); v[j].w = bfhi(raw[j].y); }
                if (m + NGW < MTOK) { const GAS v2u* p_ = (const GAS v2u*)((const bf16*)R + (size_t)(m + NGW) * DM) + F.lane;
#pragma unroll
                    for (int j = 0; j < 4; ++j) raw[j] = p_[64 * j]; }
                ln_core(v, g, bb);
                store_bf(XB, (size_t)m, v, F.lane);
                store_q8((signed char*)R + (192u << 20), (float*)(ws + WS_SX1), (size_t)m, v, F.lane);
                if (L == 1) {
                    float lg[8];
#pragma unroll
                    for (int e = 0; e < 8; ++e) lg[e] = 0.f;
#pragma unroll
                    for (int j = 0; j < 4; ++j)
#pragma unroll
                        for (int t = 0; t < 4; ++t) { const int k = 4 * F.lane + 256 * j + t; const f32x4 w0 = *(const LAS f32x4*)(wrl + k * 8), w1 = *(const LAS f32x4*)(wrl + k * 8 + 4); const float xv = v[j][t];
                            lg[0] += xv * w0.x; lg[1] += xv * w0.y; lg[2] += xv * w0.z; lg[3] += xv * w0.w; lg[4] += xv * w1.x; lg[5] += xv * w1.y; lg[6] += xv * w1.z; lg[7] += xv * w1.w; }
#pragma unroll
                    for (int e = 0; e < 8; ++e) lg[e] = wave_sum(lg[e]) + args.in[18][e];
                    int i0 = 0; float l0 = lg[0];
#pragma unroll
                    for (int e = 1; e < 8; ++e) if (lg[e] > l0) { l0 = lg[e]; i0 = e; }
                    int i1 = -1; float l1 = -3.0e38f;
#pragma unroll
                    for (int e = 0; e < 8; ++e) if (e != i0 && lg[e] > l1) { l1 = lg[e]; i1 = e; }
                    const float w0 = 1.0f / (1.0f + __expf(l1 - l0)), w1 = 1.0f - w0;
                    if (F.lane == 0) {
                        const int lp0 = __hip_atomic_fetch_add(lcnt + i0, 1, __ATOMIC_RELAXED, __HIP_MEMORY_SCOPE_WORKGROUP), lp1 = __hip_atomic_fetch_add(lcnt + i1, 1, __ATOMIC_RELAXED, __HIP_MEMORY_SCOPE_WORKGROUP);
                        ((int*)(ws + WS_TE))[m] = i0 | (i1 << 4) | ((int)blockIdx.x << 8);
                        ((int2*)(ws + WS_TP))[m] = make_int2(lp0, lp1); ((float2*)(ws + WS_TW))[m] = make_float2(w0, w1); }
                }
            }
            if (L == 1) { LDS_WAIT(); __syncthreads(); if (F.tid < 8) ((int*)(ws + WS_CNT))[blockIdx.x * 8 + F.tid] = lcnt[F.tid]; }
            cvt_rows(F, args.in[1] + (size_t)L * MTOK * PLED, (bf16*)(ws + WS_PB), (size_t)MTOK * PLED / 8);
        }
        SEAM();
        if (L == 0) {
            if (IN() && EN_G0) { PH_BEGIN();
                { pg8::Gemm g{(const pg8::bf16_t*)((const signed char*)R + (192u << 20)), (const pg8::bf16_t*)(ws + WS_W13), MTOK, 2 * DFF, 512, 0, 0}; pg8::StaticOrder S; S.init(MTOK, 2 * DFF, F.G, (int)blockIdx.x);
                  pg8::EpiGLUQ E{(pg8::bf16_t*)(ws + WS_H), DFF, (const float*)(ws + WS_SX1), (const float*)(ws + WS_SW13), (LAS float*)(F.lds + X_SCL)};
                  for (int rep_ = 0; rep_ < REP_FU; ++rep_) { pg8::gemm_phase<pg8::EpiGLUQ, pg8::StaticOrder, true, true, true>(ring, g, S, E, F.wave); __syncthreads(); } }
                __syncthreads();
                pg8::StaticOrder S; S.init(MTOK, 1024, F.G, (int)blockIdx.x);
                { pg8::Gemm g{(const pg8::bf16_t*)((const signed char*)R + (192u << 20)), (const pg8::bf16_t*)(WL + W_WPG), MTOK, 1024, 512, 0, 0};
                  pg8::EpiGate8 E{(unsigned char*)(ws + WS_G8), (const float*)(ws + WS_SX1), (const float*)(ws + WS_SWPG) + L * 1024, (LAS float*)(F.lds + X_SCL)};
                  pg8::gemm_phase<pg8::EpiGate8, pg8::StaticOrder, true, true, true>(ring, g, S, E, F.wave); }
                __syncthreads();
                { pg8::Gemm g{(const pg8::bf16_t*)(ws + WS_PB), (const pg8::bf16_t*)(WL + W_WPLE), MTOK, 1024, 256};
                  pg8::EpiGateMul E{(const unsigned char*)(ws + WS_G8), (pg8::bf16_t*)(ws + WS_PP_DENSE)};
                  pg8::gemm_phase<pg8::EpiGateMul, pg8::StaticOrder, true, true>(ring, g, S, E, F.wave); }
            }
            SEAM();
            if (IN() && EN_H0) { PH_BEGIN();
                pg8::Gemm g{(const pg8::bf16_t*)(ws + WS_H), (const pg8::bf16_t*)(ws + WS_W2), MTOK, 1024, DFF}; pg8::StaticOrder S; S.init(MTOK, 1024, F.G, (int)blockIdx.x);
                pg8::EpiRes<2> E{(const pg8::bf16_t*)XB, (pg8::bf16_t*)R, (pg8::bf16_t*)(ws + WS_PP_DENSE), ALPHA};
                pg8::gemm_phase<pg8::EpiRes<2>, pg8::StaticOrder, true, true>(ring, g, S, E, F.wave);
            }
            SEAM();
        } else {
            if (IN() && EN_G1) { PH_BEGIN();
                moe_tables(F, (const int*)(ws + WS_CNT), true);
                if (blockIdx.x == 0 && F.tid < 9) ((int*)(ws + WS_CNT + 49152))[F.tid] = ((const LAS int*)(F.lds + X_OFF))[F.tid];
                { const LAS int* off = (const LAS int*)(F.lds + X_OFF); const LAS int* pre = (const LAS int*)(F.lds + X_PRE);
                  const int gw = F.vcu * NWAVES + F.wave, NGW = F.G * NWAVES;
                  for (int m0 = gw; m0 < MTOK; m0 += 4 * NGW) {
                      int te[4]; int2 tp[4]; float2 tw[4]; int d0[4], d1[4]; v4u ra[4], rb[4];
#pragma unroll
                      for (int q = 0; q < 4; ++q) { const int m = m0 + q * NGW; te[q] = ((const int*)(ws + WS_TE))[m]; tp[q] = ((const int2*)(ws + WS_TP))[m]; tw[q] = ((const float2*)(ws + WS_TW))[m]; }
#pragma unroll
                      for (int q = 0; q < 4; ++q) { const int m = m0 + q * NGW; ra[q] = ((const GAS v4u*)((const signed char*)R + (192u << 20) + (size_t)m * DM))[F.lane]; rb[q].x = __float_as_uint(((const float*)(ws + WS_SX1))[m]); }
#pragma unroll
                      for (int q = 0; q < 4; ++q) { const int e0 = te[q] & 15, e1 = (te[q] >> 4) & 15, blk = te[q] >> 8;
                          d0[q] = off[e0] + pre[blk * 8 + e0] + tp[q].x; d1[q] = off[e1] + pre[blk * 8 + e1] + tp[q].y; }
#pragma unroll
                      for (int q = 0; q < 4; ++q) { const int m = m0 + q * NGW;
                          ((GAS v4u*)((signed char*)R + (size_t)d0[q] * DM))[F.lane] = ra[q]; ((GAS v4u*)((signed char*)R + (size_t)d1[q] * DM))[F.lane] = ra[q];
                          if (F.lane == 0) { ((float*)(ws + WS_SW))[d0[q]] = tw[q].x; ((float*)(ws + WS_SW))[d1[q]] = tw[q].y; ((int2*)(ws + WS_TPOS))[m] = make_int2(d0[q], d1[q]);
                              ((float*)(ws + WS_SXS))[d0[q]] = __uint_as_float(rb[q].x); ((float*)(ws + WS_SXS))[d1[q]] = __uint_as_float(rb[q].x); } } } }
                __syncthreads();
                pg8::StaticOrder S; S.init(MTOK, 1024, F.G, (int)blockIdx.x);
                { pg8::Gemm g{(const pg8::bf16_t*)((const signed char*)R + (192u << 20)), (const pg8::bf16_t*)(WL + W_WPG), MTOK, 1024, 512, 0, 0};
                  pg8::EpiGate8 E{(unsigned char*)(ws + WS_G8), (const float*)(ws + WS_SX1), (const float*)(ws + WS_SWPG) + L * 1024, (LAS float*)(F.lds + X_SCL)};
                  pg8::gemm_phase<pg8::EpiGate8, pg8::StaticOrder, true, true, true>(ring, g, S, E, F.wave); }
                __syncthreads();
                { pg8::Gemm g{(const pg8::bf16_t*)(ws + WS_PB), (const pg8::bf16_t*)(WL + W_WPLE), MTOK, 1024, 256};
                  pg8::EpiGateMul E{(const unsigned char*)(ws + WS_G8), (pg8::bf16_t*)(ws + WS_PP_MOE)};
                  pg8::gemm_phase<pg8::EpiGateMul, pg8::StaticOrder, true, true>(ring, g, S, E, F.wave); }
            }
            SEAM();
            for (int c = 0; c < MOE_NCHUNK; ++c) {
                if (IN() && EN_U1) { PH_BEGIN();
                    if (F.tid < 9) ((LAS int*)(F.lds + X_OFF))[F.tid] = ((const int*)(ws + WS_CNT + 49152))[F.tid];
                    LDS_WAIT(); __syncthreads();
                    const LAS int* off = (const LAS int*)(F.lds + X_OFF);
                    const int NT = __builtin_amdgcn_readfirstlane(off[8]) >> 8; const int capU = (c == MOE_NCHUNK - 1) ? MOE_CHUNK + MOE_REMT : MOE_CHUNK;
                    int nMc = NT - c * MOE_CHUNK; nMc = nMc < 0 ? 0 : (nMc > capU ? capU : nMc);
                    pg8::MoeOrder<true> S; S.nMc = nMc; S.nN = 2 * DFFE / 256; S.nwg = nMc * S.nN; S.G = F.G; S.c = (int)blockIdx.x; S.t0 = c * MOE_CHUNK;
                    S.ts1 = __builtin_amdgcn_readfirstlane(off[1]) >> 8; S.ts2 = __builtin_amdgcn_readfirstlane(off[2]) >> 8; S.ts3 = __builtin_amdgcn_readfirstlane(off[3]) >> 8; S.ts4 = __builtin_amdgcn_readfirstlane(off[4]) >> 8;
                    S.ts5 = __builtin_amdgcn_readfirstlane(off[5]) >> 8; S.ts6 = __builtin_amdgcn_readfirstlane(off[6]) >> 8; S.ts7 = __builtin_amdgcn_readfirstlane(off[7]) >> 8;
                    pg8::Gemm g{(const pg8::bf16_t*)R, (const pg8::bf16_t*)(ws + WS_WM13), MOE_MAXT * 256, 2 * DFFE, 512, 0, 0};
                    pg8::EpiGLUQ E{(pg8::bf16_t*)(ws + WS_HS), DFFE, (const float*)(ws + WS_SXS), (const float*)(ws + WS_SWM13), (LAS float*)(F.lds + X_SCL)};
                    for (int rep_ = 0; rep_ < REP_MU; ++rep_) { pg8::gemm_phase<pg8::EpiGLUQ, pg8::MoeOrder<true>, true, true, true>(ring, g, S, E, F.wave); __syncthreads(); }
                }
                SEAM();
                if (IN() && EN_D1) { PH_BEGIN();
                    if (F.tid < 9) ((LAS int*)(F.lds + X_OFF))[F.tid] = ((const int*)(ws + WS_CNT + 49152))[F.tid];
                    LDS_WAIT(); __syncthreads();
                    const LAS int* off = (const LAS int*)(F.lds + X_OFF);
                    const int NT = __builtin_amdgcn_readfirstlane(off[8]) >> 8; int nMc = NT - c * MOE_CHUNK; nMc = nMc < 0 ? 0 : (nMc > MOE_CHUNK ? MOE_CHUNK : nMc);
                    const int t1 = __builtin_amdgcn_readfirstlane(off[1]) >> 8, t2 = __builtin_amdgcn_readfirstlane(off[2]) >> 8, t3 = __builtin_amdgcn_readfirstlane(off[3]) >> 8, t4 = __builtin_amdgcn_readfirstlane(off[4]) >> 8,
                              t5 = __builtin_amdgcn_readfirstlane(off[5]) >> 8, t6 = __builtin_amdgcn_readfirstlane(off[6]) >> 8, t7 = __builtin_amdgcn_readfirstlane(off[7]) >> 8;
                    {
                        pg8::MoeOrder<false> S; S.nMc = nMc; S.nN = 4; S.nwg = nMc * 4; S.G = F.G; S.c = (int)blockIdx.x; S.t0 = c * MOE_CHUNK;
                        S.ts1 = t1; S.ts2 = t2; S.ts3 = t3; S.ts4 = t4; S.ts5 = t5; S.ts6 = t6; S.ts7 = t7;
                        pg8::Gemm g{(const pg8::bf16_t*)(ws + WS_HS), (const pg8::bf16_t*)(ws + WS_WM2), MOE_CHUNK * 256, 1024, DFFE, 0, 0};
                        pg8::EpiMoeDown E{(pg8::bf16_t*)(ws + WS_XS), (const float*)(ws + WS_SW)};
                        for (int rep_ = 0; rep_ < REP_MD; ++rep_) { pg8::gemm_phase<pg8::EpiMoeDown, pg8::MoeOrder<false>, true, true>(ring, g, S, E, F.wave); __syncthreads(); }
                    }
                    if (c == MOE_NCHUNK - 1) {
                        PH_BEGIN();
                        pg8::MoeRemOrder S; S.nT = NT - MOE_FULL; S.G = F.G; S.c = (int)blockIdx.x; S.t0 = MOE_FULL; S.KQ = DFFE / 4; S.pa0 = MOE_CHUNK;
                        S.ts1 = t1; S.ts2 = t2; S.ts3 = t3; S.ts4 = t4; S.ts5 = t5; S.ts6 = t6; S.ts7 = t7;
                        pg8::Gemm g{(const pg8::bf16_t*)(ws + WS_HS), (const pg8::bf16_t*)(ws + WS_WM2), MOE_REM_ROWS, 1024, DFFE / 4, DFFE, DFFE};
                        pg8::EpiMoeRem E{(pg8::bf16_t*)(ws + WS_PART), (const float*)(ws + WS_SW), MOE_FULL, MOE_REM_ROWS};
                        pg8::gemm_phase<pg8::EpiMoeRem, pg8::MoeRemOrder, true, true>(ring, g, S, E, F.wave);
                    }
                }
                SEAM();
            }
        }
        if (L == 1) {
            if (IN() && EN_I) { PH_BEGIN();
                if (F.tid < 9) ((LAS int*)(F.lds + X_OFF))[F.tid] = ((const int*)(ws + WS_CNT + 49152))[F.tid];
                LDS_WAIT(); __syncthreads();
                const int nrem = (__builtin_amdgcn_readfirstlane(((const LAS int*)(F.lds + X_OFF))[8]) >> 8) - MOE_FULL;
                const int gw = F.vcu * NWAVES + F.wave, NGW = F.G * NWAVES;
                for (int r = gw; r < nrem * 256; r += NGW) {
                    const GAS v2u* pp = (const GAS v2u*)((const bf16*)(ws + WS_PART) + (size_t)r * DM) + F.lane; GAS v2u* dst = (GAS v2u*)((bf16*)(ws + WS_XS) + (size_t)(MOE_FULL * 256 + r) * DM) + F.lane;
#pragma unroll
                    for (int j = 0; j < 4; ++j) { float s0 = 0.f, s1 = 0.f, s2 = 0.f, s3 = 0.f;
#pragma unroll
                        for (int q = 0; q < 4; ++q) { const v2u a = pp[(size_t)q * MOE_REM_ROWS * DM / 4 + 64 * j]; s0 += bflo(a.x); s1 += bfhi(a.x); s2 += bflo(a.y); s3 += bfhi(a.y); }
                        v2u o; o.x = pk2(s0, s1); o.y = pk2(s2, s3); dst[64 * j] = o; }
                }
            }
            SEAM();
        }
        if (IN() && EN_I) { PH_BEGIN();
            f32x4 g[4], bb[4];
            { const GAS f32x4* gp = (const GAS f32x4*)(args.in[24] + L * DM) + F.lane; const GAS f32x4* bp = (const GAS f32x4*)(args.in[25] + L * DM) + F.lane;
#pragma unroll
              for (int j = 0; j < 4; ++j) { g[j] = gp[64 * j]; bb[j] = bp[64 * j]; } }
            const int gw = F.vcu * NWAVES + F.wave, NGW = F.G * NWAVES;
            const bool tmo = (L == 1) && (__hip_atomic_load((unsigned*)(ws + WS_CTL) + CW_BAR + XB_TMO, __ATOMIC_RELAXED, __HIP_MEMORY_SCOPE_AGENT) != 0u);
            if (L == 0) {
                v2u rx[4];
                { const GAS v2u* p_ = (const GAS v2u*)((const bf16*)R + (size_t)gw * DM) + F.lane;
#pragma unroll
                  for (int j = 0; j < 4; ++j) rx[j] = p_[64 * j]; }
                for (int m = gw; m < MTOK; m += NGW) {
                    f32x4 v[4];
#pragma unroll
                    for (int j = 0; j < 4; ++j) { v[j].x = bflo(rx[j].x); v[j].y = bfhi(rx[j].x); v[j].z = bflo(rx[j].y); v[j].w = bfhi(rx[j].y); }
                    if (m + NGW < MTOK) { const GAS v2u* p_ = (const GAS v2u*)((const bf16*)R + (size_t)(m + NGW) * DM) + F.lane;
#pragma unroll
                        for (int j = 0; j < 4; ++j) rx[j] = p_[64 * j]; }
                    ln_core(v, g, bb);
                    store_bf(XB, (size_t)m, v, F.lane); store_q8((signed char*)R + (128u << 20), (float*)(ws + WS_SX), (size_t)m, v, F.lane);
                }
            } else {
                v2u rx[4], rp[4], ra[4], rb[4]; int2 tpn = ((const int2*)(ws + WS_TPOS))[gw];
#define LN2_LOAD(mm, tp_) do { const GAS v2u* x1 = (const GAS v2u*)(XB + (size_t)(mm) * DM) + F.lane; const GAS v2u* pl = (const GAS v2u*)((const bf16*)(ws + WS_PP_MOE) + (size_t)(mm) * DM) + F.lane; \
        const GAS v2u* f0 = (const GAS v2u*)((const bf16*)(ws + WS_XS) + (size_t)(tp_).x * DM) + F.lane; const GAS v2u* f1 = (const GAS v2u*)((const bf16*)(ws + WS_XS) + (size_t)(tp_).y * DM) + F.lane; \
        _Pragma("unroll") for (int j = 0; j < 4; ++j) { rx[j] = x1[64 * j]; rp[j] = pl[64 * j]; ra[j] = f0[64 * j]; rb[j] = f1[64 * j]; } } while (0)
                LN2_LOAD(gw, tpn);
                if (gw + NGW < MTOK) tpn = ((const int2*)(ws + WS_TPOS))[gw + NGW];
                for (int m = gw; m < MTOK; m += NGW) {
                    f32x4 v[4];
#pragma unroll
                    for (int j = 0; j < 4; ++j) { const v2u x = rx[j], p = rp[j], a = ra[j], b = rb[j];
                        v[j].x = ALPHA * bflo(x.x) + bflo(p.x) + (bflo(a.x) + bflo(b.x)); v[j].y = ALPHA * bfhi(x.x) + bfhi(p.x) + (bfhi(a.x) + bfhi(b.x));
                        v[j].z = ALPHA * bflo(x.y) + bflo(p.y) + (bflo(a.y) + bflo(b.y)); v[j].w = ALPHA * bfhi(x.y) + bfhi(p.y) + (bfhi(a.y) + bfhi(b.y)); }
                    if (m + NGW < MTOK) { LN2_LOAD(m + NGW, tpn); if (m + 2 * NGW < MTOK) tpn = ((const int2*)(ws + WS_TPOS))[m + 2 * NGW]; }
                    ln_core(v, g, bb);
                    if (tmo) { const float qn = __builtin_nanf("");
#pragma unroll
                        for (int j = 0; j < 4; ++j) v[j] = (f32x4){qn, qn, qn, qn}; }
                    store_row(R, XB, (size_t)m, v, F.lane, false);
                }
            }
        }
        if (L == 0) SEAM();
    }
#undef LN2_LOAD
#undef IN
#undef SEAM
}

constexpr int N_PHASES = 27;
#ifndef MK_ONE_LAUNCH
#define MK_ONE_LAUNCH 1
#endif
extern "C" void kernel_launch(void* const* d_in, const int* in_sizes, int n_in, void* d_out, int out_size, void* d_ws, size_t ws_size, hipStream_t stream) {
    static int grid = 0;
    if (grid == 0) {
        if (n_in != 26 || in_sizes[0] != MTOK * DM || out_size != MTOK * DM || ws_size < WS_END) {
            fprintf(stderr, "kernel_launch: shape mismatch: n_in %d in0 %d out %d ws %zu (need %zu)\n", n_in, n_in > 0 ? in_sizes[0] : -1, out_size, ws_size, (size_t)WS_END); grid = -1; return; }
        int dev = 0, cus = 0, per_cu = 0;
        if (hipGetDevice(&dev) != hipSuccess || hipDeviceGetAttribute(&cus, hipDeviceAttributeMultiprocessorCount, dev) != hipSuccess) { fprintf(stderr, "kernel_launch: device query failed\n"); grid = -1; return; }
        if (hipFuncSetAttribute((const void*)mk_fwd, hipFuncAttributeMaxDynamicSharedMemorySize, LDS_BYTES) != hipSuccess) { fprintf(stderr, "kernel_launch: hipFuncSetAttribute failed\n"); grid = -1; return; }
        if (hipOccupancyMaxActiveBlocksPerMultiprocessor(&per_cu, (const void*)mk_fwd, NWAVES * 64, LDS_BYTES) != hipSuccess || per_cu < 1)
            fprintf(stderr, "kernel_launch: note: occupancy query reports %d workgroups per CU\n", per_cu);
        (void)hipGetLastError();
        grid = cus > 256 ? 256 : cus;
    }
    if (grid < 0) return;
    if (hipMemsetAsync((char*)d_ws + WS_CTL, 0, CTL_ZERO_BYTES, stream) != hipSuccess) { fprintf(stderr, "kernel_launch: memset failed\n"); return; }
    Args a{};
    for (int i = 0; i < 26; ++i) a.in[i] = (const float*)d_in[i];
    a.out = (float*)d_out; a.ws = (unsigned char*)d_ws;
#if MK_ONE_LAUNCH
    a.ph_lo = 0; a.ph_hi = N_PHASES;
    hipLaunchKernelGGL(mk_fwd, dim3(grid), dim3(NWAVES * 64), LDS_BYTES, stream, a);
#else
    for (int p = 0; p < N_PHASES; ++p) { a.ph_lo = p; a.ph_hi = p + 1; hipLaunchKernelGGL(mk_fwd, dim3(grid), dim3(NWAVES * 64), LDS_BYTES, stream, a); }
#endif
    const hipError_t le = hipPeekAtLastError();
    if (le != hipSuccess) fprintf(stderr, "kernel_launch: launch failed: %s (grid %d)\n", hipGetErrorName(le), grid);
}
```

```cpp
#include <hip/hip_runtime.h>
#include <cstdio>
#include <cstdint>
#include <cmath>
#ifndef PG8_WGM
#define PG8_WGM 8
#endif
namespace pg8 {
#define PG8_LAS __attribute__((address_space(3)))
typedef unsigned short bf16_t;
typedef short bf16x8 __attribute__((ext_vector_type(8)));
typedef float f32x4 __attribute__((ext_vector_type(4)));
typedef unsigned u32x4 __attribute__((ext_vector_type(4)));
typedef int i32x4 __attribute__((ext_vector_type(4)));
constexpr int BM = 256, BK = 64, HALF = 128, HTB = HALF * BK * 2  , STAGE_BYTES = 8 * HTB, NXCD = 8, WGM = PG8_WGM;

__host__ __device__ __forceinline__ int lds_byte(int r, int c) { const int st = (r >> 4) * 2 + (c >> 5), rr = r & 15, cc = c & 31, ob = rr * 64 + cc * 2; return st * 1024 + (ob ^ (((ob >> 9) & 1) << 5)); }
__host__ __device__ __forceinline__ void stage_rc(int b, int& R, int& C) { const int st = b / 1024, sb = b % 1024, swz = sb ^ (((sb >> 9) & 1) << 5); R = (st >> 1) * 16 + swz / 64; C = (st & 1) * 32 + (swz % 64) / 2; }
__host__ __device__ __forceinline__ int perm32(int rho) { const int n = rho >> 4, i = rho & 15; return 8 * (i >> 2) + 4 * n + (i & 3); }

struct Unit { int pm, pn, pa, pb, slot, kofs, aux; };
struct Gemm { const bf16_t* A; const bf16_t* Bt; int M, N, K; int lda, ldb; };

struct StaticOrder {
    int nM, nN, nwg, G, c;
    __host__ __device__ void init(int M, int N, int G_, int c_) { nM = M / BM; nN = N / BM; nwg = nM * nN; G = G_; c = c_; }
    __host__ __device__ bool next(int i, Unit& u) const {
        const long L = (long)i * G + c; if (L >= nwg) return false;
        int wgid = (int)L; { const int q = nwg / NXCD, r = nwg % NXCD, xcd = wgid % NXCD, off = wgid / NXCD; wgid = (xcd < r ? xcd * (q + 1) : r * (q + 1) + (xcd - r) * q) + off; }
        const int nig = WGM * nN, gid = wgid / nig, fm = gid * WGM, gsz = (nM - fm) < WGM ? (nM - fm) : WGM;
        u.pm = fm + ((wgid % nig) % gsz); u.pn = (wgid % nig) / gsz; u.pa = u.pm; u.pb = u.pn; u.slot = i; u.kofs = 0; u.aux = 0; return true;
    }
    __device__ __forceinline__ void a_ready(const Unit&) const {}
    __device__ __forceinline__ void done(const Unit&) const {}
};

__device__ __forceinline__ unsigned cvt_pk_bf16(float lo, float hi) { unsigned r; asm volatile("v_cvt_pk_bf16_f32 %0, %1, %2" : "=v"(r) : "v"(lo), "v"(hi)); return r; }
typedef float f32x2 __attribute__((ext_vector_type(2)));
__device__ __forceinline__ f32x2 gelu_pk(f32x2 v) {
    const f32x2 av = __builtin_elementwise_abs(v), d = av * 0.2316418882f + 1.0f;
    f32x2 t; t.x = __builtin_amdgcn_rcpf(d.x); t.y = __builtin_amdgcn_rcpf(d.y);
    f32x2 q = t * 0.5307027145f + (-0.7265760135f); q = q * t + 0.7107068705f; q = q * t + (-0.142248368f); q = q * t + 0.127414796f; q = q * t;
    const f32x2 s = (v * v) * (-0.72134752044f);
    f32x2 e; e.x = __builtin_amdgcn_exp2f(s.x); e.y = __builtin_amdgcn_exp2f(s.y);
    const f32x2 m = v * (q * e), r = v - m;
    f32x2 o; o.x = v.x < 0.f ? m.x : r.x; o.y = v.y < 0.f ? m.y : r.y; return o;
}

template <int ACT  > struct EpiBf16 {
    static constexpr bool PERM = true, AFTER_DRAIN = false, SCALES = false; static_assert(ACT == 0 || ACT == 1, "EpiBf16: ACT is 0 (none) or 1 (gelu_pk)");
    bf16_t* O; int ldc; const float* bias; int split_cols; size_t split_stride; float scale0;
    __device__ __forceinline__ void operator()(const f32x4 (&acc)[2][2][4][2], const Unit& u, int wr, int wc, int fr, int fq) const {
        const int row0 = u.pm * BM + wr * 64 + fr; int colt = u.pn * BM; bf16_t* base = O;
        float sc = 1.f; if (split_cols) { const int t = colt / split_cols; base += (size_t)t * split_stride; colt -= t * split_cols; if (t == 0) sc = scale0; }
        const int col0 = colt + wc * 32 + 8 * fq, bcol0 = u.pn * BM + wc * 32 + 8 * fq;
        f32x4 bv[2][2];
#pragma unroll
        for (int bj = 0; bj < 2; ++bj)
#pragma unroll
            for (int n = 0; n < 2; ++n) bv[bj][n] = bias ? *(const f32x4*)(bias + bcol0 + bj * HALF + 4 * n) : (f32x4){0.f, 0.f, 0.f, 0.f};
#pragma unroll
        for (int ai = 0; ai < 2; ++ai)
#pragma unroll
            for (int m = 0; m < 4; ++m) { bf16_t* rowp = base + (size_t)(row0 + ai * HALF + m * 16) * ldc + col0;
#pragma unroll
                for (int bj = 0; bj < 2; ++bj) { f32x4 v0 = acc[ai][bj][m][0] + bv[bj][0], v1 = acc[ai][bj][m][1] + bv[bj][1];
                    if (ACT == 1) { f32x2 a = gelu_pk((f32x2){v0[0], v0[1]}), b = gelu_pk((f32x2){v0[2], v0[3]}), c = gelu_pk((f32x2){v1[0], v1[1]}), d = gelu_pk((f32x2){v1[2], v1[3]});
                        v0 = (f32x4){a.x, a.y, b.x, b.y}; v1 = (f32x4){c.x, c.y, d.x, d.y}; }
                    v0 = v0 * sc; v1 = v1 * sc; u32x4 w; w.x = cvt_pk_bf16(v0[0], v0[1]); w.y = cvt_pk_bf16(v0[2], v0[3]); w.z = cvt_pk_bf16(v1[0], v1[1]); w.w = cvt_pk_bf16(v1[2], v1[3]);
                    *(u32x4*)(rowp + bj * HALF) = w; } }
    }
};

template <class Epi, class Sched, bool ALIGN_EPI = false, bool SP2 = false, bool I8 = false>
__device__ __forceinline__ void gemm_phase(PG8_LAS unsigned char* lds, const Gemm g, const Sched& S, const Epi& E, const int wave_id) {
    int lane_; asm volatile("v_mbcnt_lo_u32_b32 %0, -1, 0\n\tv_mbcnt_hi_u32_b32 %0, -1, %0" : "=v"(lane_));
    int w_ = wave_id; asm volatile("" : "+s"(w_));
    const int wid = w_, lane = lane_, tid = wid * 64 + lane, wr = wid >> 2, wc = wid & 3, fr = lane & 15, fq = lane >> 4;
    int K_ = g.K; asm volatile("" : "+s"(K_)); const int K = K_, nt = K / BK; int la_ = g.lda ? g.lda : g.K, lb_ = g.ldb ? g.ldb : g.K; asm volatile("" : "+s"(la_), "+s"(lb_)); const int lda = la_, ldb = lb_;
    unsigned voffA[2], voffB[2];
#pragma unroll
    for (int i = 0; i < 2; ++i) { int R, C; stage_rc(tid * 16 + i * 8192, R, C); const int Rb = Epi::PERM ? ((R & ~31) + perm32(R & 31)) : R;
        voffA[i] = (unsigned)(R * lda + C) * 2u; voffB[i] = (unsigned)(Rb * ldb + C) * 2u; }
    const size_t kstep = (size_t)(BK * 2);
    const size_t hstepA = (size_t)HALF * lda * 2, hstepB = (size_t)HALF * ldb * 2;
    const size_t tstepA = 2 * hstepA, tstepB = 2 * hstepB;
    const unsigned ldsw = (unsigned)wid * 1024u;
    const int aoff = lds_byte(wr * 64 + fr, fq * 8), boff = lds_byte(wc * 32 + fr, fq * 8);
#define PG8_SA(b, h) (((b) * 2 + (h)) * HTB)
#define PG8_SB(b, h) ((4 + (b) * 2 + (h)) * HTB)
#define PG8_STAGE(bufoff, gbase, voff) do { _Pragma("unroll") for (int _i = 0; _i < 2; ++_i) \
        __builtin_amdgcn_global_load_lds((const unsigned*)((const char*)(gbase) + (voff)[_i]), (PG8_LAS unsigned*)(lds + (bufoff) + ldsw + _i * 8192), 16, 0, 0); } while (0)
#define PG8_LDA(dst, b, h) do { _Pragma("unroll") for (int m = 0; m < 4; ++m) _Pragma("unroll") for (int k = 0; k < 2; ++k) dst[m][k] = *(const PG8_LAS bf16x8*)(lds + PG8_SA(b, h) + aoff + m * 2048 + k * 1024); } while (0)
#define PG8_LDB(dst, b, h) do { _Pragma("unroll") for (int n = 0; n < 2; ++n) _Pragma("unroll") for (int k = 0; k < 2; ++k) dst[n][k] = *(const PG8_LAS bf16x8*)(lds + PG8_SB(b, h) + boff + n * 2048 + k * 1024); } while (0)
#define PG8_MMA(ai, bj, At, Bt) do { __builtin_amdgcn_s_setprio(1); _Pragma("unroll") for (int m = 0; m < 4; ++m) _Pragma("unroll") for (int n = 0; n < 2; ++n) _Pragma("unroll") for (int k = 0; k < 2; ++k) \
        { if constexpr (I8) acc[ai][bj][m][n] = __builtin_bit_cast(f32x4, __builtin_amdgcn_mfma_i32_16x16x64_i8(__builtin_bit_cast(i32x4, Bt[n][k]), __builtin_bit_cast(i32x4, At[m][k]), __builtin_bit_cast(i32x4, acc[ai][bj][m][n]), 0, 0, 0)); \
          else acc[ai][bj][m][n] = __builtin_amdgcn_mfma_f32_16x16x32_bf16(Bt[n][k], At[m][k], acc[ai][bj][m][n], 0, 0, 0); } __builtin_amdgcn_s_setprio(0); } while (0)
#define PG8_WAIT_V(n) asm volatile("s_waitcnt vmcnt(" #n ")" ::: "memory")
#define PG8_WAIT_L(n) asm volatile("s_waitcnt lgkmcnt(" #n ")" ::: "memory")
#define PG8_BAR __builtin_amdgcn_s_barrier()
#define PG8_SCHED __builtin_amdgcn_sched_barrier(0)
    Unit cur, nxt; int ui = 0;
    if (!S.next(0, cur)) return;
    f32x4 acc[2][2][4][2];
    bf16x8 At[4][2], B0[2][2], B1[2][2];
    const char* cA = (const char*)g.A + (size_t)cur.pa * tstepA + (size_t)cur.kofs * 2; const char* cB = (const char*)g.Bt + (size_t)cur.pb * tstepB + (size_t)cur.kofs * 2;
    S.a_ready(cur);
    if constexpr (Epi::SCALES) E.prefetch(cur, wid, lane);
    if constexpr (SP2) {
        PG8_STAGE(PG8_SB(0, 0), cB, voffB); PG8_STAGE(PG8_SB(0, 1), cB + hstepB, voffB); PG8_STAGE(PG8_SA(0, 0), cA, voffA); PG8_STAGE(PG8_SA(0, 1), cA + hstepA, voffA);
        if (wr == 1) PG8_BAR;
        PG8_WAIT_V(2); PG8_BAR;
        PG8_STAGE(PG8_SB(1, 0), cB + kstep, voffB); PG8_STAGE(PG8_SA(1, 0), cA + kstep, voffA); PG8_STAGE(PG8_SB(1, 1), cB + hstepB + kstep, voffB);
        PG8_WAIT_V(6); PG8_BAR;
    } else {
        PG8_STAGE(PG8_SB(0, 0), cB, voffB); PG8_STAGE(PG8_SA(0, 0), cA, voffA); PG8_STAGE(PG8_SB(0, 1), cB + hstepB, voffB); PG8_STAGE(PG8_SA(0, 1), cA + hstepA, voffA);
        if (wr == 1) PG8_BAR;
        PG8_WAIT_V(4); PG8_BAR;
        PG8_STAGE(PG8_SB(1, 0), cB + kstep, voffB); PG8_STAGE(PG8_SA(1, 0), cA + kstep, voffA); PG8_STAGE(PG8_SB(1, 1), cB + hstepB + kstep, voffB);
        PG8_WAIT_V(6); PG8_BAR;
    }
    for (;;) {
#pragma unroll
        for (int a = 0; a < 2; ++a)
#pragma unroll
            for (int b = 0; b < 2; ++b)
#pragma unroll
                for (int m = 0; m < 4; ++m)
#pragma unroll
                    for (int n = 0; n < 2; ++n) acc[a][b][m][n] = (f32x4){0.f, 0.f, 0.f, 0.f};
        const bool has_next = S.next(ui + 1, nxt);
        const char* nA = has_next ? (const char*)g.A + (size_t)nxt.pa * tstepA + (size_t)nxt.kofs * 2 : cA; const char* nB = has_next ? (const char*)g.Bt + (size_t)nxt.pb * tstepB + (size_t)nxt.kofs * 2 : cB;
        int t = 0; do {
            const bool last = (t == nt - 2);
            const char* a1 = cA + (size_t)(t + 1) * kstep;
            const char* a2 = last ? nA : cA + (size_t)(t + 2) * kstep; const char* b2 = last ? nB : cB + (size_t)(t + 2) * kstep;
            const char* a3 = a2 + kstep; const char* b3 = b2 + kstep;
            if (last && has_next) { S.a_ready(nxt); if constexpr (Epi::SCALES) E.prefetch(nxt, wid, lane); }
            if constexpr (SP2) {
            PG8_LDB(B0, 0, 0); PG8_LDB(B1, 0, 1); PG8_SCHED; PG8_LDA(At, 0, 0); PG8_STAGE(PG8_SA(1, 1), a1 + hstepA, voffA);
            PG8_WAIT_V(8); PG8_WAIT_L(0); PG8_BAR; PG8_MMA(0, 0, At, B0); PG8_MMA(0, 1, At, B1); PG8_BAR; PG8_SCHED;
            PG8_LDA(At, 0, 1); PG8_STAGE(PG8_SB(0, 0), b2, voffB); PG8_STAGE(PG8_SB(0, 1), b2 + hstepB, voffB); PG8_STAGE(PG8_SA(0, 0), a2, voffA);
            PG8_WAIT_V(8); PG8_WAIT_L(0); PG8_BAR; PG8_MMA(1, 0, At, B0); PG8_MMA(1, 1, At, B1); PG8_BAR; PG8_SCHED;
            PG8_LDB(B0, 1, 0); PG8_LDB(B1, 1, 1); PG8_SCHED; PG8_LDA(At, 1, 0); PG8_STAGE(PG8_SA(0, 1), a2 + hstepA, voffA);
            PG8_WAIT_V(8); PG8_WAIT_L(0); PG8_BAR; PG8_MMA(0, 0, At, B0); PG8_MMA(0, 1, At, B1); PG8_BAR; PG8_SCHED;
            PG8_LDA(At, 1, 1); PG8_STAGE(PG8_SB(1, 0), b3, voffB); PG8_STAGE(PG8_SB(1, 1), b3 + hstepB, voffB); PG8_STAGE(PG8_SA(1, 0), a3, voffA);
            PG8_WAIT_V(8); PG8_WAIT_L(0); PG8_BAR; PG8_MMA(1, 0, At, B0); PG8_MMA(1, 1, At, B1); PG8_BAR; PG8_SCHED;
            } else {
            PG8_LDB(B0, 0, 0); PG8_SCHED; PG8_LDA(At, 0, 0); PG8_STAGE(PG8_SA(1, 1), a1 + hstepA, voffA);
            PG8_WAIT_L(8); PG8_BAR; PG8_WAIT_L(0); PG8_MMA(0, 0, At, B0); PG8_BAR; PG8_SCHED;
            PG8_LDB(B1, 0, 1); PG8_STAGE(PG8_SB(0, 0), b2, voffB);
            PG8_BAR; PG8_WAIT_L(0); PG8_MMA(0, 1, At, B1); PG8_BAR;
            PG8_LDA(At, 0, 1); PG8_STAGE(PG8_SA(0, 0), a2, voffA);
            PG8_BAR; PG8_WAIT_L(0); PG8_MMA(1, 0, At, B0); PG8_BAR; PG8_SCHED;
            PG8_STAGE(PG8_SB(0, 1), b2 + hstepB, voffB);
            PG8_WAIT_V(6); PG8_BAR; PG8_MMA(1, 1, At, B1); PG8_BAR;
            PG8_LDB(B0, 1, 0); PG8_SCHED; PG8_LDA(At, 1, 0); PG8_STAGE(PG8_SA(0, 1), a2 + hstepA, voffA);
            PG8_WAIT_L(8); PG8_BAR; PG8_WAIT_L(0); PG8_MMA(0, 0, At, B0); PG8_BAR; PG8_SCHED;
            PG8_LDB(B1, 1, 1); PG8_STAGE(PG8_SB(1, 0), b3, voffB);
            PG8_BAR; PG8_WAIT_L(0); PG8_MMA(0, 1, At, B1); PG8_BAR;
            PG8_LDA(At, 1, 1); PG8_STAGE(PG8_SA(1, 0), a3, voffA);
            PG8_BAR; PG8_WAIT_L(0); PG8_MMA(1, 0, At, B0); PG8_BAR; PG8_SCHED;
            PG8_STAGE(PG8_SB(1, 1), b3 + hstepB, voffB);
            PG8_WAIT_V(6); PG8_BAR; PG8_MMA(1, 1, At, B1); PG8_BAR;
            }
        t += 2; } while (t < nt);
        if constexpr (ALIGN_EPI) { if (wr == 0) PG8_BAR; }
        if constexpr (!Epi::AFTER_DRAIN) { E(acc, cur, wr, wc, fr, fq); S.done(cur); }
        if (!has_next) break;
        cur = nxt; cA = nA; cB = nB; ++ui;
        if constexpr (ALIGN_EPI) { if (wr == 1) PG8_BAR; }
    }
    PG8_WAIT_V(0);
    if constexpr (!ALIGN_EPI) { if (wr == 0) PG8_BAR; }
    PG8_BAR;
    if constexpr (Epi::AFTER_DRAIN) { E.fused(acc, cur, wr, wc, fr, fq, lds, wid, lane); S.done(cur); }
#undef PG8_SA
#undef PG8_SB
#undef PG8_STAGE
#undef PG8_LDA
#undef PG8_LDB
#undef PG8_MMA
#undef PG8_WAIT_V
#undef PG8_WAIT_L
#undef PG8_BAR
#undef PG8_SCHED
}
}
#ifndef EPI_FENCE_GRP
#define EPI_FENCE_GRP 8
#endif
namespace pg8 {
typedef unsigned u32x2 __attribute__((ext_vector_type(2)));
__device__ __forceinline__ float sigm(float x) { return __builtin_amdgcn_rcpf(1.0f + __builtin_amdgcn_exp2f(-1.4426950408889634f * x)); }
__device__ __forceinline__ u32x4 pack8(const f32x4& v0, const f32x4& v1) { u32x4 w; w.x = cvt_pk_bf16(v0[0], v0[1]); w.y = cvt_pk_bf16(v0[2], v0[3]); w.z = cvt_pk_bf16(v1[0], v1[1]); w.w = cvt_pk_bf16(v1[2], v1[3]); return w; }
__device__ __forceinline__ void unpack8(const u32x4& w, f32x4& v0, f32x4& v1) {
    v0[0] = __uint_as_float(w.x << 16); v0[1] = __uint_as_float(w.x & 0xffff0000u); v0[2] = __uint_as_float(w.y << 16); v0[3] = __uint_as_float(w.y & 0xffff0000u);
    v1[0] = __uint_as_float(w.z << 16); v1[1] = __uint_as_float(w.z & 0xffff0000u); v1[2] = __uint_as_float(w.w << 16); v1[3] = __uint_as_float(w.w & 0xffff0000u); }
__device__ __forceinline__ f32x4 i2f4(const f32x4& x) { return __builtin_convertvector(__builtin_bit_cast(i32x4, x), f32x4); }
struct RopeTab { f32x4 c0, c1, c2, c3; };
__device__ __forceinline__ RopeTab rope_load(const float* tab, int fq) { const float* t = tab + 16 * (fq & 1); RopeTab r; r.c0 = *(const f32x4*)(t); r.c1 = *(const f32x4*)(t + 4); r.c2 = *(const f32x4*)(t + 8); r.c3 = *(const f32x4*)(t + 12); return r; }
__device__ __forceinline__ void rope_apply(f32x4& v0, f32x4& v1, const RopeTab& r, int fq) {
    f32x4 p0, p1;
#pragma unroll
    for (int j = 0; j < 4; ++j) { const auto a_ = __builtin_amdgcn_permlane32_swap(__float_as_uint(v0[j]), __float_as_uint(v0[j]), false, false), b_ = __builtin_amdgcn_permlane32_swap(__float_as_uint(v1[j]), __float_as_uint(v1[j]), false, false);
        p0[j] = __uint_as_float(fq < 2 ? a_[1] : a_[0]); p1[j] = __uint_as_float(fq < 2 ? b_[1] : b_[0]); }
    const f32x4 c0 = r.c0, c1 = r.c1, c2 = r.c2, c3 = r.c3;
    const float sg = (fq < 2) ? -1.f : 1.f;
    v0[0] = v0[0] * c0[0] + sg * p0[0] * c0[1]; v0[1] = v0[1] * c0[2] + sg * p0[1] * c0[3];
    v0[2] = v0[2] * c1[0] + sg * p0[2] * c1[1]; v0[3] = v0[3] * c1[2] + sg * p0[3] * c1[3];
    v1[0] = v1[0] * c2[0] + sg * p1[0] * c2[1]; v1[1] = v1[1] * c2[2] + sg * p1[1] * c2[3];
    v1[2] = v1[2] * c3[0] + sg * p1[2] * c3[1]; v1[3] = v1[3] * c3[2] + sg * p1[3] * c3[3];
}
#define EPI_MEMBAR() asm volatile("" ::: "memory")
struct EpiProj {
    static constexpr bool PERM = true, AFTER_DRAIN = false, SCALES = true;
    bf16_t *NAQKV, *QLAT, *GATES, *KVLAT, *KMLA; const float* bgate; const float* rope; float qscale; float* PS; const float* sa; const float* sb; PG8_LAS float* tbl;
    __device__ __forceinline__ void prefetch(const Unit& u, int wid, int) const {
        int lane; asm volatile("v_mbcnt_lo_u32_b32 %0, -1, 0\n\tv_mbcnt_hi_u32_b32 %0, -1, %0" : "=v"(lane));
        const float* src = (wid < 4) ? sa + (size_t)u.pa * BM + wid * 64 + lane : sb + (size_t)u.pb * BM + (wid - 4) * 64 + lane;
        __builtin_amdgcn_global_load_lds((const unsigned*)src, (PG8_LAS unsigned*)(tbl + (u.slot & 1) * 512 + wid * 64), 4, 0, 0);
    }
    __device__ __forceinline__ void operator()(f32x4 (&acc)[2][2][4][2], const Unit& u, int wr, int wc, int fr, int fq) const {
        const int pn = u.pn; const int row0 = u.pm * BM + wr * 64 + fr;
        {
            const PG8_LAS float* tb = tbl + (u.slot & 1) * 512; const PG8_LAS float* sbp = tb + 256 + wc * 32 + 8 * fq;
            const f32x4 s00 = *(const PG8_LAS f32x4*)(sbp), s01 = *(const PG8_LAS f32x4*)(sbp + 4), s10 = *(const PG8_LAS f32x4*)(sbp + HALF), s11 = *(const PG8_LAS f32x4*)(sbp + HALF + 4);
#pragma unroll
            for (int ai = 0; ai < 2; ++ai)
#pragma unroll
                for (int m = 0; m < 4; ++m) { const float ra = tb[wr * 64 + fr + ai * HALF + m * 16];
                    acc[ai][0][m][0] = i2f4(acc[ai][0][m][0]) * (s00 * ra); acc[ai][0][m][1] = i2f4(acc[ai][0][m][1]) * (s01 * ra);
                    acc[ai][1][m][0] = i2f4(acc[ai][1][m][0]) * (s10 * ra); acc[ai][1][m][1] = i2f4(acc[ai][1][m][1]) * (s11 * ra); }
        }
        if (pn == 18) {
            if (wc == 0) {
#pragma unroll
                for (int ai = 0; ai < 2; ++ai) { RopeTab rt[4];
#pragma unroll
                    for (int m = 0; m < 4; ++m) rt[m] = rope_load(rope + (size_t)((row0 + ai * HALF + m * 16) & 8191) * 32, fq);
                    EPI_MEMBAR();
#pragma unroll
                    for (int m = 0; m < 4; ++m) { const int row = row0 + ai * HALF + m * 16; f32x4 v0 = acc[ai][0][m][0], v1 = acc[ai][0][m][1];
                        rope_apply(v0, v1, rt[m], fq); const u32x4 w = pack8(v0, v1); bf16_t* dp = KMLA + (size_t)row * 768 + 64 + 8 * fq;
#pragma unroll
                        for (int h = 0; h < 8; ++h) *(u32x4*)(dp + 96 * h) = w; }
                    EPI_MEMBAR(); }
            }
            return;
        }
        if (pn >= 9 && pn < 17) {
            const int col0 = (pn - 9) * BM + wc * 32 + 8 * fq;
            f32x4 bv[2][2];
#pragma unroll
            for (int bj = 0; bj < 2; ++bj)
#pragma unroll
                for (int n = 0; n < 2; ++n) bv[bj][n] = *(const f32x4*)(bgate + col0 + bj * HALF + 4 * n);
#pragma unroll
            for (int ai = 0; ai < 2; ++ai)
#pragma unroll
                for (int m = 0; m < 4; ++m) { unsigned char* rowp = (unsigned char*)GATES + (size_t)(row0 + ai * HALF + m * 16) * 2048 + col0;
#pragma unroll
                    for (int bj = 0; bj < 2; ++bj) { const f32x4 v0 = acc[ai][bj][m][0] + bv[bj][0], v1 = acc[ai][bj][m][1] + bv[bj][1]; u32x2 w = {0u, 0u};
#pragma unroll
                        for (int j = 0; j < 4; ++j) { w.x = __builtin_amdgcn_cvt_pk_u8_f32(sigm(v0[j]) * 255.f, j, w.x); w.y = __builtin_amdgcn_cvt_pk_u8_f32(sigm(v1[j]) * 255.f, j, w.y); }
                        *(u32x2*)(rowp + bj * HALF) = w; } }
            return;
        }
        bf16_t* base; int ldc, colt, mode = 0;
        if (pn < 6) { base = NAQKV; ldc = 1536; colt = pn * BM; mode = (pn < 2) ? 1 : 0; }
        else if (pn < 9) { base = QLAT; ldc = 768; colt = (pn - 6) * BM; }
        else { base = KVLAT; ldc = 256; colt = 0; }
        const int col0 = colt + wc * 32 + 8 * fq;
        if (mode == 0 && pn >= 6) {
            const int slot = (pn == 17) ? 12 + wc : (pn - 6) * 4 + wc;
#pragma unroll
            for (int ai = 0; ai < 2; ++ai)
#pragma unroll
                for (int m = 0; m < 4; ++m) { float q = 0.f;
#pragma unroll
                    for (int bj = 0; bj < 2; ++bj)
#pragma unroll
                        for (int n = 0; n < 2; ++n) { const f32x4 x = acc[ai][bj][m][n]; q += (x[0] * x[0] + x[1] * x[1]) + (x[2] * x[2] + x[3] * x[3]); }
                    { const auto r_ = __builtin_amdgcn_permlane16_swap(__float_as_uint(q), __float_as_uint(q), false, false); q = __uint_as_float(r_[0]) + __uint_as_float(r_[1]); }
                    { const auto r_ = __builtin_amdgcn_permlane32_swap(__float_as_uint(q), __float_as_uint(q), false, false); q = __uint_as_float(r_[0]) + __uint_as_float(r_[1]); }
                    if (fq == 0) PS[(size_t)(row0 + ai * HALF + m * 16) * 16 + slot] = q; }
        }
        const float sc = (mode == 1) ? qscale : 1.f;
#pragma unroll
        for (int ai = 0; ai < 2; ++ai)
#pragma unroll
            for (int m = 0; m < 4; ++m) { bf16_t* rowp = base + (size_t)(row0 + ai * HALF + m * 16) * ldc + col0;
#pragma unroll
                for (int bj = 0; bj < 2; ++bj) *(u32x4*)(rowp + bj * HALF) = pack8(acc[ai][bj][m][0] * sc, acc[ai][bj][m][1] * sc); }
    }
};
struct EpiQup {
    static constexpr bool PERM = true, AFTER_DRAIN = false, SCALES = false;
    bf16_t* Q; const PG8_LAS float* rtab; const float* rope; float sc;
    __device__ __forceinline__ void operator()(const f32x4 (&acc)[2][2][4][2], const Unit& u, int wr, int wc, int fr, int fq) const {
        const int lr0 = wr * 64 + fr;
        const int rb0 = ((8 * u.pn + wc) % 3 == 2), rb1 = ((8 * u.pn + 4 + wc) % 3 == 2);
#pragma unroll
        for (int g2 = 0; g2 < 4; ++g2) { const int ai = g2 >> 1, m0 = (g2 & 1) * 2; RopeTab rt[2]; float rrs[2];
#pragma unroll
            for (int i = 0; i < 2; ++i) rrs[i] = rtab[u.slot * BM + lr0 + ai * HALF + (m0 + i) * 16];
            if (rb0 | rb1) {
#pragma unroll
                for (int i = 0; i < 2; ++i) rt[i] = rope_load(rope + (size_t)((u.pm * BM + lr0 + ai * HALF + (m0 + i) * 16) & 8191) * 32, fq);
#pragma unroll
                for (int i = 0; i < 2; ++i) asm volatile("" : "+v"(rt[i].c0), "+v"(rt[i].c1), "+v"(rt[i].c2), "+v"(rt[i].c3));
            }
            EPI_MEMBAR();
#pragma unroll
            for (int i = 0; i < 2; ++i) { const int m = m0 + i; const int lr = lr0 + ai * HALF + m * 16, row = u.pm * BM + lr; const float rr = rrs[i];
                bf16_t* rowp = Q + (size_t)row * 768 + u.pn * BM + wc * 32 + 8 * fq;
#pragma unroll
                for (int bj = 0; bj < 2; ++bj) { f32x4 v0 = acc[ai][bj][m][0] * rr, v1 = acc[ai][bj][m][1] * rr;
                    if (bj == 0 ? rb0 : rb1) rope_apply(v0, v1, rt[i], fq);
                    v0 = v0 * sc; v1 = v1 * sc; *(u32x4*)(rowp + bj * HALF) = pack8(v0, v1); } }
            EPI_MEMBAR(); }
    }
};
struct EpiKVup {
    static constexpr bool PERM = true, AFTER_DRAIN = false, SCALES = false;
    bf16_t *KM, *VM; const PG8_LAS float* rtab;
    __device__ __forceinline__ void operator()(const f32x4 (&acc)[2][2][4][2], const Unit& u, int wr, int wc, int fr, int fq) const {
        const int lr0 = wr * 64 + fr;
#pragma unroll
        for (int ai = 0; ai < 2; ++ai)
#pragma unroll
            for (int m = 0; m < 4; ++m) { const int lr = lr0 + ai * HALF + m * 16, row = u.pm * BM + lr; const float rr = rtab[u.slot * BM + lr];
#pragma unroll
                for (int bj = 0; bj < 2; ++bj) { const f32x4 v0 = acc[ai][bj][m][0] * rr, v1 = acc[ai][bj][m][1] * rr;
                    bf16_t* dp;
                    if (u.pn < 2) { const int h = 4 * u.pn + 2 * bj + (wc >> 1); dp = KM + (size_t)row * 768 + 96 * h + 32 * (wc & 1) + 8 * fq; }
                    else { dp = VM + (size_t)row * 512 + (u.pn - 2) * BM + bj * HALF + wc * 32 + 8 * fq; }
                    *(u32x4*)dp = pack8(v0, v1); }
                if (((ai * 4 + m + 1) % EPI_FENCE_GRP) == 0) asm volatile("" ::: "memory"); }
    }
};
struct EpiMerge {
    static constexpr bool PERM = true, AFTER_DRAIN = false, SCALES = false;
    const unsigned char* G; bf16_t* T; int second;
    __device__ __forceinline__ void operator()(const f32x4 (&acc)[2][2][4][2], const Unit& u, int wr, int wc, int fr, int fq) const {
        const int row0 = u.pm * BM + wr * 64 + fr, col0 = u.pn * BM + wc * 32 + 8 * fq;
#pragma unroll
        for (int ai = 0; ai < 2; ++ai) { u32x2 gw[4][2]; u32x4 tw[4][2];
#pragma unroll
            for (int m = 0; m < 4; ++m) { const size_t row = (size_t)(row0 + ai * HALF + m * 16);
#pragma unroll
                for (int bj = 0; bj < 2; ++bj) { const int c = col0 + bj * HALF; gw[m][bj] = *(const u32x2*)(G + row * 2048 + c); if (second) tw[m][bj] = *(const u32x4*)(T + row * 1024 + c); } }
            EPI_MEMBAR();
#pragma unroll
            for (int m = 0; m < 4; ++m) { const size_t row = (size_t)(row0 + ai * HALF + m * 16);
#pragma unroll
                for (int bj = 0; bj < 2; ++bj) { const int c = col0 + bj * HALF; const u32x2 g_ = gw[m][bj];
                    const f32x4 g0 = {(float)(g_.x & 255u), (float)((g_.x >> 8) & 255u), (float)((g_.x >> 16) & 255u), (float)(g_.x >> 24)}, g1 = {(float)(g_.y & 255u), (float)((g_.y >> 8) & 255u), (float)((g_.y >> 16) & 255u), (float)(g_.y >> 24)};
                    f32x4 v0 = acc[ai][bj][m][0] * (g0 * (1.f / 255.f)), v1 = acc[ai][bj][m][1] * (g1 * (1.f / 255.f));
                    if (second) { f32x4 t0, t1; unpack8(tw[m][bj], t0, t1); v0 = v0 + t0; v1 = v1 + t1; }
                    *(u32x4*)(T + row * 1024 + c) = pack8(v0, v1); } }
            EPI_MEMBAR(); }
    }
};
struct EpiPlain {
    static constexpr bool PERM = true, AFTER_DRAIN = false, SCALES = false;
    bf16_t* O; int ldc;
    __device__ __forceinline__ void operator()(const f32x4 (&acc)[2][2][4][2], const Unit& u, int wr, int wc, int fr, int fq) const {
        const int row0 = u.pm * BM + wr * 64 + fr, col0 = u.pn * BM + wc * 32 + 8 * fq;
#pragma unroll
        for (int ai = 0; ai < 2; ++ai)
#pragma unroll
            for (int m = 0; m < 4; ++m) { bf16_t* rowp = O + (size_t)(row0 + ai * HALF + m * 16) * ldc + col0;
#pragma unroll
                for (int bj = 0; bj < 2; ++bj) *(u32x4*)(rowp + bj * HALF) = pack8(acc[ai][bj][m][0], acc[ai][bj][m][1]); }
    }
};
template <int MODE> struct EpiRes {
    static constexpr bool PERM = true, AFTER_DRAIN = false, SCALES = (MODE == 3);
    const bf16_t* xres; bf16_t* Y; bf16_t* P; float alpha; const float* sa; const float* sb; PG8_LAS float* tbl;
    __device__ __forceinline__ void prefetch(const Unit& u, int wid, int) const {
        int lane; asm volatile("v_mbcnt_lo_u32_b32 %0, -1, 0\n\tv_mbcnt_hi_u32_b32 %0, -1, %0" : "=v"(lane));
        const float* src = (wid < 4) ? sa + (size_t)u.pa * BM + wid * 64 + lane : sb + (size_t)u.pb * BM + (wid - 4) * 64 + lane;
        __builtin_amdgcn_global_load_lds((const unsigned*)src, (PG8_LAS unsigned*)(tbl + (u.slot & 1) * 512 + wid * 64), 4, 0, 0);
    }
    __device__ __forceinline__ void operator()(const f32x4 (&acc)[2][2][4][2], const Unit& u, int wr, int wc, int fr, int fq) const {
        const int row0 = u.pm * BM + wr * 64 + fr, col0 = u.pn * BM + wc * 32 + 8 * fq;
        const PG8_LAS float* tb = (MODE == 3) ? tbl + (u.slot & 1) * 512 : nullptr;
        f32x4 sb0[2], sb1[2];
        if (MODE == 3) {
#pragma unroll
            for (int bj = 0; bj < 2; ++bj) { const PG8_LAS float* sbp = tb + 256 + bj * HALF + wc * 32 + 8 * fq; sb0[bj] = *(const PG8_LAS f32x4*)sbp; sb1[bj] = *(const PG8_LAS f32x4*)(sbp + 4); } }
#pragma unroll
        for (int ai = 0; ai < 2; ++ai) { u32x4 lx[4][2], lp[4][2];
#pragma unroll
            for (int m = 0; m < 4; ++m) { const size_t off = (size_t)(row0 + ai * HALF + m * 16) * 1024 + col0;
#pragma unroll
                for (int bj = 0; bj < 2; ++bj) { const size_t o = off + bj * HALF;
                    if (MODE == 0 || MODE == 2) lx[m][bj] = *(const u32x4*)(xres + o);
                    if (MODE != 0) lp[m][bj] = *(const u32x4*)(P + o); } }
            EPI_MEMBAR();
#pragma unroll
            for (int m = 0; m < 4; ++m) { const size_t off = (size_t)(row0 + ai * HALF + m * 16) * 1024 + col0;
#pragma unroll
                for (int bj = 0; bj < 2; ++bj) { const size_t o = off + bj * HALF; f32x4 v0 = acc[ai][bj][m][0], v1 = acc[ai][bj][m][1];
                    if (MODE == 0) { f32x4 x0, x1; unpack8(lx[m][bj], x0, x1); v0 = x0 * alpha + v0; v1 = x1 * alpha + v1; *(u32x4*)(Y + o) = pack8(v0, v1); }
                    else if (MODE == 3) { f32x4 p0, p1; unpack8(lp[m][bj], p0, p1); const float ra = tb[wr * 64 + fr + ai * HALF + m * 16];
                        v0 = i2f4(v0) * (sb0[bj] * ra); v1 = i2f4(v1) * (sb1[bj] * ra);
#pragma unroll
                        for (int j = 0; j < 4; ++j) { v0[j] = sigm(v0[j]) * p0[j]; v1[j] = sigm(v1[j]) * p1[j]; }
                        *(u32x4*)(P + o) = pack8(v0, v1); }
                    else if (MODE == 1) { f32x4 p0, p1; unpack8(lp[m][bj], p0, p1);
#pragma unroll
                        for (int j = 0; j < 4; ++j) { v0[j] = sigm(v0[j]) * p0[j]; v1[j] = sigm(v1[j]) * p1[j]; }
                        *(u32x4*)(P + o) = pack8(v0, v1); }
                    else { f32x4 x0, x1, p0, p1; unpack8(lx[m][bj], x0, x1); unpack8(lp[m][bj], p0, p1);
                        v0 = x0 * alpha + p0 + v0; v1 = x1 * alpha + p1 + v1; *(u32x4*)(Y + o) = pack8(v0, v1); } } }
            EPI_MEMBAR(); }
    }
};
struct EpiGate8 {
    static constexpr bool PERM = true, AFTER_DRAIN = false, SCALES = true;
    unsigned char* G8; const float* sa; const float* sb; PG8_LAS float* tbl;
    __device__ __forceinline__ void prefetch(const Unit& u, int wid, int) const {
        int lane; asm volatile("v_mbcnt_lo_u32_b32 %0, -1, 0\n\tv_mbcnt_hi_u32_b32 %0, -1, %0" : "=v"(lane));
        const float* src = (wid < 4) ? sa + (size_t)u.pa * BM + wid * 64 + lane : sb + (size_t)u.pb * BM + (wid - 4) * 64 + lane;
        __builtin_amdgcn_global_load_lds((const unsigned*)src, (PG8_LAS unsigned*)(tbl + (u.slot & 1) * 512 + wid * 64), 4, 0, 0);
    }
    __device__ __forceinline__ void operator()(const f32x4 (&acc)[2][2][4][2], const Unit& u, int wr, int wc, int fr, int fq) const {
        const int row0 = u.pm * BM + wr * 64 + fr, col0 = u.pn * BM + wc * 32 + 8 * fq;
        const PG8_LAS float* tb = tbl + (u.slot & 1) * 512;
        f32x4 sb0[2], sb1[2];
#pragma unroll
        for (int bj = 0; bj < 2; ++bj) { const PG8_LAS float* sbp = tb + 256 + bj * HALF + wc * 32 + 8 * fq; sb0[bj] = *(const PG8_LAS f32x4*)sbp; sb1[bj] = *(const PG8_LAS f32x4*)(sbp + 4); }
#pragma unroll
        for (int ai = 0; ai < 2; ++ai)
#pragma unroll
            for (int m = 0; m < 4; ++m) { const float ra = tb[wr * 64 + fr + ai * HALF + m * 16]; unsigned char* rowp = G8 + (size_t)(row0 + ai * HALF + m * 16) * 1024 + col0;
#pragma unroll
                for (int bj = 0; bj < 2; ++bj) { const f32x4 v0 = i2f4(acc[ai][bj][m][0]) * (sb0[bj] * ra), v1 = i2f4(acc[ai][bj][m][1]) * (sb1[bj] * ra); u32x2 w = {0u, 0u};
#pragma unroll
                    for (int j = 0; j < 4; ++j) { w.x = __builtin_amdgcn_cvt_pk_u8_f32(sigm(v0[j]) * 255.f, j, w.x); w.y = __builtin_amdgcn_cvt_pk_u8_f32(sigm(v1[j]) * 255.f, j, w.y); }
                    *(u32x2*)(rowp + bj * HALF) = w; } }
    }
};
struct EpiGateMul {
    static constexpr bool PERM = true, AFTER_DRAIN = false, SCALES = false;
    const unsigned char* G8; bf16_t* P;
    __device__ __forceinline__ void operator()(const f32x4 (&acc)[2][2][4][2], const Unit& u, int wr, int wc, int fr, int fq) const {
        const int row0 = u.pm * BM + wr * 64 + fr, col0 = u.pn * BM + wc * 32 + 8 * fq;
        u32x2 gw[8][2];
#pragma unroll
        for (int i = 0; i < 8; ++i)
#pragma unroll
            for (int bj = 0; bj < 2; ++bj) gw[i][bj] = *(const u32x2*)(G8 + (size_t)(row0 + (i >> 2) * HALF + (i & 3) * 16) * 1024 + col0 + bj * HALF);
        EPI_MEMBAR();
#pragma unroll
        for (int i = 0; i < 8; ++i) { const int ai = i >> 2, m = i & 3; bf16_t* rowp = P + (size_t)(row0 + ai * HALF + m * 16) * 1024 + col0;
#pragma unroll
            for (int bj = 0; bj < 2; ++bj) { const u32x2 g_ = gw[i][bj];
                const f32x4 g0 = {(float)(g_.x & 255u), (float)((g_.x >> 8) & 255u), (float)((g_.x >> 16) & 255u), (float)(g_.x >> 24)}, g1 = {(float)(g_.y & 255u), (float)((g_.y >> 8) & 255u), (float)((g_.y >> 16) & 255u), (float)(g_.y >> 24)};
                *(u32x4*)(rowp + bj * HALF) = pack8(acc[ai][bj][m][0] * (g0 * (1.f / 255.f)), acc[ai][bj][m][1] * (g1 * (1.f / 255.f))); } }
    }
};
struct EpiGLU {
    static constexpr bool PERM = true, AFTER_DRAIN = false, SCALES = false;
    bf16_t* H; int ldh;
    __device__ __forceinline__ void operator()(const f32x4 (&acc)[2][2][4][2], const Unit& u, int wr, int wc, int fr, int fq) const {
        const int row0 = u.pm * BM + wr * 64 + fr, col0 = u.pn * HALF + wc * 32 + 8 * fq;
#pragma unroll
        for (int ai = 0; ai < 2; ++ai)
#pragma unroll
            for (int m = 0; m < 4; ++m) { f32x4 h0, h1;
#pragma unroll
                for (int j = 0; j < 4; ++j) { const float a0 = acc[ai][0][m][0][j], a1 = acc[ai][0][m][1][j]; h0[j] = a0 * sigm(a0) * acc[ai][1][m][0][j]; h1[j] = a1 * sigm(a1) * acc[ai][1][m][1][j]; }
                *(u32x4*)(H + (size_t)(row0 + ai * HALF + m * 16) * ldh + col0) = pack8(h0, h1); }
    }
};
struct EpiGLUQ {
    static constexpr bool PERM = true, AFTER_DRAIN = false, SCALES = true;
    bf16_t* H; int ldh; const float* sa; const float* sb; PG8_LAS float* tbl;
    __device__ __forceinline__ void prefetch(const Unit& u, int wid, int) const {
        int lane; asm volatile("v_mbcnt_lo_u32_b32 %0, -1, 0\n\tv_mbcnt_hi_u32_b32 %0, -1, %0" : "=v"(lane));
        const float* src = (wid < 4) ? sa + (size_t)u.pa * BM + wid * 64 + lane : sb + (size_t)u.pb * BM + (wid - 4) * 64 + lane;
        __builtin_amdgcn_global_load_lds((const unsigned*)src, (PG8_LAS unsigned*)(tbl + (u.slot & 1) * 512 + wid * 64), 4, 0, 0);
    }
    __device__ __forceinline__ void operator()(const f32x4 (&acc)[2][2][4][2], const Unit& u, int wr, int wc, int fr, int fq) const {
        const int lrow0 = wr * 64 + fr, row0 = u.pm * BM + lrow0, col0 = u.pn * HALF + wc * 32 + 8 * fq;
        const PG8_LAS float* tb = tbl + (u.slot & 1) * 512; const PG8_LAS float* sbp = tb + 256 + wc * 32 + 8 * fq;
        const f32x4 s10 = *(const PG8_LAS f32x4*)(sbp), s11 = *(const PG8_LAS f32x4*)(sbp + 4), s30 = *(const PG8_LAS f32x4*)(sbp + HALF), s31 = *(const PG8_LAS f32x4*)(sbp + HALF + 4);
#pragma unroll
        for (int ai = 0; ai < 2; ++ai)
#pragma unroll
            for (int m = 0; m < 4; ++m) { const float ra = tb[lrow0 + ai * HALF + m * 16];
                const f32x4 a0 = i2f4(acc[ai][0][m][0]) * (s10 * ra), a1 = i2f4(acc[ai][0][m][1]) * (s11 * ra), b0 = i2f4(acc[ai][1][m][0]) * (s30 * ra), b1 = i2f4(acc[ai][1][m][1]) * (s31 * ra);
                f32x4 h0, h1;
#pragma unroll
                for (int j = 0; j < 4; ++j) { h0[j] = a0[j] * sigm(a0[j]) * b0[j]; h1[j] = a1[j] * sigm(a1[j]) * b1[j]; }
                *(u32x4*)(H + (size_t)(row0 + ai * HALF + m * 16) * ldh + col0) = pack8(h0, h1); }
    }
};
struct EpiMoeDown {
    static constexpr bool PERM = true, AFTER_DRAIN = false, SCALES = false;
    bf16_t* O; const float* SW;
    __device__ __forceinline__ void operator()(const f32x4 (&acc)[2][2][4][2], const Unit& u, int wr, int wc, int fr, int fq) const {
        const int row0 = u.pm * BM + wr * 64 + fr, col0 = u.pn * BM + wc * 32 + 8 * fq;
        float gws[8];
#pragma unroll
        for (int i = 0; i < 8; ++i) gws[i] = SW[row0 + (i >> 2) * HALF + (i & 3) * 16];
        EPI_MEMBAR();
#pragma unroll
        for (int ai = 0; ai < 2; ++ai)
#pragma unroll
            for (int m = 0; m < 4; ++m) { const int row = row0 + ai * HALF + m * 16; const float gw = gws[ai * 4 + m]; bf16_t* rowp = O + (size_t)row * 1024 + col0;
#pragma unroll
                for (int bj = 0; bj < 2; ++bj) *(u32x4*)(rowp + bj * HALF) = pack8(acc[ai][bj][m][0] * gw, acc[ai][bj][m][1] * gw); }
    }
};
template <bool UP> struct MoeOrder {
    int nMc, nN, nwg, G, c, t0; int ts1, ts2, ts3, ts4, ts5, ts6, ts7;
    __device__ __forceinline__ bool next(int i, Unit& u) const {
        const long L = (long)i * G + c; if (L >= nwg) return false;
        int wgid = (int)L; { const int q = nwg / NXCD, r = nwg % NXCD, xcd = wgid % NXCD, off = wgid / NXCD; wgid = (xcd < r ? xcd * (q + 1) : r * (q + 1) + (xcd - r) * q) + off; }
        const int nig = WGM * nN, gid = wgid / nig, fm = gid * WGM, gsz = (nMc - fm) < WGM ? (nMc - fm) : WGM;
        const int pml = fm + ((wgid % nig) % gsz), pn = (wgid % nig) / gsz, t = t0 + pml;
        const int e = (t >= ts1) + (t >= ts2) + (t >= ts3) + (t >= ts4) + (t >= ts5) + (t >= ts6) + (t >= ts7);
        u.pn = pn; u.pb = e * nN + pn; u.slot = i; u.kofs = 0; u.aux = 0;
        if (UP) { u.pa = t; u.pm = pml; } else { u.pa = pml; u.pm = t; }
        return true;
    }
    __device__ __forceinline__ void a_ready(const Unit&) const {}
    __device__ __forceinline__ void done(const Unit&) const {}
};
struct MoeRemOrder {
    int nT, G, c, t0, KQ, pa0; int ts1, ts2, ts3, ts4, ts5, ts6, ts7;
    __device__ __forceinline__ bool next(int i, Unit& u) const {
        const int L = i * G + c; if (L >= nT * 16) return false;
        const int tl = L >> 4, pn = (L >> 2) & 3, kq = L & 3, t = t0 + tl;
        const int e = (t >= ts1) + (t >= ts2) + (t >= ts3) + (t >= ts4) + (t >= ts5) + (t >= ts6) + (t >= ts7);
        u.pa = pa0 + tl; u.pm = tl; u.pn = pn; u.pb = e * 4 + pn; u.slot = i; u.kofs = kq * KQ; u.aux = kq; return true;
    }
    __device__ __forceinline__ void a_ready(const Unit&) const {}
    __device__ __forceinline__ void done(const Unit&) const {}
};
struct EpiMoeRem {
    static constexpr bool PERM = true, AFTER_DRAIN = false, SCALES = false;
    bf16_t* PART; const float* SW; int t0, prows;
    __device__ __forceinline__ void operator()(const f32x4 (&acc)[2][2][4][2], const Unit& u, int wr, int wc, int fr, int fq) const {
        const int row0 = u.pm * BM + wr * 64 + fr, col0 = u.pn * BM + wc * 32 + 8 * fq;
        float gws[8];
#pragma unroll
        for (int i = 0; i < 8; ++i) gws[i] = SW[t0 * BM + row0 + (i >> 2) * HALF + (i & 3) * 16];
        EPI_MEMBAR();
#pragma unroll
        for (int ai = 0; ai < 2; ++ai)
#pragma unroll
            for (int m = 0; m < 4; ++m) { const int row = row0 + ai * HALF + m * 16; const float gw = gws[ai * 4 + m]; bf16_t* rowp = PART + ((size_t)u.aux * prows + row) * 1024 + col0;
#pragma unroll
                for (int bj = 0; bj < 2; ++bj) *(u32x4*)(rowp + bj * HALF) = pack8(acc[ai][bj][m][0] * gw, acc[ai][bj][m][1] * gw); }
    }
};
}
namespace att {
#define ATT_LAS __attribute__((address_space(3)))
typedef unsigned short bf16;
using bf16x8 = __attribute__((ext_vector_type(8))) short;
using s16x4  = __attribute__((ext_vector_type(4))) short;
using f32x16 = __attribute__((ext_vector_type(16))) float;
using u32x4  = __attribute__((ext_vector_type(4))) unsigned;
#define SBAR() __builtin_amdgcn_sched_barrier(0)
__device__ __forceinline__ int crow(int r, int hi) { return (r & 3) + 8 * (r >> 2) + 4 * hi; }
__device__ __forceinline__ unsigned cvtpk(float lo, float hi) { unsigned r; asm volatile("v_cvt_pk_bf16_f32 %0, %1, %2" : "=v"(r) : "v"(lo), "v"(hi)); return r; }
__device__ __forceinline__ unsigned short f2bf(float f) { return (unsigned short)(cvtpk(f, f) & 0xffffu); }
constexpr int OIMG_WAVE = 32 * 144;
__device__ __forceinline__ int crow(int r, int hi);
__device__ __forceinline__ void store_o(const f32x16 (&o)[2], const ATT_LAS float* li_l, bf16* Ow, ATT_LAS char* img, int lane, int r32, int hi) {
  typedef unsigned u32x4_t __attribute__((ext_vector_type(4)));
#pragma unroll
  for (int r = 0; r < 16; ++r) { const int orow = (r & 3) + 8 * (r >> 2) + 4 * hi; const float rl = __builtin_amdgcn_rcpf(li_l[orow]);
    ATT_LAS unsigned short* rp = (ATT_LAS unsigned short*)(img + orow * 144) + r32;
    rp[0] = f2bf(o[0][r] * rl); rp[32] = f2bf(o[1][r] * rl); }
  asm volatile("s_waitcnt lgkmcnt(0)" ::: "memory");
#pragma unroll
  for (int j = 0; j < 4; ++j) { const int pc = j * 64 + lane, row = pc >> 3, c16 = pc & 7;
    const u32x4_t v = *(const ATT_LAS u32x4_t*)(img + row * 144 + c16 * 16);
    *reinterpret_cast<u32x4_t*>(Ow + (long)row * 512 + c16 * 8) = v; }
}
__device__ __forceinline__ int v_st(int k, int c) { const int kk = (k & ~0xC) | ((k & 4) << 1) | ((k & 8) >> 1); return ((kk >> 3) * 2 + (c >> 5)) * 512 + ((kk & 7) * 32 + (c & 31)) * 2; }
__device__ __forceinline__ int v_rd_base(int lane) { return ((lane & 3) << 3) | (((lane >> 2) & 3) << 6) | (((lane >> 4) & 1) << 5) | (((lane >> 5) & 1) << 8); }
constexpr int v_rd_off(int d0, int ks, int half) { return d0 * 512 + ks * 2048 + half * 1024; }
template <int OFF> __device__ __forceinline__ s16x4 tr_read(int vb) { s16x4 r; asm volatile("ds_read_b64_tr_b16 %0, %1 offset:%2" : "=&v"(r) : "v"(vb), "i"(OFF) : "memory"); return r; }
template <int D0> __device__ __forceinline__ void pv_one(f32x16& od, int vb, bf16x8 pa0, bf16x8 pa1, bf16x8 pa2, bf16x8 pa3) {
  const s16x4 l0 = tr_read<v_rd_off(D0, 0, 0)>(vb), h0 = tr_read<v_rd_off(D0, 0, 1)>(vb), l1 = tr_read<v_rd_off(D0, 1, 0)>(vb), h1 = tr_read<v_rd_off(D0, 1, 1)>(vb);
  const s16x4 l2 = tr_read<v_rd_off(D0, 2, 0)>(vb), h2 = tr_read<v_rd_off(D0, 2, 1)>(vb), l3 = tr_read<v_rd_off(D0, 3, 0)>(vb), h3 = tr_read<v_rd_off(D0, 3, 1)>(vb);
  asm volatile("s_waitcnt lgkmcnt(0)" ::: "memory"); SBAR();
#define PK(L, H) (bf16x8){L[0], L[1], L[2], L[3], H[0], H[1], H[2], H[3]}
  od = __builtin_amdgcn_mfma_f32_32x32x16_bf16(pa0, PK(l0, h0), od, 0, 0, 0);
  od = __builtin_amdgcn_mfma_f32_32x32x16_bf16(pa1, PK(l1, h1), od, 0, 0, 0);
  od = __builtin_amdgcn_mfma_f32_32x32x16_bf16(pa2, PK(l2, h2), od, 0, 0, 0);
  od = __builtin_amdgcn_mfma_f32_32x32x16_bf16(pa3, PK(l3, h3), od, 0, 0, 0);
#undef PK
}
__device__ __forceinline__ void pv2(f32x16* o, int vb, bf16x8 pa0, bf16x8 pa1, bf16x8 pa2, bf16x8 pa3) { pv_one<0>(o[0], vb, pa0, pa1, pa2, pa3); pv_one<1>(o[1], vb, pa0, pa1, pa2, pa3); }
template <int NS, int ROWB> __device__ __forceinline__ void qkt(f32x16& p0, f32x16& p1, const ATT_LAS char* Ks, const bf16x8* qr, int r32, int hi) {
  p0 = f32x16{}; p1 = f32x16{};
#pragma unroll
  for (int d0 = 0; d0 < NS; ++d0) { const int cb = d0 * 32 + hi * 16;
    const bf16x8 b0 = *(const ATT_LAS bf16x8*)(Ks + r32 * ROWB + cb);
    const bf16x8 b1 = *(const ATT_LAS bf16x8*)(Ks + (32 + r32) * ROWB + cb);
    p0 = __builtin_amdgcn_mfma_f32_32x32x16_bf16(b0, qr[d0], p0, 0, 0, 0);
    p1 = __builtin_amdgcn_mfma_f32_32x32x16_bf16(b1, qr[d0], p1, 0, 0, 0); }
}
constexpr float THR = 8.f;
__device__ __forceinline__ void partialSM(f32x16& p0, f32x16& p1, float& m_reg, float& alpha) {
  float pmax = p0[0];
#pragma unroll
  for (int r = 1; r < 16; ++r) pmax = fmaxf(pmax, p0[r]);
#pragma unroll
  for (int r = 0; r < 16; ++r) pmax = fmaxf(pmax, p1[r]);
  { auto rr = __builtin_amdgcn_permlane32_swap(__float_as_uint(pmax), __float_as_uint(pmax), false, false); pmax = fmaxf(__uint_as_float(rr[0]), __uint_as_float(rr[1])); }
  float mn;
  if (__builtin_expect(__all(pmax - m_reg <= THR), 1)) { mn = m_reg; alpha = 1.f; }
  else { mn = fmaxf(m_reg, pmax); alpha = __builtin_amdgcn_exp2f(m_reg - mn); m_reg = mn; }
#pragma unroll
  for (int r = 0; r < 16; ++r) p0[r] = p0[r] - mn;
#pragma unroll
  for (int r = 0; r < 16; ++r) p1[r] = p1[r] - mn;
#pragma unroll
  for (int r = 0; r < 16; ++r) p0[r] = __builtin_amdgcn_exp2f(p0[r]);
}
__device__ __forceinline__ void finishSM(f32x16& p0, f32x16& p1, float alpha, float& l_reg, bf16x8& pa0, bf16x8& pa1, bf16x8& pa2, bf16x8& pa3) {
#pragma unroll
  for (int r = 0; r < 16; ++r) p1[r] = __builtin_amdgcn_exp2f(p1[r]);
  float ps = 0;
#pragma unroll
  for (int r = 0; r < 16; ++r) ps += p0[r];
#pragma unroll
  for (int r = 0; r < 16; ++r) ps += p1[r];
  { auto rr = __builtin_amdgcn_permlane32_swap(__float_as_uint(ps), __float_as_uint(ps), false, false); ps = __uint_as_float(rr[0]) + __uint_as_float(rr[1]); }
  l_reg = l_reg * alpha + ps;
#define PK4(P, BASE, OUT) do { unsigned a0 = cvtpk(P[BASE + 0], P[BASE + 1]), a1 = cvtpk(P[BASE + 2], P[BASE + 3]);   \
    unsigned b0 = cvtpk(P[BASE + 4], P[BASE + 5]), b1 = cvtpk(P[BASE + 6], P[BASE + 7]);                              \
    auto r0 = __builtin_amdgcn_permlane32_swap(a0, b0, false, false); auto r1 = __builtin_amdgcn_permlane32_swap(a1, b1, false, false); \
    u32x4 w = {r0[0], r1[0], r0[1], r1[1]}; OUT = *reinterpret_cast<bf16x8*>(&w); } while (0)
  PK4(p0, 0, pa0); PK4(p0, 8, pa1); PK4(p1, 0, pa2); PK4(p1, 8, pa3);
#undef PK4
}

#define MX3(a, b, c) __builtin_fmaxf(__builtin_fmaxf((a), (b)), (c))
__device__ __forceinline__ float rowmax32(const f32x16& p0, const f32x16& p1) {
  float a = MX3(p0[0], p0[1], p1[0]), b = MX3(p0[2], p0[3], p1[1]); a = MX3(a, p1[2], p1[3]);
#pragma unroll
  for (int r = 4; r < 16; r += 4) { a = MX3(a, p0[r], p0[r + 1]); b = MX3(b, p0[r + 2], p0[r + 3]); a = MX3(a, p1[r], p1[r + 1]); b = MX3(b, p1[r + 2], p1[r + 3]); }
  float m = __builtin_fmaxf(a, b);
  { auto rr = __builtin_amdgcn_permlane32_swap(__float_as_uint(m), __float_as_uint(m), false, false); m = __builtin_fmaxf(__uint_as_float(rr[0]), __uint_as_float(rr[1])); }
  return m;
}
template <int NS, int ROWB> __device__ __forceinline__ void qkt_from(f32x16& p0, f32x16& p1, const ATT_LAS char* Ks, const bf16x8* qr, const f32x16& c0, int r32, int hi) {
#pragma unroll
  for (int d0 = 0; d0 < NS; ++d0) { const int cb = d0 * 32 + hi * 16;
    const bf16x8 b0 = *(const ATT_LAS bf16x8*)(Ks + r32 * ROWB + cb);
    const bf16x8 b1 = *(const ATT_LAS bf16x8*)(Ks + (32 + r32) * ROWB + cb);
    if (d0 == 0) { p0 = __builtin_amdgcn_mfma_f32_32x32x16_bf16(b0, qr[0], c0, 0, 0, 0); p1 = __builtin_amdgcn_mfma_f32_32x32x16_bf16(b1, qr[0], c0, 0, 0, 0); }
    else { p0 = __builtin_amdgcn_mfma_f32_32x32x16_bf16(b0, qr[d0], p0, 0, 0, 0); p1 = __builtin_amdgcn_mfma_f32_32x32x16_bf16(b1, qr[d0], p1, 0, 0, 0); } }
}
template <bool FIRST> __device__ __forceinline__ void partialSM2(f32x16& p0, f32x16& p1, float& m_ref, f32x16& negm, float& alpha) {
  const float rm = rowmax32(p0, p1);
  alpha = 1.f;
  if (FIRST || !__builtin_expect(__all(rm <= THR), 1)) {
    const float dl = FIRST ? rm : __builtin_fmaxf(rm, 0.f);
    m_ref += dl;
#pragma unroll
    for (int r = 0; r < 16; ++r) { p0[r] -= dl; p1[r] -= dl; }
#pragma unroll
    for (int r = 0; r < 16; ++r) negm[r] = -m_ref;
    asm volatile("" : "+v"(negm));
    if (!FIRST) alpha = __builtin_amdgcn_exp2f(-dl);
  }
#pragma unroll
  for (int r = 0; r < 16; ++r) p0[r] = __builtin_amdgcn_exp2f(p0[r]);
}
__device__ __forceinline__ void finishSM2(f32x16& p0, f32x16& p1, bf16x8& pa0, bf16x8& pa1, bf16x8& pa2, bf16x8& pa3) {
#pragma unroll
  for (int r = 0; r < 16; ++r) p1[r] = __builtin_amdgcn_exp2f(p1[r]);
#define PK4(P, BASE, OUT) do { unsigned a0 = cvtpk(P[BASE + 0], P[BASE + 1]), a1 = cvtpk(P[BASE + 2], P[BASE + 3]);   \
    unsigned b0 = cvtpk(P[BASE + 4], P[BASE + 5]), b1 = cvtpk(P[BASE + 6], P[BASE + 7]);                              \
    auto r0 = __builtin_amdgcn_permlane32_swap(a0, b0, false, false); auto r1 = __builtin_amdgcn_permlane32_swap(a1, b1, false, false); \
    u32x4 w = {r0[0], r1[0], r0[1], r1[1]}; OUT = *reinterpret_cast<bf16x8*>(&w); } while (0)
  PK4(p0, 0, pa0); PK4(p0, 8, pa1); PK4(p1, 0, pa2); PK4(p1, 8, pa3);
#undef PK4
}
__device__ __forceinline__ void pv3(f32x16* o, f32x16& ol, int vb, bf16x8 pa0, bf16x8 pa1, bf16x8 pa2, bf16x8 pa3) {
  const bf16x8 ones = {0x3F80, 0x3F80, 0x3F80, 0x3F80, 0x3F80, 0x3F80, 0x3F80, 0x3F80};
  pv_one<0>(o[0], vb, pa0, pa1, pa2, pa3);
  ol = __builtin_amdgcn_mfma_f32_32x32x16_bf16(pa0, ones, ol, 0, 0, 0); ol = __builtin_amdgcn_mfma_f32_32x32x16_bf16(pa1, ones, ol, 0, 0, 0);
  pv_one<1>(o[1], vb, pa0, pa1, pa2, pa3);
  ol = __builtin_amdgcn_mfma_f32_32x32x16_bf16(pa2, ones, ol, 0, 0, 0); ol = __builtin_amdgcn_mfma_f32_32x32x16_bf16(pa3, ones, ol, 0, 0, 0);
}
#ifndef MLA_CHK_ODD
#define MLA_CHK_ODD 0
#endif
constexpr int KSLOT = 12288, VSLOT = 8192, NSLOT = 4, MLA_OIMG = NSLOT * (KSLOT + VSLOT) + 8 * 256  , MLA_LDS = MLA_OIMG + 8 * OIMG_WAVE;
__device__ __forceinline__ void glds16(const void* gsrc, unsigned lds_dst) { unsigned keep;
  asm volatile("s_mov_b32 %0, m0\n\ts_mov_b32 m0, %2\n\ts_nop 0\n\tglobal_load_lds_dwordx4 %1, off\n\ts_mov_b32 m0, %0" : "=&s"(keep) : "v"(gsrc), "s"(lds_dst) : "memory"); }
#define BAR_L() asm volatile("s_waitcnt lgkmcnt(0)\n\ts_barrier" ::: "memory")
#define BAR_V(N) asm volatile("s_waitcnt vmcnt(" #N ") lgkmcnt(0)\n\ts_barrier" ::: "memory")
typedef short v4i16_t __attribute__((ext_vector_type(4)));
__device__ __forceinline__ s16x4 vtr(const ATT_LAS char* p) { return __builtin_bit_cast(s16x4, __builtin_amdgcn_ds_read_tr16_b64_v4i16((ATT_LAS v4i16_t*)p)); }
__device__ __forceinline__ void kfetch(bf16x8 (&kf)[12], const ATT_LAS char* Ks, int r32, int hi) {
#pragma unroll
  for (int d0 = 0; d0 < 6; ++d0) { const ATT_LAS char* p = Ks + (2 * d0 + hi) * 1024 + r32 * 16;
    kf[2 * d0] = *(const ATT_LAS bf16x8*)p; kf[2 * d0 + 1] = *(const ATT_LAS bf16x8*)(p + 512); }
}
#define MX3(a, b, c) __builtin_fmaxf(__builtin_fmaxf((a), (b)), (c))
__device__ __forceinline__ void mla_unit(const bf16* __restrict__ Qb, const bf16* __restrict__ Kh, const bf16* __restrict__ Vh, bf16* __restrict__ Ob, int seq, ATT_LAS char* lds, const int wave_id) {
  int lane_; asm volatile("v_mbcnt_lo_u32_b32 %0, -1, 0\n\tv_mbcnt_hi_u32_b32 %0, -1, %0" : "=v"(lane_));
  int w_ = wave_id; asm volatile("" : "+s"(w_));
  const int wid = w_, lane = lane_, r32 = lane & 31, hi = lane >> 5;
  const int half = wid >> 2;
  ATT_LAS char* K_lds = lds; ATT_LAS char* V_lds = lds + NSLOT * KSLOT;
  ATT_LAS float* al_l = (ATT_LAS float*)(lds + NSLOT * (KSLOT + VSLOT)) + wid * 64; ATT_LAS float* li_l = al_l + 32;
  const unsigned lds0 = (unsigned)(uintptr_t)lds;
  const int NT = seq / 64;
  const bf16* ksrc0 = Kh + (long)lane * 768 + wid * 8; const bf16* ksrc1 = ksrc0 + 64;
  const bf16* vsrc = Vh + (long)(16 * (wid & 3) + (lane >> 2)) * 512 + (wid >> 2) * 32 + (lane & 3) * 8;
  const unsigned kdst0 = lds0 + wid * 1024, vdst = lds0 + NSLOT * KSLOT + wid * 1024;
#define DMA_K(tile, slot) do { const int tl_ = (tile) < NT ? (tile) : NT - 1; const unsigned d_ = (unsigned)__builtin_amdgcn_readfirstlane(kdst0 + ((slot) & 3) * KSLOT); \
    glds16(ksrc0 + (long)tl_ * 64 * 768, d_); if (!half) glds16(ksrc1 + (long)tl_ * 64 * 768, d_ + 8192); } while (0)
#define DMA_V(tile, slot) do { const int tl_ = (tile) < NT ? (tile) : NT - 1; glds16(vsrc + (long)tl_ * 64 * 512, (unsigned)__builtin_amdgcn_readfirstlane(vdst + ((slot) & 3) * VSLOT)); } while (0)
#define STEP_BAR() do { SBAR(); if (!half) { BAR_V(6); } else { BAR_V(4); } SBAR(); } while (0)
  DMA_K(0, 0); DMA_K(1, 1); DMA_K(2, 2); DMA_K(3, 3); DMA_V(0, 0); DMA_V(1, 1);
  float m_ref = 0.f, l_reg = 0.f, pend = 0.f; f32x16 o[2] = {}; f32x16 negm = {}; bf16x8 qr[6];
  const bf16* Qw = Qb + (long)(wid * 32 + r32) * 768 + hi * 8;
#pragma unroll
  for (int d0 = 0; d0 < 6; ++d0) qr[d0] = *reinterpret_cast<const bf16x8*>(Qw + d0 * 16);
  const ATT_LAS char* vbp0 = V_lds + ((lane >> 4) & 1) * 32 + (lane & 3) * 8 + (4 * hi + ((lane & 15) >> 2)) * 64; const ATT_LAS char* kb0 = K_lds + hi * 1024 + r32 * 16;
  BAR_V(0);
  f32x16 pA0, pA1, pB0, pB1; bf16x8 paA0, paA1, paA2, paA3, paB0, paB1, paB2, paB3;
  paB0 = paB1 = paB2 = paB3 = (bf16x8){0, 0, 0, 0, 0, 0, 0, 0};
#define KFR(kb, i) (*(const ATT_LAS bf16x8*)((kb) + ((i) >> 1) * 2048 + ((i) & 1) * 512))
#pragma unroll
  for (int i = 0; i < 12; i += 2) { const bf16x8 k0_ = KFR(kb0, i), k1_ = KFR(kb0, i + 1);
    if (i == 0) { pA0 = __builtin_amdgcn_mfma_f32_32x32x16_bf16(k0_, qr[0], negm, 0, 0, 0); pA1 = __builtin_amdgcn_mfma_f32_32x32x16_bf16(k1_, qr[0], negm, 0, 0, 0); }
    else { pA0 = __builtin_amdgcn_mfma_f32_32x32x16_bf16(k0_, qr[i >> 1], pA0, 0, 0, 0); pA1 = __builtin_amdgcn_mfma_f32_32x32x16_bf16(k1_, qr[i >> 1], pA1, 0, 0, 0); } }
#define QKM(i, N0, N1) do { if ((i) == 0) N0 = __builtin_amdgcn_mfma_f32_32x32x16_bf16(kf[0], qr[0], negm, 0, 0, 0); else if ((i) == 1) N1 = __builtin_amdgcn_mfma_f32_32x32x16_bf16(kf[1], qr[0], negm, 0, 0, 0); \
    else if (((i) & 1) == 0) N0 = __builtin_amdgcn_mfma_f32_32x32x16_bf16(kf[i], qr[(i) >> 1], N0, 0, 0, 0); else N1 = __builtin_amdgcn_mfma_f32_32x32x16_bf16(kf[i], qr[(i) >> 1], N1, 0, 0, 0); } while (0)
#define VRDJ(j) do { vl[j] = vtr(vbp + ((j) >> 2) * 4096 + ((j) & 3) * 1024); vh[j] = vtr(vbp + ((j) >> 2) * 4096 + ((j) & 3) * 1024 + 512); } while (0)
#define PKV(i) (bf16x8){vl[i][0], vl[i][1], vl[i][2], vl[i][3], vh[i][0], vh[i][1], vh[i][2], vh[i][3]}
#define EXQ(idx, C0, C1) do { if ((idx) < 16) C0[(idx)] = __builtin_amdgcn_exp2f(C0[(idx)]); else C1[(idx) - 16] = __builtin_amdgcn_exp2f(C1[(idx) - 16]); } while (0)
#define CV(idx, C0, C1) ((idx) < 16 ? C0[(idx)] : C1[(idx) - 16])
#define EX2(k, C0, C1) do { EXQ(2 * (k), C0, C1); EXQ(2 * (k) + 1, C0, C1); ps2 += (f32x2_t){CV(2 * (k), C0, C1), CV(2 * (k) + 1, C0, C1)}; } while (0)
#define PK4(P, BASE, OUT) do { u32x4 w = {cvtpk(P[BASE + 0], P[BASE + 1]), cvtpk(P[BASE + 2], P[BASE + 3]), cvtpk(P[BASE + 4], P[BASE + 5]), cvtpk(P[BASE + 6], P[BASE + 7])}; OUT = *reinterpret_cast<bf16x8*>(&w); } while (0)
#define STEP(t, C0, C1, N0, N1, PC0, PC1, PC2, PC3, PO0, PO1, PO2, PO3, FIRST, CHK) do { \
    typedef float f32x2_t __attribute__((ext_vector_type(2))); \
    STEP_BAR(); \
    DMA_K((t) + 4, (t)); DMA_V((t) + 2, (t) + 2); \
    const ATT_LAS char* kb = kb0 + (((t) + 1) & 3) * KSLOT; const ATT_LAS char* vbp = vbp0 + (((t) - 1) & 3) * VSLOT; \
    bf16x8 kf[12]; s16x4 vl[8], vh[8]; f32x2_t ps2 = {0.f, 0.f}; float al = 1.f; \
    kf[0] = KFR(kb, 0); kf[1] = KFR(kb, 1); kf[2] = KFR(kb, 2); kf[3] = KFR(kb, 3); \
    float a_ = 0.f, b_ = 0.f, rm = 0.f; \
    if (CHK) { a_ = MX3(C0[0], C0[1], C1[0]); b_ = MX3(C0[2], C0[3], C1[1]); a_ = MX3(a_, C1[2], C1[3]); \
    a_ = MX3(a_, C0[4], C0[5]); b_ = MX3(b_, C0[6], C0[7]); a_ = MX3(a_, C1[4], C1[5]); b_ = MX3(b_, C1[6], C1[7]); } SBAR(); \
    QKM(0, N0, N1); kf[4] = KFR(kb, 4); if (CHK) { a_ = MX3(a_, C0[8], C0[9]); b_ = MX3(b_, C0[10], C0[11]); a_ = MX3(a_, C1[8], C1[9]); b_ = MX3(b_, C1[10], C1[11]); } SBAR(); \
    QKM(1, N0, N1); kf[5] = KFR(kb, 5); if (CHK) { a_ = MX3(a_, C0[12], C0[13]); b_ = MX3(b_, C0[14], C0[15]); a_ = MX3(a_, C1[12], C1[13]); b_ = MX3(b_, C1[14], C1[15]); } SBAR(); \
    QKM(2, N0, N1); kf[6] = KFR(kb, 6); if (CHK) { rm = __builtin_fmaxf(a_, b_); { auto rr = __builtin_amdgcn_permlane32_swap(__float_as_uint(rm), __float_as_uint(rm), false, false); rm = __builtin_fmaxf(__uint_as_float(rr[0]), __uint_as_float(rr[1])); } } SBAR(); \
    QKM(3, N0, N1); kf[7] = KFR(kb, 7); SBAR(); \
    if ((CHK) && ((FIRST) || !__builtin_expect(__all(rm <= THR), 1))) { const float dl = (FIRST) ? rm : __builtin_fmaxf(rm, 0.f); m_ref += dl; pend = dl; \
      _Pragma("unroll") for (int r = 0; r < 16; ++r) { C0[r] -= dl; C1[r] -= dl; } \
      _Pragma("unroll") for (int r = 0; r < 16; ++r) negm[r] = -m_ref; \
      asm volatile("" : "+v"(negm)); if (!(FIRST)) al = __builtin_amdgcn_exp2f(-dl); } \
    SBAR(); \
    QKM(4, N0, N1); kf[8] = KFR(kb, 8); EX2(0, C0, C1); SBAR(); \
    QKM(5, N0, N1); kf[9] = KFR(kb, 9); EX2(1, C0, C1); SBAR(); \
    QKM(6, N0, N1); kf[10] = KFR(kb, 10); EX2(2, C0, C1); SBAR(); \
    QKM(7, N0, N1); kf[11] = KFR(kb, 11); EX2(3, C0, C1); SBAR(); \
    QKM(8, N0, N1); EX2(4, C0, C1); PK4(C0, 0, PC0); SBAR(); \
    QKM(9, N0, N1); if (!(FIRST)) { VRDJ(0); } EX2(5, C0, C1); SBAR(); \
    QKM(10, N0, N1); if (!(FIRST)) { VRDJ(4); } EX2(6, C0, C1); SBAR(); \
    QKM(11, N0, N1); if (!(FIRST)) { VRDJ(1); } EX2(7, C0, C1); SBAR(); \
    if (!(FIRST)) o[0] = __builtin_amdgcn_mfma_f32_32x32x16_bf16(PO0, PKV(0), o[0], 0, 0, 0); if (!(FIRST)) { VRDJ(5); } EX2(8, C0, C1); PK4(C0, 8, PC1); SBAR(); \
    if (!(FIRST)) o[1] = __builtin_amdgcn_mfma_f32_32x32x16_bf16(PO0, PKV(4), o[1], 0, 0, 0); if (!(FIRST)) { VRDJ(2); } EX2(9, C0, C1); SBAR(); \
    if (!(FIRST)) o[0] = __builtin_amdgcn_mfma_f32_32x32x16_bf16(PO1, PKV(1), o[0], 0, 0, 0); if (!(FIRST)) { VRDJ(6); } EX2(10, C0, C1); SBAR(); \
    if (!(FIRST)) o[1] = __builtin_amdgcn_mfma_f32_32x32x16_bf16(PO1, PKV(5), o[1], 0, 0, 0); if (!(FIRST)) { VRDJ(3); } EX2(11, C0, C1); SBAR(); \
    if (!(FIRST)) o[0] = __builtin_amdgcn_mfma_f32_32x32x16_bf16(PO2, PKV(2), o[0], 0, 0, 0); if (!(FIRST)) { VRDJ(7); } EX2(12, C0, C1); PK4(C1, 0, PC2); SBAR(); \
    if (!(FIRST)) o[1] = __builtin_amdgcn_mfma_f32_32x32x16_bf16(PO2, PKV(6), o[1], 0, 0, 0); EX2(13, C0, C1); SBAR(); \
    if (!(FIRST)) o[0] = __builtin_amdgcn_mfma_f32_32x32x16_bf16(PO3, PKV(3), o[0], 0, 0, 0); EX2(14, C0, C1); SBAR(); \
    if (!(FIRST)) o[1] = __builtin_amdgcn_mfma_f32_32x32x16_bf16(PO3, PKV(7), o[1], 0, 0, 0); EX2(15, C0, C1); PK4(C1, 8, PC3); SBAR(); \
    l_reg = l_reg * al + (ps2.x + ps2.y); \
    if (__builtin_expect(__any(pend != 0.f), 0)) {       \
      const float f_ = (FIRST) ? 1.f : __builtin_amdgcn_exp2f(-pend); if (hi == 0) al_l[r32] = f_; asm volatile("s_waitcnt lgkmcnt(0)" ::: "memory"); \
      _Pragma("unroll") for (int r = 0; r < 16; ++r) { const float g_ = al_l[crow(r, hi)]; o[0][r] *= g_; o[1][r] *= g_; N0[r] -= pend; N1[r] -= pend; } \
      pend = 0.f; } \
  } while (0)
  STEP(0, pA0, pA1, pB0, pB1, paA0, paA1, paA2, paA3, paB0, paB1, paB2, paB3, true, 1);
  for (int t = 1; t + 1 < NT; t += 2) {
    STEP(t, pB0, pB1, pA0, pA1, paB0, paB1, paB2, paB3, paA0, paA1, paA2, paA3, false, MLA_CHK_ODD);
    STEP(t + 1, pA0, pA1, pB0, pB1, paA0, paA1, paA2, paA3, paB0, paB1, paB2, paB3, false, 1);
  }
  STEP(NT - 1, pB0, pB1, pA0, pA1, paB0, paB1, paB2, paB3, paA0, paA1, paA2, paA3, false, MLA_CHK_ODD);
  STEP_BAR();
  { const ATT_LAS char* vbp = vbp0 + ((NT - 1) & 3) * VSLOT; s16x4 vl[8], vh[8];
#pragma unroll
    for (int j = 0; j < 8; ++j) VRDJ(j);
    o[0] = __builtin_amdgcn_mfma_f32_32x32x16_bf16(paB0, PKV(0), o[0], 0, 0, 0); o[1] = __builtin_amdgcn_mfma_f32_32x32x16_bf16(paB0, PKV(4), o[1], 0, 0, 0);
    o[0] = __builtin_amdgcn_mfma_f32_32x32x16_bf16(paB1, PKV(1), o[0], 0, 0, 0); o[1] = __builtin_amdgcn_mfma_f32_32x32x16_bf16(paB1, PKV(5), o[1], 0, 0, 0);
    o[0] = __builtin_amdgcn_mfma_f32_32x32x16_bf16(paB2, PKV(2), o[0], 0, 0, 0); o[1] = __builtin_amdgcn_mfma_f32_32x32x16_bf16(paB2, PKV(6), o[1], 0, 0, 0);
    o[0] = __builtin_amdgcn_mfma_f32_32x32x16_bf16(paB3, PKV(3), o[0], 0, 0, 0); o[1] = __builtin_amdgcn_mfma_f32_32x32x16_bf16(paB3, PKV(7), o[1], 0, 0, 0); }
  { auto rr = __builtin_amdgcn_permlane32_swap(__float_as_uint(l_reg), __float_as_uint(l_reg), false, false); l_reg = __uint_as_float(rr[0]) + __uint_as_float(rr[1]); }
  if (hi == 0) li_l[r32] = l_reg; asm volatile("s_waitcnt lgkmcnt(0)" ::: "memory");
  store_o(o, li_l, Ob + (long)(wid * 32) * 512, lds + MLA_OIMG + wid * OIMG_WAVE, lane, r32, hi);
  BAR_V(0);
#undef DMA_K
#undef DMA_V
#undef STEP_BAR
#undef KFR
#undef QKM
#undef VRDJ
#undef PKV
#undef EXQ
#undef CV
#undef EX2
#undef PK4
#undef STEP
}
#undef BAR_L
#undef BAR_V

constexpr int NA_KROWB = 144, NA_LDS_K = 64 * NA_KROWB  , NA_SLOT = NA_LDS_K + 8192  , NA_OIMG = 2 * NA_SLOT + 15 * 32 * 4 + 8 * 256  , NA_LDS = NA_OIMG + 8 * OIMG_WAVE;
template <int CH> __device__ __forceinline__ constexpr bool na_live0(int q) { return CH == 0 ? true : q >= 12; }
template <int CH> __device__ __forceinline__ constexpr bool na_live1(int q) { return CH == 0 ? q < 4 : true; }
template <int CH> __device__ __forceinline__ void na_tile(f32x16& p0, f32x16& p1, const ATT_LAS float* trow, int qcol, int wstart, int hi, int r32, bool first,
                                                          float& m_ref, float& l_reg, f32x16& negm, f32x16 (&o)[2], ATT_LAS float* al_l, int vb) {
  float bz0[16], bz1[16];
#pragma unroll
  for (int q = 0; q < 16; ++q) { const int kc0 = crow(q, hi), kc1 = kc0 + 32;
    if (na_live0<CH>(q)) { const int i0 = min(max(kc0 - qcol + 15, 0), 30); bz0[q] = trow[i0]; }
    if (na_live1<CH>(q)) { const int i1 = min(max(kc1 - qcol + 15, 0), 30); bz1[q] = trow[i1]; } }
#pragma unroll
  for (int q = 0; q < 16; ++q) { if (na_live0<CH>(q)) asm volatile("" : "+v"(bz0[q])); if (na_live1<CH>(q)) asm volatile("" : "+v"(bz1[q])); }
#pragma unroll
  for (int q = 0; q < 16; ++q) { const int kc0 = crow(q, hi), kc1 = kc0 + 32;
    if (na_live0<CH>(q)) p0[q] = ((unsigned)(kc0 - wstart) < 16u) ? p0[q] + bz0[q] : -1e30f;
    if (na_live1<CH>(q)) p1[q] = ((unsigned)(kc1 - wstart) < 16u) ? p1[q] + bz1[q] : -1e30f; }
  float rm = -1e30f;
#pragma unroll
  for (int q = 0; q < 16; ++q) { if (na_live0<CH>(q)) rm = __builtin_fmaxf(rm, p0[q]); if (na_live1<CH>(q)) rm = __builtin_fmaxf(rm, p1[q]); }
  { auto rr = __builtin_amdgcn_permlane32_swap(__float_as_uint(rm), __float_as_uint(rm), false, false); rm = __builtin_fmaxf(__uint_as_float(rr[0]), __uint_as_float(rr[1])); }
  float al = 1.f;
  if (first || !__builtin_expect(__all(rm <= THR), 1)) {
    const float dl = first ? rm : __builtin_fmaxf(rm, 0.f); m_ref += dl;
#pragma unroll
    for (int q = 0; q < 16; ++q) { if (na_live0<CH>(q)) p0[q] -= dl; if (na_live1<CH>(q)) p1[q] -= dl; }
#pragma unroll
    for (int q = 0; q < 16; ++q) negm[q] = -m_ref;
    asm volatile("" : "+v"(negm));
    if (!first) al = __builtin_amdgcn_exp2f(-dl);
    if (__any(al < 1.f)) { if (hi == 0) al_l[r32] = al; asm volatile("s_waitcnt lgkmcnt(0)" ::: "memory");
#pragma unroll
      for (int q = 0; q < 16; ++q) { const float f_ = al_l[crow(q, hi)]; o[0][q] *= f_; o[1][q] *= f_; } }
  }
  float ps = 0.f;
#pragma unroll
  for (int q = 0; q < 16; ++q) { if (na_live0<CH>(q)) { p0[q] = __builtin_amdgcn_exp2f(p0[q]); ps += p0[q]; } else p0[q] = 0.f;
    if (na_live1<CH>(q)) { p1[q] = __builtin_amdgcn_exp2f(p1[q]); ps += p1[q]; } else p1[q] = 0.f; }
  l_reg = l_reg * al + ps;
  bf16x8 pa0, pa1, pa2, pa3;
#define PK4(P, BASE, OUT) do { unsigned a0 = cvtpk(P[BASE + 0], P[BASE + 1]), a1 = cvtpk(P[BASE + 2], P[BASE + 3]);   \
    unsigned b0_ = cvtpk(P[BASE + 4], P[BASE + 5]), b1_ = cvtpk(P[BASE + 6], P[BASE + 7]);                              \
    auto r0_ = __builtin_amdgcn_permlane32_swap(a0, b0_, false, false); auto r1_ = __builtin_amdgcn_permlane32_swap(a1, b1_, false, false); \
    u32x4 w = {r0_[0], r1_[0], r0_[1], r1_[1]}; OUT = *reinterpret_cast<bf16x8*>(&w); } while (0)
  if (CH == 1) { PK4(p0, 8, pa1); PK4(p1, 0, pa2); PK4(p1, 8, pa3); } else { PK4(p0, 0, pa0); PK4(p0, 8, pa1); PK4(p1, 0, pa2); }
#undef PK4
  SBAR();
  { const ATT_LAS char* vbp = (const ATT_LAS char*)(unsigned)vb;
#define NA_VF(D0, KS) const s16x4 l##D0##KS = vtr(vbp + v_rd_off(D0, KS, 0)), h##D0##KS = vtr(vbp + v_rd_off(D0, KS, 1))
#define NA_PV(D0, KS, PA) o[D0] = __builtin_amdgcn_mfma_f32_32x32x16_bf16(PA, (bf16x8){l##D0##KS[0], l##D0##KS[1], l##D0##KS[2], l##D0##KS[3], h##D0##KS[0], h##D0##KS[1], h##D0##KS[2], h##D0##KS[3]}, o[D0], 0, 0, 0)
    NA_VF(0, 1); NA_VF(1, 1); NA_VF(0, 2); NA_VF(1, 2);
    if (CH == 0) { NA_VF(0, 0); NA_VF(1, 0); NA_PV(0, 0, pa0); NA_PV(1, 0, pa0); }
    NA_PV(0, 1, pa1); NA_PV(1, 1, pa1); NA_PV(0, 2, pa2); NA_PV(1, 2, pa2);
    if (CH == 1) { NA_VF(0, 3); NA_VF(1, 3); NA_PV(0, 3, pa3); NA_PV(1, 3, pa3); }
#undef NA_VF
#undef NA_PV
  }
}
__device__ __forceinline__ void na_unit(int b, int h, int rg, const bf16* __restrict__ QKV, bf16* __restrict__ O, const float* __restrict__ rpb, ATT_LAS char* lds, const int wave_id) {
  int lane_; asm volatile("v_mbcnt_lo_u32_b32 %0, -1, 0\n\tv_mbcnt_hi_u32_b32 %0, -1, %0" : "=v"(lane_));
  int w_ = wave_id; asm volatile("" : "+s"(w_));
  const int wid = w_, lane = lane_, tid = wid * 64 + lane, r32 = lane & 31, hi = lane >> 5;
  ATT_LAS char* K_lds = lds; ATT_LAS char* V_lds = lds + NA_LDS_K; ATT_LAS float* tab = (ATT_LAS float*)(lds + 2 * NA_SLOT);
  ATT_LAS float* ws = (ATT_LAS float*)(lds + 2 * NA_SLOT + 15 * 32 * 4) + wid * 64; ATT_LAS float* li_l = ws; ATT_LAS float* al_l = ws + 32;
  const int r0 = 4 * rg, r = r0 + (wid >> 1), ch = wid & 1, qcol = 32 * ch + r32;
  const int rs = min(max(r - 4, 0), 120), lo = min(max(r0 - 4, 0), 120), hiR = min(max(r0 + 3 - 4, 0), 120) + 7;
  const int wstart = min(max(qcol - 8, 0), 48);
  const long tok0 = (long)b * 8192;
  if (tid < 15 * 32) { const int dr = tid >> 5, dc = tid & 31; tab[tid] = (dc < 31) ? rpb[(h * 15 + dr) * 31 + dc] * 1.4426950408889634f : 0.f; }
  bf16x8 qr[4];
  { const bf16* Qw = QKV + (tok0 + r * 64 + qcol) * 1536 + h * 64 + hi * 8;
#pragma unroll
    for (int d0 = 0; d0 < 4; ++d0) qr[d0] = *reinterpret_cast<const bf16x8*>(Qw + d0 * 16); }
  const int srow = tid >> 3, sch = tid & 7; const int kst = srow * NA_KROWB + sch * 16, vst = v_st(srow, sch * 8);
  const int vb0 = (int)(unsigned)(uintptr_t)V_lds + v_rd_base(lane);
  const bf16* Ksrc = QKV + (tok0 + srow) * 1536 + 512 + h * 64 + sch * 8; const bf16* Vsrc = Ksrc + 512;
  float m_ref = 0.f, l_reg = 0.f; f32x16 o[2] = {}; f32x16 negm = {};
#define NA_LD(KR, KV, VV) do { const int kk_ = min((KR), hiR); KV = *reinterpret_cast<const bf16x8*>(Ksrc + (long)kk_ * 64 * 1536); VV = *reinterpret_cast<const bf16x8*>(Vsrc + (long)kk_ * 64 * 1536); } while (0)
#define NA_BODY(KR, KN, VN, CHV) do { \
    __syncthreads();                                               \
    if ((KR) + 1 <= hiR) { *(ATT_LAS bf16x8*)(K_lds + (par ^ 1) * NA_SLOT + kst) = KN; *(ATT_LAS bf16x8*)(V_lds + (par ^ 1) * NA_SLOT + vst) = VN; NA_LD((KR) + 3, KN, VN); } \
    if ((KR) >= rs && (KR) < rs + 8) {                              \
      f32x16 p0, p1; qkt_from<4, NA_KROWB>(p0, p1, K_lds + par * NA_SLOT, qr, negm, r32, hi); \
      const ATT_LAS float* trow = tab + ((KR) - r + 7) * 32; \
      na_tile<CHV>(p0, p1, trow, qcol, wstart, hi, r32, (KR) == rs, m_ref, l_reg, negm, o, al_l, vb0 + par * NA_SLOT); \
    } \
    par ^= 1; } while (0)
  bf16x8 k0, v0, k1, v1;
  NA_LD(lo, k0, v0); NA_LD(lo + 1, k1, v1);
  *(ATT_LAS bf16x8*)(K_lds + kst) = k0; *(ATT_LAS bf16x8*)(V_lds + vst) = v0; NA_LD(lo + 2, k0, v0);
  int par = 0;
  if (ch == 0) {
    for (int kr = lo; kr <= hiR; kr += 2) {
      NA_BODY(kr, k1, v1, 0);
      if (kr + 1 > hiR) break;
      NA_BODY(kr + 1, k0, v0, 0);
    }
  } else {
    for (int kr = lo; kr <= hiR; kr += 2) {
      NA_BODY(kr, k1, v1, 1);
      if (kr + 1 > hiR) break;
      NA_BODY(kr + 1, k0, v0, 1);
    }
  }
#undef NA_LD
#undef NA_BODY
  { auto rr = __builtin_amdgcn_permlane32_swap(__float_as_uint(l_reg), __float_as_uint(l_reg), false, false); l_reg = __uint_as_float(rr[0]) + __uint_as_float(rr[1]); }
  if (hi == 0) li_l[r32] = l_reg; asm volatile("s_waitcnt lgkmcnt(0)" ::: "memory");
  store_o(o, li_l, O + (tok0 + r * 64 + 32 * ch) * 512 + h * 64, lds + NA_OIMG + wid * OIMG_WAVE, lane, r32, hi);
  __syncthreads();
}
#undef SBAR
}

constexpr int NWAVES = 8;
constexpr int NB = 8, SEQ = 8192, DM = 1024, MTOK = NB * SEQ;
constexpr int NIN = 4640, NPROJ = 4864;
constexpr int DFF = 2816, DFFE = 3584, NEXP = 8, PLED = 256;
constexpr int QLORA = 768, KVLORA = 256;
constexpr float ALPHA = 1.4142135623730951f;
constexpr float LN_EPS = 1e-5f, RMS_EPS = 1e-6f;
constexpr float LOG2E = 1.4426950408889634f;
constexpr float NA_QSCALE = 0.125f * LOG2E;
constexpr float MLA_QSCALE = 0.10206207261596575f * LOG2E;
constexpr int MOE_CHUNK = 128, MOE_NCHUNK = 4, MOE_REMT = 8, MOE_MAXT = 520;

constexpr size_t MiB = 1u << 20;
constexpr size_t WS_CTL = 0, CTL_ZERO_BYTES = 64 * 1024;
constexpr size_t WS_ROPE = 1 * MiB;
constexpr size_t WS_W = 2 * MiB;
constexpr size_t W_WIN = 0, W_WUQ = W_WIN + (size_t)NPROJ * 1024 * 2, W_WUKV = W_WUQ + 768 * 768 * 2, W_WNAO = W_WUKV + 1024 * 256 * 2, W_WMLAO = W_WNAO + 1024 * 512 * 2,
                 W_WOUT = W_WMLAO + 1024 * 512 * 2, W_WPG = W_WOUT + 1024 * 1024 * 2, W_WPLE = W_WPG + 1024 * 1024 * 2, W_LAYER = W_WPLE + 1024 * 256 * 2;
constexpr size_t WS_W13 = WS_W + 2 * W_LAYER, WS_W2 = WS_W13 + (size_t)2 * DFF * 1024 * 2, WS_WEND = WS_W2 + (size_t)1024 * DFF * 2;
static_assert(WS_WEND <= 56 * MiB, "weights");
constexpr size_t WS_SX = 54 * MiB, WS_SX1 = WS_SX + 256 * 1024, WS_SXS = WS_SX + 512 * 1024;
constexpr size_t WS_SWIN = 55 * MiB + 256 * 1024, WS_SW13 = WS_SWIN + 64 * 1024, WS_SWM13 = WS_SW13 + 32 * 1024;
constexpr size_t WS_SWPG = WS_SWM13 + 8 * 7168 * 4;
static_assert(WS_WEND <= WS_SX && WS_SWPG + 2 * 1024 * 4 <= 56 * MiB, "scales");
constexpr size_t WS_PB = 56 * MiB;
constexpr size_t WS_TE = 88 * MiB, WS_TP = 88 * MiB + 512 * 1024, WS_TW = 89 * MiB, WS_TPOS = 89 * MiB + 512 * 1024, WS_SW = 90 * MiB, WS_CNT = 91 * MiB;
constexpr size_t WS_PS = 92 * MiB;
constexpr size_t WS_XB = 96 * MiB;
constexpr size_t WS_QMLA = WS_XB;
constexpr size_t WS_GATES = 224 * MiB;
constexpr size_t WS_NAQKV = 480 * MiB;
constexpr size_t WS_MERGED = WS_NAQKV;
constexpr size_t WS_QLAT = 672 * MiB, WS_KVLAT = 768 * MiB;
constexpr size_t WS_ONA = 672 * MiB, WS_OMLA = 736 * MiB;
constexpr size_t WS_KMLA = 800 * MiB, WS_VMLA = 896 * MiB;
constexpr size_t WS_H = 224 * MiB, WS_PP_DENSE = 576 * MiB;
constexpr size_t WS_PP_MOE = 224 * MiB, WS_XS = 352 * MiB, WS_HS = 612 * MiB, WS_WM13 = 856 * MiB, WS_WM2 = 968 * MiB, WS_END = 1024 * MiB;
static_assert(WS_XS + (size_t)MOE_MAXT * 256 * 1024 * 2 <= WS_HS && WS_HS + (size_t)(MOE_CHUNK + MOE_REMT) * 256 * DFFE * 2 <= WS_WM13 && WS_WM13 + (size_t)NEXP * 2 * DFFE * 1024 * 2 == WS_WM2 && WS_WM2 + (size_t)NEXP * 1024 * DFFE * 2 == WS_END, "moe map");
static_assert(WS_H + (size_t)MTOK * DFF * 2 <= WS_PP_DENSE, "dense map");
constexpr size_t WS_G8 = 704 * MiB;
constexpr size_t WS_PART = 912 * MiB;
constexpr int MOE_REM_ROWS = MOE_REMT * 256, MOE_FULL = MOE_NCHUNK * MOE_CHUNK;
static_assert(WS_PART >= WS_WM13 + (size_t)NEXP * 2 * DFFE * 1024 && WS_PART + (size_t)4 * MOE_REM_ROWS * 1024 * 2 <= WS_WM2, "partials");
static_assert(WS_G8 >= WS_PP_DENSE + (size_t)MTOK * 1024 * 2 && WS_G8 >= WS_HS && WS_G8 + (size_t)MTOK * 1024 <= WS_WM13, "gate map");
constexpr int CW_BAR = 4096;
constexpr int RING_OFF = 0, RING_BYTES = 131072;
constexpr int LDSCTL_OFF = RING_BYTES;
constexpr int X_LCNT = RING_BYTES + 512, X_OFF = X_LCNT + 64, X_TOT = X_OFF + 64, X_RTAB = X_TOT + 64, X_PRE = X_RTAB + 4 * 256 * 4, X_END = X_PRE + 256 * 8 * 4;
constexpr int X_SCL = 147456;
constexpr int LDS_BYTES = 155648;
static_assert(X_END <= X_SCL && X_SCL + 4096 <= LDS_BYTES, "LDS map");

#include <hip/hip_bf16.h>
#define GAS __attribute__((address_space(1)))
#define LAS __attribute__((address_space(3)))
typedef unsigned short bf16;
typedef unsigned v4u __attribute__((ext_vector_type(4)));
typedef float f32x4 __attribute__((ext_vector_type(4)));
typedef short bf16x8 __attribute__((ext_vector_type(8)));
typedef GAS unsigned gu32;
typedef GAS unsigned long long gu64;
#define RLX_AGENT __ATOMIC_RELAXED, __HIP_MEMORY_SCOPE_AGENT
#define LDS_WAIT() asm volatile("s_waitcnt lgkmcnt(0)" ::: "memory")
#define VM_WAIT() asm volatile("s_waitcnt vmcnt(0)" ::: "memory")
__device__ __forceinline__ unsigned long long rt() { return __builtin_amdgcn_s_memrealtime(); }
__device__ __forceinline__ unsigned f2bf(float f) { unsigned u = __builtin_bit_cast(unsigned, f); return (u + 0x7fffu + ((u >> 16) & 1u)) >> 16; }
__device__ __forceinline__ unsigned pk2(float lo, float hi) { return f2bf(lo) | (f2bf(hi) << 16); }

#define XB_TMO      128
#define XB_XCNT(j)  (256  + 64 * (j))
#define XB_XSUB(j)  (1280 + 64 * (j))
#define XB_XGEN(j)  (2304 + 64 * (j))
#define XB_TOP      3328
#define XB_TOPGEN   3392
#define XCD_BAR_WORDS 3456
#define XB_SPIN_CAP (1u << 18)

__device__ __forceinline__ unsigned xb_ld(unsigned* p)              { return __hip_atomic_load(p, __ATOMIC_RELAXED, __HIP_MEMORY_SCOPE_AGENT); }
__device__ __forceinline__ unsigned xb_add(unsigned* p, unsigned v) { return __hip_atomic_fetch_add(p, v, __ATOMIC_RELAXED, __HIP_MEMORY_SCOPE_AGENT); }
__device__ __forceinline__ unsigned xb_xcc_id() { return (unsigned)__builtin_amdgcn_s_getreg((3 << 11) | 20) & 0xFu; }
#define XB_SPIN(cond, bar) do { unsigned _sp = 0; while (cond) { __builtin_amdgcn_s_sleep(1); \
    if ((++_sp & 255u) == 0u) { if (xb_ld(&(bar)[XB_TMO])) break; if (_sp > XB_SPIN_CAP) { atomicAdd(&(bar)[XB_TMO], 1u); break; } } } } while (0)

struct XcdBarrier {
    unsigned* bar; unsigned x;
    volatile LAS unsigned* st;
    unsigned w0;
};

__device__ __forceinline__ XcdBarrier xcd_barrier_post(unsigned* bar, volatile LAS unsigned* st) {
    XcdBarrier b; b.bar = bar; b.x = xb_xcc_id(); b.st = st; b.w0 = (unsigned)__builtin_amdgcn_readfirstlane(threadIdx.x < 64u ? 1 : 0);
    if (threadIdx.x == 0) (void)xb_add(&bar[XB_XCNT(b.x)], 1u);
    return b;
}
__device__ __forceinline__ void xcd_barrier_complete(unsigned* bar, unsigned x, unsigned& nloc, unsigned& nx) {
    const unsigned G = gridDim.x * gridDim.y * gridDim.z;
    unsigned sum, cnt, mine, sp = 0u;
    for (;;) {
        sum = 0u; cnt = 0u; mine = 0u;
#pragma unroll
        for (unsigned j = 0; j < 16; ++j) { const unsigned c = xb_ld(&bar[XB_XCNT(j)]); sum += c; cnt += (c > 0u) ? 1u : 0u; mine = (j == x) ? c : mine; }
        if (sum == G) break;
        __builtin_amdgcn_s_sleep(1);
        if ((++sp & 255u) == 0u) { if (xb_ld(&bar[XB_TMO])) break; if (sp > XB_SPIN_CAP) { atomicAdd(&bar[XB_TMO], 1u); break; } }
    }
    nloc = mine > 0u ? mine : 1u; nx = cnt > 0u ? cnt : 1u;
}

__device__ __forceinline__ void xcd_barrier(const XcdBarrier& b) {
    asm volatile("s_waitcnt vmcnt(0)" ::: "memory");
    __syncthreads();
    int xl_; asm volatile("v_mbcnt_lo_u32_b32 %0, -1, 0\n\tv_mbcnt_hi_u32_b32 %0, -1, %0" : "=v"(xl_));
    if (b.w0 && xl_ == 0) {
        unsigned* bar = b.bar;
        __builtin_amdgcn_s_waitcnt(0);
        unsigned nloc = b.st[0], nx = b.st[1];
        if (nloc == 0u) { xcd_barrier_complete(bar, b.x, nloc, nx); b.st[0] = nloc; b.st[1] = nx; }
        const unsigned old = xb_add(&bar[XB_XSUB(b.x)], 1u);
        const unsigned gen = old / nloc;
        if (old + 1u == (gen + 1u) * nloc) {
            __builtin_amdgcn_fence(__ATOMIC_RELEASE, "agent");
            asm volatile("s_waitcnt vmcnt(0)" ::: "memory");
            const unsigned og = xb_add(&bar[XB_TOP], 1u);
            const unsigned tg = og / nx;
            if (og + 1u == (tg + 1u) * nx) xb_add(&bar[XB_TOPGEN], 1u);
            else XB_SPIN(xb_ld(&bar[XB_TOPGEN]) == tg, bar);
            __builtin_amdgcn_fence(__ATOMIC_ACQUIRE, "agent");
            xb_add(&bar[XB_XGEN(b.x)], 1u);
            asm volatile("s_waitcnt vmcnt(0)" ::: "memory");
        } else {
            XB_SPIN(xb_ld(&bar[XB_XGEN(b.x)]) == gen, bar);
            __builtin_amdgcn_fence(__ATOMIC_ACQUIRE, "agent");
            asm volatile("s_waitcnt vmcnt(0)" ::: "memory");
        }
    }
    __syncthreads();
}


typedef unsigned v2u __attribute__((ext_vector_type(2)));
struct Args { const float* in[26]; float* out; unsigned char* ws; int ph_lo, ph_hi; };
struct Frame {
    LAS unsigned char* lds;
    int tid, lane, wave, vcu, G;
};
#define WR_DPP(v, ctrl) __int_as_float(__builtin_amdgcn_update_dpp(0, __float_as_int(v), (ctrl), 0xf, 0xf, true))
__device__ __forceinline__ float wave_sum(float v) {
    v += WR_DPP(v, 0xB1); v += WR_DPP(v, 0x4E); v += WR_DPP(v, 0x141); v += WR_DPP(v, 0x140);
    { const auto r = __builtin_amdgcn_permlane16_swap(__float_as_uint(v), __float_as_uint(v), false, false); v = __uint_as_float(r[0]) + __uint_as_float(r[1]); }
    { const auto r = __builtin_amdgcn_permlane32_swap(__float_as_uint(v), __float_as_uint(v), false, false); v = __uint_as_float(r[0]) + __uint_as_float(r[1]); }
    return v;
}
__device__ __forceinline__ float wave_max(float v) {
    v = fmaxf(v, WR_DPP(v, 0xB1)); v = fmaxf(v, WR_DPP(v, 0x4E)); v = fmaxf(v, WR_DPP(v, 0x141)); v = fmaxf(v, WR_DPP(v, 0x140));
    { const auto r = __builtin_amdgcn_permlane16_swap(__float_as_uint(v), __float_as_uint(v), false, false); v = fmaxf(__uint_as_float(r[0]), __uint_as_float(r[1])); }
    { const auto r = __builtin_amdgcn_permlane32_swap(__float_as_uint(v), __float_as_uint(v), false, false); v = fmaxf(__uint_as_float(r[0]), __uint_as_float(r[1])); }
    return v;
}
__device__ __forceinline__ float half_max32(float v) { const auto r = __builtin_amdgcn_permlane32_swap(__float_as_uint(v), __float_as_uint(v), false, false); return fmaxf(__uint_as_float(r[0]), __uint_as_float(r[1])); }
__device__ __forceinline__ float bflo(unsigned w) { return __uint_as_float(w << 16); }
__device__ __forceinline__ float bfhi(unsigned w) { return __uint_as_float(w & 0xffff0000u); }

__device__ __forceinline__ void tr_item(const float* W, int K, int N, bf16* WT, int g, int s0, int ss, int d0, int ds, const float* gs, LAS float* scr, int item, int ncols, int lane) {
    const int nblk = ncols / 32, kb = item / nblk, nb = item % nblk, k0 = 64 * kb, j0 = 32 * nb;
    const int grp = j0 / g, jin = j0 % g, sn0 = s0 + grp * ss + jin, dn0 = d0 + grp * ds + jin;
    float v[32];
#pragma unroll
    for (int i = 0; i < 32; ++i) { const int kk = 2 * i + (lane >> 5); v[i] = W[(size_t)(k0 + kk) * N + sn0 + (lane & 31)]; }
    if (gs) {
#pragma unroll
        for (int i = 0; i < 32; ++i) v[i] *= gs[k0 + 2 * i + (lane >> 5)]; }
#pragma unroll
    for (int i = 0; i < 32; ++i) scr[(2 * i + (lane >> 5)) * 33 + (lane & 31)] = v[i];
    LDS_WAIT(); asm volatile("" ::: "memory");
    const int c = lane & 7;
#pragma unroll
    for (int j = 0; j < 4; ++j) { const int n = (lane >> 3) + 8 * j; const LAS float* s = scr + (8 * c) * 33 + n;
        v4u o; o.x = pk2(s[0 * 33], s[1 * 33]); o.y = pk2(s[2 * 33], s[3 * 33]); o.z = pk2(s[4 * 33], s[5 * 33]); o.w = pk2(s[6 * 33], s[7 * 33]);
        *(GAS v4u*)(WT + (size_t)(dn0 + n) * K + k0 + 8 * c) = o; }
    LDS_WAIT(); asm volatile("" ::: "memory");
}
__device__ __forceinline__ void tr_job(Frame& F, int& rot, const float* W, int K, int N, int ncols, bf16* WT, int g, int s0, int ss, int d0, int ds, const float* gs) {
    LAS float* scr = (LAS float*)(F.lds + RING_OFF + F.wave * 16384);
    const int NGW = F.G * NWAVES, gw = F.vcu * NWAVES + F.wave, nitems = (K / 64) * (ncols / 32);
    int first = (gw - rot) % NGW; if (first < 0) first += NGW;
    for (int it = first; it < nitems; it += NGW) tr_item(W, K, N, WT, g, s0, ss, d0, ds, gs, scr, it, ncols, F.lane);
    rot = (rot + nitems) % NGW;
}
__device__ __forceinline__ void tr_plain(Frame& F, int& rot, const float* W, int K, int N, bf16* WT) { tr_job(F, rot, W, K, N, N, WT, N, 0, 0, 0, 0, nullptr); }
__device__ __forceinline__ void cvt_rows(Frame& F, const float* src, bf16* dst, size_t n8) {
    const size_t NT = (size_t)F.G * NWAVES * 64, t0 = (size_t)(F.vcu * NWAVES + F.wave) * 64 + F.lane;
    size_t i = t0;
    for (; i + 3 * NT < n8; i += 4 * NT) { f32x4 a[4], b[4];
#pragma unroll
        for (int q = 0; q < 4; ++q) { a[q] = *(const GAS f32x4*)(src + (i + q * NT) * 8); b[q] = *(const GAS f32x4*)(src + (i + q * NT) * 8 + 4); }
#pragma unroll
        for (int q = 0; q < 4; ++q) { v4u o; o.x = pk2(a[q].x, a[q].y); o.y = pk2(a[q].z, a[q].w); o.z = pk2(b[q].x, b[q].y); o.w = pk2(b[q].z, b[q].w); *(GAS v4u*)(dst + (i + q * NT) * 8) = o; } }
    for (; i < n8; i += NT) { const f32x4 a = *(const GAS f32x4*)(src + i * 8), b = *(const GAS f32x4*)(src + i * 8 + 4);
        v4u o; o.x = pk2(a.x, a.y); o.y = pk2(a.z, a.w); o.z = pk2(b.x, b.y); o.w = pk2(b.z, b.w); *(GAS v4u*)(dst + i * 8) = o; }
}

__device__ __forceinline__ unsigned pack4i8(float a, float b, float c, float d) {
    const int ia = (int)__builtin_rintf(a), ib = (int)__builtin_rintf(b), ic = (int)__builtin_rintf(c), id = (int)__builtin_rintf(d);
    return (unsigned)(ia & 0xff) | ((unsigned)(ib & 0xff) << 8) | ((unsigned)(ic & 0xff) << 16) | ((unsigned)id << 24);
}
__device__ __forceinline__ void trq_job(Frame& F, int& rot, const float* W, int K, int N, int ncols, signed char* WQ, float* SC, int g, int s0, int ss, int d0, int ds) {
    LAS float* scr = (LAS float*)(F.lds + RING_OFF + F.wave * 16384);
    const int NGW = F.G * NWAVES, gw = F.vcu * NWAVES + F.wave, nitems = ncols / 32, lane = F.lane;
    int first = (gw - rot) % NGW; if (first < 0) first += NGW;
    for (int it = first; it < nitems; it += NGW) {
        const int j0 = 32 * it, grp = j0 / g, jin = j0 % g, sn0 = s0 + grp * ss + jin, dn0 = d0 + grp * ds + jin;
        const float* wp = W + sn0 + (lane & 31) + (size_t)(lane >> 5) * N;
        float mx = 0.f;
        for (int kb = 0; kb < K / 64; ++kb) { float v[32];
#pragma unroll
            for (int i = 0; i < 32; ++i) v[i] = wp[(size_t)(kb * 64 + 2 * i) * N];
#pragma unroll
            for (int i = 0; i < 32; ++i) mx = fmaxf(mx, fabsf(v[i])); }
        mx = half_max32(mx);
        const float inv = mx > 0.f ? 127.f / mx : 0.f;
        if (lane < 32) SC[dn0 + lane] = mx > 0.f ? mx * (1.f / 127.f) : 1.f;
        for (int kb = 0; kb < K / 64; ++kb) { float v[32];
#pragma unroll
            for (int i = 0; i < 32; ++i) v[i] = wp[(size_t)(kb * 64 + 2 * i) * N];
#pragma unroll
            for (int i = 0; i < 32; ++i) scr[(2 * i + (lane >> 5)) * 33 + (lane & 31)] = v[i] * inv;
            LDS_WAIT(); asm volatile("" ::: "memory");
            const int n = lane >> 1, hf = lane & 1; const LAS float* s = scr + (hf * 32) * 33 + n;
            v4u o0, o1;
            o0.x = pack4i8(s[0 * 33], s[1 * 33], s[2 * 33], s[3 * 33]); o0.y = pack4i8(s[4 * 33], s[5 * 33], s[6 * 33], s[7 * 33]); o0.z = pack4i8(s[8 * 33], s[9 * 33], s[10 * 33], s[11 * 33]); o0.w = pack4i8(s[12 * 33], s[13 * 33], s[14 * 33], s[15 * 33]);
            o1.x = pack4i8(s[16 * 33], s[17 * 33], s[18 * 33], s[19 * 33]); o1.y = pack4i8(s[20 * 33], s[21 * 33], s[22 * 33], s[23 * 33]); o1.z = pack4i8(s[24 * 33], s[25 * 33], s[26 * 33], s[27 * 33]); o1.w = pack4i8(s[28 * 33], s[29 * 33], s[30 * 33], s[31 * 33]);
            GAS v4u* dp = (GAS v4u*)(WQ + (size_t)(dn0 + n) * K + kb * 64 + hf * 32); dp[0] = o0; dp[1] = o1;
            LDS_WAIT(); asm volatile("" ::: "memory"); }
    }
    rot = (rot + nitems) % NGW;
}
__device__ __forceinline__ void store_q8(signed char* XQ, float* SX, size_t m, const f32x4 (&v)[4], int lane) {
    float mx = 0.f;
#pragma unroll
    for (int j = 0; j < 4; ++j) mx = fmaxf(fmaxf(mx, fmaxf(fabsf(v[j].x), fabsf(v[j].y))), fmaxf(fabsf(v[j].z), fabsf(v[j].w)));
    mx = wave_max(mx);
    const float inv = mx > 0.f ? 127.f / mx : 0.f;
    GAS unsigned* o4 = (GAS unsigned*)(XQ + m * DM) + lane;
#pragma unroll
    for (int j = 0; j < 4; ++j) o4[64 * j] = pack4i8(v[j].x * inv, v[j].y * inv, v[j].z * inv, v[j].w * inv);
    if (lane == 0) SX[m] = mx > 0.f ? mx * (1.f / 127.f) : 1.f;
}

template <class Sched> __device__ __forceinline__ void rms_prepass(Frame& F, const Sched& S, const float* PS, int p0, int NP, int K) {
    LAS float* rtab = (LAS float*)(F.lds + X_RTAB); pg8::Unit u;
    if (F.tid < 256) {
        for (int i = 0; i < 4 && S.next(i, u); ++i) { const GAS f32x4* pp = (const GAS f32x4*)(PS + (size_t)(u.pa * 256 + F.tid) * 16 + p0);
            float s = 0.f;
            for (int j = 0; j < NP / 4; ++j) { const f32x4 x = pp[j]; s += (x[0] + x[1]) + (x[2] + x[3]); }
            rtab[i * 256 + F.tid] = 1.0f / sqrtf(s / (float)K + RMS_EPS); }
    }
    LDS_WAIT(); __syncthreads();
}

__device__ __forceinline__ void ln_core(f32x4 (&v)[4], const f32x4 (&g)[4], const f32x4 (&bb)[4]) {
    float s = 0.f;
#pragma unroll
    for (int j = 0; j < 4; ++j) s += (v[j].x + v[j].y) + (v[j].z + v[j].w);
    const float mean = wave_sum(s) * (1.f / DM); float s2 = 0.f;
#pragma unroll
    for (int j = 0; j < 4; ++j) { v[j] = v[j] - mean; s2 += (v[j].x * v[j].x + v[j].y * v[j].y) + (v[j].z * v[j].z + v[j].w * v[j].w); }
    const float rstd = 1.f / sqrtf(wave_sum(s2) * (1.f / DM) + LN_EPS);
#pragma unroll
    for (int j = 0; j < 4; ++j) v[j] = v[j] * rstd * g[j] + bb[j];
}
__device__ __forceinline__ void store_row(float* R, bf16* XB, size_t m, const f32x4 (&v)[4], int lane, bool wb) {
    GAS f32x4* o = (GAS f32x4*)(R + m * DM) + lane;
#pragma unroll
    for (int j = 0; j < 4; ++j) o[64 * j] = v[j];
    if (wb) { GAS unsigned long long* o8 = (GAS unsigned long long*)(XB + m * DM) + lane;
#pragma unroll
        for (int j = 0; j < 4; ++j) o8[64 * j] = (unsigned long long)pk2(v[j].x, v[j].y) | ((unsigned long long)pk2(v[j].z, v[j].w) << 32); }
}

__device__ __forceinline__ void load_bf(f32x4 (&v)[4], const bf16* Y, size_t m, int lane) {
    const GAS v2u* p = (const GAS v2u*)(Y + m * DM) + lane;
#pragma unroll
    for (int j = 0; j < 4; ++j) { const v2u w = p[64 * j]; v[j].x = bflo(w.x); v[j].y = bfhi(w.x); v[j].z = bflo(w.y); v[j].w = bfhi(w.y); }
}
__device__ __forceinline__ void store_bf(bf16* XB, size_t m, const f32x4 (&v)[4], int lane) {
    GAS unsigned long long* o8 = (GAS unsigned long long*)(XB + m * DM) + lane;
#pragma unroll
    for (int j = 0; j < 4; ++j) o8[64 * j] = (unsigned long long)pk2(v[j].x, v[j].y) | ((unsigned long long)pk2(v[j].z, v[j].w) << 32);
}
__device__ __forceinline__ void moe_tables(Frame& F, const int* CNT, bool wantPre) {
    LAS int* tot = (LAS int*)(F.lds + X_TOT); LAS int* off = (LAS int*)(F.lds + X_OFF); LAS int* pre = (LAS int*)(F.lds + X_PRE);
    const int e = F.wave;
    int carry = 0;
    for (int b0 = 0; b0 < F.G; b0 += 64) { const int blk = b0 + F.lane; const int v = (blk < F.G) ? CNT[blk * 8 + e] : 0;
        int inc = v;
#pragma unroll
        for (int o = 1; o < 64; o <<= 1) { const int t = __builtin_amdgcn_ds_bpermute(4 * (F.lane - o), inc); if (F.lane >= o) inc += t; }
        if (wantPre && blk < F.G && blk < 256) pre[blk * 8 + e] = carry + inc - v;
        carry += __builtin_amdgcn_readlane(inc, 63); }
    if (F.lane == 0) tot[e] = carry;
    LDS_WAIT(); __syncthreads();
    if (F.tid == 0) { int o = 0; for (int j = 0; j < 8; ++j) { off[j] = o; o += (tot[j] + 255) & ~255; } off[8] = o; }
    LDS_WAIT(); __syncthreads();
}

#ifndef REP_P0
#define REP_P0 1
#endif
#ifndef REP_MC
#define REP_MC 1
#endif
#ifndef REP_A
#define REP_A 1
#endif
#ifndef REP_MU
#define REP_MU 1
#endif
#ifndef REP_MD
#define REP_MD 1
#endif
#ifndef REP_B
#define REP_B 1
#endif
#ifndef REP_D
#define REP_D 1
#endif
#ifndef REP_FU
#define REP_FU 1
#endif
#ifndef REP_PM
#define REP_PM 1
#endif
#ifndef REP_LN
#define REP_LN 1
#endif
#ifndef REP_NA
#define REP_NA 1
#endif
#ifndef REP_MLA
#define REP_MLA 1
#endif
#ifndef EN_P0
#define EN_P0 1
#endif
#ifndef EN_A
#define EN_A 1
#endif
#ifndef EN_B
#define EN_B 1
#endif
#ifndef EN_C
#define EN_C 1
#endif
#ifndef EN_D
#define EN_D 1
#endif
#ifndef EN_E
#define EN_E 1
#endif
#ifndef EN_F
#define EN_F 1
#endif
#ifndef EN_G0
#define EN_G0 1
#endif
#ifndef EN_H0
#define EN_H0 1
#endif
#ifndef EN_G1
#define EN_G1 1
#endif
#ifndef EN_U1
#define EN_U1 1
#endif
#ifndef EN_D1
#define EN_D1 1
#endif
#ifndef EN_I
#define EN_I 1
#endif
__global__ void __launch_bounds__(NWAVES * 64, 2) mk_fwd(Args args) {
    extern __shared__ __attribute__((aligned(16))) unsigned char lds[];
    Frame F;
    F.lds = (LAS unsigned char*)lds;
    volatile LAS unsigned* MISC = (volatile LAS unsigned*)(F.lds + LDSCTL_OFF);
    F.tid = threadIdx.x; F.lane = F.tid & 63; F.wave = __builtin_amdgcn_readfirstlane(F.tid >> 6);
    F.G = gridDim.x; { const int bx = blockIdx.x; F.vcu = (F.G % 8 == 0) ? (bx % 8) * (F.G / 8) + bx / 8 : bx; }
    unsigned char* ws = args.ws; float* R = args.out;
    for (int u = F.tid; u < 128; u += NWAVES * 64) ((LAS unsigned*)(F.lds + LDSCTL_OFF))[u] = 0u;
    __syncthreads();
    const int lo = args.ph_lo, hi = args.ph_hi;
    const bool multi = (hi - lo) > 1;
    XcdBarrier bar; bar.bar = (unsigned*)(ws + WS_CTL) + CW_BAR; bar.x = 0; bar.st = nullptr; bar.w0 = 0;
    if (multi) bar = xcd_barrier_post((unsigned*)(ws + WS_CTL) + CW_BAR, MISC + 8);
    int ph = 0;
#define IN() (lo <= ph && ph < hi)
#define PH_BEGIN() do { int l_; asm volatile("v_mbcnt_lo_u32_b32 %0, -1, 0\n\tv_mbcnt_hi_u32_b32 %0, -1, %0" : "=v"(l_)); F.lane = l_; F.tid = F.wave * 64 + l_; } while (0)
#define SEAM() do { if (lo <= ph && ph + 1 < hi) xcd_barrier(bar); ++ph; } while (0)
    LAS unsigned char* ring = F.lds + RING_OFF;
    bf16* const XB = (bf16*)(ws + WS_XB);
    const float* const ROPE = (const float*)(ws + WS_ROPE);

    if (IN() && EN_P0) { PH_BEGIN();
        int rot = 0;
        for (int rep_ = 0; rep_ < REP_P0; ++rep_)
        for (int L = 0; L < 2; ++L) {
            bf16* WL = (bf16*)(ws + WS_W + (size_t)L * W_LAYER);
            const float* win = args.in[2] + (size_t)L * 1024 * NIN;
            bf16* WIN = (bf16*)((unsigned char*)WL + W_WIN);
            signed char* WINQ = (signed char*)WIN; float* swin = (float*)(ws + WS_SWIN) + L * NPROJ;
            trq_job(F, rot, win, 1024, NIN, 1536, WINQ, swin, 1536, 0, 0, 0, 0);
            trq_job(F, rot, win, 1024, NIN, 768, WINQ, swin, 768, 1536, 0, 1536, 0);
            trq_job(F, rot, win, 1024, NIN, 2048, WINQ, swin, 2048, 2592, 0, 2304, 0);
            trq_job(F, rot, win, 1024, NIN, 256, WINQ, swin, 256, 2304, 0, 4352, 0);
            trq_job(F, rot, win, 1024, NIN, 32, WINQ, swin, 32, 2560, 0, 4608, 0);
            { const size_t n16 = (size_t)(NPROJ - 4640) * 1024 / 16, NT = (size_t)F.G * NWAVES * 64; signed char* z = WINQ + (size_t)4640 * 1024;
              for (size_t i = (size_t)(F.vcu * NWAVES + F.wave) * 64 + F.lane; i < n16; i += NT) *(GAS v4u*)(z + i * 16) = (v4u){0u, 0u, 0u, 0u};
              for (size_t i = (size_t)(F.vcu * NWAVES + F.wave) * 64 + F.lane; i < (size_t)(NPROJ - 4640); i += NT) swin[4640 + i] = 1.f; }
            tr_job(F, rot, args.in[5] + (size_t)L * 768 * 768, 768, 768, 768, (bf16*)((unsigned char*)WL + W_WUQ), 768, 0, 0, 0, 0, args.in[4] + L * 768);
            const float* wukv = args.in[7] + (size_t)L * 256 * 1024; const float* kvg = args.in[6] + L * 256;
            tr_job(F, rot, wukv, 256, 1024, 512, (bf16*)((unsigned char*)WL + W_WUKV), 64, 0, 128, 0, 64, kvg);
            tr_job(F, rot, wukv, 256, 1024, 512, (bf16*)((unsigned char*)WL + W_WUKV), 64, 64, 128, 512, 64, kvg);
            tr_plain(F, rot, args.in[9] + (size_t)L * 512 * 1024, 512, 1024, (bf16*)((unsigned char*)WL + W_WNAO));
            tr_plain(F, rot, args.in[10] + (size_t)L * 512 * 1024, 512, 1024, (bf16*)((unsigned char*)WL + W_WMLAO));
            tr_plain(F, rot, args.in[11] + (size_t)L * 1024 * 1024, 1024, 1024, (bf16*)((unsigned char*)WL + W_WOUT));
            trq_job(F, rot, args.in[22] + (size_t)L * 1024 * 1024, 1024, 1024, 1024, (signed char*)((unsigned char*)WL + W_WPG), (float*)(ws + WS_SWPG) + L * 1024, 1024, 0, 0, 0, 0);
            tr_plain(F, rot, args.in[23] + (size_t)L * 256 * 1024, 256, 1024, (bf16*)((unsigned char*)WL + W_WPLE));
        }
        trq_job(F, rot, args.in[14], 1024, DFF, DFF, (signed char*)(ws + WS_W13), (float*)(ws + WS_SW13), 128, 0, 128, 0, 256);
        trq_job(F, rot, args.in[15], 1024, DFF, DFF, (signed char*)(ws + WS_W13), (float*)(ws + WS_SW13), 128, 0, 128, 128, 256);
        tr_plain(F, rot, args.in[16], DFF, 1024, (bf16*)(ws + WS_W2));
        { const int NT = F.G * NWAVES * 64; float* rt_ = (float*)(ws + WS_ROPE);
          for (int i = (F.vcu * NWAVES + F.wave) * 64 + F.lane; i < SEQ * 16; i += NT) { const int pos = i >> 4, k = i & 15;
              double invf = 1.0; for (int q_ = 0; q_ < k; ++q_) invf *= 0.5623413251903491;
              const double rev = (double)pos * invf * 0.15915494309189535; const float fr_ = (float)(rev - floor(rev));
              rt_[2 * i] = __builtin_amdgcn_cosf(fr_); rt_[2 * i + 1] = __builtin_amdgcn_sinf(fr_); } }
        { const int gw = F.vcu * NWAVES + F.wave, NGW = F.G * NWAVES;
          for (int m = gw; m < MTOK; m += NGW) { f32x4 v[4]; const GAS f32x4* xr = (const GAS f32x4*)(args.in[0] + (size_t)m * DM) + F.lane;
#pragma unroll
              for (int j = 0; j < 4; ++j) v[j] = xr[64 * j];
              store_bf(XB, (size_t)m, v, F.lane); store_q8((signed char*)R + (128u << 20), (float*)(ws + WS_SX), (size_t)m, v, F.lane); } }
    }
    SEAM();

    for (int L = 0; L < 2; ++L) {
        unsigned char* WL = ws + WS_W + (size_t)L * W_LAYER;
        if (IN() && EN_A) { PH_BEGIN();
            pg8::Gemm g{(const pg8::bf16_t*)((const signed char*)R + (128u << 20)), (const pg8::bf16_t*)(WL + W_WIN), MTOK, NPROJ, 512, 0, 0}; pg8::StaticOrder S; S.init(MTOK, NPROJ, F.G, (int)blockIdx.x);
            pg8::EpiProj E{(bf16*)(ws + WS_NAQKV), (bf16*)(ws + WS_QLAT), (bf16*)(ws + WS_GATES), (bf16*)(ws + WS_KVLAT), (bf16*)(ws + WS_KMLA), args.in[3] + L * 2048, ROPE, NA_QSCALE, (float*)(ws + WS_PS), (const float*)(ws + WS_SX), (const float*)(ws + WS_SWIN) + L * NPROJ, (LAS float*)(F.lds + X_SCL)};
            for (int rep_ = 0; rep_ < REP_A; ++rep_) { pg8::gemm_phase<pg8::EpiProj, pg8::StaticOrder, true, true, true>(ring, g, S, E, F.wave); __syncthreads(); }
        }
        SEAM();
        if (IN() && EN_B) { PH_BEGIN();
            for (int rep_ = 0; rep_ < REP_B; ++rep_) {
            { pg8::Gemm g{(const pg8::bf16_t*)(ws + WS_QLAT), (const pg8::bf16_t*)(WL + W_WUQ), MTOK, 768, 768}; pg8::StaticOrder S; S.init(MTOK, 768, F.G, (int)blockIdx.x);
              asm volatile("" : "+s"(S.c), "+s"(S.G)); rms_prepass(F, S, (const float*)(ws + WS_PS), 0, 12, 768); asm volatile("" : "+s"(S.c), "+s"(S.G));
              pg8::EpiQup E{(bf16*)R, (const LAS float*)(F.lds + X_RTAB), ROPE, MLA_QSCALE};
              pg8::gemm_phase<pg8::EpiQup, pg8::StaticOrder, true, true>(ring, g, S, E, F.wave); }
            __syncthreads(); PH_BEGIN();
            { pg8::Gemm g{(const pg8::bf16_t*)(ws + WS_KVLAT), (const pg8::bf16_t*)(WL + W_WUKV), MTOK, 1024, 256}; pg8::StaticOrder S; S.init(MTOK, 1024, F.G, (int)blockIdx.x);
              asm volatile("" : "+s"(S.c), "+s"(S.G)); rms_prepass(F, S, (const float*)(ws + WS_PS), 12, 4, 256); asm volatile("" : "+s"(S.c), "+s"(S.G));
              pg8::EpiKVup E{(bf16*)(ws + WS_KMLA), (bf16*)(ws + WS_VMLA), (const LAS float*)(F.lds + X_RTAB)};
              pg8::gemm_phase<pg8::EpiKVup, pg8::StaticOrder, true, true>(ring, g, S, E, F.wave); }
            __syncthreads(); }
        }
        SEAM();
        if (IN() && EN_C) { PH_BEGIN();
            const float* rpb = args.in[8] + (size_t)L * 8 * 15 * 31;
            for (int rep_ = 0; rep_ < REP_NA; ++rep_)
            for (int uid = F.vcu; uid < 2048; uid += F.G) { const int pair = uid >> 5, rg = uid & 31;
                att::na_unit(pair >> 3, pair & 7, rg, (const att::bf16*)(ws + WS_NAQKV), (att::bf16*)(ws + WS_ONA), rpb, (LAS char*)ring, F.wave); }
            for (int rep_ = 0; rep_ < REP_MLA; ++rep_)
            for (int uid = F.vcu; uid < 2048; uid += F.G) { const int pair = uid >> 5, qb = uid & 31, b = pair >> 3, h = pair & 7;
                const size_t row0 = (size_t)b * SEQ;
                att::mla_unit((const att::bf16*)R + (row0 + qb * 256) * 768 + h * 96, (const att::bf16*)(ws + WS_KMLA) + row0 * 768 + h * 96,
                              (const att::bf16*)(ws + WS_VMLA) + row0 * 512 + h * 64, (att::bf16*)(ws + WS_OMLA) + (row0 + qb * 256) * 512 + h * 64, SEQ, (LAS char*)ring, F.wave); }
        }
        SEAM();
        if (IN() && EN_D) { PH_BEGIN();
            for (int rep_ = 0; rep_ < REP_D; ++rep_) {
            pg8::StaticOrder S; S.init(MTOK, 1024, F.G, (int)blockIdx.x);
            { pg8::Gemm g{(const pg8::bf16_t*)(ws + WS_ONA), (const pg8::bf16_t*)(WL + W_WNAO), MTOK, 1024, 512};
              pg8::EpiMerge E{(const unsigned char*)(ws + WS_GATES), (pg8::bf16_t*)(ws + WS_MERGED), 0};
              pg8::gemm_phase<pg8::EpiMerge, pg8::StaticOrder, true, true>(ring, g, S, E, F.wave); }
            __syncthreads();
            { pg8::Gemm g{(const pg8::bf16_t*)(ws + WS_OMLA), (const pg8::bf16_t*)(WL + W_WMLAO), MTOK, 1024, 512};
              pg8::EpiMerge E{(const unsigned char*)(ws + WS_GATES) + 1024, (pg8::bf16_t*)(ws + WS_MERGED), 1};
              pg8::gemm_phase<pg8::EpiMerge, pg8::StaticOrder, true, true>(ring, g, S, E, F.wave); }
            __syncthreads(); }
        }
        SEAM();
        if (IN() && EN_E) { PH_BEGIN();
            { pg8::Gemm g{(const pg8::bf16_t*)(ws + WS_MERGED), (const pg8::bf16_t*)(WL + W_WOUT), MTOK, 1024, 1024}; pg8::StaticOrder S; S.init(MTOK, 1024, F.G, (int)blockIdx.x);
              pg8::EpiRes<0> E{(const pg8::bf16_t*)XB, (pg8::bf16_t*)R, nullptr, ALPHA};
              pg8::gemm_phase<pg8::EpiRes<0>, pg8::StaticOrder, true, true>(ring, g, S, E, F.wave); }
            if (L == 1) { __syncthreads(); PH_BEGIN(); int rot = 0;
                for (int rep_ = 0; rep_ < REP_MC; ++rep_)
                for (int e = 0; e < NEXP; ++e) {
                    signed char* w13 = (signed char*)(ws + WS_WM13) + (size_t)e * 2 * DFFE * 1024; float* sc13 = (float*)(ws + WS_SWM13) + (size_t)e * 2 * DFFE;
                    trq_job(F, rot, args.in[19] + (size_t)e * 1024 * DFFE, 1024, DFFE, DFFE, w13, sc13, 128, 0, 128, 0, 256);
                    trq_job(F, rot, args.in[20] + (size_t)e * 1024 * DFFE, 1024, DFFE, DFFE, w13, sc13, 128, 0, 128, 128, 256);
                    tr_plain(F, rot, args.in[21] + (size_t)e * DFFE * 1024, DFFE, 1024, (bf16*)(ws + WS_WM2) + (size_t)e * 1024 * DFFE); } }
        }
        SEAM();
        if (IN() && EN_F) { PH_BEGIN();
            f32x4 g[4], bb[4];
            { const GAS f32x4* gp = (const GAS f32x4*)(args.in[12] + L * DM) + F.lane; const GAS f32x4* bp = (const GAS f32x4*)(args.in[13] + L * DM) + F.lane;
#pragma unroll
              for (int j = 0; j < 4; ++j) { g[j] = gp[64 * j]; bb[j] = bp[64 * j]; } }
            LAS float* wrl = (LAS float*)ring; LAS int* lcnt = (LAS int*)(F.lds + X_LCNT);
            if (L == 1) { const float* wr = args.in[17];
                for (int i = F.tid; i < 1024 * 8 / 4; i += NWAVES * 64) ((LAS f32x4*)wrl)[i] = ((const GAS f32x4*)wr)[i];
                if (F.tid < 8) lcnt[F.tid] = 0;
                LDS_WAIT(); __syncthreads(); }
            const int gw = F.vcu * NWAVES + F.wave, NGW = F.G * NWAVES;
            if (REP_LN > 1) for (int m = gw; m < MTOK; m += NGW) {
                f32x4 v[4]; const GAS f32x4* xr = (const GAS f32x4*)(R + (size_t)m * DM) + F.lane;
#pragma unroll
                for (int j = 0; j < 4; ++j) v[j] = xr[64 * j];
                ln_core(v, g, bb);
                store_row((float*)(ws + WS_GATES), XB, (size_t)m, v, F.lane, true); }
            v2u raw[4];
            { const GAS v2u* p_ = (const GAS v2u*)((const bf16*)R + (size_t)gw * DM) + F.lane;
#pragma unroll
              for (int j = 0; j < 4; ++j) raw[j] = p_[64 * j]; }
            for (int m = gw; m < MTOK; m += NGW) {
                f32x4 v[4];
#pragma unroll
                for (int j = 0; j < 4; ++j) { v[j].x = bflo(raw[j].x); v[j].y = bfhi(raw[j].x); v[j].z = bflo(raw[j].y); v[j].w = bfhi(raw[j].y); }
                if (m + NGW < MTOK) { const GAS v2u* p_ = (const GAS v2u*)((const bf16*)R + (size_t)(m + NGW) * DM) + F.lane;
#pragma unroll
                    for (int j = 0; j < 4; ++j) raw[j] = p_[64 * j]; }
                ln_core(v, g, bb);
                store_bf(XB, (size_t)m, v, F.lane);
                store_q8((signed char*)R + (192u << 20), (float*)(ws + WS_SX1), (size_t)m, v, F.lane);
                if (L == 1) {
                    float lg[8];
#pragma unroll
                    for (int e = 0; e < 8; ++e) lg[e] = 0.f;
#pragma unroll
                    for (int j = 0; j < 4; ++j)
#pragma unroll
                        for (int t = 0; t < 4; ++t) { const int k = 4 * F.lane + 256 * j + t; const f32x4 w0 = *(const LAS f32x4*)(wrl + k * 8), w1 = *(const LAS f32x4*)(wrl + k * 8 + 4); const float xv = v[j][t];
                            lg[0] += xv * w0.x; lg[1] += xv * w0.y; lg[2] += xv * w0.z; lg[3] += xv * w0.w; lg[4] += xv * w1.x; lg[5] += xv * w1.y; lg[6] += xv * w1.z; lg[7] += xv * w1.w; }
#pragma unroll
                    for (int e = 0; e < 8; ++e) lg[e] = wave_sum(lg[e]) + args.in[18][e];
                    int i0 = 0; float l0 = lg[0];
#pragma unroll
                    for (int e = 1; e < 8; ++e) if (lg[e] > l0) { l0 = lg[e]; i0 = e; }
                    int i1 = -1; float l1 = -3.0e38f;
#pragma unroll
                    for (int e = 0; e < 8; ++e) if (e != i0 && lg[e] > l1) { l1 = lg[e]; i1 = e; }
                    const float w0 = 1.0f / (1.0f + __expf(l1 - l0)), w1 = 1.0f - w0;
                    if (F.lane == 0) {
                        const int lp0 = __hip_atomic_fetch_add(lcnt + i0, 1, __ATOMIC_RELAXED, __HIP_MEMORY_SCOPE_WORKGROUP), lp1 = __hip_atomic_fetch_add(lcnt + i1, 1, __ATOMIC_RELAXED, __HIP_MEMORY_SCOPE_WORKGROUP);
                        ((int*)(ws + WS_TE))[m] = i0 | (i1 << 4) | ((int)blockIdx.x << 8);
                        ((int2*)(ws + WS_TP))[m] = make_int2(lp0, lp1); ((float2*)(ws + WS_TW))[m] = make_float2(w0, w1); }
                }
            }
            if (L == 1) { LDS_WAIT(); __syncthreads(); if (F.tid < 8) ((int*)(ws + WS_CNT))[blockIdx.x * 8 + F.tid] = lcnt[F.tid]; }
            cvt_rows(F, args.in[1] + (size_t)L * MTOK * PLED, (bf16*)(ws + WS_PB), (size_t)MTOK * PLED / 8);
        }
        SEAM();
        if (L == 0) {
            if (IN() && EN_G0) { PH_BEGIN();
                { pg8::Gemm g{(const pg8::bf16_t*)((const signed char*)R + (192u << 20)), (const pg8::bf16_t*)(ws + WS_W13), MTOK, 2 * DFF, 512, 0, 0}; pg8::StaticOrder S; S.init(MTOK, 2 * DFF, F.G, (int)blockIdx.x);
                  pg8::EpiGLUQ E{(pg8::bf16_t*)(ws + WS_H), DFF, (const float*)(ws + WS_SX1), (const float*)(ws + WS_SW13), (LAS float*)(F.lds + X_SCL)};
                  for (int rep_ = 0; rep_ < REP_FU; ++rep_) { pg8::gemm_phase<pg8::EpiGLUQ, pg8::StaticOrder, true, true, true>(ring, g, S, E, F.wave); __syncthreads(); } }
                __syncthreads();
                pg8::StaticOrder S; S.init(MTOK, 1024, F.G, (int)blockIdx.x);
                { pg8::Gemm g{(const pg8::bf16_t*)((const signed char*)R + (192u << 20)), (const pg8::bf16_t*)(WL + W_WPG), MTOK, 1024, 512, 0, 0};
                  pg8::EpiGate8 E{(unsigned char*)(ws + WS_G8), (const float*)(ws + WS_SX1), (const float*)(ws + WS_SWPG) + L * 1024, (LAS float*)(F.lds + X_SCL)};
                  pg8::gemm_phase<pg8::EpiGate8, pg8::StaticOrder, true, true, true>(ring, g, S, E, F.wave); }
                __syncthreads();
                { pg8::Gemm g{(const pg8::bf16_t*)(ws + WS_PB), (const pg8::bf16_t*)(WL + W_WPLE), MTOK, 1024, 256};
                  pg8::EpiGateMul E{(const unsigned char*)(ws + WS_G8), (pg8::bf16_t*)(ws + WS_PP_DENSE)};
                  pg8::gemm_phase<pg8::EpiGateMul, pg8::StaticOrder, true, true>(ring, g, S, E, F.wave); }
            }
            SEAM();
            if (IN() && EN_H0) { PH_BEGIN();
                pg8::Gemm g{(const pg8::bf16_t*)(ws + WS_H), (const pg8::bf16_t*)(ws + WS_W2), MTOK, 1024, DFF}; pg8::StaticOrder S; S.init(MTOK, 1024, F.G, (int)blockIdx.x);
                pg8::EpiRes<2> E{(const pg8::bf16_t*)XB, (pg8::bf16_t*)R, (pg8::bf16_t*)(ws + WS_PP_DENSE), ALPHA};
                pg8::gemm_phase<pg8::EpiRes<2>, pg8::StaticOrder, true, true>(ring, g, S, E, F.wave);
            }
            SEAM();
        } else {
            if (IN() && EN_G1) { PH_BEGIN();
                moe_tables(F, (const int*)(ws + WS_CNT), true);
                if (blockIdx.x == 0 && F.tid < 9) ((int*)(ws + WS_CNT + 49152))[F.tid] = ((const LAS int*)(F.lds + X_OFF))[F.tid];
                { const LAS int* off = (const LAS int*)(F.lds + X_OFF); const LAS int* pre = (const LAS int*)(F.lds + X_PRE);
                  const int gw = F.vcu * NWAVES + F.wave, NGW = F.G * NWAVES;
                  for (int m0 = gw; m0 < MTOK; m0 += 4 * NGW) {
                      int te[4]; int2 tp[4]; float2 tw[4]; int d0[4], d1[4]; v4u ra[4], rb[4];
#pragma unroll
                      for (int q = 0; q < 4; ++q) { const int m = m0 + q * NGW; te[q] = ((const int*)(ws + WS_TE))[m]; tp[q] = ((const int2*)(ws + WS_TP))[m]; tw[q] = ((const float2*)(ws + WS_TW))[m]; }
#pragma unroll
                      for (int q = 0; q < 4; ++q) { const int m = m0 + q * NGW; ra[q] = ((const GAS v4u*)((const signed char*)R + (192u << 20) + (size_t)m * DM))[F.lane]; rb[q].x = __float_as_uint(((const float*)(ws + WS_SX1))[m]); }
#pragma unroll
                      for (int q = 0; q < 4; ++q) { const int e0 = te[q] & 15, e1 = (te[q] >> 4) & 15, blk = te[q] >> 8;
                          d0[q] = off[e0] + pre[blk * 8 + e0] + tp[q].x; d1[q] = off[e1] + pre[blk * 8 + e1] + tp[q].y; }
#pragma unroll
                      for (int q = 0; q < 4; ++q) { const int m = m0 + q * NGW;
                          ((GAS v4u*)((signed char*)R + (size_t)d0[q] * DM))[F.lane] = ra[q]; ((GAS v4u*)((signed char*)R + (size_t)d1[q] * DM))[F.lane] = ra[q];
                          if (F.lane == 0) { ((float*)(ws + WS_SW))[d0[q]] = tw[q].x; ((float*)(ws + WS_SW))[d1[q]] = tw[q].y; ((int2*)(ws + WS_TPOS))[m] = make_int2(d0[q], d1[q]);
                              ((float*)(ws + WS_SXS))[d0[q]] = __uint_as_float(rb[q].x); ((float*)(ws + WS_SXS))[d1[q]] = __uint_as_float(rb[q].x); } } } }
                __syncthreads();
                pg8::StaticOrder S; S.init(MTOK, 1024, F.G, (int)blockIdx.x);
                { pg8::Gemm g{(const pg8::bf16_t*)((const signed char*)R + (192u << 20)), (const pg8::bf16_t*)(WL + W_WPG), MTOK, 1024, 512, 0, 0};
                  pg8::EpiGate8 E{(unsigned char*)(ws + WS_G8), (const float*)(ws + WS_SX1), (const float*)(ws + WS_SWPG) + L * 1024, (LAS float*)(F.lds + X_SCL)};
                  pg8::gemm_phase<pg8::EpiGate8, pg8::StaticOrder, true, true, true>(ring, g, S, E, F.wave); }
                __syncthreads();
                { pg8::Gemm g{(const pg8::bf16_t*)(ws + WS_PB), (const pg8::bf16_t*)(WL + W_WPLE), MTOK, 1024, 256};
                  pg8::EpiGateMul E{(const unsigned char*)(ws + WS_G8), (pg8::bf16_t*)(ws + WS_PP_MOE)};
                  pg8::gemm_phase<pg8::EpiGateMul, pg8::StaticOrder, true, true>(ring, g, S, E, F.wave); }
            }
            SEAM();
            for (int c = 0; c < MOE_NCHUNK; ++c) {
                if (IN() && EN_U1) { PH_BEGIN();
                    if (F.tid < 9) ((LAS int*)(F.lds + X_OFF))[F.tid] = ((const int*)(ws + WS_CNT + 49152))[F.tid];
                    LDS_WAIT(); __syncthreads();
                    const LAS int* off = (const LAS int*)(F.lds + X_OFF);
                    const int NT = __builtin_amdgcn_readfirstlane(off[8]) >> 8; const int capU = (c == MOE_NCHUNK - 1) ? MOE_CHUNK + MOE_REMT : MOE_CHUNK;
                    int nMc = NT - c * MOE_CHUNK; nMc = nMc < 0 ? 0 : (nMc > capU ? capU : nMc);
                    pg8::MoeOrder<true> S; S.nMc = nMc; S.nN = 2 * DFFE / 256; S.nwg = nMc * S.nN; S.G = F.G; S.c = (int)blockIdx.x; S.t0 = c * MOE_CHUNK;
                    S.ts1 = __builtin_amdgcn_readfirstlane(off[1]) >> 8; S.ts2 = __builtin_amdgcn_readfirstlane(off[2]) >> 8; S.ts3 = __builtin_amdgcn_readfirstlane(off[3]) >> 8; S.ts4 = __builtin_amdgcn_readfirstlane(off[4]) >> 8;
                    S.ts5 = __builtin_amdgcn_readfirstlane(off[5]) >> 8; S.ts6 = __builtin_amdgcn_readfirstlane(off[6]) >> 8; S.ts7 = __builtin_amdgcn_readfirstlane(off[7]) >> 8;
                    pg8::Gemm g{(const pg8::bf16_t*)R, (const pg8::bf16_t*)(ws + WS_WM13), MOE_MAXT * 256, 2 * DFFE, 512, 0, 0};
                    pg8::EpiGLUQ E{(pg8::bf16_t*)(ws + WS_HS), DFFE, (const float*)(ws + WS_SXS), (const float*)(ws + WS_SWM13), (LAS float*)(F.lds + X_SCL)};
                    for (int rep_ = 0; rep_ < REP_MU; ++rep_) { pg8::gemm_phase<pg8::EpiGLUQ, pg8::MoeOrder<true>, true, true, true>(ring, g, S, E, F.wave); __syncthreads(); }
                }
                SEAM();
                if (IN() && EN_D1) { PH_BEGIN();
                    if (F.tid < 9) ((LAS int*)(F.lds + X_OFF))[F.tid] = ((const int*)(ws + WS_CNT + 49152))[F.tid];
                    LDS_WAIT(); __syncthreads();
                    const LAS int* off = (const LAS int*)(F.lds + X_OFF);
                    const int NT = __builtin_amdgcn_readfirstlane(off[8]) >> 8; int nMc = NT - c * MOE_CHUNK; nMc = nMc < 0 ? 0 : (nMc > MOE_CHUNK ? MOE_CHUNK : nMc);
                    const int t1 = __builtin_amdgcn_readfirstlane(off[1]) >> 8, t2 = __builtin_amdgcn_readfirstlane(off[2]) >> 8, t3 = __builtin_amdgcn_readfirstlane(off[3]) >> 8, t4 = __builtin_amdgcn_readfirstlane(off[4]) >> 8,
                              t5 = __builtin_amdgcn_readfirstlane(off[5]) >> 8, t6 = __builtin_amdgcn_readfirstlane(off[6]) >> 8, t7 = __builtin_amdgcn_readfirstlane(off[7]) >> 8;
                    {
                        pg8::MoeOrder<false> S; S.nMc = nMc; S.nN = 4; S.nwg = nMc * 4; S.G = F.G; S.c = (int)blockIdx.x; S.t0 = c * MOE_CHUNK;
                        S.ts1 = t1; S.ts2 = t2; S.ts3 = t3; S.ts4 = t4; S.ts5 = t5; S.ts6 = t6; S.ts7 = t7;
                        pg8::Gemm g{(const pg8::bf16_t*)(ws + WS_HS), (const pg8::bf16_t*)(ws + WS_WM2), MOE_CHUNK * 256, 1024, DFFE, 0, 0};
                        pg8::EpiMoeDown E{(pg8::bf16_t*)(ws + WS_XS), (const float*)(ws + WS_SW)};
                        for (int rep_ = 0; rep_ < REP_MD; ++rep_) { pg8::gemm_phase<pg8::EpiMoeDown, pg8::MoeOrder<false>, true, true>(ring, g, S, E, F.wave); __syncthreads(); }
                    }
                    if (c == MOE_NCHUNK - 1) {
                        PH_BEGIN();
                        pg8::MoeRemOrder S; S.nT = NT - MOE_FULL; S.G = F.G; S.c = (int)blockIdx.x; S.t0 = MOE_FULL; S.KQ = DFFE / 4; S.pa0 = MOE_CHUNK;
                        S.ts1 = t1; S.ts2 = t2; S.ts3 = t3; S.ts4 = t4; S.ts5 = t5; S.ts6 = t6; S.ts7 = t7;
                        pg8::Gemm g{(const pg8::bf16_t*)(ws + WS_HS), (const pg8::bf16_t*)(ws + WS_WM2), MOE_REM_ROWS, 1024, DFFE / 4, DFFE, DFFE};
                        pg8::EpiMoeRem E{(pg8::bf16_t*)(ws + WS_PART), (const float*)(ws + WS_SW), MOE_FULL, MOE_REM_ROWS};
                        pg8::gemm_phase<pg8::EpiMoeRem, pg8::MoeRemOrder, true, true>(ring, g, S, E, F.wave);
                    }
                }
                SEAM();
            }
        }
        if (L == 1) {
            if (IN() && EN_I) { PH_BEGIN();
                if (F.tid < 9) ((LAS int*)(F.lds + X_OFF))[F.tid] = ((const int*)(ws + WS_CNT + 49152))[F.tid];
                LDS_WAIT(); __syncthreads();
                const int nrem = (__builtin_amdgcn_readfirstlane(((const LAS int*)(F.lds + X_OFF))[8]) >> 8) - MOE_FULL;
                const int gw = F.vcu * NWAVES + F.wave, NGW = F.G * NWAVES;
                for (int r = gw; r < nrem * 256; r += NGW) {
                    const GAS v2u* pp = (const GAS v2u*)((const bf16*)(ws + WS_PART) + (size_t)r * DM) + F.lane; GAS v2u* dst = (GAS v2u*)((bf16*)(ws + WS_XS) + (size_t)(MOE_FULL * 256 + r) * DM) + F.lane;
#pragma unroll
                    for (int j = 0; j < 4; ++j) { float s0 = 0.f, s1 = 0.f, s2 = 0.f, s3 = 0.f;
#pragma unroll
                        for (int q = 0; q < 4; ++q) { const v2u a = pp[(size_t)q * MOE_REM_ROWS * DM / 4 + 64 * j]; s0 += bflo(a.x); s1 += bfhi(a.x); s2 += bflo(a.y); s3 += bfhi(a.y); }
                        v2u o; o.x = pk2(s0, s1); o.y = pk2(s2, s3); dst[64 * j] = o; }
                }
            }
            SEAM();
        }
        if (IN() && EN_I) { PH_BEGIN();
            f32x4 g[4], bb[4];
            { const GAS f32x4* gp = (const GAS f32x4*)(args.in[24] + L * DM) + F.lane; const GAS f32x4* bp = (const GAS f32x4*)(args.in[25] + L * DM) + F.lane;
#pragma unroll
              for (int j = 0; j < 4; ++j) { g[j] = gp[64 * j]; bb[j] = bp[64 * j]; } }
            const int gw = F.vcu * NWAVES + F.wave, NGW = F.G * NWAVES;
            const bool tmo = (L == 1) && (__hip_atomic_load((unsigned*)(ws + WS_CTL) + CW_BAR + XB_TMO, __ATOMIC_RELAXED, __HIP_MEMORY_SCOPE_AGENT) != 0u);
            if (L == 0) {
                v2u rx[4];
                { const GAS v2u* p_ = (const GAS v2u*)((const bf16*)R + (size_t)gw * DM) + F.lane;
#pragma unroll
                  for (int j = 0; j < 4; ++j) rx[j] = p_[64 * j]; }
                for (int m = gw; m < MTOK; m += NGW) {
                    f32x4 v[4];
#pragma unroll
                    for (int j = 0; j < 4; ++j) { v[j].x = bflo(rx[j].x); v[j].y = bfhi(rx[j].x); v[j].z = bflo(rx[j].y); v[j].w = bfhi(rx[j].y); }
                    if (m + NGW < MTOK) { const GAS v2u* p_ = (const GAS v2u*)((const bf16*)R + (size_t)(m + NGW) * DM) + F.lane;
#pragma unroll
                        for (int j = 0; j < 4; ++j) rx[j] = p_[64 * j]; }
                    ln_core(v, g, bb);
                    store_bf(XB, (size_t)m, v, F.lane); store_q8((signed char*)R + (128u << 20), (float*)(ws + WS_SX), (size_t)m, v, F.lane);
                }
            } else {
                v2u rx[4], rp[4], ra[4], rb[4]; int2 tpn = ((const int2*)(ws + WS_TPOS))[gw];
#define LN2_LOAD(mm, tp_) do { const GAS v2u* x1 = (const GAS v2u*)(XB + (size_t)(mm) * DM) + F.lane; const GAS v2u* pl = (const GAS v2u*)((const bf16*)(ws + WS_PP_MOE) + (size_t)(mm) * DM) + F.lane; \
        const GAS v2u* f0 = (const GAS v2u*)((const bf16*)(ws + WS_XS) + (size_t)(tp_).x * DM) + F.lane; const GAS v2u* f1 = (const GAS v2u*)((const bf16*)(ws + WS_XS) + (size_t)(tp_).y * DM) + F.lane; \
        _Pragma("unroll") for (int j = 0; j < 4; ++j) { rx[j] = x1[64 * j]; rp[j] = pl[64 * j]; ra[j] = f0[64 * j]; rb[j] = f1[64 * j]; } } while (0)
                LN2_LOAD(gw, tpn);
                if (gw + NGW < MTOK) tpn = ((const int2*)(ws + WS_TPOS))[gw + NGW];
                for (int m = gw; m < MTOK; m += NGW) {
                    f32x4 v[4];
#pragma unroll
                    for (int j = 0; j < 4; ++j) { const v2u x = rx[j], p = rp[j], a = ra[j], b = rb[j];
                        v[j].x = ALPHA * bflo(x.x) + bflo(p.x) + (bflo(a.x) + bflo(b.x)); v[j].y = ALPHA * bfhi(x.x) + bfhi(p.x) + (bfhi(a.x) + bfhi(b.x));
                        v[j].z = ALPHA * bflo(x.y) + bflo(p.y) + (bflo(a.y) + bflo(b.y)); v[j].w = ALPHA * bfhi(x.y) + bfhi(p.y) + (bfhi(a.y) + bfhi(b.y)); }
                    if (m + NGW < MTOK) { LN2_LOAD(m + NGW, tpn); if (m + 2 * NGW < MTOK) tpn = ((const int2*)(ws + WS_TPOS))[m + 2 * NGW]; }
                    ln_core(v, g, bb);
                    if (tmo) { const float qn = __builtin_nanf("");
#pragma unroll
                        for (int j = 0; j < 4; ++j) v[j] = (f32x4){qn, qn, qn, qn}; }
                    store_row(R, XB, (size_t)m, v, F.lane, false);
                }
            }
        }
        if (L == 0) SEAM();
    }
#undef LN2_LOAD
#undef IN
#undef SEAM
}

constexpr int N_PHASES = 27;
#ifndef MK_ONE_LAUNCH
#define MK_ONE_LAUNCH 1
#endif
extern "C" void kernel_launch(void* const* d_in, const int* in_sizes, int n_in, void* d_out, int out_size, void* d_ws, size_t ws_size, hipStream_t stream) {
    static int grid = 0;
    if (grid == 0) {
        if (n_in != 26 || in_sizes[0] != MTOK * DM || out_size != MTOK * DM || ws_size < WS_END) {
            fprintf(stderr, "kernel_launch: shape mismatch: n_in %d in0 %d out %d ws %zu (need %zu)\n", n_in, n_in > 0 ? in_sizes[0] : -1, out_size, ws_size, (size_t)WS_END); grid = -1; return; }
        int dev = 0, cus = 0, per_cu = 0;
        if (hipGetDevice(&dev) != hipSuccess || hipDeviceGetAttribute(&cus, hipDeviceAttributeMultiprocessorCount, dev) != hipSuccess) { fprintf(stderr, "kernel_launch: device query failed\n"); grid = -1; return; }
        if (hipFuncSetAttribute((const void*)mk_fwd, hipFuncAttributeMaxDynamicSharedMemorySize, LDS_BYTES) != hipSuccess) { fprintf(stderr, "kernel_launch: hipFuncSetAttribute failed\n"); grid = -1; return; }
        if (hipOccupancyMaxActiveBlocksPerMultiprocessor(&per_cu, (const void*)mk_fwd, NWAVES * 64, LDS_BYTES) != hipSuccess || per_cu < 1)
            fprintf(stderr, "kernel_launch: note: occupancy query reports %d workgroups per CU\n", per_cu);
        (void)hipGetLastError();
        grid = cus > 256 ? 256 : cus;
    }
    if (grid < 0) return;
    if (hipMemsetAsync((char*)d_ws + WS_CTL, 0, CTL_ZERO_BYTES, stream) != hipSuccess) { fprintf(stderr, "kernel_launch: memset failed\n"); return; }
    Args a{};
    for (int i = 0; i < 26; ++i) a.in[i] = (const float*)d_in[i];
    a.out = (float*)d_out; a.ws = (unsigned char*)d_ws;
#if MK_ONE_LAUNCH
    a.ph_lo = 0; a.ph_hi = N_PHASES;
    hipLaunchKernelGGL(mk_fwd, dim3(grid), dim3(NWAVES * 64), LDS_BYTES, stream, a);
#else
    for (int p = 0; p < N_PHASES; ++p) { a.ph_lo = p; a.ph_hi = p + 1; hipLaunchKernelGGL(mk_fwd, dim3(grid), dim3(NWAVES * 64), LDS_BYTES, stream, a); }
#endif
    const hipError_t le = hipPeekAtLastError();
    if (le != hipSuccess) fprintf(stderr, "kernel_launch: launch failed: %s (grid %d)\n", hipGetErrorName(le), grid);
}
```

```cpp
#include <hip/hip_runtime.h>
#include <cstdio>
#include <cstdint>
#include <cmath>
#ifndef PG8_WGM
#define PG8_WGM 8
#endif
namespace pg8 {
#define PG8_LAS __attribute__((address_space(3)))
typedef unsigned short bf16_t;
typedef short bf16x8 __attribute__((ext_vector_type(8)));
typedef float f32x4 __attribute__((ext_vector_type(4)));
typedef unsigned u32x4 __attribute__((ext_vector_type(4)));
typedef int i32x4 __attribute__((ext_vector_type(4)));
constexpr int BM = 256, BK = 64, HALF = 128, HTB = HALF * BK * 2  , STAGE_BYTES = 8 * HTB, NXCD = 8, WGM = PG8_WGM;

__host__ __device__ __forceinline__ int lds_byte(int r, int c) { const int st = (r >> 4) * 2 + (c >> 5), rr = r & 15, cc = c & 31, ob = rr * 64 + cc * 2; return st * 1024 + (ob ^ (((ob >> 9) & 1) << 5)); }
__host__ __device__ __forceinline__ void stage_rc(int b, int& R, int& C) { const int st = b / 1024, sb = b % 1024, swz = sb ^ (((sb >> 9) & 1) << 5); R = (st >> 1) * 16 + swz / 64; C = (st & 1) * 32 + (swz % 64) / 2; }
__host__ __device__ __forceinline__ int perm32(int rho) { const int n = rho >> 4, i = rho & 15; return 8 * (i >> 2) + 4 * n + (i & 3); }

struct Unit { int pm, pn, pa, pb, slot, kofs, aux; };
struct Gemm { const bf16_t* A; const bf16_t* Bt; int M, N, K; int lda, ldb; };

struct StaticOrder {
    int nM, nN, nwg, G, c;
    __host__ __device__ void init(int M, int N, int G_, int c_) { nM = M / BM; nN = N / BM; nwg = nM * nN; G = G_; c = c_; }
    __host__ __device__ bool next(int i, Unit& u) const {
        const long L = (long)i * G + c; if (L >= nwg) return false;
        int wgid = (int)L; { const int q = nwg / NXCD, r = nwg % NXCD, xcd = wgid % NXCD, off = wgid / NXCD; wgid = (xcd < r ? xcd * (q + 1) : r * (q + 1) + (xcd - r) * q) + off; }
        const int nig = WGM * nN, gid = wgid / nig, fm = gid * WGM, gsz = (nM - fm) < WGM ? (nM - fm) : WGM;
        u.pm = fm + ((wgid % nig) % gsz); u.pn = (wgid % nig) / gsz; u.pa = u.pm; u.pb = u.pn; u.slot = i; u.kofs = 0; u.aux = 0; return true;
    }
    __device__ __forceinline__ void a_ready(const Unit&) const {}
    __device__ __forceinline__ void done(const Unit&) const {}
};

__device__ __forceinline__ unsigned cvt_pk_bf16(float lo, float hi) { unsigned r; asm volatile("v_cvt_pk_bf16_f32 %0, %1, %2" : "=v"(r) : "v"(lo), "v"(hi)); return r; }
typedef float f32x2 __attribute__((ext_vector_type(2)));
__device__ __forceinline__ f32x2 gelu_pk(f32x2 v) {
    const f32x2 av = __builtin_elementwise_abs(v), d = av * 0.2316418882f + 1.0f;
    f32x2 t; t.x = __builtin_amdgcn_rcpf(d.x); t.y = __builtin_amdgcn_rcpf(d.y);
    f32x2 q = t * 0.5307027145f + (-0.7265760135f); q = q * t + 0.7107068705f; q = q * t + (-0.142248368f); q = q * t + 0.127414796f; q = q * t;
    const f32x2 s = (v * v) * (-0.72134752044f);
    f32x2 e; e.x = __builtin_amdgcn_exp2f(s.x); e.y = __builtin_amdgcn_exp2f(s.y);
    const f32x2 m = v * (q * e), r = v - m;
    f32x2 o; o.x = v.x < 0.f ? m.x : r.x; o.y = v.y < 0.f ? m.y : r.y; return o;
}

template <int ACT  > struct EpiBf16 {
    static constexpr bool PERM = true, AFTER_DRAIN = false, SCALES = false; static_assert(ACT == 0 || ACT == 1, "EpiBf16: ACT is 0 (none) or 1 (gelu_pk)");
    bf16_t* O; int ldc; const float* bias; int split_cols; size_t split_stride; float scale0;
    __device__ __forceinline__ void operator()(const f32x4 (&acc)[2][2][4][2], const Unit& u, int wr, int wc, int fr, int fq) const {
        const int row0 = u.pm * BM + wr * 64 + fr; int colt = u.pn * BM; bf16_t* base = O;
        float sc = 1.f; if (split_cols) { const int t = colt / split_cols; base += (size_t)t * split_stride; colt -= t * split_cols; if (t == 0) sc = scale0; }
        const int col0 = colt + wc * 32 + 8 * fq, bcol0 = u.pn * BM + wc * 32 + 8 * fq;
        f32x4 bv[2][2];
#pragma unroll
        for (int bj = 0; bj < 2; ++bj)
#pragma unroll
            for (int n = 0; n < 2; ++n) bv[bj][n] = bias ? *(const f32x4*)(bias + bcol0 + bj * HALF + 4 * n) : (f32x4){0.f, 0.f, 0.f, 0.f};
#pragma unroll
        for (int ai = 0; ai < 2; ++ai)
#pragma unroll
            for (int m = 0; m < 4; ++m) { bf16_t* rowp = base + (size_t)(row0 + ai * HALF + m * 16) * ldc + col0;
#pragma unroll
                for (int bj = 0; bj < 2; ++bj) { f32x4 v0 = acc[ai][bj][m][0] + bv[bj][0], v1 = acc[ai][bj][m][1] + bv[bj][1];
                    if (ACT == 1) { f32x2 a = gelu_pk((f32x2){v0[0], v0[1]}), b = gelu_pk((f32x2){v0[2], v0[3]}), c = gelu_pk((f32x2){v1[0], v1[1]}), d = gelu_pk((f32x2){v1[2], v1[3]});
                        v0 = (f32x4){a.x, a.y, b.x, b.y}; v1 = (f32x4){c.x, c.y, d.x, d.y}; }
                    v0 = v0 * sc; v1 = v1 * sc; u32x4 w; w.x = cvt_pk_bf16(v0[0], v0[1]); w.y = cvt_pk_bf16(v0[2], v0[3]); w.z = cvt_pk_bf16(v1[0], v1[1]); w.w = cvt_pk_bf16(v1[2], v1[3]);
                    *(u32x4*)(rowp + bj * HALF) = w; } }
    }
};

template <class Epi, class Sched, bool ALIGN_EPI = false, bool SP2 = false, bool I8 = false>
__device__ __forceinline__ void gemm_phase(PG8_LAS unsigned char* lds, const Gemm g, const Sched& S, const Epi& E, const int wave_id) {
    int lane_; asm volatile("v_mbcnt_lo_u32_b32 %0, -1, 0\n\tv_mbcnt_hi_u32_b32 %0, -1, %0" : "=v"(lane_));
    int w_ = wave_id; asm volatile("" : "+s"(w_));
    const int wid = w_, lane = lane_, tid = wid * 64 + lane, wr = wid >> 2, wc = wid & 3, fr = lane & 15, fq = lane >> 4;
    int K_ = g.K; asm volatile("" : "+s"(K_)); const int K = K_, nt = K / BK; int la_ = g.lda ? g.lda : g.K, lb_ = g.ldb ? g.ldb : g.K; asm volatile("" : "+s"(la_), "+s"(lb_)); const int lda = la_, ldb = lb_;
    unsigned voffA[2], voffB[2];
#pragma unroll
    for (int i = 0; i < 2; ++i) { int R, C; stage_rc(tid * 16 + i * 8192, R, C); const int Rb = Epi::PERM ? ((R & ~31) + perm32(R & 31)) : R;
        voffA[i] = (unsigned)(R * lda + C) * 2u; voffB[i] = (unsigned)(Rb * ldb + C) * 2u; }
    const size_t kstep = (size_t)(BK * 2);
    const size_t hstepA = (size_t)HALF * lda * 2, hstepB = (size_t)HALF * ldb * 2;
    const size_t tstepA = 2 * hstepA, tstepB = 2 * hstepB;
    const unsigned ldsw = (unsigned)wid * 1024u;
    const int aoff = lds_byte(wr * 64 + fr, fq * 8), boff = lds_byte(wc * 32 + fr, fq * 8);
#define PG8_SA(b, h) (((b) * 2 + (h)) * HTB)
#define PG8_SB(b, h) ((4 + (b) * 2 + (h)) * HTB)
#define PG8_STAGE(bufoff, gbase, voff) do { _Pragma("unroll") for (int _i = 0; _i < 2; ++_i) \
        __builtin_amdgcn_global_load_lds((const unsigned*)((const char*)(gbase) + (voff)[_i]), (PG8_LAS unsigned*)(lds + (bufoff) + ldsw + _i * 8192), 16, 0, 0); } while (0)
#define PG8_LDA(dst, b, h) do { _Pragma("unroll") for (int m = 0; m < 4; ++m) _Pragma("unroll") for (int k = 0; k < 2; ++k) dst[m][k] = *(const PG8_LAS bf16x8*)(lds + PG8_SA(b, h) + aoff + m * 2048 + k * 1024); } while (0)
#define PG8_LDB(dst, b, h) do { _Pragma("unroll") for (int n = 0; n < 2; ++n) _Pragma("unroll") for (int k = 0; k < 2; ++k) dst[n][k] = *(const PG8_LAS bf16x8*)(lds + PG8_SB(b, h) + boff + n * 2048 + k * 1024); } while (0)
#define PG8_MMA(ai, bj, At, Bt) do { __builtin_amdgcn_s_setprio(1); _Pragma("unroll") for (int m = 0; m < 4; ++m) _Pragma("unroll") for (int n = 0; n < 2; ++n) _Pragma("unroll") for (int k = 0; k < 2; ++k) \
        { if constexpr (I8) acc[ai][bj][m][n] = __builtin_bit_cast(f32x4, __builtin_amdgcn_mfma_i32_16x16x64_i8(__builtin_bit_cast(i32x4, Bt[n][k]), __builtin_bit_cast(i32x4, At[m][k]), __builtin_bit_cast(i32x4, acc[ai][bj][m][n]), 0, 0, 0)); \
          else acc[ai][bj][m][n] = __builtin_amdgcn_mfma_f32_16x16x32_bf16(Bt[n][k], At[m][k], acc[ai][bj][m][n], 0, 0, 0); } __builtin_amdgcn_s_setprio(0); } while (0)
#define PG8_WAIT_V(n) asm volatile("s_waitcnt vmcnt(" #n ")" ::: "memory")
#define PG8_WAIT_L(n) asm volatile("s_waitcnt lgkmcnt(" #n ")" ::: "memory")
#define PG8_BAR __builtin_amdgcn_s_barrier()
#define PG8_SCHED __builtin_amdgcn_sched_barrier(0)
    Unit cur, nxt; int ui = 0;
    if (!S.next(0, cur)) return;
    f32x4 acc[2][2][4][2];
    bf16x8 At[4][2], B0[2][2], B1[2][2];
    const char* cA = (const char*)g.A + (size_t)cur.pa * tstepA + (size_t)cur.kofs * 2; const char* cB = (const char*)g.Bt + (size_t)cur.pb * tstepB + (size_t)cur.kofs * 2;
    S.a_ready(cur);
    if constexpr (Epi::SCALES) E.prefetch(cur, wid, lane);
    if constexpr (SP2) {
        PG8_STAGE(PG8_SB(0, 0), cB, voffB); PG8_STAGE(PG8_SB(0, 1), cB + hstepB, voffB); PG8_STAGE(PG8_SA(0, 0), cA, voffA); PG8_STAGE(PG8_SA(0, 1), cA + hstepA, voffA);
        if (wr == 1) PG8_BAR;
        PG8_WAIT_V(2); PG8_BAR;
        PG8_STAGE(PG8_SB(1, 0), cB + kstep, voffB); PG8_STAGE(PG8_SA(1, 0), cA + kstep, voffA); PG8_STAGE(PG8_SB(1, 1), cB + hstepB + kstep, voffB);
        PG8_WAIT_V(6); PG8_BAR;
    } else {
        PG8_STAGE(PG8_SB(0, 0), cB, voffB); PG8_STAGE(PG8_SA(0, 0), cA, voffA); PG8_STAGE(PG8_SB(0, 1), cB + hstepB, voffB); PG8_STAGE(PG8_SA(0, 1), cA + hstepA, voffA);
        if (wr == 1) PG8_BAR;
        PG8_WAIT_V(4); PG8_BAR;
        PG8_STAGE(PG8_SB(1, 0), cB + kstep, voffB); PG8_STAGE(PG8_SA(1, 0), cA + kstep, voffA); PG8_STAGE(PG8_SB(1, 1), cB + hstepB + kstep, voffB);
        PG8_WAIT_V(6); PG8_BAR;
    }
    for (;;) {
#pragma unroll
        for (int a = 0; a < 2; ++a)
#pragma unroll
            for (int b = 0; b < 2; ++b)
#pragma unroll
                for (int m = 0; m < 4; ++m)
#pragma unroll
                    for (int n = 0; n < 2; ++n) acc[a][b][m][n] = (f32x4){0.f, 0.f, 0.f, 0.f};
        const bool has_next = S.next(ui + 1, nxt);
        const char* nA = has_next ? (const char*)g.A + (size_t)nxt.pa * tstepA + (size_t)nxt.kofs * 2 : cA; const char* nB = has_next ? (const char*)g.Bt + (size_t)nxt.pb * tstepB + (size_t)nxt.kofs * 2 : cB;
        int t = 0; do {
            const bool last = (t == nt - 2);
            const char* a1 = cA + (size_t)(t + 1) * kstep;
            const char* a2 = last ? nA : cA + (size_t)(t + 2) * kstep; const char* b2 = last ? nB : cB + (size_t)(t + 2) * kstep;
            const char* a3 = a2 + kstep; const char* b3 = b2 + kstep;
            if (last && has_next) { S.a_ready(nxt); if constexpr (Epi::SCALES) E.prefetch(nxt, wid, lane); }
            if constexpr (SP2) {
            PG8_LDB(B0, 0, 0); PG8_LDB(B1, 0, 1); PG8_SCHED; PG8_LDA(At, 0, 0); PG8_STAGE(PG8_SA(1, 1), a1 + hstepA, voffA);
            PG8_WAIT_V(8); PG8_WAIT_L(0); PG8_BAR; PG8_MMA(0, 0, At, B0); PG8_MMA(0, 1, At, B1); PG8_BAR; PG8_SCHED;
            PG8_LDA(At, 0, 1); PG8_STAGE(PG8_SB(0, 0), b2, voffB); PG8_STAGE(PG8_SB(0, 1), b2 + hstepB, voffB); PG8_STAGE(PG8_SA(0, 0), a2, voffA);
            PG8_WAIT_V(8); PG8_WAIT_L(0); PG8_BAR; PG8_MMA(1, 0, At, B0); PG8_MMA(1, 1, At, B1); PG8_BAR; PG8_SCHED;
            PG8_LDB(B0, 1, 0); PG8_LDB(B1, 1, 1); PG8_SCHED; PG8_LDA(At, 1, 0); PG8_STAGE(PG8_SA(0, 1), a2 + hstepA, voffA);
            PG8_WAIT_V(8); PG8_WAIT_L(0); PG8_BAR; PG8_MMA(0, 0, At, B0); PG8_MMA(0, 1, At, B1); PG8_BAR; PG8_SCHED;
            PG8_LDA(At, 1, 1); PG8_STAGE(PG8_SB(1, 0), b3, voffB); PG8_STAGE(PG8_SB(1, 1), b3 + hstepB, voffB); PG8_STAGE(PG8_SA(1, 0), a3, voffA);
            PG8_WAIT_V(8); PG8_WAIT_L(0); PG8_BAR; PG8_MMA(1, 0, At, B0); PG8_MMA(1, 1, At, B1); PG8_BAR; PG8_SCHED;
            } else {
            PG8_LDB(B0, 0, 0); PG8_SCHED; PG8_LDA(At, 0, 0); PG8_STAGE(PG8_SA(1, 1), a1 + hstepA, voffA);
            PG8_WAIT_L(8); PG8_BAR; PG8_WAIT_L(0); PG8_MMA(0, 0, At, B0); PG8_BAR; PG8_SCHED;
            PG8_LDB(B1, 0, 1); PG8_STAGE(PG8_SB(0, 0), b2, voffB);
            PG8_BAR; PG8_WAIT_L(0); PG8_MMA(0, 1, At, B1); PG8_BAR;
            PG8_LDA(At, 0, 1); PG8_STAGE(PG8_SA(0, 0), a2, voffA);
            PG8_BAR; PG8_WAIT_L(0); PG8_MMA(1, 0, At, B0); PG8_BAR; PG8_SCHED;
            PG8_STAGE(PG8_SB(0, 1), b2 + hstepB, voffB);
            PG8_WAIT_V(6); PG8_BAR; PG8_MMA(1, 1, At, B1); PG8_BAR;
            PG8_LDB(B0, 1, 0); PG8_SCHED; PG8_LDA(At, 1, 0); PG8_STAGE(PG8_SA(0, 1), a2 + hstepA, voffA);
            PG8_WAIT_L(8); PG8_BAR; PG8_WAIT_L(0); PG8_MMA(0, 0, At, B0); PG8_BAR; PG8_SCHED;
            PG8_LDB(B1, 1, 1); PG8_STAGE(PG8_SB(1, 0), b3, voffB);
            PG8_BAR; PG8_WAIT_L(0); PG8_MMA(0, 1, At, B1); PG8_BAR;
            PG8_LDA(At, 1, 1); PG8_STAGE(PG8_SA(1, 0), a3, voffA);
            PG8_BAR; PG8_WAIT_L(0); PG8_MMA(1, 0, At, B0); PG8_BAR; PG8_SCHED;
            PG8_STAGE(PG8_SB(1, 1), b3 + hstepB, voffB);
            PG8_WAIT_V(6); PG8_BAR; PG8_MMA(1, 1, At, B1); PG8_BAR;
            }
        t += 2; } while (t < nt);
        if constexpr (ALIGN_EPI) { if (wr == 0) PG8_BAR; }
        if constexpr (!Epi::AFTER_DRAIN) { E(acc, cur, wr, wc, fr, fq); S.done(cur); }
        if (!has_next) break;
        cur = nxt; cA = nA; cB = nB; ++ui;
        if constexpr (ALIGN_EPI) { if (wr == 1) PG8_BAR; }
    }
    PG8_WAIT_V(0);
    if constexpr (!ALIGN_EPI) { if (wr == 0) PG8_BAR; }
    PG8_BAR;
    if constexpr (Epi::AFTER_DRAIN) { E.fused(acc, cur, wr, wc, fr, fq, lds, wid, lane); S.done(cur); }
#undef PG8_SA
#undef PG8_SB
#undef PG8_STAGE
#undef PG8_LDA
#undef PG8_LDB
#undef PG8_MMA
#undef PG8_WAIT_V
#undef PG8_WAIT_L
#undef PG8_BAR
#undef PG8_SCHED
}
}
#ifndef EPI_FENCE_GRP
#define EPI_FENCE_GRP 8
#endif
namespace pg8 {
typedef unsigned u32x2 __attribute__((ext_vector_type(2)));
__device__ __forceinline__ float sigm(float x) { return __builtin_amdgcn_rcpf(1.0f + __builtin_amdgcn_exp2f(-1.4426950408889634f * x)); }
__device__ __forceinline__ void sigm8(f32x4& a, f32x4& b) {
    f32x4 ea = a * -1.4426950408889634f, eb = b * -1.4426950408889634f;
#pragma unroll
    for (int j = 0; j < 4; ++j) ea[j] = __builtin_amdgcn_exp2f(ea[j]);
#pragma unroll
    for (int j = 0; j < 4; ++j) eb[j] = __builtin_amdgcn_exp2f(eb[j]);
    ea = ea + 1.0f; eb = eb + 1.0f;
#pragma unroll
    for (int j = 0; j < 4; ++j) ea[j] = __builtin_amdgcn_rcpf(ea[j]);
#pragma unroll
    for (int j = 0; j < 4; ++j) eb[j] = __builtin_amdgcn_rcpf(eb[j]);
    a = ea; b = eb;
}
__device__ __forceinline__ u32x4 pack8(const f32x4& v0, const f32x4& v1) { u32x4 w; w.x = cvt_pk_bf16(v0[0], v0[1]); w.y = cvt_pk_bf16(v0[2], v0[3]); w.z = cvt_pk_bf16(v1[0], v1[1]); w.w = cvt_pk_bf16(v1[2], v1[3]); return w; }
__device__ __forceinline__ void unpack8(const u32x4& w, f32x4& v0, f32x4& v1) {
    v0[0] = __uint_as_float(w.x << 16); v0[1] = __uint_as_float(w.x & 0xffff0000u); v0[2] = __uint_as_float(w.y << 16); v0[3] = __uint_as_float(w.y & 0xffff0000u);
    v1[0] = __uint_as_float(w.z << 16); v1[1] = __uint_as_float(w.z & 0xffff0000u); v1[2] = __uint_as_float(w.w << 16); v1[3] = __uint_as_float(w.w & 0xffff0000u); }
__device__ __forceinline__ f32x4 i2f4(const f32x4& x) { return __builtin_convertvector(__builtin_bit_cast(i32x4, x), f32x4); }
struct RopeTab { f32x4 c0, c1, c2, c3; };
__device__ __forceinline__ RopeTab rope_load(const float* tab, int fq) { const float* t = tab + 16 * (fq & 1); RopeTab r; r.c0 = *(const f32x4*)(t); r.c1 = *(const f32x4*)(t + 4); r.c2 = *(const f32x4*)(t + 8); r.c3 = *(const f32x4*)(t + 12); return r; }
__device__ __forceinline__ void rope_apply(f32x4& v0, f32x4& v1, const RopeTab& r, int fq) {
    f32x4 p0, p1;
#pragma unroll
    for (int j = 0; j < 4; ++j) { const auto a_ = __builtin_amdgcn_permlane32_swap(__float_as_uint(v0[j]), __float_as_uint(v0[j]), false, false), b_ = __builtin_amdgcn_permlane32_swap(__float_as_uint(v1[j]), __float_as_uint(v1[j]), false, false);
        p0[j] = __uint_as_float(fq < 2 ? a_[1] : a_[0]); p1[j] = __uint_as_float(fq < 2 ? b_[1] : b_[0]); }
    const f32x4 c0 = r.c0, c1 = r.c1, c2 = r.c2, c3 = r.c3;
    const float sg = (fq < 2) ? -1.f : 1.f;
    v0[0] = v0[0] * c0[0] + sg * p0[0] * c0[1]; v0[1] = v0[1] * c0[2] + sg * p0[1] * c0[3];
    v0[2] = v0[2] * c1[0] + sg * p0[2] * c1[1]; v0[3] = v0[3] * c1[2] + sg * p0[3] * c1[3];
    v1[0] = v1[0] * c2[0] + sg * p1[0] * c2[1]; v1[1] = v1[1] * c2[2] + sg * p1[1] * c2[3];
    v1[2] = v1[2] * c3[0] + sg * p1[2] * c3[1]; v1[3] = v1[3] * c3[2] + sg * p1[3] * c3[3];
}
#define EPI_MEMBAR() asm volatile("" ::: "memory")
struct EpiProj {
    static constexpr bool PERM = true, AFTER_DRAIN = false, SCALES = true;
    bf16_t *NAQKV, *QLAT, *GATES, *KVLAT, *KMLA; const float* bgate; const float* rope; float qscale; float* PS; const float* sa; const float* sb; PG8_LAS float* tbl;
    __device__ __forceinline__ void prefetch(const Unit& u, int wid, int) const {
        int lane; asm volatile("v_mbcnt_lo_u32_b32 %0, -1, 0\n\tv_mbcnt_hi_u32_b32 %0, -1, %0" : "=v"(lane));
        const float* src = (wid < 4) ? sa + (size_t)u.pa * BM + wid * 64 + lane : sb + (size_t)u.pb * BM + (wid - 4) * 64 + lane;
        __builtin_amdgcn_global_load_lds((const unsigned*)src, (PG8_LAS unsigned*)(tbl + (u.slot & 1) * 512 + wid * 64), 4, 0, 0);
    }
    __device__ __forceinline__ void operator()(f32x4 (&acc)[2][2][4][2], const Unit& u, int wr, int wc, int fr, int fq) const {
        const int pn = u.pn; const int row0 = u.pm * BM + wr * 64 + fr;
        {
            const PG8_LAS float* tb = tbl + (u.slot & 1) * 512; const PG8_LAS float* sbp = tb + 256 + wc * 32 + 8 * fq;
            const f32x4 s00 = *(const PG8_LAS f32x4*)(sbp), s01 = *(const PG8_LAS f32x4*)(sbp + 4), s10 = *(const PG8_LAS f32x4*)(sbp + HALF), s11 = *(const PG8_LAS f32x4*)(sbp + HALF + 4);
#pragma unroll
            for (int ai = 0; ai < 2; ++ai)
#pragma unroll
                for (int m = 0; m < 4; ++m) { const float ra = tb[wr * 64 + fr + ai * HALF + m * 16];
                    acc[ai][0][m][0] = i2f4(acc[ai][0][m][0]) * (s00 * ra); acc[ai][0][m][1] = i2f4(acc[ai][0][m][1]) * (s01 * ra);
                    acc[ai][1][m][0] = i2f4(acc[ai][1][m][0]) * (s10 * ra); acc[ai][1][m][1] = i2f4(acc[ai][1][m][1]) * (s11 * ra); }
        }
        if (pn == 18) {
            if (wc == 0) {
#pragma unroll
                for (int ai = 0; ai < 2; ++ai) { RopeTab rt[4];
#pragma unroll
                    for (int m = 0; m < 4; ++m) rt[m] = rope_load(rope + (size_t)((row0 + ai * HALF + m * 16) & 8191) * 32, fq);
                    EPI_MEMBAR();
#pragma unroll
                    for (int m = 0; m < 4; ++m) { const int row = row0 + ai * HALF + m * 16; f32x4 v0 = acc[ai][0][m][0], v1 = acc[ai][0][m][1];
                        rope_apply(v0, v1, rt[m], fq); const u32x4 w = pack8(v0, v1); bf16_t* dp = KMLA + (size_t)row * 768 + 64 + 8 * fq;
#pragma unroll
                        for (int h = 0; h < 8; ++h) *(u32x4*)(dp + 96 * h) = w; }
                    EPI_MEMBAR(); }
            }
            return;
        }
        if (pn >= 9 && pn < 17) {
            const int col0 = (pn - 9) * BM + wc * 32 + 8 * fq;
            f32x4 bv[2][2];
#pragma unroll
            for (int bj = 0; bj < 2; ++bj)
#pragma unroll
                for (int n = 0; n < 2; ++n) bv[bj][n] = *(const f32x4*)(bgate + col0 + bj * HALF + 4 * n);
#pragma unroll
            for (int ai = 0; ai < 2; ++ai)
#pragma unroll
                for (int m = 0; m < 4; ++m) { unsigned char* rowp = (unsigned char*)GATES + (size_t)(row0 + ai * HALF + m * 16) * 2048 + col0;
#pragma unroll
                    for (int bj = 0; bj < 2; ++bj) { f32x4 v0 = acc[ai][bj][m][0] + bv[bj][0], v1 = acc[ai][bj][m][1] + bv[bj][1]; u32x2 w = {0u, 0u};
                        sigm8(v0, v1); v0 = v0 * 255.f; v1 = v1 * 255.f;
#pragma unroll
                        for (int j = 0; j < 4; ++j) { w.x = __builtin_amdgcn_cvt_pk_u8_f32(v0[j], j, w.x); w.y = __builtin_amdgcn_cvt_pk_u8_f32(v1[j], j, w.y); }
                        *(u32x2*)(rowp + bj * HALF) = w; } }
            return;
        }
        bf16_t* base; int ldc, colt, mode = 0;
        if (pn < 6) { base = NAQKV; ldc = 1536; colt = pn * BM; mode = (pn < 2) ? 1 : 0; }
        else if (pn < 9) { base = QLAT; ldc = 768; colt = (pn - 6) * BM; }
        else { base = KVLAT; ldc = 256; colt = 0; }
        const int col0 = colt + wc * 32 + 8 * fq;
        if (mode == 0 && pn >= 6) {
            const int slot = (pn == 17) ? 12 + wc : (pn - 6) * 4 + wc;
#pragma unroll
            for (int ai = 0; ai < 2; ++ai)
#pragma unroll
                for (int m = 0; m < 4; ++m) { float q = 0.f;
#pragma unroll
                    for (int bj = 0; bj < 2; ++bj)
#pragma unroll
                        for (int n = 0; n < 2; ++n) { const f32x4 x = acc[ai][bj][m][n]; q += (x[0] * x[0] + x[1] * x[1]) + (x[2] * x[2] + x[3] * x[3]); }
                    { const auto r_ = __builtin_amdgcn_permlane16_swap(__float_as_uint(q), __float_as_uint(q), false, false); q = __uint_as_float(r_[0]) + __uint_as_float(r_[1]); }
                    { const auto r_ = __builtin_amdgcn_permlane32_swap(__float_as_uint(q), __float_as_uint(q), false, false); q = __uint_as_float(r_[0]) + __uint_as_float(r_[1]); }
                    if (fq == 0) PS[(size_t)(row0 + ai * HALF + m * 16) * 16 + slot] = q; }
        }
        const float sc = (mode == 1) ? qscale : 1.f;
#pragma unroll
        for (int ai = 0; ai < 2; ++ai)
#pragma unroll
            for (int m = 0; m < 4; ++m) { bf16_t* rowp = base + (size_t)(row0 + ai * HALF + m * 16) * ldc + col0;
#pragma unroll
                for (int bj = 0; bj < 2; ++bj) *(u32x4*)(rowp + bj * HALF) = pack8(acc[ai][bj][m][0] * sc, acc[ai][bj][m][1] * sc); }
    }
};
struct EpiQup {
    static constexpr bool PERM = true, AFTER_DRAIN = false, SCALES = false;
    bf16_t* Q; const PG8_LAS float* rtab; const float* rope; float sc;
    __device__ __forceinline__ void operator()(const f32x4 (&acc)[2][2][4][2], const Unit& u, int wr, int wc, int fr, int fq) const {
        const int lr0 = wr * 64 + fr;
        const int rb0 = ((8 * u.pn + wc) % 3 == 2), rb1 = ((8 * u.pn + 4 + wc) % 3 == 2);
#pragma unroll
        for (int g2 = 0; g2 < 4; ++g2) { const int ai = g2 >> 1, m0 = (g2 & 1) * 2; RopeTab rt[2]; float rrs[2];
#pragma unroll
            for (int i = 0; i < 2; ++i) rrs[i] = rtab[u.slot * BM + lr0 + ai * HALF + (m0 + i) * 16];
            if (rb0 | rb1) {
#pragma unroll
                for (int i = 0; i < 2; ++i) rt[i] = rope_load(rope + (size_t)((u.pm * BM + lr0 + ai * HALF + (m0 + i) * 16) & 8191) * 32, fq);
#pragma unroll
                for (int i = 0; i < 2; ++i) asm volatile("" : "+v"(rt[i].c0), "+v"(rt[i].c1), "+v"(rt[i].c2), "+v"(rt[i].c3));
            }
            EPI_MEMBAR();
#pragma unroll
            for (int i = 0; i < 2; ++i) { const int m = m0 + i; const int lr = lr0 + ai * HALF + m * 16, row = u.pm * BM + lr; const float rr = rrs[i];
                bf16_t* rowp = Q + (size_t)row * 768 + u.pn * BM + wc * 32 + 8 * fq;
#pragma unroll
                for (int bj = 0; bj < 2; ++bj) { f32x4 v0 = acc[ai][bj][m][0] * rr, v1 = acc[ai][bj][m][1] * rr;
                    if (bj == 0 ? rb0 : rb1) rope_apply(v0, v1, rt[i], fq);
                    v0 = v0 * sc; v1 = v1 * sc; *(u32x4*)(rowp + bj * HALF) = pack8(v0, v1); } }
            EPI_MEMBAR(); }
    }
};
struct EpiKVup {
    static constexpr bool PERM = true, AFTER_DRAIN = false, SCALES = false;
    bf16_t *KM, *VM; const PG8_LAS float* rtab;
    __device__ __forceinline__ void operator()(const f32x4 (&acc)[2][2][4][2], const Unit& u, int wr, int wc, int fr, int fq) const {
        const int lr0 = wr * 64 + fr;
#pragma unroll
        for (int ai = 0; ai < 2; ++ai)
#pragma unroll
            for (int m = 0; m < 4; ++m) { const int lr = lr0 + ai * HALF + m * 16, row = u.pm * BM + lr; const float rr = rtab[u.slot * BM + lr];
#pragma unroll
                for (int bj = 0; bj < 2; ++bj) { const f32x4 v0 = acc[ai][bj][m][0] * rr, v1 = acc[ai][bj][m][1] * rr;
                    bf16_t* dp;
                    if (u.pn < 2) { const int h = 4 * u.pn + 2 * bj + (wc >> 1); dp = KM + (size_t)row * 768 + 96 * h + 32 * (wc & 1) + 8 * fq; }
                    else { dp = VM + (size_t)row * 512 + (u.pn - 2) * BM + bj * HALF + wc * 32 + 8 * fq; }
                    *(u32x4*)dp = pack8(v0, v1); }
                if (((ai * 4 + m + 1) % EPI_FENCE_GRP) == 0) asm volatile("" ::: "memory"); }
    }
};
struct EpiMerge {
    static constexpr bool PERM = true, AFTER_DRAIN = false, SCALES = false;
    const unsigned char* G; bf16_t* T; int second;
    __device__ __forceinline__ void operator()(const f32x4 (&acc)[2][2][4][2], const Unit& u, int wr, int wc, int fr, int fq) const {
        const int row0 = u.pm * BM + wr * 64 + fr, col0 = u.pn * BM + wc * 32 + 8 * fq;
#pragma unroll
        for (int ai = 0; ai < 2; ++ai) { u32x2 gw[4][2]; u32x4 tw[4][2];
#pragma unroll
            for (int m = 0; m < 4; ++m) { const size_t row = (size_t)(row0 + ai * HALF + m * 16);
#pragma unroll
                for (int bj = 0; bj < 2; ++bj) { const int c = col0 + bj * HALF; gw[m][bj] = *(const u32x2*)(G + row * 2048 + c); if (second) tw[m][bj] = *(const u32x4*)(T + row * 1024 + c); } }
            EPI_MEMBAR();
#pragma unroll
            for (int m = 0; m < 4; ++m) { const size_t row = (size_t)(row0 + ai * HALF + m * 16);
#pragma unroll
                for (int bj = 0; bj < 2; ++bj) { const int c = col0 + bj * HALF; const u32x2 g_ = gw[m][bj];
                    const f32x4 g0 = {(float)(g_.x & 255u), (float)((g_.x >> 8) & 255u), (float)((g_.x >> 16) & 255u), (float)(g_.x >> 24)}, g1 = {(float)(g_.y & 255u), (float)((g_.y >> 8) & 255u), (float)((g_.y >> 16) & 255u), (float)(g_.y >> 24)};
                    f32x4 v0 = acc[ai][bj][m][0] * (g0 * (1.f / 255.f)), v1 = acc[ai][bj][m][1] * (g1 * (1.f / 255.f));
                    if (second) { f32x4 t0, t1; unpack8(tw[m][bj], t0, t1); v0 = v0 + t0; v1 = v1 + t1; }
                    *(u32x4*)(T + row * 1024 + c) = pack8(v0, v1); } }
            EPI_MEMBAR(); }
    }
};
struct EpiPlain {
    static constexpr bool PERM = true, AFTER_DRAIN = false, SCALES = false;
    bf16_t* O; int ldc;
    __device__ __forceinline__ void operator()(const f32x4 (&acc)[2][2][4][2], const Unit& u, int wr, int wc, int fr, int fq) const {
        const int row0 = u.pm * BM + wr * 64 + fr, col0 = u.pn * BM + wc * 32 + 8 * fq;
#pragma unroll
        for (int ai = 0; ai < 2; ++ai)
#pragma unroll
            for (int m = 0; m < 4; ++m) { bf16_t* rowp = O + (size_t)(row0 + ai * HALF + m * 16) * ldc + col0;
#pragma unroll
                for (int bj = 0; bj < 2; ++bj) *(u32x4*)(rowp + bj * HALF) = pack8(acc[ai][bj][m][0], acc[ai][bj][m][1]); }
    }
};
template <int MODE> struct EpiRes {
    static constexpr bool PERM = true, AFTER_DRAIN = false, SCALES = (MODE == 3);
    const bf16_t* xres; bf16_t* Y; bf16_t* P; float alpha; const float* sa; const float* sb; PG8_LAS float* tbl;
    __device__ __forceinline__ void prefetch(const Unit& u, int wid, int) const {
        int lane; asm volatile("v_mbcnt_lo_u32_b32 %0, -1, 0\n\tv_mbcnt_hi_u32_b32 %0, -1, %0" : "=v"(lane));
        const float* src = (wid < 4) ? sa + (size_t)u.pa * BM + wid * 64 + lane : sb + (size_t)u.pb * BM + (wid - 4) * 64 + lane;
        __builtin_amdgcn_global_load_lds((const unsigned*)src, (PG8_LAS unsigned*)(tbl + (u.slot & 1) * 512 + wid * 64), 4, 0, 0);
    }
    __device__ __forceinline__ void operator()(const f32x4 (&acc)[2][2][4][2], const Unit& u, int wr, int wc, int fr, int fq) const {
        const int row0 = u.pm * BM + wr * 64 + fr, col0 = u.pn * BM + wc * 32 + 8 * fq;
        const PG8_LAS float* tb = (MODE == 3) ? tbl + (u.slot & 1) * 512 : nullptr;
        f32x4 sb0[2], sb1[2];
        if (MODE == 3) {
#pragma unroll
            for (int bj = 0; bj < 2; ++bj) { const PG8_LAS float* sbp = tb + 256 + bj * HALF + wc * 32 + 8 * fq; sb0[bj] = *(const PG8_LAS f32x4*)sbp; sb1[bj] = *(const PG8_LAS f32x4*)(sbp + 4); } }
#pragma unroll
        for (int ai = 0; ai < 2; ++ai) { u32x4 lx[4][2], lp[4][2];
#pragma unroll
            for (int m = 0; m < 4; ++m) { const size_t off = (size_t)(row0 + ai * HALF + m * 16) * 1024 + col0;
#pragma unroll
                for (int bj = 0; bj < 2; ++bj) { const size_t o = off + bj * HALF;
                    if (MODE == 0 || MODE == 2) lx[m][bj] = *(const u32x4*)(xres + o);
                    if (MODE != 0) lp[m][bj] = *(const u32x4*)(P + o); } }
            EPI_MEMBAR();
#pragma unroll
            for (int m = 0; m < 4; ++m) { const size_t off = (size_t)(row0 + ai * HALF + m * 16) * 1024 + col0;
#pragma unroll
                for (int bj = 0; bj < 2; ++bj) { const size_t o = off + bj * HALF; f32x4 v0 = acc[ai][bj][m][0], v1 = acc[ai][bj][m][1];
                    if (MODE == 0) { f32x4 x0, x1; unpack8(lx[m][bj], x0, x1); v0 = x0 * alpha + v0; v1 = x1 * alpha + v1; *(u32x4*)(Y + o) = pack8(v0, v1); }
                    else if (MODE == 3) { f32x4 p0, p1; unpack8(lp[m][bj], p0, p1); const float ra = tb[wr * 64 + fr + ai * HALF + m * 16];
                        v0 = i2f4(v0) * (sb0[bj] * ra); v1 = i2f4(v1) * (sb1[bj] * ra);
                        sigm8(v0, v1); v0 = v0 * p0; v1 = v1 * p1;
                        *(u32x4*)(P + o) = pack8(v0, v1); }
                    else if (MODE == 1) { f32x4 p0, p1; unpack8(lp[m][bj], p0, p1);
                        sigm8(v0, v1); v0 = v0 * p0; v1 = v1 * p1;
                        *(u32x4*)(P + o) = pack8(v0, v1); }
                    else { f32x4 x0, x1, p0, p1; unpack8(lx[m][bj], x0, x1); unpack8(lp[m][bj], p0, p1);
                        v0 = x0 * alpha + p0 + v0; v1 = x1 * alpha + p1 + v1; *(u32x4*)(Y + o) = pack8(v0, v1); } } }
            EPI_MEMBAR(); }
    }
};
struct EpiGate8 {
    static constexpr bool PERM = true, AFTER_DRAIN = false, SCALES = true;
    unsigned char* G8; const float* sa; const float* sb; PG8_LAS float* tbl;
    __device__ __forceinline__ void prefetch(const Unit& u, int wid, int) const {
        int lane; asm volatile("v_mbcnt_lo_u32_b32 %0, -1, 0\n\tv_mbcnt_hi_u32_b32 %0, -1, %0" : "=v"(lane));
        const float* src = (wid < 4) ? sa + (size_t)u.pa * BM + wid * 64 + lane : sb + (size_t)u.pb * BM + (wid - 4) * 64 + lane;
        __builtin_amdgcn_global_load_lds((const unsigned*)src, (PG8_LAS unsigned*)(tbl + (u.slot & 1) * 512 + wid * 64), 4, 0, 0);
    }
    __device__ __forceinline__ void operator()(const f32x4 (&acc)[2][2][4][2], const Unit& u, int wr, int wc, int fr, int fq) const {
        const int row0 = u.pm * BM + wr * 64 + fr, col0 = u.pn * BM + wc * 32 + 8 * fq;
        const PG8_LAS float* tb = tbl + (u.slot & 1) * 512;
        f32x4 sb0[2], sb1[2];
#pragma unroll
        for (int bj = 0; bj < 2; ++bj) { const PG8_LAS float* sbp = tb + 256 + bj * HALF + wc * 32 + 8 * fq; sb0[bj] = *(const PG8_LAS f32x4*)sbp; sb1[bj] = *(const PG8_LAS f32x4*)(sbp + 4); }
#pragma unroll
        for (int ai = 0; ai < 2; ++ai)
#pragma unroll
            for (int m = 0; m < 4; ++m) { const float ra = tb[wr * 64 + fr + ai * HALF + m * 16]; unsigned char* rowp = G8 + (size_t)(row0 + ai * HALF + m * 16) * 1024 + col0;
#pragma unroll
                for (int bj = 0; bj < 2; ++bj) { f32x4 v0 = i2f4(acc[ai][bj][m][0]) * (sb0[bj] * ra), v1 = i2f4(acc[ai][bj][m][1]) * (sb1[bj] * ra); u32x2 w = {0u, 0u};
                    sigm8(v0, v1); v0 = v0 * 255.f; v1 = v1 * 255.f;
#pragma unroll
                    for (int j = 0; j < 4; ++j) { w.x = __builtin_amdgcn_cvt_pk_u8_f32(v0[j], j, w.x); w.y = __builtin_amdgcn_cvt_pk_u8_f32(v1[j], j, w.y); }
                    *(u32x2*)(rowp + bj * HALF) = w; } }
    }
};
struct EpiGateMul {
    static constexpr bool PERM = true, AFTER_DRAIN = false, SCALES = false;
    const unsigned char* G8; bf16_t* P;
    __device__ __forceinline__ void operator()(const f32x4 (&acc)[2][2][4][2], const Unit& u, int wr, int wc, int fr, int fq) const {
        const int row0 = u.pm * BM + wr * 64 + fr, col0 = u.pn * BM + wc * 32 + 8 * fq;
        u32x2 gw[8][2];
#pragma unroll
        for (int i = 0; i < 8; ++i)
#pragma unroll
            for (int bj = 0; bj < 2; ++bj) gw[i][bj] = *(const u32x2*)(G8 + (size_t)(row0 + (i >> 2) * HALF + (i & 3) * 16) * 1024 + col0 + bj * HALF);
        EPI_MEMBAR();
#pragma unroll
        for (int i = 0; i < 8; ++i) { const int ai = i >> 2, m = i & 3; bf16_t* rowp = P + (size_t)(row0 + ai * HALF + m * 16) * 1024 + col0;
#pragma unroll
            for (int bj = 0; bj < 2; ++bj) { const u32x2 g_ = gw[i][bj];
                const f32x4 g0 = {(float)(g_.x & 255u), (float)((g_.x >> 8) & 255u), (float)((g_.x >> 16) & 255u), (float)(g_.x >> 24)}, g1 = {(float)(g_.y & 255u), (float)((g_.y >> 8) & 255u), (float)((g_.y >> 16) & 255u), (float)(g_.y >> 24)};
                *(u32x4*)(rowp + bj * HALF) = pack8(acc[ai][bj][m][0] * (g0 * (1.f / 255.f)), acc[ai][bj][m][1] * (g1 * (1.f / 255.f))); } }
    }
};
struct EpiGLU {
    static constexpr bool PERM = true, AFTER_DRAIN = false, SCALES = false;
    bf16_t* H; int ldh;
    __device__ __forceinline__ void operator()(const f32x4 (&acc)[2][2][4][2], const Unit& u, int wr, int wc, int fr, int fq) const {
        const int row0 = u.pm * BM + wr * 64 + fr, col0 = u.pn * HALF + wc * 32 + 8 * fq;
#pragma unroll
        for (int ai = 0; ai < 2; ++ai)
#pragma unroll
            for (int m = 0; m < 4; ++m) { f32x4 h0, h1;
#pragma unroll
                for (int j = 0; j < 4; ++j) { const float a0 = acc[ai][0][m][0][j], a1 = acc[ai][0][m][1][j]; h0[j] = a0 * sigm(a0) * acc[ai][1][m][0][j]; h1[j] = a1 * sigm(a1) * acc[ai][1][m][1][j]; }
                *(u32x4*)(H + (size_t)(row0 + ai * HALF + m * 16) * ldh + col0) = pack8(h0, h1); }
    }
};
struct EpiGLUQ {
    static constexpr bool PERM = true, AFTER_DRAIN = false, SCALES = true;
    bf16_t* H; int ldh; const float* sa; const float* sb; PG8_LAS float* tbl;
    __device__ __forceinline__ void prefetch(const Unit& u, int wid, int) const {
        int lane; asm volatile("v_mbcnt_lo_u32_b32 %0, -1, 0\n\tv_mbcnt_hi_u32_b32 %0, -1, %0" : "=v"(lane));
        const float* src = (wid < 4) ? sa + (size_t)u.pa * BM + wid * 64 + lane : sb + (size_t)u.pb * BM + (wid - 4) * 64 + lane;
        __builtin_amdgcn_global_load_lds((const unsigned*)src, (PG8_LAS unsigned*)(tbl + (u.slot & 1) * 512 + wid * 64), 4, 0, 0);
    }
    __device__ __forceinline__ void operator()(const f32x4 (&acc)[2][2][4][2], const Unit& u, int wr, int wc, int fr, int fq) const {
        const int lrow0 = wr * 64 + fr, row0 = u.pm * BM + lrow0, col0 = u.pn * HALF + wc * 32 + 8 * fq;
        const PG8_LAS float* tb = tbl + (u.slot & 1) * 512; const PG8_LAS float* sbp = tb + 256 + wc * 32 + 8 * fq;
        const f32x4 s10 = *(const PG8_LAS f32x4*)(sbp), s11 = *(const PG8_LAS f32x4*)(sbp + 4), s30 = *(const PG8_LAS f32x4*)(sbp + HALF), s31 = *(const PG8_LAS f32x4*)(sbp + HALF + 4);
#pragma unroll
        for (int ai = 0; ai < 2; ++ai)
#pragma unroll
            for (int m = 0; m < 4; ++m) { const float ra = tb[lrow0 + ai * HALF + m * 16];
                const f32x4 a0 = i2f4(acc[ai][0][m][0]) * (s10 * ra), a1 = i2f4(acc[ai][0][m][1]) * (s11 * ra), b0 = i2f4(acc[ai][1][m][0]) * (s30 * ra), b1 = i2f4(acc[ai][1][m][1]) * (s31 * ra);
                f32x4 h0 = a0, h1 = a1; sigm8(h0, h1); h0 = (a0 * h0) * b0; h1 = (a1 * h1) * b1;
                *(u32x4*)(H + (size_t)(row0 + ai * HALF + m * 16) * ldh + col0) = pack8(h0, h1); }
    }
};
struct EpiMoeDown {
    static constexpr bool PERM = true, AFTER_DRAIN = false, SCALES = false;
    bf16_t* O; const float* SW;
    __device__ __forceinline__ void operator()(const f32x4 (&acc)[2][2][4][2], const Unit& u, int wr, int wc, int fr, int fq) const {
        const int row0 = u.pm * BM + wr * 64 + fr, col0 = u.pn * BM + wc * 32 + 8 * fq;
        float gws[8];
#pragma unroll
        for (int i = 0; i < 8; ++i) gws[i] = SW[row0 + (i >> 2) * HALF + (i & 3) * 16];
        EPI_MEMBAR();
#pragma unroll
        for (int ai = 0; ai < 2; ++ai)
#pragma unroll
            for (int m = 0; m < 4; ++m) { const int row = row0 + ai * HALF + m * 16; const float gw = gws[ai * 4 + m]; bf16_t* rowp = O + (size_t)row * 1024 + col0;
#pragma unroll
                for (int bj = 0; bj < 2; ++bj) *(u32x4*)(rowp + bj * HALF) = pack8(acc[ai][bj][m][0] * gw, acc[ai][bj][m][1] * gw); }
    }
};
template <bool UP> struct MoeOrder {
    int nMc, nN, nwg, G, c, t0; int ts1, ts2, ts3, ts4, ts5, ts6, ts7;
    __device__ __forceinline__ bool next(int i, Unit& u) const {
        const long L = (long)i * G + c; if (L >= nwg) return false;
        int wgid = (int)L; { const int q = nwg / NXCD, r = nwg % NXCD, xcd = wgid % NXCD, off = wgid / NXCD; wgid = (xcd < r ? xcd * (q + 1) : r * (q + 1) + (xcd - r) * q) + off; }
        const int nig = WGM * nN, gid = wgid / nig, fm = gid * WGM, gsz = (nMc - fm) < WGM ? (nMc - fm) : WGM;
        const int pml = fm + ((wgid % nig) % gsz), pn = (wgid % nig) / gsz, t = t0 + pml;
        const int e = (t >= ts1) + (t >= ts2) + (t >= ts3) + (t >= ts4) + (t >= ts5) + (t >= ts6) + (t >= ts7);
        u.pn = pn; u.pb = e * nN + pn; u.slot = i; u.kofs = 0; u.aux = 0;
        if (UP) { u.pa = t; u.pm = pml; } else { u.pa = pml; u.pm = t; }
        return true;
    }
    __device__ __forceinline__ void a_ready(const Unit&) const {}
    __device__ __forceinline__ void done(const Unit&) const {}
};
struct MoeRemOrder {
    int nT, G, c, t0, KQ, pa0; int ts1, ts2, ts3, ts4, ts5, ts6, ts7;
    __device__ __forceinline__ bool next(int i, Unit& u) const {
        const int L = i * G + c; if (L >= nT * 16) return false;
        const int tl = L >> 4, pn = (L >> 2) & 3, kq = L & 3, t = t0 + tl;
        const int e = (t >= ts1) + (t >= ts2) + (t >= ts3) + (t >= ts4) + (t >= ts5) + (t >= ts6) + (t >= ts7);
        u.pa = pa0 + tl; u.pm = tl; u.pn = pn; u.pb = e * 4 + pn; u.slot = i; u.kofs = kq * KQ; u.aux = kq; return true;
    }
    __device__ __forceinline__ void a_ready(const Unit&) const {}
    __device__ __forceinline__ void done(const Unit&) const {}
};
struct EpiMoeRem {
    static constexpr bool PERM = true, AFTER_DRAIN = false, SCALES = false;
    bf16_t* PART; const float* SW; int t0, prows;
    __device__ __forceinline__ void operator()(const f32x4 (&acc)[2][2][4][2], const Unit& u, int wr, int wc, int fr, int fq) const {
        const int row0 = u.pm * BM + wr * 64 + fr, col0 = u.pn * BM + wc * 32 + 8 * fq;
        float gws[8];
#pragma unroll
        for (int i = 0; i < 8; ++i) gws[i] = SW[t0 * BM + row0 + (i >> 2) * HALF + (i & 3) * 16];
        EPI_MEMBAR();
#pragma unroll
        for (int ai = 0; ai < 2; ++ai)
#pragma unroll
            for (int m = 0; m < 4; ++m) { const int row = row0 + ai * HALF + m * 16; const float gw = gws[ai * 4 + m]; bf16_t* rowp = PART + ((size_t)u.aux * prows + row) * 1024 + col0;
#pragma unroll
                for (int bj = 0; bj < 2; ++bj) *(u32x4*)(rowp + bj * HALF) = pack8(acc[ai][bj][m][0] * gw, acc[ai][bj][m][1] * gw); }
    }
};
}
namespace att {
#define ATT_LAS __attribute__((address_space(3)))
typedef unsigned short bf16;
using bf16x8 = __attribute__((ext_vector_type(8))) short;
using s16x4  = __attribute__((ext_vector_type(4))) short;
using f32x16 = __attribute__((ext_vector_type(16))) float;
using u32x4  = __attribute__((ext_vector_type(4))) unsigned;
#define SBAR() __builtin_amdgcn_sched_barrier(0)
__device__ __forceinline__ int crow(int r, int hi) { return (r & 3) + 8 * (r >> 2) + 4 * hi; }
__device__ __forceinline__ unsigned cvtpk(float lo, float hi) { unsigned r; asm volatile("v_cvt_pk_bf16_f32 %0, %1, %2" : "=v"(r) : "v"(lo), "v"(hi)); return r; }
__device__ __forceinline__ unsigned short f2bf(float f) { return (unsigned short)(cvtpk(f, f) & 0xffffu); }
constexpr int OIMG_WAVE = 32 * 144;
__device__ __forceinline__ int crow(int r, int hi);
__device__ __forceinline__ void store_o(const f32x16 (&o)[2], const ATT_LAS float* li_l, bf16* Ow, ATT_LAS char* img, int lane, int r32, int hi) {
  typedef unsigned u32x4_t __attribute__((ext_vector_type(4)));
#pragma unroll
  for (int r = 0; r < 16; ++r) { const int orow = (r & 3) + 8 * (r >> 2) + 4 * hi; const float rl = __builtin_amdgcn_rcpf(li_l[orow]);
    ATT_LAS unsigned short* rp = (ATT_LAS unsigned short*)(img + orow * 144) + r32;
    rp[0] = f2bf(o[0][r] * rl); rp[32] = f2bf(o[1][r] * rl); }
  asm volatile("s_waitcnt lgkmcnt(0)" ::: "memory");
#pragma unroll
  for (int j = 0; j < 4; ++j) { const int pc = j * 64 + lane, row = pc >> 3, c16 = pc & 7;
    const u32x4_t v = *(const ATT_LAS u32x4_t*)(img + row * 144 + c16 * 16);
    *reinterpret_cast<u32x4_t*>(Ow + (long)row * 512 + c16 * 8) = v; }
}
__device__ __forceinline__ int v_st(int k, int c) { const int kk = (k & ~0xC) | ((k & 4) << 1) | ((k & 8) >> 1); return ((kk >> 3) * 2 + (c >> 5)) * 512 + ((kk & 7) * 32 + (c & 31)) * 2; }
__device__ __forceinline__ int v_rd_base(int lane) { return ((lane & 3) << 3) | (((lane >> 2) & 3) << 6) | (((lane >> 4) & 1) << 5) | (((lane >> 5) & 1) << 8); }
constexpr int v_rd_off(int d0, int ks, int half) { return d0 * 512 + ks * 2048 + half * 1024; }
template <int OFF> __device__ __forceinline__ s16x4 tr_read(int vb) { s16x4 r; asm volatile("ds_read_b64_tr_b16 %0, %1 offset:%2" : "=&v"(r) : "v"(vb), "i"(OFF) : "memory"); return r; }
template <int D0> __device__ __forceinline__ void pv_one(f32x16& od, int vb, bf16x8 pa0, bf16x8 pa1, bf16x8 pa2, bf16x8 pa3) {
  const s16x4 l0 = tr_read<v_rd_off(D0, 0, 0)>(vb), h0 = tr_read<v_rd_off(D0, 0, 1)>(vb), l1 = tr_read<v_rd_off(D0, 1, 0)>(vb), h1 = tr_read<v_rd_off(D0, 1, 1)>(vb);
  const s16x4 l2 = tr_read<v_rd_off(D0, 2, 0)>(vb), h2 = tr_read<v_rd_off(D0, 2, 1)>(vb), l3 = tr_read<v_rd_off(D0, 3, 0)>(vb), h3 = tr_read<v_rd_off(D0, 3, 1)>(vb);
  asm volatile("s_waitcnt lgkmcnt(0)" ::: "memory"); SBAR();
#define PK(L, H) (bf16x8){L[0], L[1], L[2], L[3], H[0], H[1], H[2], H[3]}
  od = __builtin_amdgcn_mfma_f32_32x32x16_bf16(pa0, PK(l0, h0), od, 0, 0, 0);
  od = __builtin_amdgcn_mfma_f32_32x32x16_bf16(pa1, PK(l1, h1), od, 0, 0, 0);
  od = __builtin_amdgcn_mfma_f32_32x32x16_bf16(pa2, PK(l2, h2), od, 0, 0, 0);
  od = __builtin_amdgcn_mfma_f32_32x32x16_bf16(pa3, PK(l3, h3), od, 0, 0, 0);
#undef PK
}
__device__ __forceinline__ void pv2(f32x16* o, int vb, bf16x8 pa0, bf16x8 pa1, bf16x8 pa2, bf16x8 pa3) { pv_one<0>(o[0], vb, pa0, pa1, pa2, pa3); pv_one<1>(o[1], vb, pa0, pa1, pa2, pa3); }
template <int NS, int ROWB> __device__ __forceinline__ void qkt(f32x16& p0, f32x16& p1, const ATT_LAS char* Ks, const bf16x8* qr, int r32, int hi) {
  p0 = f32x16{}; p1 = f32x16{};
#pragma unroll
  for (int d0 = 0; d0 < NS; ++d0) { const int cb = d0 * 32 + hi * 16;
    const bf16x8 b0 = *(const ATT_LAS bf16x8*)(Ks + r32 * ROWB + cb);
    const bf16x8 b1 = *(const ATT_LAS bf16x8*)(Ks + (32 + r32) * ROWB + cb);
    p0 = __builtin_amdgcn_mfma_f32_32x32x16_bf16(b0, qr[d0], p0, 0, 0, 0);
    p1 = __builtin_amdgcn_mfma_f32_32x32x16_bf16(b1, qr[d0], p1, 0, 0, 0); }
}
constexpr float THR = 8.f;
__device__ __forceinline__ void partialSM(f32x16& p0, f32x16& p1, float& m_reg, float& alpha) {
  float pmax = p0[0];
#pragma unroll
  for (int r = 1; r < 16; ++r) pmax = fmaxf(pmax, p0[r]);
#pragma unroll
  for (int r = 0; r < 16; ++r) pmax = fmaxf(pmax, p1[r]);
  { auto rr = __builtin_amdgcn_permlane32_swap(__float_as_uint(pmax), __float_as_uint(pmax), false, false); pmax = fmaxf(__uint_as_float(rr[0]), __uint_as_float(rr[1])); }
  float mn;
  if (__builtin_expect(__all(pmax - m_reg <= THR), 1)) { mn = m_reg; alpha = 1.f; }
  else { mn = fmaxf(m_reg, pmax); alpha = __builtin_amdgcn_exp2f(m_reg - mn); m_reg = mn; }
#pragma unroll
  for (int r = 0; r < 16; ++r) p0[r] = p0[r] - mn;
#pragma unroll
  for (int r = 0; r < 16; ++r) p1[r] = p1[r] - mn;
#pragma unroll
  for (int r = 0; r < 16; ++r) p0[r] = __builtin_amdgcn_exp2f(p0[r]);
}
__device__ __forceinline__ void finishSM(f32x16& p0, f32x16& p1, float alpha, float& l_reg, bf16x8& pa0, bf16x8& pa1, bf16x8& pa2, bf16x8& pa3) {
#pragma unroll
  for (int r = 0; r < 16; ++r) p1[r] = __builtin_amdgcn_exp2f(p1[r]);
  float ps = 0;
#pragma unroll
  for (int r = 0; r < 16; ++r) ps += p0[r];
#pragma unroll
  for (int r = 0; r < 16; ++r) ps += p1[r];
  { auto rr = __builtin_amdgcn_permlane32_swap(__float_as_uint(ps), __float_as_uint(ps), false, false); ps = __uint_as_float(rr[0]) + __uint_as_float(rr[1]); }
  l_reg = l_reg * alpha + ps;
#define PK4(P, BASE, OUT) do { unsigned a0 = cvtpk(P[BASE + 0], P[BASE + 1]), a1 = cvtpk(P[BASE + 2], P[BASE + 3]);   \
    unsigned b0 = cvtpk(P[BASE + 4], P[BASE + 5]), b1 = cvtpk(P[BASE + 6], P[BASE + 7]);                              \
    auto r0 = __builtin_amdgcn_permlane32_swap(a0, b0, false, false); auto r1 = __builtin_amdgcn_permlane32_swap(a1, b1, false, false); \
    u32x4 w = {r0[0], r1[0], r0[1], r1[1]}; OUT = *reinterpret_cast<bf16x8*>(&w); } while (0)
  PK4(p0, 0, pa0); PK4(p0, 8, pa1); PK4(p1, 0, pa2); PK4(p1, 8, pa3);
#undef PK4
}

#define MX3(a, b, c) __builtin_fmaxf(__builtin_fmaxf((a), (b)), (c))
__device__ __forceinline__ float rowmax32(const f32x16& p0, const f32x16& p1) {
  float a = MX3(p0[0], p0[1], p1[0]), b = MX3(p0[2], p0[3], p1[1]); a = MX3(a, p1[2], p1[3]);
#pragma unroll
  for (int r = 4; r < 16; r += 4) { a = MX3(a, p0[r], p0[r + 1]); b = MX3(b, p0[r + 2], p0[r + 3]); a = MX3(a, p1[r], p1[r + 1]); b = MX3(b, p1[r + 2], p1[r + 3]); }
  float m = __builtin_fmaxf(a, b);
  { auto rr = __builtin_amdgcn_permlane32_swap(__float_as_uint(m), __float_as_uint(m), false, false); m = __builtin_fmaxf(__uint_as_float(rr[0]), __uint_as_float(rr[1])); }
  return m;
}
template <int NS, int ROWB> __device__ __forceinline__ void qkt_from(f32x16& p0, f32x16& p1, const ATT_LAS char* Ks, const bf16x8* qr, const f32x16& c0, int r32, int hi) {
#pragma unroll
  for (int d0 = 0; d0 < NS; ++d0) { const int cb = d0 * 32 + hi * 16;
    const bf16x8 b0 = *(const ATT_LAS bf16x8*)(Ks + r32 * ROWB + cb);
    const bf16x8 b1 = *(const ATT_LAS bf16x8*)(Ks + (32 + r32) * ROWB + cb);
    if (d0 == 0) { p0 = __builtin_amdgcn_mfma_f32_32x32x16_bf16(b0, qr[0], c0, 0, 0, 0); p1 = __builtin_amdgcn_mfma_f32_32x32x16_bf16(b1, qr[0], c0, 0, 0, 0); }
    else { p0 = __builtin_amdgcn_mfma_f32_32x32x16_bf16(b0, qr[d0], p0, 0, 0, 0); p1 = __builtin_amdgcn_mfma_f32_32x32x16_bf16(b1, qr[d0], p1, 0, 0, 0); } }
}
template <bool FIRST> __device__ __forceinline__ void partialSM2(f32x16& p0, f32x16& p1, float& m_ref, f32x16& negm, float& alpha) {
  const float rm = rowmax32(p0, p1);
  alpha = 1.f;
  if (FIRST || !__builtin_expect(__all(rm <= THR), 1)) {
    const float dl = FIRST ? rm : __builtin_fmaxf(rm, 0.f);
    m_ref += dl;
#pragma unroll
    for (int r = 0; r < 16; ++r) { p0[r] -= dl; p1[r] -= dl; }
#pragma unroll
    for (int r = 0; r < 16; ++r) negm[r] = -m_ref;
    asm volatile("" : "+v"(negm));
    if (!FIRST) alpha = __builtin_amdgcn_exp2f(-dl);
  }
#pragma unroll
  for (int r = 0; r < 16; ++r) p0[r] = __builtin_amdgcn_exp2f(p0[r]);
}
__device__ __forceinline__ void finishSM2(f32x16& p0, f32x16& p1, bf16x8& pa0, bf16x8& pa1, bf16x8& pa2, bf16x8& pa3) {
#pragma unroll
  for (int r = 0; r < 16; ++r) p1[r] = __builtin_amdgcn_exp2f(p1[r]);
#define PK4(P, BASE, OUT) do { unsigned a0 = cvtpk(P[BASE + 0], P[BASE + 1]), a1 = cvtpk(P[BASE + 2], P[BASE + 3]);   \
    unsigned b0 = cvtpk(P[BASE + 4], P[BASE + 5]), b1 = cvtpk(P[BASE + 6], P[BASE + 7]);                              \
    auto r0 = __builtin_amdgcn_permlane32_swap(a0, b0, false, false); auto r1 = __builtin_amdgcn_permlane32_swap(a1, b1, false, false); \
    u32x4 w = {r0[0], r1[0], r0[1], r1[1]}; OUT = *reinterpret_cast<bf16x8*>(&w); } while (0)
  PK4(p0, 0, pa0); PK4(p0, 8, pa1); PK4(p1, 0, pa2); PK4(p1, 8, pa3);
#undef PK4
}
__device__ __forceinline__ void pv3(f32x16* o, f32x16& ol, int vb, bf16x8 pa0, bf16x8 pa1, bf16x8 pa2, bf16x8 pa3) {
  const bf16x8 ones = {0x3F80, 0x3F80, 0x3F80, 0x3F80, 0x3F80, 0x3F80, 0x3F80, 0x3F80};
  pv_one<0>(o[0], vb, pa0, pa1, pa2, pa3);
  ol = __builtin_amdgcn_mfma_f32_32x32x16_bf16(pa0, ones, ol, 0, 0, 0); ol = __builtin_amdgcn_mfma_f32_32x32x16_bf16(pa1, ones, ol, 0, 0, 0);
  pv_one<1>(o[1], vb, pa0, pa1, pa2, pa3);
  ol = __builtin_amdgcn_mfma_f32_32x32x16_bf16(pa2, ones, ol, 0, 0, 0); ol = __builtin_amdgcn_mfma_f32_32x32x16_bf16(pa3, ones, ol, 0, 0, 0);
}
#ifndef MLA_CHK_ODD
#define MLA_CHK_ODD 0
#endif
constexpr int KSLOT = 12288, VSLOT = 8192, NSLOT = 4, MLA_OIMG = NSLOT * (KSLOT + VSLOT) + 8 * 256  , MLA_LDS = MLA_OIMG + 8 * OIMG_WAVE;
__device__ __forceinline__ void glds16(const void* gsrc, unsigned lds_dst) { unsigned keep;
  asm volatile("s_mov_b32 %0, m0\n\ts_mov_b32 m0, %2\n\ts_nop 0\n\tglobal_load_lds_dwordx4 %1, off\n\ts_mov_b32 m0, %0" : "=&s"(keep) : "v"(gsrc), "s"(lds_dst) : "memory"); }
#define BAR_L() asm volatile("s_waitcnt lgkmcnt(0)\n\ts_barrier" ::: "memory")
#define BAR_V(N) asm volatile("s_waitcnt vmcnt(" #N ") lgkmcnt(0)\n\ts_barrier" ::: "memory")
typedef short v4i16_t __attribute__((ext_vector_type(4)));
__device__ __forceinline__ s16x4 vtr(const ATT_LAS char* p) { return __builtin_bit_cast(s16x4, __builtin_amdgcn_ds_read_tr16_b64_v4i16((ATT_LAS v4i16_t*)p)); }
__device__ __forceinline__ void kfetch(bf16x8 (&kf)[12], const ATT_LAS char* Ks, int r32, int hi) {
#pragma unroll
  for (int d0 = 0; d0 < 6; ++d0) { const ATT_LAS char* p = Ks + (2 * d0 + hi) * 1024 + r32 * 16;
    kf[2 * d0] = *(const ATT_LAS bf16x8*)p; kf[2 * d0 + 1] = *(const ATT_LAS bf16x8*)(p + 512); }
}
#define MX3(a, b, c) __builtin_fmaxf(__builtin_fmaxf((a), (b)), (c))
__device__ __forceinline__ void mla_unit(const bf16* __restrict__ Qb, const bf16* __restrict__ Kh, const bf16* __restrict__ Vh, bf16* __restrict__ Ob, int seq, ATT_LAS char* lds, const int wave_id) {
  int lane_; asm volatile("v_mbcnt_lo_u32_b32 %0, -1, 0\n\tv_mbcnt_hi_u32_b32 %0, -1, %0" : "=v"(lane_));
  int w_ = wave_id; asm volatile("" : "+s"(w_));
  const int wid = w_, lane = lane_, r32 = lane & 31, hi = lane >> 5;
  const int half = wid >> 2;
  ATT_LAS char* K_lds = lds; ATT_LAS char* V_lds = lds + NSLOT * KSLOT;
  ATT_LAS float* al_l = (ATT_LAS float*)(lds + NSLOT * (KSLOT + VSLOT)) + wid * 64; ATT_LAS float* li_l = al_l + 32;
  const unsigned lds0 = (unsigned)(uintptr_t)lds;
  const int NT = seq / 64;
  const bf16* ksrc0 = Kh + (long)lane * 768 + wid * 8; const bf16* ksrc1 = ksrc0 + 64;
  const bf16* vsrc = Vh + (long)(16 * (wid & 3) + (lane >> 2)) * 512 + (wid >> 2) * 32 + (lane & 3) * 8;
  const unsigned kdst0 = lds0 + wid * 1024, vdst = lds0 + NSLOT * KSLOT + wid * 1024;
#define DMA_K(tile, slot) do { const int tl_ = (tile) < NT ? (tile) : NT - 1; const unsigned d_ = (unsigned)__builtin_amdgcn_readfirstlane(kdst0 + ((slot) & 3) * KSLOT); \
    glds16(ksrc0 + (long)tl_ * 64 * 768, d_); if (!half) glds16(ksrc1 + (long)tl_ * 64 * 768, d_ + 8192); } while (0)
#define DMA_V(tile, slot) do { const int tl_ = (tile) < NT ? (tile) : NT - 1; glds16(vsrc + (long)tl_ * 64 * 512, (unsigned)__builtin_amdgcn_readfirstlane(vdst + ((slot) & 3) * VSLOT)); } while (0)
#define STEP_BAR() do { SBAR(); if (!half) { BAR_V(6); } else { BAR_V(4); } SBAR(); } while (0)
  DMA_K(0, 0); DMA_K(1, 1); DMA_K(2, 2); DMA_K(3, 3); DMA_V(0, 0); DMA_V(1, 1);
  float m_ref = 0.f, l_reg = 0.f, pend = 0.f; f32x16 o[2] = {}; f32x16 negm = {}; bf16x8 qr[6];
  const bf16* Qw = Qb + (long)(wid * 32 + r32) * 768 + hi * 8;
#pragma unroll
  for (int d0 = 0; d0 < 6; ++d0) qr[d0] = *reinterpret_cast<const bf16x8*>(Qw + d0 * 16);
  const ATT_LAS char* vbp0 = V_lds + ((lane >> 4) & 1) * 32 + (lane & 3) * 8 + (4 * hi + ((lane & 15) >> 2)) * 64; const ATT_LAS char* kb0 = K_lds + hi * 1024 + r32 * 16;
  BAR_V(0);
  f32x16 pA0, pA1, pB0, pB1; bf16x8 paA0, paA1, paA2, paA3, paB0, paB1, paB2, paB3;
  paB0 = paB1 = paB2 = paB3 = (bf16x8){0, 0, 0, 0, 0, 0, 0, 0};
#define KFR(kb, i) (*(const ATT_LAS bf16x8*)((kb) + ((i) >> 1) * 2048 + ((i) & 1) * 512))
#pragma unroll
  for (int i = 0; i < 12; i += 2) { const bf16x8 k0_ = KFR(kb0, i), k1_ = KFR(kb0, i + 1);
    if (i == 0) { pA0 = __builtin_amdgcn_mfma_f32_32x32x16_bf16(k0_, qr[0], negm, 0, 0, 0); pA1 = __builtin_amdgcn_mfma_f32_32x32x16_bf16(k1_, qr[0], negm, 0, 0, 0); }
    else { pA0 = __builtin_amdgcn_mfma_f32_32x32x16_bf16(k0_, qr[i >> 1], pA0, 0, 0, 0); pA1 = __builtin_amdgcn_mfma_f32_32x32x16_bf16(k1_, qr[i >> 1], pA1, 0, 0, 0); } }
#define QKM(i, N0, N1) do { if ((i) == 0) N0 = __builtin_amdgcn_mfma_f32_32x32x16_bf16(kf[0], qr[0], negm, 0, 0, 0); else if ((i) == 1) N1 = __builtin_amdgcn_mfma_f32_32x32x16_bf16(kf[1], qr[0], negm, 0, 0, 0); \
    else if (((i) & 1) == 0) N0 = __builtin_amdgcn_mfma_f32_32x32x16_bf16(kf[i], qr[(i) >> 1], N0, 0, 0, 0); else N1 = __builtin_amdgcn_mfma_f32_32x32x16_bf16(kf[i], qr[(i) >> 1], N1, 0, 0, 0); } while (0)
#define VRDJ(j) do { vl[j] = vtr(vbp + ((j) >> 2) * 4096 + ((j) & 3) * 1024); vh[j] = vtr(vbp + ((j) >> 2) * 4096 + ((j) & 3) * 1024 + 512); } while (0)
#define PKV(i) (bf16x8){vl[i][0], vl[i][1], vl[i][2], vl[i][3], vh[i][0], vh[i][1], vh[i][2], vh[i][3]}
#define EXQ(idx, C0, C1) do { if ((idx) < 16) C0[(idx)] = __builtin_amdgcn_exp2f(C0[(idx)]); else C1[(idx) - 16] = __builtin_amdgcn_exp2f(C1[(idx) - 16]); } while (0)
#define CV(idx, C0, C1) ((idx) < 16 ? C0[(idx)] : C1[(idx) - 16])
#define EX2(k, C0, C1) do { EXQ(2 * (k), C0, C1); EXQ(2 * (k) + 1, C0, C1); ps2 += (f32x2_t){CV(2 * (k), C0, C1), CV(2 * (k) + 1, C0, C1)}; } while (0)
#define PK4(P, BASE, OUT) do { u32x4 w = {cvtpk(P[BASE + 0], P[BASE + 1]), cvtpk(P[BASE + 2], P[BASE + 3]), cvtpk(P[BASE + 4], P[BASE + 5]), cvtpk(P[BASE + 6], P[BASE + 7])}; OUT = *reinterpret_cast<bf16x8*>(&w); } while (0)
#define STEP(t, C0, C1, N0, N1, PC0, PC1, PC2, PC3, PO0, PO1, PO2, PO3, FIRST, CHK) do { \
    typedef float f32x2_t __attribute__((ext_vector_type(2))); \
    STEP_BAR(); \
    DMA_K((t) + 4, (t)); DMA_V((t) + 2, (t) + 2); \
    const ATT_LAS char* kb = kb0 + (((t) + 1) & 3) * KSLOT; const ATT_LAS char* vbp = vbp0 + (((t) - 1) & 3) * VSLOT; \
    bf16x8 kf[12]; s16x4 vl[8], vh[8]; f32x2_t ps2 = {0.f, 0.f}; float al = 1.f; \
    kf[0] = KFR(kb, 0); kf[1] = KFR(kb, 1); kf[2] = KFR(kb, 2); kf[3] = KFR(kb, 3); \
    float a_ = 0.f, b_ = 0.f, rm = 0.f; \
    if (CHK) { a_ = MX3(C0[0], C0[1], C1[0]); b_ = MX3(C0[2], C0[3], C1[1]); a_ = MX3(a_, C1[2], C1[3]); \
    a_ = MX3(a_, C0[4], C0[5]); b_ = MX3(b_, C0[6], C0[7]); a_ = MX3(a_, C1[4], C1[5]); b_ = MX3(b_, C1[6], C1[7]); } SBAR(); \
    QKM(0, N0, N1); kf[4] = KFR(kb, 4); if (CHK) { a_ = MX3(a_, C0[8], C0[9]); b_ = MX3(b_, C0[10], C0[11]); a_ = MX3(a_, C1[8], C1[9]); b_ = MX3(b_, C1[10], C1[11]); } SBAR(); \
    QKM(1, N0, N1); kf[5] = KFR(kb, 5); if (CHK) { a_ = MX3(a_, C0[12], C0[13]); b_ = MX3(b_, C0[14], C0[15]); a_ = MX3(a_, C1[12], C1[13]); b_ = MX3(b_, C1[14], C1[15]); } SBAR(); \
    QKM(2, N0, N1); kf[6] = KFR(kb, 6); if (CHK) { rm = __builtin_fmaxf(a_, b_); { auto rr = __builtin_amdgcn_permlane32_swap(__float_as_uint(rm), __float_as_uint(rm), false, false); rm = __builtin_fmaxf(__uint_as_float(rr[0]), __uint_as_float(rr[1])); } } SBAR(); \
    QKM(3, N0, N1); kf[7] = KFR(kb, 7); SBAR(); \
    if ((CHK) && ((FIRST) || !__builtin_expect(__all(rm <= THR), 1))) { const float dl = (FIRST) ? rm : __builtin_fmaxf(rm, 0.f); m_ref += dl; pend = dl; \
      _Pragma("unroll") for (int r = 0; r < 16; ++r) { C0[r] -= dl; C1[r] -= dl; } \
      _Pragma("unroll") for (int r = 0; r < 16; ++r) negm[r] = -m_ref; \
      asm volatile("" : "+v"(negm)); if (!(FIRST)) al = __builtin_amdgcn_exp2f(-dl); } \
    SBAR(); \
    QKM(4, N0, N1); kf[8] = KFR(kb, 8); EX2(0, C0, C1); SBAR(); \
    QKM(5, N0, N1); kf[9] = KFR(kb, 9); EX2(1, C0, C1); SBAR(); \
    QKM(6, N0, N1); kf[10] = KFR(kb, 10); EX2(2, C0, C1); SBAR(); \
    QKM(7, N0, N1); kf[11] = KFR(kb, 11); EX2(3, C0, C1); SBAR(); \
    QKM(8, N0, N1); EX2(4, C0, C1); PK4(C0, 0, PC0); SBAR(); \
    QKM(9, N0, N1); if (!(FIRST)) { VRDJ(0); } EX2(5, C0, C1); SBAR(); \
    QKM(10, N0, N1); if (!(FIRST)) { VRDJ(4); } EX2(6, C0, C1); SBAR(); \
    QKM(11, N0, N1); if (!(FIRST)) { VRDJ(1); } EX2(7, C0, C1); SBAR(); \
    if (!(FIRST)) o[0] = __builtin_amdgcn_mfma_f32_32x32x16_bf16(PO0, PKV(0), o[0], 0, 0, 0); if (!(FIRST)) { VRDJ(5); } EX2(8, C0, C1); PK4(C0, 8, PC1); SBAR(); \
    if (!(FIRST)) o[1] = __builtin_amdgcn_mfma_f32_32x32x16_bf16(PO0, PKV(4), o[1], 0, 0, 0); if (!(FIRST)) { VRDJ(2); } EX2(9, C0, C1); SBAR(); \
    if (!(FIRST)) o[0] = __builtin_amdgcn_mfma_f32_32x32x16_bf16(PO1, PKV(1), o[0], 0, 0, 0); if (!(FIRST)) { VRDJ(6); } EX2(10, C0, C1); SBAR(); \
    if (!(FIRST)) o[1] = __builtin_amdgcn_mfma_f32_32x32x16_bf16(PO1, PKV(5), o[1], 0, 0, 0); if (!(FIRST)) { VRDJ(3); } EX2(11, C0, C1); SBAR(); \
    if (!(FIRST)) o[0] = __builtin_amdgcn_mfma_f32_32x32x16_bf16(PO2, PKV(2), o[0], 0, 0, 0); if (!(FIRST)) { VRDJ(7); } EX2(12, C0, C1); PK4(C1, 0, PC2); SBAR(); \
    if (!(FIRST)) o[1] = __builtin_amdgcn_mfma_f32_32x32x16_bf16(PO2, PKV(6), o[1], 0, 0, 0); EX2(13, C0, C1); SBAR(); \
    if (!(FIRST)) o[0] = __builtin_amdgcn_mfma_f32_32x32x16_bf16(PO3, PKV(3), o[0], 0, 0, 0); EX2(14, C0, C1); SBAR(); \
    if (!(FIRST)) o[1] = __builtin_amdgcn_mfma_f32_32x32x16_bf16(PO3, PKV(7), o[1], 0, 0, 0); EX2(15, C0, C1); PK4(C1, 8, PC3); SBAR(); \
    l_reg = l_reg * al + (ps2.x + ps2.y); \
    if (__builtin_expect(__any(pend != 0.f), 0)) {       \
      const float f_ = (FIRST) ? 1.f : __builtin_amdgcn_exp2f(-pend); if (hi == 0) al_l[r32] = f_; asm volatile("s_waitcnt lgkmcnt(0)" ::: "memory"); \
      _Pragma("unroll") for (int r = 0; r < 16; ++r) { const float g_ = al_l[crow(r, hi)]; o[0][r] *= g_; o[1][r] *= g_; N0[r] -= pend; N1[r] -= pend; } \
      pend = 0.f; } \
  } while (0)
  STEP(0, pA0, pA1, pB0, pB1, paA0, paA1, paA2, paA3, paB0, paB1, paB2, paB3, true, 1);
  for (int t = 1; t + 1 < NT; t += 2) {
    STEP(t, pB0, pB1, pA0, pA1, paB0, paB1, paB2, paB3, paA0, paA1, paA2, paA3, false, MLA_CHK_ODD);
    STEP(t + 1, pA0, pA1, pB0, pB1, paA0, paA1, paA2, paA3, paB0, paB1, paB2, paB3, false, 1);
  }
  STEP(NT - 1, pB0, pB1, pA0, pA1, paB0, paB1, paB2, paB3, paA0, paA1, paA2, paA3, false, MLA_CHK_ODD);
  STEP_BAR();
  { const ATT_LAS char* vbp = vbp0 + ((NT - 1) & 3) * VSLOT; s16x4 vl[8], vh[8];
#pragma unroll
    for (int j = 0; j < 8; ++j) VRDJ(j);
    o[0] = __builtin_amdgcn_mfma_f32_32x32x16_bf16(paB0, PKV(0), o[0], 0, 0, 0); o[1] = __builtin_amdgcn_mfma_f32_32x32x16_bf16(paB0, PKV(4), o[1], 0, 0, 0);
    o[0] = __builtin_amdgcn_mfma_f32_32x32x16_bf16(paB1, PKV(1), o[0], 0, 0, 0); o[1] = __builtin_amdgcn_mfma_f32_32x32x16_bf16(paB1, PKV(5), o[1], 0, 0, 0);
    o[0] = __builtin_amdgcn_mfma_f32_32x32x16_bf16(paB2, PKV(2), o[0], 0, 0, 0); o[1] = __builtin_amdgcn_mfma_f32_32x32x16_bf16(paB2, PKV(6), o[1], 0, 0, 0);
    o[0] = __builtin_amdgcn_mfma_f32_32x32x16_bf16(paB3, PKV(3), o[0], 0, 0, 0); o[1] = __builtin_amdgcn_mfma_f32_32x32x16_bf16(paB3, PKV(7), o[1], 0, 0, 0); }
  { auto rr = __builtin_amdgcn_permlane32_swap(__float_as_uint(l_reg), __float_as_uint(l_reg), false, false); l_reg = __uint_as_float(rr[0]) + __uint_as_float(rr[1]); }
  if (hi == 0) li_l[r32] = l_reg; asm volatile("s_waitcnt lgkmcnt(0)" ::: "memory");
  store_o(o, li_l, Ob + (long)(wid * 32) * 512, lds + MLA_OIMG + wid * OIMG_WAVE, lane, r32, hi);
  BAR_V(0);
#undef DMA_K
#undef DMA_V
#undef STEP_BAR
#undef KFR
#undef QKM
#undef VRDJ
#undef PKV
#undef EXQ
#undef CV
#undef EX2
#undef PK4
#undef STEP
}
#undef BAR_L
#undef BAR_V

constexpr int NA_KROWB = 144, NA_LDS_K = 64 * NA_KROWB  , NA_SLOT = NA_LDS_K + 8192  , NA_OIMG = 2 * NA_SLOT + 15 * 32 * 4 + 8 * 256  , NA_LDS = NA_OIMG + 8 * OIMG_WAVE;
template <int CH> __device__ __forceinline__ constexpr bool na_live0(int q) { return CH == 0 ? true : q >= 12; }
template <int CH> __device__ __forceinline__ constexpr bool na_live1(int q) { return CH == 0 ? q < 4 : true; }
template <int CH> __device__ __forceinline__ void na_tile(f32x16& p0, f32x16& p1, const ATT_LAS float* trow, int qcol, int wstart, int hi, int r32, bool first,
                                                          float& m_ref, float& l_reg, f32x16& negm, f32x16 (&o)[2], ATT_LAS float* al_l, int vb) {
  float bz0[16], bz1[16];
#pragma unroll
  for (int q = 0; q < 16; ++q) { const int kc0 = crow(q, hi), kc1 = kc0 + 32;
    if (na_live0<CH>(q)) { const int i0 = min(max(kc0 - qcol + 15, 0), 30); bz0[q] = trow[i0]; }
    if (na_live1<CH>(q)) { const int i1 = min(max(kc1 - qcol + 15, 0), 30); bz1[q] = trow[i1]; } }
#pragma unroll
  for (int q = 0; q < 16; ++q) { if (na_live0<CH>(q)) asm volatile("" : "+v"(bz0[q])); if (na_live1<CH>(q)) asm volatile("" : "+v"(bz1[q])); }
#pragma unroll
  for (int q = 0; q < 16; ++q) { const int kc0 = crow(q, hi), kc1 = kc0 + 32;
    if (na_live0<CH>(q)) p0[q] = ((unsigned)(kc0 - wstart) < 16u) ? p0[q] + bz0[q] : -1e30f;
    if (na_live1<CH>(q)) p1[q] = ((unsigned)(kc1 - wstart) < 16u) ? p1[q] + bz1[q] : -1e30f; }
  float rm = -1e30f;
#pragma unroll
  for (int q = 0; q < 16; ++q) { if (na_live0<CH>(q)) rm = __builtin_fmaxf(rm, p0[q]); if (na_live1<CH>(q)) rm = __builtin_fmaxf(rm, p1[q]); }
  { auto rr = __builtin_amdgcn_permlane32_swap(__float_as_uint(rm), __float_as_uint(rm), false, false); rm = __builtin_fmaxf(__uint_as_float(rr[0]), __uint_as_float(rr[1])); }
  float al = 1.f;
  if (first || !__builtin_expect(__all(rm <= THR), 1)) {
    const float dl = first ? rm : __builtin_fmaxf(rm, 0.f); m_ref += dl;
#pragma unroll
    for (int q = 0; q < 16; ++q) { if (na_live0<CH>(q)) p0[q] -= dl; if (na_live1<CH>(q)) p1[q] -= dl; }
#pragma unroll
    for (int q = 0; q < 16; ++q) negm[q] = -m_ref;
    asm volatile("" : "+v"(negm));
    if (!first) al = __builtin_amdgcn_exp2f(-dl);
    if (__any(al < 1.f)) { if (hi == 0) al_l[r32] = al; asm volatile("s_waitcnt lgkmcnt(0)" ::: "memory");
#pragma unroll
      for (int q = 0; q < 16; ++q) { const float f_ = al_l[crow(q, hi)]; o[0][q] *= f_; o[1][q] *= f_; } }
  }
  float ps = 0.f;
#pragma unroll
  for (int q = 0; q < 16; ++q) { if (na_live0<CH>(q)) { p0[q] = __builtin_amdgcn_exp2f(p0[q]); ps += p0[q]; } else p0[q] = 0.f;
    if (na_live1<CH>(q)) { p1[q] = __builtin_amdgcn_exp2f(p1[q]); ps += p1[q]; } else p1[q] = 0.f; }
  l_reg = l_reg * al + ps;
  bf16x8 pa0, pa1, pa2, pa3;
#define PK4(P, BASE, OUT) do { unsigned a0 = cvtpk(P[BASE + 0], P[BASE + 1]), a1 = cvtpk(P[BASE + 2], P[BASE + 3]);   \
    unsigned b0_ = cvtpk(P[BASE + 4], P[BASE + 5]), b1_ = cvtpk(P[BASE + 6], P[BASE + 7]);                              \
    auto r0_ = __builtin_amdgcn_permlane32_swap(a0, b0_, false, false); auto r1_ = __builtin_amdgcn_permlane32_swap(a1, b1_, false, false); \
    u32x4 w = {r0_[0], r1_[0], r0_[1], r1_[1]}; OUT = *reinterpret_cast<bf16x8*>(&w); } while (0)
  if (CH == 1) { PK4(p0, 8, pa1); PK4(p1, 0, pa2); PK4(p1, 8, pa3); } else { PK4(p0, 0, pa0); PK4(p0, 8, pa1); PK4(p1, 0, pa2); }
#undef PK4
  SBAR();
  { const ATT_LAS char* vbp = (const ATT_LAS char*)(unsigned)vb;
#define NA_VF(D0, KS) const s16x4 l##D0##KS = vtr(vbp + v_rd_off(D0, KS, 0)), h##D0##KS = vtr(vbp + v_rd_off(D0, KS, 1))
#define NA_PV(D0, KS, PA) o[D0] = __builtin_amdgcn_mfma_f32_32x32x16_bf16(PA, (bf16x8){l##D0##KS[0], l##D0##KS[1], l##D0##KS[2], l##D0##KS[3], h##D0##KS[0], h##D0##KS[1], h##D0##KS[2], h##D0##KS[3]}, o[D0], 0, 0, 0)
    NA_VF(0, 1); NA_VF(1, 1); NA_VF(0, 2); NA_VF(1, 2);
    if (CH == 0) { NA_VF(0, 0); NA_VF(1, 0); NA_PV(0, 0, pa0); NA_PV(1, 0, pa0); }
    NA_PV(0, 1, pa1); NA_PV(1, 1, pa1); NA_PV(0, 2, pa2); NA_PV(1, 2, pa2);
    if (CH == 1) { NA_VF(0, 3); NA_VF(1, 3); NA_PV(0, 3, pa3); NA_PV(1, 3, pa3); }
#undef NA_VF
#undef NA_PV
  }
}
__device__ __forceinline__ void na_unit(int b, int h, int rg, const bf16* __restrict__ QKV, bf16* __restrict__ O, const float* __restrict__ rpb, ATT_LAS char* lds, const int wave_id) {
  int lane_; asm volatile("v_mbcnt_lo_u32_b32 %0, -1, 0\n\tv_mbcnt_hi_u32_b32 %0, -1, %0" : "=v"(lane_));
  int w_ = wave_id; asm volatile("" : "+s"(w_));
  const int wid = w_, lane = lane_, tid = wid * 64 + lane, r32 = lane & 31, hi = lane >> 5;
  ATT_LAS char* K_lds = lds; ATT_LAS char* V_lds = lds + NA_LDS_K; ATT_LAS float* tab = (ATT_LAS float*)(lds + 2 * NA_SLOT);
  ATT_LAS float* ws = (ATT_LAS float*)(lds + 2 * NA_SLOT + 15 * 32 * 4) + wid * 64; ATT_LAS float* li_l = ws; ATT_LAS float* al_l = ws + 32;
  const int r0 = 4 * rg, r = r0 + (wid >> 1), ch = wid & 1, qcol = 32 * ch + r32;
  const int rs = min(max(r - 4, 0), 120), lo = min(max(r0 - 4, 0), 120), hiR = min(max(r0 + 3 - 4, 0), 120) + 7;
  const int wstart = min(max(qcol - 8, 0), 48);
  const long tok0 = (long)b * 8192;
  if (tid < 15 * 32) { const int dr = tid >> 5, dc = tid & 31; tab[tid] = (dc < 31) ? rpb[(h * 15 + dr) * 31 + dc] * 1.4426950408889634f : 0.f; }
  bf16x8 qr[4];
  { const bf16* Qw = QKV + (tok0 + r * 64 + qcol) * 1536 + h * 64 + hi * 8;
#pragma unroll
    for (int d0 = 0; d0 < 4; ++d0) qr[d0] = *reinterpret_cast<const bf16x8*>(Qw + d0 * 16); }
  const int srow = tid >> 3, sch = tid & 7; const int kst = srow * NA_KROWB + sch * 16, vst = v_st(srow, sch * 8);
  const int vb0 = (int)(unsigned)(uintptr_t)V_lds + v_rd_base(lane);
  const bf16* Ksrc = QKV + (tok0 + srow) * 1536 + 512 + h * 64 + sch * 8; const bf16* Vsrc = Ksrc + 512;
  float m_ref = 0.f, l_reg = 0.f; f32x16 o[2] = {}; f32x16 negm = {};
#define NA_LD(KR, KV, VV) do { const int kk_ = min((KR), hiR); KV = *reinterpret_cast<const bf16x8*>(Ksrc + (long)kk_ * 64 * 1536); VV = *reinterpret_cast<const bf16x8*>(Vsrc + (long)kk_ * 64 * 1536); } while (0)
#define NA_BODY(KR, KN, VN, CHV) do { \
    __syncthreads();                                               \
    if ((KR) + 1 <= hiR) { *(ATT_LAS bf16x8*)(K_lds + (par ^ 1) * NA_SLOT + kst) = KN; *(ATT_LAS bf16x8*)(V_lds + (par ^ 1) * NA_SLOT + vst) = VN; NA_LD((KR) + 3, KN, VN); } \
    if ((KR) >= rs && (KR) < rs + 8) {                              \
      f32x16 p0, p1; qkt_from<4, NA_KROWB>(p0, p1, K_lds + par * NA_SLOT, qr, negm, r32, hi); \
      const ATT_LAS float* trow = tab + ((KR) - r + 7) * 32; \
      na_tile<CHV>(p0, p1, trow, qcol, wstart, hi, r32, (KR) == rs, m_ref, l_reg, negm, o, al_l, vb0 + par * NA_SLOT); \
    } \
    par ^= 1; } while (0)
  bf16x8 k0, v0, k1, v1;
  NA_LD(lo, k0, v0); NA_LD(lo + 1, k1, v1);
  *(ATT_LAS bf16x8*)(K_lds + kst) = k0; *(ATT_LAS bf16x8*)(V_lds + vst) = v0; NA_LD(lo + 2, k0, v0);
  int par = 0;
  if (ch == 0) {
    for (int kr = lo; kr <= hiR; kr += 2) {
      NA_BODY(kr, k1, v1, 0);
      if (kr + 1 > hiR) break;
      NA_BODY(kr + 1, k0, v0, 0);
    }
  } else {
    for (int kr = lo; kr <= hiR; kr += 2) {
      NA_BODY(kr, k1, v1, 1);
      if (kr + 1 > hiR) break;
      NA_BODY(kr + 1, k0, v0, 1);
    }
  }
#undef NA_LD
#undef NA_BODY
  { auto rr = __builtin_amdgcn_permlane32_swap(__float_as_uint(l_reg), __float_as_uint(l_reg), false, false); l_reg = __uint_as_float(rr[0]) + __uint_as_float(rr[1]); }
  if (hi == 0) li_l[r32] = l_reg; asm volatile("s_waitcnt lgkmcnt(0)" ::: "memory");
  store_o(o, li_l, O + (tok0 + r * 64 + 32 * ch) * 512 + h * 64, lds + NA_OIMG + wid * OIMG_WAVE, lane, r32, hi);
  __syncthreads();
}
#undef SBAR
}

constexpr int NWAVES = 8;
constexpr int NB = 8, SEQ = 8192, DM = 1024, MTOK = NB * SEQ;
constexpr int NIN = 4640, NPROJ = 4864;
constexpr int DFF = 2816, DFFE = 3584, NEXP = 8, PLED = 256;
constexpr int QLORA = 768, KVLORA = 256;
constexpr float ALPHA = 1.4142135623730951f;
constexpr float LN_EPS = 1e-5f, RMS_EPS = 1e-6f;
constexpr float LOG2E = 1.4426950408889634f;
constexpr float NA_QSCALE = 0.125f * LOG2E;
constexpr float MLA_QSCALE = 0.10206207261596575f * LOG2E;
constexpr int MOE_CHUNK = 128, MOE_NCHUNK = 4, MOE_REMT = 8, MOE_MAXT = 520;

constexpr size_t MiB = 1u << 20;
constexpr size_t WS_CTL = 0, CTL_ZERO_BYTES = 64 * 1024;
constexpr size_t WS_ROPE = 1 * MiB;
constexpr size_t WS_W = 2 * MiB;
constexpr size_t W_WIN = 0, W_WUQ = W_WIN + (size_t)NPROJ * 1024 * 2, W_WUKV = W_WUQ + 768 * 768 * 2, W_WNAO = W_WUKV + 1024 * 256 * 2, W_WMLAO = W_WNAO + 1024 * 512 * 2,
                 W_WOUT = W_WMLAO + 1024 * 512 * 2, W_WPG = W_WOUT + 1024 * 1024 * 2, W_WPLE = W_WPG + 1024 * 1024 * 2, W_LAYER = W_WPLE + 1024 * 256 * 2;
constexpr size_t WS_W13 = WS_W + 2 * W_LAYER, WS_W2 = WS_W13 + (size_t)2 * DFF * 1024 * 2, WS_WEND = WS_W2 + (size_t)1024 * DFF * 2;
static_assert(WS_WEND <= 56 * MiB, "weights");
constexpr size_t WS_SX = 54 * MiB, WS_SX1 = WS_SX + 256 * 1024, WS_SXS = WS_SX + 512 * 1024;
constexpr size_t WS_SWIN = 55 * MiB + 256 * 1024, WS_SW13 = WS_SWIN + 64 * 1024, WS_SWM13 = WS_SW13 + 32 * 1024;
constexpr size_t WS_SWPG = WS_SWM13 + 8 * 7168 * 4;
static_assert(WS_WEND <= WS_SX && WS_SWPG + 2 * 1024 * 4 <= 56 * MiB, "scales");
constexpr size_t WS_PB = 56 * MiB;
constexpr size_t WS_TE = 88 * MiB, WS_TP = 88 * MiB + 512 * 1024, WS_TW = 89 * MiB, WS_TPOS = 89 * MiB + 512 * 1024, WS_SW = 90 * MiB, WS_CNT = 91 * MiB;
constexpr size_t WS_PS = 92 * MiB;
constexpr size_t WS_XB = 96 * MiB;
constexpr size_t WS_QMLA = WS_XB;
constexpr size_t WS_GATES = 224 * MiB;
constexpr size_t WS_NAQKV = 480 * MiB;
constexpr size_t WS_MERGED = WS_NAQKV;
constexpr size_t WS_QLAT = 672 * MiB, WS_KVLAT = 768 * MiB;
constexpr size_t WS_ONA = 672 * MiB, WS_OMLA = 736 * MiB;
constexpr size_t WS_KMLA = 800 * MiB, WS_VMLA = 896 * MiB;
constexpr size_t WS_H = 224 * MiB, WS_PP_DENSE = 576 * MiB;
constexpr size_t WS_PP_MOE = 224 * MiB, WS_XS = 352 * MiB, WS_HS = 612 * MiB, WS_WM13 = 856 * MiB, WS_WM2 = 968 * MiB, WS_END = 1024 * MiB;
static_assert(WS_XS + (size_t)MOE_MAXT * 256 * 1024 * 2 <= WS_HS && WS_HS + (size_t)(MOE_CHUNK + MOE_REMT) * 256 * DFFE * 2 <= WS_WM13 && WS_WM13 + (size_t)NEXP * 2 * DFFE * 1024 * 2 == WS_WM2 && WS_WM2 + (size_t)NEXP * 1024 * DFFE * 2 == WS_END, "moe map");
static_assert(WS_H + (size_t)MTOK * DFF * 2 <= WS_PP_DENSE, "dense map");
constexpr size_t WS_G8 = 704 * MiB;
constexpr size_t WS_PART = 912 * MiB;
constexpr int MOE_REM_ROWS = MOE_REMT * 256, MOE_FULL = MOE_NCHUNK * MOE_CHUNK;
static_assert(WS_PART >= WS_WM13 + (size_t)NEXP * 2 * DFFE * 1024 && WS_PART + (size_t)4 * MOE_REM_ROWS * 1024 * 2 <= WS_WM2, "partials");
static_assert(WS_G8 >= WS_PP_DENSE + (size_t)MTOK * 1024 * 2 && WS_G8 >= WS_HS && WS_G8 + (size_t)MTOK * 1024 <= WS_WM13, "gate map");
constexpr int CW_BAR = 4096;
constexpr int RING_OFF = 0, RING_BYTES = 131072;
constexpr int LDSCTL_OFF = RING_BYTES;
constexpr int X_LCNT = RING_BYTES + 512, X_OFF = X_LCNT + 64, X_TOT = X_OFF + 64, X_RTAB = X_TOT + 64, X_PRE = X_RTAB + 4 * 256 * 4, X_END = X_PRE + 256 * 8 * 4;
constexpr int X_SCL = 147456;
constexpr int LDS_BYTES = 155648;
static_assert(X_END <= X_SCL && X_SCL + 4096 <= LDS_BYTES, "LDS map");

#include <hip/hip_bf16.h>
#define GAS __attribute__((address_space(1)))
#define LAS __attribute__((address_space(3)))
typedef unsigned short bf16;
typedef unsigned v4u __attribute__((ext_vector_type(4)));
typedef float f32x4 __attribute__((ext_vector_type(4)));
typedef short bf16x8 __attribute__((ext_vector_type(8)));
typedef GAS unsigned gu32;
typedef GAS unsigned long long gu64;
#define RLX_AGENT __ATOMIC_RELAXED, __HIP_MEMORY_SCOPE_AGENT
#define LDS_WAIT() asm volatile("s_waitcnt lgkmcnt(0)" ::: "memory")
#define VM_WAIT() asm volatile("s_waitcnt vmcnt(0)" ::: "memory")
__device__ __forceinline__ unsigned long long rt() { return __builtin_amdgcn_s_memrealtime(); }
__device__ __forceinline__ unsigned f2bf(float f) { unsigned u = __builtin_bit_cast(unsigned, f); return (u + 0x7fffu + ((u >> 16) & 1u)) >> 16; }
__device__ __forceinline__ unsigned pk2(float lo, float hi) { return f2bf(lo) | (f2bf(hi) << 16); }

#define XB_TMO      128
#define XB_XCNT(j)  (256  + 64 * (j))
#define XB_XSUB(j)  (1280 + 64 * (j))
#define XB_XGEN(j)  (2304 + 64 * (j))
#define XB_TOP      3328
#define XB_TOPGEN   3392
#define XCD_BAR_WORDS 3456
#define XB_SPIN_CAP (1u << 18)

__device__ __forceinline__ unsigned xb_ld(unsigned* p)              { return __hip_atomic_load(p, __ATOMIC_RELAXED, __HIP_MEMORY_SCOPE_AGENT); }
__device__ __forceinline__ unsigned xb_add(unsigned* p, unsigned v) { return __hip_atomic_fetch_add(p, v, __ATOMIC_RELAXED, __HIP_MEMORY_SCOPE_AGENT); }
__device__ __forceinline__ unsigned xb_xcc_id() { return (unsigned)__builtin_amdgcn_s_getreg((3 << 11) | 20) & 0xFu; }
#define XB_SPIN(cond, bar) do { unsigned _sp = 0; while (cond) { __builtin_amdgcn_s_sleep(1); \
    if ((++_sp & 255u) == 0u) { if (xb_ld(&(bar)[XB_TMO])) break; if (_sp > XB_SPIN_CAP) { atomicAdd(&(bar)[XB_TMO], 1u); break; } } } } while (0)

struct XcdBarrier {
    unsigned* bar; unsigned x;
    volatile LAS unsigned* st;
    unsigned w0;
};

__device__ __forceinline__ XcdBarrier xcd_barrier_post(unsigned* bar, volatile LAS unsigned* st) {
    XcdBarrier b; b.bar = bar; b.x = xb_xcc_id(); b.st = st; b.w0 = (unsigned)__builtin_amdgcn_readfirstlane(threadIdx.x < 64u ? 1 : 0);
    if (threadIdx.x == 0) (void)xb_add(&bar[XB_XCNT(b.x)], 1u);
    return b;
}
__device__ __forceinline__ void xcd_barrier_complete(unsigned* bar, unsigned x, unsigned& nloc, unsigned& nx) {
    const unsigned G = gridDim.x * gridDim.y * gridDim.z;
    unsigned sum, cnt, mine, sp = 0u;
    for (;;) {
        sum = 0u; cnt = 0u; mine = 0u;
#pragma unroll
        for (unsigned j = 0; j < 16; ++j) { const unsigned c = xb_ld(&bar[XB_XCNT(j)]); sum += c; cnt += (c > 0u) ? 1u : 0u; mine = (j == x) ? c : mine; }
        if (sum == G) break;
        __builtin_amdgcn_s_sleep(1);
        if ((++sp & 255u) == 0u) { if (xb_ld(&bar[XB_TMO])) break; if (sp > XB_SPIN_CAP) { atomicAdd(&bar[XB_TMO], 1u); break; } }
    }
    nloc = mine > 0u ? mine : 1u; nx = cnt > 0u ? cnt : 1u;
}

__device__ __forceinline__ void xcd_barrier(const XcdBarrier& b) {
    asm volatile("s_waitcnt vmcnt(0)" ::: "memory");
    __syncthreads();
    int xl_; asm volatile("v_mbcnt_lo_u32_b32 %0, -1, 0\n\tv_mbcnt_hi_u32_b32 %0, -1, %0" : "=v"(xl_));
    if (b.w0 && xl_ == 0) {
        unsigned* bar = b.bar;
        __builtin_amdgcn_s_waitcnt(0);
        unsigned nloc = b.st[0], nx = b.st[1];
        if (nloc == 0u) { xcd_barrier_complete(bar, b.x, nloc, nx); b.st[0] = nloc; b.st[1] = nx; }
        const unsigned old = xb_add(&bar[XB_XSUB(b.x)], 1u);
        const unsigned gen = old / nloc;
        if (old + 1u == (gen + 1u) * nloc) {
            __builtin_amdgcn_fence(__ATOMIC_RELEASE, "agent");
            asm volatile("s_waitcnt vmcnt(0)" ::: "memory");
            const unsigned og = xb_add(&bar[XB_TOP], 1u);
            const unsigned tg = og / nx;
            if (og + 1u == (tg + 1u) * nx) xb_add(&bar[XB_TOPGEN], 1u);
            else XB_SPIN(xb_ld(&bar[XB_TOPGEN]) == tg, bar);
            __builtin_amdgcn_fence(__ATOMIC_ACQUIRE, "agent");
            xb_add(&bar[XB_XGEN(b.x)], 1u);
            asm volatile("s_waitcnt vmcnt(0)" ::: "memory");
        } else {
            XB_SPIN(xb_ld(&bar[XB_XGEN(b.x)]) == gen, bar);
            __builtin_amdgcn_fence(__ATOMIC_ACQUIRE, "agent");
            asm volatile("s_waitcnt vmcnt(0)" ::: "memory");
        }
    }
    __syncthreads();
}


typedef unsigned v2u __attribute__((ext_vector_type(2)));
struct Args { const float* in[26]; float* out; unsigned char* ws; int ph_lo, ph_hi; };
struct Frame {
    LAS unsigned char* lds;
    int tid, lane, wave, vcu, G;
};
#define WR_DPP(v, ctrl) __int_as_float(__builtin_amdgcn_update_dpp(0, __float_as_int(v), (ctrl), 0xf, 0xf, true))
__device__ __forceinline__ float wave_sum(float v) {
    v += WR_DPP(v, 0xB1); v += WR_DPP(v, 0x4E); v += WR_DPP(v, 0x141); v += WR_DPP(v, 0x140);
    { const auto r = __builtin_amdgcn_permlane16_swap(__float_as_uint(v), __float_as_uint(v), false, false); v = __uint_as_float(r[0]) + __uint_as_float(r[1]); }
    { const auto r = __builtin_amdgcn_permlane32_swap(__float_as_uint(v), __float_as_uint(v), false, false); v = __uint_as_float(r[0]) + __uint_as_float(r[1]); }
    return v;
}
__device__ __forceinline__ float wave_max(float v) {
    v = fmaxf(v, WR_DPP(v, 0xB1)); v = fmaxf(v, WR_DPP(v, 0x4E)); v = fmaxf(v, WR_DPP(v, 0x141)); v = fmaxf(v, WR_DPP(v, 0x140));
    { const auto r = __builtin_amdgcn_permlane16_swap(__float_as_uint(v), __float_as_uint(v), false, false); v = fmaxf(__uint_as_float(r[0]), __uint_as_float(r[1])); }
    { const auto r = __builtin_amdgcn_permlane32_swap(__float_as_uint(v), __float_as_uint(v), false, false); v = fmaxf(__uint_as_float(r[0]), __uint_as_float(r[1])); }
    return v;
}
__device__ __forceinline__ float half_max32(float v) { const auto r = __builtin_amdgcn_permlane32_swap(__float_as_uint(v), __float_as_uint(v), false, false); return fmaxf(__uint_as_float(r[0]), __uint_as_float(r[1])); }
__device__ __forceinline__ float bflo(unsigned w) { return __uint_as_float(w << 16); }
__device__ __forceinline__ float bfhi(unsigned w) { return __uint_as_float(w & 0xffff0000u); }

__device__ __forceinline__ void tr_item(const float* W, int K, int N, bf16* WT, int g, int s0, int ss, int d0, int ds, const float* gs, LAS float* scr, int item, int ncols, int lane) {
    const int nblk = ncols / 32, kb = item / nblk, nb = item % nblk, k0 = 64 * kb, j0 = 32 * nb;
    const int grp = j0 / g, jin = j0 % g, sn0 = s0 + grp * ss + jin, dn0 = d0 + grp * ds + jin;
    float v[32];
#pragma unroll
    for (int i = 0; i < 32; ++i) { const int kk = 2 * i + (lane >> 5); v[i] = W[(size_t)(k0 + kk) * N + sn0 + (lane & 31)]; }
    if (gs) {
#pragma unroll
        for (int i = 0; i < 32; ++i) v[i] *= gs[k0 + 2 * i + (lane >> 5)]; }
#pragma unroll
    for (int i = 0; i < 32; ++i) scr[(2 * i + (lane >> 5)) * 33 + (lane & 31)] = v[i];
    LDS_WAIT(); asm volatile("" ::: "memory");
    const int c = lane & 7;
#pragma unroll
    for (int j = 0; j < 4; ++j) { const int n = (lane >> 3) + 8 * j; const LAS float* s = scr + (8 * c) * 33 + n;
        v4u o; o.x = pk2(s[0 * 33], s[1 * 33]); o.y = pk2(s[2 * 33], s[3 * 33]); o.z = pk2(s[4 * 33], s[5 * 33]); o.w = pk2(s[6 * 33], s[7 * 33]);
        *(GAS v4u*)(WT + (size_t)(dn0 + n) * K + k0 + 8 * c) = o; }
    LDS_WAIT(); asm volatile("" ::: "memory");
}
__device__ __forceinline__ void tr_job(Frame& F, int& rot, const float* W, int K, int N, int ncols, bf16* WT, int g, int s0, int ss, int d0, int ds, const float* gs) {
    LAS float* scr = (LAS float*)(F.lds + RING_OFF + F.wave * 16384);
    const int NGW = F.G * NWAVES, gw = F.vcu * NWAVES + F.wave, nitems = (K / 64) * (ncols / 32);
    int first = (gw - rot) % NGW; if (first < 0) first += NGW;
    for (int it = first; it < nitems; it += NGW) tr_item(W, K, N, WT, g, s0, ss, d0, ds, gs, scr, it, ncols, F.lane);
    rot = (rot + nitems) % NGW;
}
__device__ __forceinline__ void tr_plain(Frame& F, int& rot, const float* W, int K, int N, bf16* WT) { tr_job(F, rot, W, K, N, N, WT, N, 0, 0, 0, 0, nullptr); }
__device__ __forceinline__ void cvt_rows(Frame& F, const float* src, bf16* dst, size_t n8) {
    const size_t NT = (size_t)F.G * NWAVES * 64, t0 = (size_t)(F.vcu * NWAVES + F.wave) * 64 + F.lane;
    size_t i = t0;
    for (; i + 3 * NT < n8; i += 4 * NT) { f32x4 a[4], b[4];
#pragma unroll
        for (int q = 0; q < 4; ++q) { a[q] = *(const GAS f32x4*)(src + (i + q * NT) * 8); b[q] = *(const GAS f32x4*)(src + (i + q * NT) * 8 + 4); }
#pragma unroll
        for (int q = 0; q < 4; ++q) { v4u o; o.x = pk2(a[q].x, a[q].y); o.y = pk2(a[q].z, a[q].w); o.z = pk2(b[q].x, b[q].y); o.w = pk2(b[q].z, b[q].w); *(GAS v4u*)(dst + (i + q * NT) * 8) = o; } }
    for (; i < n8; i += NT) { const f32x4 a = *(const GAS f32x4*)(src + i * 8), b = *(const GAS f32x4*)(src + i * 8 + 4);
        v4u o; o.x = pk2(a.x, a.y); o.y = pk2(a.z, a.w); o.z = pk2(b.x, b.y); o.w = pk2(b.z, b.w); *(GAS v4u*)(dst + i * 8) = o; }
}

__device__ __forceinline__ unsigned pack4i8(float a, float b, float c, float d) {
    const int ia = (int)__builtin_rintf(a), ib = (int)__builtin_rintf(b), ic = (int)__builtin_rintf(c), id = (int)__builtin_rintf(d);
    return (unsigned)(ia & 0xff) | ((unsigned)(ib & 0xff) << 8) | ((unsigned)(ic & 0xff) << 16) | ((unsigned)id << 24);
}
__device__ __forceinline__ void trq_job(Frame& F, int& rot, const float* W, int K, int N, int ncols, signed char* WQ, float* SC, int g, int s0, int ss, int d0, int ds) {
    LAS float* scr = (LAS float*)(F.lds + RING_OFF + F.wave * 16384);
    const int NGW = F.G * NWAVES, gw = F.vcu * NWAVES + F.wave, nitems = ncols / 32, lane = F.lane;
    int first = (gw - rot) % NGW; if (first < 0) first += NGW;
    for (int it = first; it < nitems; it += NGW) {
        const int j0 = 32 * it, grp = j0 / g, jin = j0 % g, sn0 = s0 + grp * ss + jin, dn0 = d0 + grp * ds + jin;
        const float* wp = W + sn0 + (lane & 31) + (size_t)(lane >> 5) * N;
        float mx = 0.f;
        for (int kb = 0; kb < K / 64; ++kb) { float v[32];
#pragma unroll
            for (int i = 0; i < 32; ++i) v[i] = wp[(size_t)(kb * 64 + 2 * i) * N];
#pragma unroll
            for (int i = 0; i < 32; ++i) mx = fmaxf(mx, fabsf(v[i])); }
        mx = half_max32(mx);
        const float inv = mx > 0.f ? 127.f / mx : 0.f;
        if (lane < 32) SC[dn0 + lane] = mx > 0.f ? mx * (1.f / 127.f) : 1.f;
        for (int kb = 0; kb < K / 64; ++kb) { float v[32];
#pragma unroll
            for (int i = 0; i < 32; ++i) v[i] = wp[(size_t)(kb * 64 + 2 * i) * N];
#pragma unroll
            for (int i = 0; i < 32; ++i) scr[(2 * i + (lane >> 5)) * 33 + (lane & 31)] = v[i] * inv;
            LDS_WAIT(); asm volatile("" ::: "memory");
            const int n = lane >> 1, hf = lane & 1; const LAS float* s = scr + (hf * 32) * 33 + n;
            v4u o0, o1;
            o0.x = pack4i8(s[0 * 33], s[1 * 33], s[2 * 33], s[3 * 33]); o0.y = pack4i8(s[4 * 33], s[5 * 33], s[6 * 33], s[7 * 33]); o0.z = pack4i8(s[8 * 33], s[9 * 33], s[10 * 33], s[11 * 33]); o0.w = pack4i8(s[12 * 33], s[13 * 33], s[14 * 33], s[15 * 33]);
            o1.x = pack4i8(s[16 * 33], s[17 * 33], s[18 * 33], s[19 * 33]); o1.y = pack4i8(s[20 * 33], s[21 * 33], s[22 * 33], s[23 * 33]); o1.z = pack4i8(s[24 * 33], s[25 * 33], s[26 * 33], s[27 * 33]); o1.w = pack4i8(s[28 * 33], s[29 * 33], s[30 * 33], s[31 * 33]);
            GAS v4u* dp = (GAS v4u*)(WQ + (size_t)(dn0 + n) * K + kb * 64 + hf * 32); dp[0] = o0; dp[1] = o1;
            LDS_WAIT(); asm volatile("" ::: "memory"); }
    }
    rot = (rot + nitems) % NGW;
}
__device__ __forceinline__ void store_q8(signed char* XQ, float* SX, size_t m, const f32x4 (&v)[4], int lane) {
    float mx = 0.f;
#pragma unroll
    for (int j = 0; j < 4; ++j) mx = fmaxf(fmaxf(mx, fmaxf(fabsf(v[j].x), fabsf(v[j].y))), fmaxf(fabsf(v[j].z), fabsf(v[j].w)));
    mx = wave_max(mx);
    const float inv = mx > 0.f ? 127.f / mx : 0.f;
    GAS unsigned* o4 = (GAS unsigned*)(XQ + m * DM) + lane;
#pragma unroll
    for (int j = 0; j < 4; ++j) o4[64 * j] = pack4i8(v[j].x * inv, v[j].y * inv, v[j].z * inv, v[j].w * inv);
    if (lane == 0) SX[m] = mx > 0.f ? mx * (1.f / 127.f) : 1.f;
}

template <class Sched> __device__ __forceinline__ void rms_prepass(Frame& F, const Sched& S, const float* PS, int p0, int NP, int K) {
    LAS float* rtab = (LAS float*)(F.lds + X_RTAB); pg8::Unit u;
    if (F.tid < 256) {
        for (int i = 0; i < 4 && S.next(i, u); ++i) { const GAS f32x4* pp = (const GAS f32x4*)(PS + (size_t)(u.pa * 256 + F.tid) * 16 + p0);
            float s = 0.f;
            for (int j = 0; j < NP / 4; ++j) { const f32x4 x = pp[j]; s += (x[0] + x[1]) + (x[2] + x[3]); }
            rtab[i * 256 + F.tid] = 1.0f / sqrtf(s / (float)K + RMS_EPS); }
    }
    LDS_WAIT(); __syncthreads();
}

__device__ __forceinline__ void ln_core(f32x4 (&v)[4], const f32x4 (&g)[4], const f32x4 (&bb)[4]) {
    float s = 0.f;
#pragma unroll
    for (int j = 0; j < 4; ++j) s += (v[j].x + v[j].y) + (v[j].z + v[j].w);
    const float mean = wave_sum(s) * (1.f / DM); float s2 = 0.f;
#pragma unroll
    for (int j = 0; j < 4; ++j) { v[j] = v[j] - mean; s2 += (v[j].x * v[j].x + v[j].y * v[j].y) + (v[j].z * v[j].z + v[j].w * v[j].w); }
    const float rstd = 1.f / sqrtf(wave_sum(s2) * (1.f / DM) + LN_EPS);
#pragma unroll
    for (int j = 0; j < 4; ++j) v[j] = v[j] * rstd * g[j] + bb[j];
}
__device__ __forceinline__ void store_row(float* R, bf16* XB, size_t m, const f32x4 (&v)[4], int lane, bool wb) {
    GAS f32x4* o = (GAS f32x4*)(R + m * DM) + lane;
#pragma unroll
    for (int j = 0; j < 4; ++j) o[64 * j] = v[j];
    if (wb) { GAS unsigned long long* o8 = (GAS unsigned long long*)(XB + m * DM) + lane;
#pragma unroll
        for (int j = 0; j < 4; ++j) o8[64 * j] = (unsigned long long)pk2(v[j].x, v[j].y) | ((unsigned long long)pk2(v[j].z, v[j].w) << 32); }
}

__device__ __forceinline__ void load_bf(f32x4 (&v)[4], const bf16* Y, size_t m, int lane) {
    const GAS v2u* p = (const GAS v2u*)(Y + m * DM) + lane;
#pragma unroll
    for (int j = 0; j < 4; ++j) { const v2u w = p[64 * j]; v[j].x = bflo(w.x); v[j].y = bfhi(w.x); v[j].z = bflo(w.y); v[j].w = bfhi(w.y); }
}
__device__ __forceinline__ void store_bf(bf16* XB, size_t m, const f32x4 (&v)[4], int lane) {
    GAS unsigned long long* o8 = (GAS unsigned long long*)(XB + m * DM) + lane;
#pragma unroll
    for (int j = 0; j < 4; ++j) o8[64 * j] = (unsigned long long)pk2(v[j].x, v[j].y) | ((unsigned long long)pk2(v[j].z, v[j].w) << 32);
}
__device__ __forceinline__ void moe_tables(Frame& F, const int* CNT, bool wantPre) {
    LAS int* tot = (LAS int*)(F.lds + X_TOT); LAS int* off = (LAS int*)(F.lds + X_OFF); LAS int* pre = (LAS int*)(F.lds + X_PRE);
    const int e = F.wave;
    int carry = 0;
    for (int b0 = 0; b0 < F.G; b0 += 64) { const int blk = b0 + F.lane; const int v = (blk < F.G) ? CNT[blk * 8 + e] : 0;
        int inc = v;
#pragma unroll
        for (int o = 1; o < 64; o <<= 1) { const int t = __builtin_amdgcn_ds_bpermute(4 * (F.lane - o), inc); if (F.lane >= o) inc += t; }
        if (wantPre && blk < F.G && blk < 256) pre[blk * 8 + e] = carry + inc - v;
        carry += __builtin_amdgcn_readlane(inc, 63); }
    if (F.lane == 0) tot[e] = carry;
    LDS_WAIT(); __syncthreads();
    if (F.tid == 0) { int o = 0; for (int j = 0; j < 8; ++j) { off[j] = o; o += (tot[j] + 255) & ~255; } off[8] = o; }
    LDS_WAIT(); __syncthreads();
}

#ifndef REP_P0
#define REP_P0 1
#endif
#ifndef REP_MC
#define REP_MC 1
#endif
#ifndef REP_A
#define REP_A 1
#endif
#ifndef REP_MU
#define REP_MU 1
#endif
#ifndef REP_MD
#define REP_MD 1
#endif
#ifndef REP_B
#define REP_B 1
#endif
#ifndef REP_D
#define REP_D 1
#endif
#ifndef REP_FU
#define REP_FU 1
#endif
#ifndef REP_PM
#define REP_PM 1
#endif
#ifndef REP_LN
#define REP_LN 1
#endif
#ifndef REP_NA
#define REP_NA 1
#endif
#ifndef REP_MLA
#define REP_MLA 1
#endif
#ifndef EN_P0
#define EN_P0 1
#endif
#ifndef EN_A
#define EN_A 1
#endif
#ifndef EN_B
#define EN_B 1
#endif
#ifndef EN_C
#define EN_C 1
#endif
#ifndef EN_D
#define EN_D 1
#endif
#ifndef EN_E
#define EN_E 1
#endif
#ifndef EN_F
#define EN_F 1
#endif
#ifndef EN_G0
#define EN_G0 1
#endif
#ifndef EN_H0
#define EN_H0 1
#endif
#ifndef EN_G1
#define EN_G1 1
#endif
#ifndef EN_U1
#define EN_U1 1
#endif
#ifndef EN_D1
#define EN_D1 1
#endif
#ifndef EN_I
#define EN_I 1
#endif
__global__ void __launch_bounds__(NWAVES * 64, 2) mk_fwd(Args args) {
    extern __shared__ __attribute__((aligned(16))) unsigned char lds[];
    Frame F;
    F.lds = (LAS unsigned char*)lds;
    volatile LAS unsigned* MISC = (volatile LAS unsigned*)(F.lds + LDSCTL_OFF);
    F.tid = threadIdx.x; F.lane = F.tid & 63; F.wave = __builtin_amdgcn_readfirstlane(F.tid >> 6);
    F.G = gridDim.x; { const int bx = blockIdx.x; F.vcu = (F.G % 8 == 0) ? (bx % 8) * (F.G / 8) + bx / 8 : bx; }
    unsigned char* ws = args.ws; float* R = args.out;
    for (int u = F.tid; u < 128; u += NWAVES * 64) ((LAS unsigned*)(F.lds + LDSCTL_OFF))[u] = 0u;
    __syncthreads();
    const int lo = args.ph_lo, hi = args.ph_hi;
    const bool multi = (hi - lo) > 1;
    XcdBarrier bar; bar.bar = (unsigned*)(ws + WS_CTL) + CW_BAR; bar.x = 0; bar.st = nullptr; bar.w0 = 0;
    if (multi) bar = xcd_barrier_post((unsigned*)(ws + WS_CTL) + CW_BAR, MISC + 8);
    int ph = 0;
#define IN() (lo <= ph && ph < hi)
#define PH_BEGIN() do { int l_; asm volatile("v_mbcnt_lo_u32_b32 %0, -1, 0\n\tv_mbcnt_hi_u32_b32 %0, -1, %0" : "=v"(l_)); F.lane = l_; F.tid = F.wave * 64 + l_; } while (0)
#define SEAM() do { if (lo <= ph && ph + 1 < hi) xcd_barrier(bar); ++ph; } while (0)
    LAS unsigned char* ring = F.lds + RING_OFF;
    bf16* const XB = (bf16*)(ws + WS_XB);
    const float* const ROPE = (const float*)(ws + WS_ROPE);

    if (IN() && EN_P0) { PH_BEGIN();
        int rot = 0;
        for (int rep_ = 0; rep_ < REP_P0; ++rep_)
        for (int L = 0; L < 2; ++L) {
            bf16* WL = (bf16*)(ws + WS_W + (size_t)L * W_LAYER);
            const float* win = args.in[2] + (size_t)L * 1024 * NIN;
            bf16* WIN = (bf16*)((unsigned char*)WL + W_WIN);
            signed char* WINQ = (signed char*)WIN; float* swin = (float*)(ws + WS_SWIN) + L * NPROJ;
            trq_job(F, rot, win, 1024, NIN, 1536, WINQ, swin, 1536, 0, 0, 0, 0);
            trq_job(F, rot, win, 1024, NIN, 768, WINQ, swin, 768, 1536, 0, 1536, 0);
            trq_job(F, rot, win, 1024, NIN, 2048, WINQ, swin, 2048, 2592, 0, 2304, 0);
            trq_job(F, rot, win, 1024, NIN, 256, WINQ, swin, 256, 2304, 0, 4352, 0);
            trq_job(F, rot, win, 1024, NIN, 32, WINQ, swin, 32, 2560, 0, 4608, 0);
            { const size_t n16 = (size_t)(NPROJ - 4640) * 1024 / 16, NT = (size_t)F.G * NWAVES * 64; signed char* z = WINQ + (size_t)4640 * 1024;
              for (size_t i = (size_t)(F.vcu * NWAVES + F.wave) * 64 + F.lane; i < n16; i += NT) *(GAS v4u*)(z + i * 16) = (v4u){0u, 0u, 0u, 0u};
              for (size_t i = (size_t)(F.vcu * NWAVES + F.wave) * 64 + F.lane; i < (size_t)(NPROJ - 4640); i += NT) swin[4640 + i] = 1.f; }
            tr_job(F, rot, args.in[5] + (size_t)L * 768 * 768, 768, 768, 768, (bf16*)((unsigned char*)WL + W_WUQ), 768, 0, 0, 0, 0, args.in[4] + L * 768);
            const float* wukv = args.in[7] + (size_t)L * 256 * 1024; const float* kvg = args.in[6] + L * 256;
            tr_job(F, rot, wukv, 256, 1024, 512, (bf16*)((unsigned char*)WL + W_WUKV), 64, 0, 128, 0, 64, kvg);
            tr_job(F, rot, wukv, 256, 1024, 512, (bf16*)((unsigned char*)WL + W_WUKV), 64, 64, 128, 512, 64, kvg);
            tr_plain(F, rot, args.in[9] + (size_t)L * 512 * 1024, 512, 1024, (bf16*)((unsigned char*)WL + W_WNAO));
            tr_plain(F, rot, args.in[10] + (size_t)L * 512 * 1024, 512, 1024, (bf16*)((unsigned char*)WL + W_WMLAO));
            tr_plain(F, rot, args.in[11] + (size_t)L * 1024 * 1024, 1024, 1024, (bf16*)((unsigned char*)WL + W_WOUT));
            trq_job(F, rot, args.in[22] + (size_t)L * 1024 * 1024, 1024, 1024, 1024, (signed char*)((unsigned char*)WL + W_WPG), (float*)(ws + WS_SWPG) + L * 1024, 1024, 0, 0, 0, 0);
            tr_plain(F, rot, args.in[23] + (size_t)L * 256 * 1024, 256, 1024, (bf16*)((unsigned char*)WL + W_WPLE));
        }
        trq_job(F, rot, args.in[14], 1024, DFF, DFF, (signed char*)(ws + WS_W13), (float*)(ws + WS_SW13), 128, 0, 128, 0, 256);
        trq_job(F, rot, args.in[15], 1024, DFF, DFF, (signed char*)(ws + WS_W13), (float*)(ws + WS_SW13), 128, 0, 128, 128, 256);
        tr_plain(F, rot, args.in[16], DFF, 1024, (bf16*)(ws + WS_W2));
        { const int NT = F.G * NWAVES * 64; float* rt_ = (float*)(ws + WS_ROPE);
          for (int i = (F.vcu * NWAVES + F.wave) * 64 + F.lane; i < SEQ * 16; i += NT) { const int pos = i >> 4, k = i & 15;
              double invf = 1.0; for (int q_ = 0; q_ < k; ++q_) invf *= 0.5623413251903491;
              const double rev = (double)pos * invf * 0.15915494309189535; const float fr_ = (float)(rev - floor(rev));
              rt_[2 * i] = __builtin_amdgcn_cosf(fr_); rt_[2 * i + 1] = __builtin_amdgcn_sinf(fr_); } }
        { const int gw = F.vcu * NWAVES + F.wave, NGW = F.G * NWAVES;
          for (int m = gw; m < MTOK; m += NGW) { f32x4 v[4]; const GAS f32x4* xr = (const GAS f32x4*)(args.in[0] + (size_t)m * DM) + F.lane;
#pragma unroll
              for (int j = 0; j < 4; ++j) v[j] = xr[64 * j];
              store_bf(XB, (size_t)m, v, F.lane); store_q8((signed char*)R + (128u << 20), (float*)(ws + WS_SX), (size_t)m, v, F.lane); } }
    }
    SEAM();

    for (int L = 0; L < 2; ++L) {
        unsigned char* WL = ws + WS_W + (size_t)L * W_LAYER;
        if (IN() && EN_A) { PH_BEGIN();
            pg8::Gemm g{(const pg8::bf16_t*)((const signed char*)R + (128u << 20)), (const pg8::bf16_t*)(WL + W_WIN), MTOK, NPROJ, 512, 0, 0}; pg8::StaticOrder S; S.init(MTOK, NPROJ, F.G, (int)blockIdx.x);
            pg8::EpiProj E{(bf16*)(ws + WS_NAQKV), (bf16*)(ws + WS_QLAT), (bf16*)(ws + WS_GATES), (bf16*)(ws + WS_KVLAT), (bf16*)(ws + WS_KMLA), args.in[3] + L * 2048, ROPE, NA_QSCALE, (float*)(ws + WS_PS), (const float*)(ws + WS_SX), (const float*)(ws + WS_SWIN) + L * NPROJ, (LAS float*)(F.lds + X_SCL)};
            for (int rep_ = 0; rep_ < REP_A; ++rep_) { pg8::gemm_phase<pg8::EpiProj, pg8::StaticOrder, true, true, true>(ring, g, S, E, F.wave); __syncthreads(); }
        }
        SEAM();
        if (IN() && EN_B) { PH_BEGIN();
            for (int rep_ = 0; rep_ < REP_B; ++rep_) {
            { pg8::Gemm g{(const pg8::bf16_t*)(ws + WS_QLAT), (const pg8::bf16_t*)(WL + W_WUQ), MTOK, 768, 768}; pg8::StaticOrder S; S.init(MTOK, 768, F.G, (int)blockIdx.x);
              asm volatile("" : "+s"(S.c), "+s"(S.G)); rms_prepass(F, S, (const float*)(ws + WS_PS), 0, 12, 768); asm volatile("" : "+s"(S.c), "+s"(S.G));
              pg8::EpiQup E{(bf16*)R, (const LAS float*)(F.lds + X_RTAB), ROPE, MLA_QSCALE};
              pg8::gemm_phase<pg8::EpiQup, pg8::StaticOrder, true, true>(ring, g, S, E, F.wave); }
            __syncthreads(); PH_BEGIN();
            { pg8::Gemm g{(const pg8::bf16_t*)(ws + WS_KVLAT), (const pg8::bf16_t*)(WL + W_WUKV), MTOK, 1024, 256}; pg8::StaticOrder S; S.init(MTOK, 1024, F.G, (int)blockIdx.x);
              asm volatile("" : "+s"(S.c), "+s"(S.G)); rms_prepass(F, S, (const float*)(ws + WS_PS), 12, 4, 256); asm volatile("" : "+s"(S.c), "+s"(S.G));
              pg8::EpiKVup E{(bf16*)(ws + WS_KMLA), (bf16*)(ws + WS_VMLA), (const LAS float*)(F.lds + X_RTAB)};
              pg8::gemm_phase<pg8::EpiKVup, pg8::StaticOrder, true, true>(ring, g, S, E, F.wave); }
            __syncthreads(); }
        }
        SEAM();
        if (IN() && EN_C) { PH_BEGIN();
            const float* rpb = args.in[8] + (size_t)L * 8 * 15 * 31;
            for (int rep_ = 0; rep_ < REP_NA; ++rep_)
            for (int uid = F.vcu; uid < 2048; uid += F.G) { const int pair = uid >> 5, rg = uid & 31;
                att::na_unit(pair >> 3, pair & 7, rg, (const att::bf16*)(ws + WS_NAQKV), (att::bf16*)(ws + WS_ONA), rpb, (LAS char*)ring, F.wave); }
            for (int rep_ = 0; rep_ < REP_MLA; ++rep_)
            for (int uid = F.vcu; uid < 2048; uid += F.G) { const int pair = uid >> 5, qb = uid & 31, b = pair >> 3, h = pair & 7;
                const size_t row0 = (size_t)b * SEQ;
                att::mla_unit((const att::bf16*)R + (row0 + qb * 256) * 768 + h * 96, (const att::bf16*)(ws + WS_KMLA) + row0 * 768 + h * 96,
                              (const att::bf16*)(ws + WS_VMLA) + row0 * 512 + h * 64, (att::bf16*)(ws + WS_OMLA) + (row0 + qb * 256) * 512 + h * 64, SEQ, (LAS char*)ring, F.wave); }
        }
        SEAM();
        if (IN() && EN_D) { PH_BEGIN();
            for (int rep_ = 0; rep_ < REP_D; ++rep_) {
            pg8::StaticOrder S; S.init(MTOK, 1024, F.G, (int)blockIdx.x);
            { pg8::Gemm g{(const pg8::bf16_t*)(ws + WS_ONA), (const pg8::bf16_t*)(WL + W_WNAO), MTOK, 1024, 512};
              pg8::EpiMerge E{(const unsigned char*)(ws + WS_GATES), (pg8::bf16_t*)(ws + WS_MERGED), 0};
              pg8::gemm_phase<pg8::EpiMerge, pg8::StaticOrder, true, true>(ring, g, S, E, F.wave); }
            __syncthreads();
            { pg8::Gemm g{(const pg8::bf16_t*)(ws + WS_OMLA), (const pg8::bf16_t*)(WL + W_WMLAO), MTOK, 1024, 512};
              pg8::EpiMerge E{(const unsigned char*)(ws + WS_GATES) + 1024, (pg8::bf16_t*)(ws + WS_MERGED), 1};
              pg8::gemm_phase<pg8::EpiMerge, pg8::StaticOrder, true, true>(ring, g, S, E, F.wave); }
            __syncthreads(); }
        }
        SEAM();
        if (IN() && EN_E) { PH_BEGIN();
            { pg8::Gemm g{(const pg8::bf16_t*)(ws + WS_MERGED), (const pg8::bf16_t*)(WL + W_WOUT), MTOK, 1024, 1024}; pg8::StaticOrder S; S.init(MTOK, 1024, F.G, (int)blockIdx.x);
              pg8::EpiRes<0> E{(const pg8::bf16_t*)XB, (pg8::bf16_t*)R, nullptr, ALPHA};
              pg8::gemm_phase<pg8::EpiRes<0>, pg8::StaticOrder, true, true>(ring, g, S, E, F.wave); }
            if (L == 1) { __syncthreads(); PH_BEGIN(); int rot = 0;
                for (int rep_ = 0; rep_ < REP_MC; ++rep_)
                for (int e = 0; e < NEXP; ++e) {
                    signed char* w13 = (signed char*)(ws + WS_WM13) + (size_t)e * 2 * DFFE * 1024; float* sc13 = (float*)(ws + WS_SWM13) + (size_t)e * 2 * DFFE;
                    trq_job(F, rot, args.in[19] + (size_t)e * 1024 * DFFE, 1024, DFFE, DFFE, w13, sc13, 128, 0, 128, 0, 256);
                    trq_job(F, rot, args.in[20] + (size_t)e * 1024 * DFFE, 1024, DFFE, DFFE, w13, sc13, 128, 0, 128, 128, 256);
                    tr_plain(F, rot, args.in[21] + (size_t)e * DFFE * 1024, DFFE, 1024, (bf16*)(ws + WS_WM2) + (size_t)e * 1024 * DFFE); } }
        }
        SEAM();
        if (IN() && EN_F) { PH_BEGIN();
            f32x4 g[4], bb[4];
            { const GAS f32x4* gp = (const GAS f32x4*)(args.in[12] + L * DM) + F.lane; const GAS f32x4* bp = (const GAS f32x4*)(args.in[13] + L * DM) + F.lane;
#pragma unroll
              for (int j = 0; j < 4; ++j) { g[j] = gp[64 * j]; bb[j] = bp[64 * j]; } }
            LAS float* wrl = (LAS float*)ring; LAS int* lcnt = (LAS int*)(F.lds + X_LCNT);
            if (L == 1) { const float* wr = args.in[17];
                for (int i = F.tid; i < 1024 * 8 / 4; i += NWAVES * 64) ((LAS f32x4*)wrl)[i] = ((const GAS f32x4*)wr)[i];
                if (F.tid < 8) lcnt[F.tid] = 0;
                LDS_WAIT(); __syncthreads(); }
            const int gw = F.vcu * NWAVES + F.wave, NGW = F.G * NWAVES;
            if (REP_LN > 1) for (int m = gw; m < MTOK; m += NGW) {
                f32x4 v[4]; const GAS f32x4* xr = (const GAS f32x4*)(R + (size_t)m * DM) + F.lane;
#pragma unroll
                for (int j = 0; j < 4; ++j) v[j] = xr[64 * j];
                ln_core(v, g, bb);
                store_row((float*)(ws + WS_GATES), XB, (size_t)m, v, F.lane, true); }
            v2u raw[4];
            { const GAS v2u* p_ = (const GAS v2u*)((const bf16*)R + (size_t)gw * DM) + F.lane;
#pragma unroll
              for (int j = 0; j < 4; ++j) raw[j] = p_[64 * j]; }
            for (int m = gw; m < MTOK; m += NGW) {
                f32x4 v[4];
#pragma unroll
                for (int j = 0; j < 4; ++j) { v[j].x = bflo(raw[j].x); v[j].y = bfhi(raw[j].x); v[j].z = bflo(raw[j].y); v[j].w = bfhi(raw[j].y); }
                if (m + NGW < MTOK) { const GAS v2u* p_ = (const GAS v2u*)((const bf16*)R + (size_t)(m + NGW) * DM) + F.lane;
#pragma unroll
                    for (int j = 0; j < 4; ++j) raw[j] = p_[64 * j]; }
                ln_core(v, g, bb);
                store_bf(XB, (size_t)m, v, F.lane);
                store_q8((signed char*)R + (192u << 20), (float*)(ws + WS_SX1), (size_t)m, v, F.lane);
                if (L == 1) {
                    float lg[8];
#pragma unroll
                    for (int e = 0; e < 8; ++e) lg[e] = 0.f;
#pragma unroll
                    for (int j = 0; j < 4; ++j)
#pragma unroll
                        for (int t = 0; t < 4; ++t) { const int k = 4 * F.lane + 256 * j + t; const f32x4 w0 = *(const LAS f32x4*)(wrl + k * 8), w1 = *(const LAS f32x4*)(wrl + k * 8 + 4); const float xv = v[j][t];
                            lg[0] += xv * w0.x; lg[1] += xv * w0.y; lg[2] += xv * w0.z; lg[3] += xv * w0.w; lg[4] += xv * w1.x; lg[5] += xv * w1.y; lg[6] += xv * w1.z; lg[7] += xv * w1.w; }
#pragma unroll
                    for (int e = 0; e < 8; ++e) lg[e] = wave_sum(lg[e]) + args.in[18][e];
                    int i0 = 0; float l0 = lg[0];
#pragma unroll
                    for (int e = 1; e < 8; ++e) if (lg[e] > l0) { l0 = lg[e]; i0 = e; }
                    int i1 = -1; float l1 = -3.0e38f;
#pragma unroll
                    for (int e = 0; e < 8; ++e) if (e != i0 && lg[e] > l1) { l1 = lg[e]; i1 = e; }
                    const float w0 = 1.0f / (1.0f + __expf(l1 - l0)), w1 = 1.0f - w0;
                    if (F.lane == 0) {
                        const int lp0 = __hip_atomic_fetch_add(lcnt + i0, 1, __ATOMIC_RELAXED, __HIP_MEMORY_SCOPE_WORKGROUP), lp1 = __hip_atomic_fetch_add(lcnt + i1, 1, __ATOMIC_RELAXED, __HIP_MEMORY_SCOPE_WORKGROUP);
                        ((int*)(ws + WS_TE))[m] = i0 | (i1 << 4) | ((int)blockIdx.x << 8);
                        ((int2*)(ws + WS_TP))[m] = make_int2(lp0, lp1); ((float2*)(ws + WS_TW))[m] = make_float2(w0, w1); }
                }
            }
            if (L == 1) { LDS_WAIT(); __syncthreads(); if (F.tid < 8) ((int*)(ws + WS_CNT))[blockIdx.x * 8 + F.tid] = lcnt[F.tid]; }
            cvt_rows(F, args.in[1] + (size_t)L * MTOK * PLED, (bf16*)(ws + WS_PB), (size_t)MTOK * PLED / 8);
        }
        SEAM();
        if (L == 0) {
            if (IN() && EN_G0) { PH_BEGIN();
                { pg8::Gemm g{(const pg8::bf16_t*)((const signed char*)R + (192u << 20)), (const pg8::bf16_t*)(ws + WS_W13), MTOK, 2 * DFF, 512, 0, 0}; pg8::StaticOrder S; S.init(MTOK, 2 * DFF, F.G, (int)blockIdx.x);
                  pg8::EpiGLUQ E{(pg8::bf16_t*)(ws + WS_H), DFF, (const float*)(ws + WS_SX1), (const float*)(ws + WS_SW13), (LAS float*)(F.lds + X_SCL)};
                  for (int rep_ = 0; rep_ < REP_FU; ++rep_) { pg8::gemm_phase<pg8::EpiGLUQ, pg8::StaticOrder, true, true, true>(ring, g, S, E, F.wave); __syncthreads(); } }
                __syncthreads();
                pg8::StaticOrder S; S.init(MTOK, 1024, F.G, (int)blockIdx.x);
                { pg8::Gemm g{(const pg8::bf16_t*)((const signed char*)R + (192u << 20)), (const pg8::bf16_t*)(WL + W_WPG), MTOK, 1024, 512, 0, 0};
                  pg8::EpiGate8 E{(unsigned char*)(ws + WS_G8), (const float*)(ws + WS_SX1), (const float*)(ws + WS_SWPG) + L * 1024, (LAS float*)(F.lds + X_SCL)};
                  pg8::gemm_phase<pg8::EpiGate8, pg8::StaticOrder, true, true, true>(ring, g, S, E, F.wave); }
                __syncthreads();
                { pg8::Gemm g{(const pg8::bf16_t*)(ws + WS_PB), (const pg8::bf16_t*)(WL + W_WPLE), MTOK, 1024, 256};
                  pg8::EpiGateMul E{(const unsigned char*)(ws + WS_G8), (pg8::bf16_t*)(ws + WS_PP_DENSE)};
                  pg8::gemm_phase<pg8::EpiGateMul, pg8::StaticOrder, true, true>(ring, g, S, E, F.wave); }
            }
            SEAM();
            if (IN() && EN_H0) { PH_BEGIN();
                pg8::Gemm g{(const pg8::bf16_t*)(ws + WS_H), (const pg8::bf16_t*)(ws + WS_W2), MTOK, 1024, DFF}; pg8::StaticOrder S; S.init(MTOK, 1024, F.G, (int)blockIdx.x);
                pg8::EpiRes<2> E{(const pg8::bf16_t*)XB, (pg8::bf16_t*)R, (pg8::bf16_t*)(ws + WS_PP_DENSE), ALPHA};
                pg8::gemm_phase<pg8::EpiRes<2>, pg8::StaticOrder, true, true>(ring, g, S, E, F.wave);
            }
            SEAM();
        } else {
            if (IN() && EN_G1) { PH_BEGIN();
                moe_tables(F, (const int*)(ws + WS_CNT), true);
                if (blockIdx.x == 0 && F.tid < 9) ((int*)(ws + WS_CNT + 49152))[F.tid] = ((const LAS int*)(F.lds + X_OFF))[F.tid];
                { const LAS int* off = (const LAS int*)(F.lds + X_OFF); const LAS int* pre = (const LAS int*)(F.lds + X_PRE);
                  const int gw = F.vcu * NWAVES + F.wave, NGW = F.G * NWAVES;
                  for (int m0 = gw; m0 < MTOK; m0 += 4 * NGW) {
                      int te[4]; int2 tp[4]; float2 tw[4]; int d0[4], d1[4]; v4u ra[4], rb[4];
#pragma unroll
                      for (int q = 0; q < 4; ++q) { const int m = m0 + q * NGW; te[q] = ((const int*)(ws + WS_TE))[m]; tp[q] = ((const int2*)(ws + WS_TP))[m]; tw[q] = ((const float2*)(ws + WS_TW))[m]; }
#pragma unroll
                      for (int q = 0; q < 4; ++q) { const int m = m0 + q * NGW; ra[q] = ((const GAS v4u*)((const signed char*)R + (192u << 20) + (size_t)m * DM))[F.lane]; rb[q].x = __float_as_uint(((const float*)(ws + WS_SX1))[m]); }
#pragma unroll
                      for (int q = 0; q < 4; ++q) { const int e0 = te[q] & 15, e1 = (te[q] >> 4) & 15, blk = te[q] >> 8;
                          d0[q] = off[e0] + pre[blk * 8 + e0] + tp[q].x; d1[q] = off[e1] + pre[blk * 8 + e1] + tp[q].y; }
#pragma unroll
                      for (int q = 0; q < 4; ++q) { const int m = m0 + q * NGW;
                          ((GAS v4u*)((signed char*)R + (size_t)d0[q] * DM))[F.lane] = ra[q]; ((GAS v4u*)((signed char*)R + (size_t)d1[q] * DM))[F.lane] = ra[q];
                          if (F.lane == 0) { ((float*)(ws + WS_SW))[d0[q]] = tw[q].x; ((float*)(ws + WS_SW))[d1[q]] = tw[q].y; ((int2*)(ws + WS_TPOS))[m] = make_int2(d0[q], d1[q]);
                              ((float*)(ws + WS_SXS))[d0[q]] = __uint_as_float(rb[q].x); ((float*)(ws + WS_SXS))[d1[q]] = __uint_as_float(rb[q].x); } } } }
                __syncthreads();
                pg8::StaticOrder S; S.init(MTOK, 1024, F.G, (int)blockIdx.x);
                { pg8::Gemm g{(const pg8::bf16_t*)((const signed char*)R + (192u << 20)), (const pg8::bf16_t*)(WL + W_WPG), MTOK, 1024, 512, 0, 0};
                  pg8::EpiGate8 E{(unsigned char*)(ws + WS_G8), (const float*)(ws + WS_SX1), (const float*)(ws + WS_SWPG) + L * 1024, (LAS float*)(F.lds + X_SCL)};
                  pg8::gemm_phase<pg8::EpiGate8, pg8::StaticOrder, true, true, true>(ring, g, S, E, F.wave); }
                __syncthreads();
                { pg8::Gemm g{(const pg8::bf16_t*)(ws + WS_PB), (const pg8::bf16_t*)(WL + W_WPLE), MTOK, 1024, 256};
                  pg8::EpiGateMul E{(const unsigned char*)(ws + WS_G8), (pg8::bf16_t*)(ws + WS_PP_MOE)};
                  pg8::gemm_phase<pg8::EpiGateMul, pg8::StaticOrder, true, true>(ring, g, S, E, F.wave); }
            }
            SEAM();
            for (int c = 0; c < MOE_NCHUNK; ++c) {
                if (IN() && EN_U1) { PH_BEGIN();
                    if (F.tid < 9) ((LAS int*)(F.lds + X_OFF))[F.tid] = ((const int*)(ws + WS_CNT + 49152))[F.tid];
                    LDS_WAIT(); __syncthreads();
                    const LAS int* off = (const LAS int*)(F.lds + X_OFF);
                    const int NT = __builtin_amdgcn_readfirstlane(off[8]) >> 8; const int capU = (c == MOE_NCHUNK - 1) ? MOE_CHUNK + MOE_REMT : MOE_CHUNK;
                    int nMc = NT - c * MOE_CHUNK; nMc = nMc < 0 ? 0 : (nMc > capU ? capU : nMc);
                    pg8::MoeOrder<true> S; S.nMc = nMc; S.nN = 2 * DFFE / 256; S.nwg = nMc * S.nN; S.G = F.G; S.c = (int)blockIdx.x; S.t0 = c * MOE_CHUNK;
                    S.ts1 = __builtin_amdgcn_readfirstlane(off[1]) >> 8; S.ts2 = __builtin_amdgcn_readfirstlane(off[2]) >> 8; S.ts3 = __builtin_amdgcn_readfirstlane(off[3]) >> 8; S.ts4 = __builtin_amdgcn_readfirstlane(off[4]) >> 8;
                    S.ts5 = __builtin_amdgcn_readfirstlane(off[5]) >> 8; S.ts6 = __builtin_amdgcn_readfirstlane(off[6]) >> 8; S.ts7 = __builtin_amdgcn_readfirstlane(off[7]) >> 8;
                    pg8::Gemm g{(const pg8::bf16_t*)R, (const pg8::bf16_t*)(ws + WS_WM13), MOE_MAXT * 256, 2 * DFFE, 512, 0, 0};
                    pg8::EpiGLUQ E{(pg8::bf16_t*)(ws + WS_HS), DFFE, (const float*)(ws + WS_SXS), (const float*)(ws + WS_SWM13), (LAS float*)(F.lds + X_SCL)};
                    for (int rep_ = 0; rep_ < REP_MU; ++rep_) { pg8::gemm_phase<pg8::EpiGLUQ, pg8::MoeOrder<true>, true, true, true>(ring, g, S, E, F.wave); __syncthreads(); }
                }
                SEAM();
                if (IN() && EN_D1) { PH_BEGIN();
                    if (F.tid < 9) ((LAS int*)(F.lds + X_OFF))[F.tid] = ((const int*)(ws + WS_CNT + 49152))[F.tid];
                    LDS_WAIT(); __syncthreads();
                    const LAS int* off = (const LAS int*)(F.lds + X_OFF);
                    const int NT = __builtin_amdgcn_readfirstlane(off[8]) >> 8; int nMc = NT - c * MOE_CHUNK; nMc = nMc < 0 ? 0 : (nMc > MOE_CHUNK ? MOE_CHUNK : nMc);
                    const int t1 = __builtin_amdgcn_readfirstlane(off[1]) >> 8, t2 = __builtin_amdgcn_readfirstlane(off[2]) >> 8, t3 = __builtin_amdgcn_readfirstlane(off[3]) >> 8, t4 = __builtin_amdgcn_readfirstlane(off[4]) >> 8,
                              t5 = __builtin_amdgcn_readfirstlane(off[5]) >> 8, t6 = __builtin_amdgcn_readfirstlane(off[6]) >> 8, t7 = __builtin_amdgcn_readfirstlane(off[7]) >> 8;
                    {
                        pg8::MoeOrder<false> S; S.nMc = nMc; S.nN = 4; S.nwg = nMc * 4; S.G = F.G; S.c = (int)blockIdx.x; S.t0 = c * MOE_CHUNK;
                        S.ts1 = t1; S.ts2 = t2; S.ts3 = t3; S.ts4 = t4; S.ts5 = t5; S.ts6 = t6; S.ts7 = t7;
                        pg8::Gemm g{(const pg8::bf16_t*)(ws + WS_HS), (const pg8::bf16_t*)(ws + WS_WM2), MOE_CHUNK * 256, 1024, DFFE, 0, 0};
                        pg8::EpiMoeDown E{(pg8::bf16_t*)(ws + WS_XS), (const float*)(ws + WS_SW)};
                        for (int rep_ = 0; rep_ < REP_MD; ++rep_) { pg8::gemm_phase<pg8::EpiMoeDown, pg8::MoeOrder<false>, true, true>(ring, g, S, E, F.wave); __syncthreads(); }
                    }
                    if (c == MOE_NCHUNK - 1) {
                        PH_BEGIN();
                        pg8::MoeRemOrder S; S.nT = NT - MOE_FULL; S.G = F.G; S.c = (int)blockIdx.x; S.t0 = MOE_FULL; S.KQ = DFFE / 4; S.pa0 = MOE_CHUNK;
                        S.ts1 = t1; S.ts2 = t2; S.ts3 = t3; S.ts4 = t4; S.ts5 = t5; S.ts6 = t6; S.ts7 = t7;
                        pg8::Gemm g{(const pg8::bf16_t*)(ws + WS_HS), (const pg8::bf16_t*)(ws + WS_WM2), MOE_REM_ROWS, 1024, DFFE / 4, DFFE, DFFE};
                        pg8::EpiMoeRem E{(pg8::bf16_t*)(ws + WS_PART), (const float*)(ws + WS_SW), MOE_FULL, MOE_REM_ROWS};
                        pg8::gemm_phase<pg8::EpiMoeRem, pg8::MoeRemOrder, true, true>(ring, g, S, E, F.wave);
                    }
                }
                SEAM();
            }
        }
        if (L == 1) {
            if (IN() && EN_I) { PH_BEGIN();
                if (F.tid < 9) ((LAS int*)(F.lds + X_OFF))[F.tid] = ((const int*)(ws + WS_CNT + 49152))[F.tid];
                LDS_WAIT(); __syncthreads();
                const int nrem = (__builtin_amdgcn_readfirstlane(((const LAS int*)(F.lds + X_OFF))[8]) >> 8) - MOE_FULL;
                const int gw = F.vcu * NWAVES + F.wave, NGW = F.G * NWAVES;
                for (int r = gw; r < nrem * 256; r += NGW) {
                    const GAS v2u* pp = (const GAS v2u*)((const bf16*)(ws + WS_PART) + (size_t)r * DM) + F.lane; GAS v2u* dst = (GAS v2u*)((bf16*)(ws + WS_XS) + (size_t)(MOE_FULL * 256 + r) * DM) + F.lane;
#pragma unroll
                    for (int j = 0; j < 4; ++j) { float s0 = 0.f, s1 = 0.f, s2 = 0.f, s3 = 0.f;
#pragma unroll
                        for (int q = 0; q < 4; ++q) { const v2u a = pp[(size_t)q * MOE_REM_ROWS * DM / 4 + 64 * j]; s0 += bflo(a.x); s1 += bfhi(a.x); s2 += bflo(a.y); s3 += bfhi(a.y); }
                        v2u o; o.x = pk2(s0, s1); o.y = pk2(s2, s3); dst[64 * j] = o; }
                }
            }
            SEAM();
        }
        if (IN() && EN_I) { PH_BEGIN();
            f32x4 g[4], bb[4];
            { const GAS f32x4* gp = (const GAS f32x4*)(args.in[24] + L * DM) + F.lane; const GAS f32x4* bp = (const GAS f32x4*)(args.in[25] + L * DM) + F.lane;
#pragma unroll
              for (int j = 0; j < 4; ++j) { g[j] = gp[64 * j]; bb[j] = bp[64 * j]; } }
            const int gw = F.vcu * NWAVES + F.wave, NGW = F.G * NWAVES;
            const bool tmo = (L == 1) && (__hip_atomic_load((unsigned*)(ws + WS_CTL) + CW_BAR + XB_TMO, __ATOMIC_RELAXED, __HIP_MEMORY_SCOPE_AGENT) != 0u);
            if (L == 0) {
                v2u rx[4];
                { const GAS v2u* p_ = (const GAS v2u*)((const bf16*)R + (size_t)gw * DM) + F.lane;
#pragma unroll
                  for (int j = 0; j < 4; ++j) rx[j] = p_[64 * j]; }
                for (int m = gw; m < MTOK; m += NGW) {
                    f32x4 v[4];
#pragma unroll
                    for (int j = 0; j < 4; ++j) { v[j].x = bflo(rx[j].x); v[j].y = bfhi(rx[j].x); v[j].z = bflo(rx[j].y); v[j].w = bfhi(rx[j].y); }
                    if (m + NGW < MTOK) { const GAS v2u* p_ = (const GAS v2u*)((const bf16*)R + (size_t)(m + NGW) * DM) + F.lane;
#pragma unroll
                        for (int j = 0; j < 4; ++j) rx[j] = p_[64 * j]; }
                    ln_core(v, g, bb);
                    store_bf(XB, (size_t)m, v, F.lane); store_q8((signed char*)R + (128u << 20), (float*)(ws + WS_SX), (size_t)m, v, F.lane);
                }
            } else {
                v2u rx[4], rp[4], ra[4], rb[4]; int2 tpn = ((const int2*)(ws + WS_TPOS))[gw];
#define LN2_LOAD(mm, tp_) do { const GAS v2u* x1 = (const GAS v2u*)(XB + (size_t)(mm) * DM) + F.lane; const GAS v2u* pl = (const GAS v2u*)((const bf16*)(ws + WS_PP_MOE) + (size_t)(mm) * DM) + F.lane; \
        const GAS v2u* f0 = (const GAS v2u*)((const bf16*)(ws + WS_XS) + (size_t)(tp_).x * DM) + F.lane; const GAS v2u* f1 = (const GAS v2u*)((const bf16*)(ws + WS_XS) + (size_t)(tp_).y * DM) + F.lane; \
        _Pragma("unroll") for (int j = 0; j < 4; ++j) { rx[j] = x1[64 * j]; rp[j] = pl[64 * j]; ra[j] = f0[64 * j]; rb[j] = f1[64 * j]; } } while (0)
                LN2_LOAD(gw, tpn);
                if (gw + NGW < MTOK) tpn = ((const int2*)(ws + WS_TPOS))[gw + NGW];
                for (int m = gw; m < MTOK; m += NGW) {
                    f32x4 v[4];
#pragma unroll
                    for (int j = 0; j < 4; ++j) { const v2u x = rx[j], p = rp[j], a = ra[j], b = rb[j];
                        v[j].x = ALPHA * bflo(x.x) + bflo(p.x) + (bflo(a.x) + bflo(b.x)); v[j].y = ALPHA * bfhi(x.x) + bfhi(p.x) + (bfhi(a.x) + bfhi(b.x));
                        v[j].z = ALPHA * bflo(x.y) + bflo(p.y) + (bflo(a.y) + bflo(b.y)); v[j].w = ALPHA * bfhi(x.y) + bfhi(p.y) + (bfhi(a.y) + bfhi(b.y)); }
                    if (m + NGW < MTOK) { LN2_LOAD(m + NGW, tpn); if (m + 2 * NGW < MTOK) tpn = ((const int2*)(ws + WS_TPOS))[m + 2 * NGW]; }
                    ln_core(v, g, bb);
                    if (tmo) { const float qn = __builtin_nanf("");
#pragma unroll
                        for (int j = 0; j < 4; ++j) v[j] = (f32x4){qn, qn, qn, qn}; }
                    store_row(R, XB, (size_t)m, v, F.lane, false);
                }
            }
        }
        if (L == 0) SEAM();
    }
#undef LN2_LOAD
#undef IN
#undef SEAM
}

constexpr int N_PHASES = 27;
#ifndef MK_ONE_LAUNCH
#define MK_ONE_LAUNCH 1
#endif
extern "C" void kernel_launch(void* const* d_in, const int* in_sizes, int n_in, void* d_out, int out_size, void* d_ws, size_t ws_size, hipStream_t stream) {
    static int grid = 0;
    if (grid == 0) {
        if (n_in != 26 || in_sizes[0] != MTOK * DM || out_size != MTOK * DM || ws_size < WS_END) {
            fprintf(stderr, "kernel_launch: shape mismatch: n_in %d in0 %d out %d ws %zu (need %zu)\n", n_in, n_in > 0 ? in_sizes[0] : -1, out_size, ws_size, (size_t)WS_END); grid = -1; return; }
        int dev = 0, cus = 0, per_cu = 0;
        if (hipGetDevice(&dev) != hipSuccess || hipDeviceGetAttribute(&cus, hipDeviceAttributeMultiprocessorCount, dev) != hipSuccess) { fprintf(stderr, "kernel_launch: device query failed\n"); grid = -1; return; }
        if (hipFuncSetAttribute((const void*)mk_fwd, hipFuncAttributeMaxDynamicSharedMemorySize, LDS_BYTES) != hipSuccess) { fprintf(stderr, "kernel_launch: hipFuncSetAttribute failed\n"); grid = -1; return; }
        if (hipOccupancyMaxActiveBlocksPerMultiprocessor(&per_cu, (const void*)mk_fwd, NWAVES * 64, LDS_BYTES) != hipSuccess || per_cu < 1)
            fprintf(stderr, "kernel_launch: note: occupancy query reports %d workgroups per CU\n", per_cu);
        (void)hipGetLastError();
        grid = cus > 256 ? 256 : cus;
    }
    if (grid < 0) return;
    if (hipMemsetAsync((char*)d_ws + WS_CTL, 0, CTL_ZERO_BYTES, stream) != hipSuccess) { fprintf(stderr, "kernel_launch: memset failed\n"); return; }
    Args a{};
    for (int i = 0; i < 26; ++i) a.in[i] = (const float*)d_in[i];
    a.out = (float*)d_out; a.ws = (unsigned char*)d_ws;
#if MK_ONE_LAUNCH
    a.ph_lo = 0; a.ph_hi = N_PHASES;
    hipLaunchKernelGGL(mk_fwd, dim3(grid), dim3(NWAVES * 64), LDS_BYTES, stream, a);
#else
    for (int p = 0; p < N_PHASES; ++p) { a.ph_lo = p; a.ph_hi = p + 1; hipLaunchKernelGGL(mk_fwd, dim3(grid), dim3(NWAVES * 64), LDS_BYTES, stream, a); }
#endif
    const hipError_t le = hipPeekAtLastError();
    if (le != hipSuccess) fprintf(stderr, "kernel_launch: launch failed: %s (grid %d)\n", hipGetErrorName(le), grid);
}
```

```cpp
#include <hip/hip_runtime.h>
#include <cstdio>
#include <cstdint>
#include <cmath>
#ifndef PG8_WGM
#define PG8_WGM 8
#endif
namespace pg8 {
#define PG8_LAS __attribute__((address_space(3)))
typedef unsigned short bf16_t;
typedef short bf16x8 __attribute__((ext_vector_type(8)));
typedef float f32x4 __attribute__((ext_vector_type(4)));
typedef unsigned u32x4 __attribute__((ext_vector_type(4)));
typedef int i32x4 __attribute__((ext_vector_type(4)));
constexpr int BM = 256, BK = 64, HALF = 128, HTB = HALF * BK * 2  , STAGE_BYTES = 8 * HTB, NXCD = 8, WGM = PG8_WGM;

__host__ __device__ __forceinline__ int lds_byte(int r, int c) { const int st = (r >> 4) * 2 + (c >> 5), rr = r & 15, cc = c & 31, ob = rr * 64 + cc * 2; return st * 1024 + (ob ^ (((ob >> 9) & 1) << 5)); }
__host__ __device__ __forceinline__ void stage_rc(int b, int& R, int& C) { const int st = b / 1024, sb = b % 1024, swz = sb ^ (((sb >> 9) & 1) << 5); R = (st >> 1) * 16 + swz / 64; C = (st & 1) * 32 + (swz % 64) / 2; }
__host__ __device__ __forceinline__ int perm32(int rho) { const int n = rho >> 4, i = rho & 15; return 8 * (i >> 2) + 4 * n + (i & 3); }

struct Unit { int pm, pn, pa, pb, slot, kofs, aux; };
struct Gemm { const bf16_t* A; const bf16_t* Bt; int M, N, K; int lda, ldb; };

struct StaticOrder {
    int nM, nN, nwg, G, c;
    __host__ __device__ void init(int M, int N, int G_, int c_) { nM = M / BM; nN = N / BM; nwg = nM * nN; G = G_; c = c_; }
    __host__ __device__ bool next(int i, Unit& u) const {
        const long L = (long)i * G + c; if (L >= nwg) return false;
        int wgid = (int)L; { const int q = nwg / NXCD, r = nwg % NXCD, xcd = wgid % NXCD, off = wgid / NXCD; wgid = (xcd < r ? xcd * (q + 1) : r * (q + 1) + (xcd - r) * q) + off; }
        const int nig = WGM * nN, gid = wgid / nig, fm = gid * WGM, gsz = (nM - fm) < WGM ? (nM - fm) : WGM;
        u.pm = fm + ((wgid % nig) % gsz); u.pn = (wgid % nig) / gsz; u.pa = u.pm; u.pb = u.pn; u.slot = i; u.kofs = 0; u.aux = 0; return true;
    }
    __device__ __forceinline__ void a_ready(const Unit&) const {}
    __device__ __forceinline__ void done(const Unit&) const {}
};

__device__ __forceinline__ unsigned cvt_pk_bf16(float lo, float hi) { unsigned r; asm volatile("v_cvt_pk_bf16_f32 %0, %1, %2" : "=v"(r) : "v"(lo), "v"(hi)); return r; }
typedef float f32x2 __attribute__((ext_vector_type(2)));
__device__ __forceinline__ f32x2 gelu_pk(f32x2 v) {
    const f32x2 av = __builtin_elementwise_abs(v), d = av * 0.2316418882f + 1.0f;
    f32x2 t; t.x = __builtin_amdgcn_rcpf(d.x); t.y = __builtin_amdgcn_rcpf(d.y);
    f32x2 q = t * 0.5307027145f + (-0.7265760135f); q = q * t + 0.7107068705f; q = q * t + (-0.142248368f); q = q * t + 0.127414796f; q = q * t;
    const f32x2 s = (v * v) * (-0.72134752044f);
    f32x2 e; e.x = __builtin_amdgcn_exp2f(s.x); e.y = __builtin_amdgcn_exp2f(s.y);
    const f32x2 m = v * (q * e), r = v - m;
    f32x2 o; o.x = v.x < 0.f ? m.x : r.x; o.y = v.y < 0.f ? m.y : r.y; return o;
}

template <int ACT  > struct EpiBf16 {
    static constexpr bool PERM = true, AFTER_DRAIN = false, SCALES = false; static_assert(ACT == 0 || ACT == 1, "EpiBf16: ACT is 0 (none) or 1 (gelu_pk)");
    bf16_t* O; int ldc; const float* bias; int split_cols; size_t split_stride; float scale0;
    __device__ __forceinline__ void operator()(const f32x4 (&acc)[2][2][4][2], const Unit& u, int wr, int wc, int fr, int fq) const {
        const int row0 = u.pm * BM + wr * 64 + fr; int colt = u.pn * BM; bf16_t* base = O;
        float sc = 1.f; if (split_cols) { const int t = colt / split_cols; base += (size_t)t * split_stride; colt -= t * split_cols; if (t == 0) sc = scale0; }
        const int col0 = colt + wc * 32 + 8 * fq, bcol0 = u.pn * BM + wc * 32 + 8 * fq;
        f32x4 bv[2][2];
#pragma unroll
        for (int bj = 0; bj < 2; ++bj)
#pragma unroll
            for (int n = 0; n < 2; ++n) bv[bj][n] = bias ? *(const f32x4*)(bias + bcol0 + bj * HALF + 4 * n) : (f32x4){0.f, 0.f, 0.f, 0.f};
#pragma unroll
        for (int ai = 0; ai < 2; ++ai)
#pragma unroll
            for (int m = 0; m < 4; ++m) { bf16_t* rowp = base + (size_t)(row0 + ai * HALF + m * 16) * ldc + col0;
#pragma unroll
                for (int bj = 0; bj < 2; ++bj) { f32x4 v0 = acc[ai][bj][m][0] + bv[bj][0], v1 = acc[ai][bj][m][1] + bv[bj][1];
                    if (ACT == 1) { f32x2 a = gelu_pk((f32x2){v0[0], v0[1]}), b = gelu_pk((f32x2){v0[2], v0[3]}), c = gelu_pk((f32x2){v1[0], v1[1]}), d = gelu_pk((f32x2){v1[2], v1[3]});
                        v0 = (f32x4){a.x, a.y, b.x, b.y}; v1 = (f32x4){c.x, c.y, d.x, d.y}; }
                    v0 = v0 * sc; v1 = v1 * sc; u32x4 w; w.x = cvt_pk_bf16(v0[0], v0[1]); w.y = cvt_pk_bf16(v0[2], v0[3]); w.z = cvt_pk_bf16(v1[0], v1[1]); w.w = cvt_pk_bf16(v1[2], v1[3]);
                    *(u32x4*)(rowp + bj * HALF) = w; } }
    }
};

template <class Epi, class Sched, bool ALIGN_EPI = false, bool SP2 = false, bool I8 = false>
__device__ __forceinline__ void gemm_phase(PG8_LAS unsigned char* lds, const Gemm g, const Sched& S, const Epi& E, const int wave_id) {
    int lane_; asm volatile("v_mbcnt_lo_u32_b32 %0, -1, 0\n\tv_mbcnt_hi_u32_b32 %0, -1, %0" : "=v"(lane_));
    int w_ = wave_id; asm volatile("" : "+s"(w_));
    const int wid = w_, lane = lane_, tid = wid * 64 + lane, wr = wid >> 2, wc = wid & 3, fr = lane & 15, fq = lane >> 4;
    int K_ = g.K; asm volatile("" : "+s"(K_)); const int K = K_, nt = K / BK; int la_ = g.lda ? g.lda : g.K, lb_ = g.ldb ? g.ldb : g.K; asm volatile("" : "+s"(la_), "+s"(lb_)); const int lda = la_, ldb = lb_;
    unsigned voffA[2], voffB[2];
#pragma unroll
    for (int i = 0; i < 2; ++i) { int R, C; stage_rc(tid * 16 + i * 8192, R, C); const int Rb = Epi::PERM ? ((R & ~31) + perm32(R & 31)) : R;
        voffA[i] = (unsigned)(R * lda + C) * 2u; voffB[i] = (unsigned)(Rb * ldb + C) * 2u; }
    const size_t kstep = (size_t)(BK * 2);
    const size_t hstepA = (size_t)HALF * lda * 2, hstepB = (size_t)HALF * ldb * 2;
    const size_t tstepA = 2 * hstepA, tstepB = 2 * hstepB;
    const unsigned ldsw = (unsigned)wid * 1024u;
    const int aoff = lds_byte(wr * 64 + fr, fq * 8), boff = lds_byte(wc * 32 + fr, fq * 8);
#define PG8_SA(b, h) (((b) * 2 + (h)) * HTB)
#define PG8_SB(b, h) ((4 + (b) * 2 + (h)) * HTB)
#define PG8_STAGE(bufoff, gbase, voff) do { _Pragma("unroll") for (int _i = 0; _i < 2; ++_i) \
        __builtin_amdgcn_global_load_lds((const unsigned*)((const char*)(gbase) + (voff)[_i]), (PG8_LAS unsigned*)(lds + (bufoff) + ldsw + _i * 8192), 16, 0, 0); } while (0)
#define PG8_LDA(dst, b, h) do { _Pragma("unroll") for (int m = 0; m < 4; ++m) _Pragma("unroll") for (int k = 0; k < 2; ++k) dst[m][k] = *(const PG8_LAS bf16x8*)(lds + PG8_SA(b, h) + aoff + m * 2048 + k * 1024); } while (0)
#define PG8_LDB(dst, b, h) do { _Pragma("unroll") for (int n = 0; n < 2; ++n) _Pragma("unroll") for (int k = 0; k < 2; ++k) dst[n][k] = *(const PG8_LAS bf16x8*)(lds + PG8_SB(b, h) + boff + n * 2048 + k * 1024); } while (0)
#define PG8_MMA(ai, bj, At, Bt) do { __builtin_amdgcn_s_setprio(1); _Pragma("unroll") for (int m = 0; m < 4; ++m) _Pragma("unroll") for (int n = 0; n < 2; ++n) _Pragma("unroll") for (int k = 0; k < 2; ++k) \
        { if constexpr (I8) acc[ai][bj][m][n] = __builtin_bit_cast(f32x4, __builtin_amdgcn_mfma_i32_16x16x64_i8(__builtin_bit_cast(i32x4, Bt[n][k]), __builtin_bit_cast(i32x4, At[m][k]), __builtin_bit_cast(i32x4, acc[ai][bj][m][n]), 0, 0, 0)); \
          else acc[ai][bj][m][n] = __builtin_amdgcn_mfma_f32_16x16x32_bf16(Bt[n][k], At[m][k], acc[ai][bj][m][n], 0, 0, 0); } __builtin_amdgcn_s_setprio(0); } while (0)
#define PG8_WAIT_V(n) asm volatile("s_waitcnt vmcnt(" #n ")" ::: "memory")
#define PG8_WAIT_L(n) asm volatile("s_waitcnt lgkmcnt(" #n ")" ::: "memory")
#define PG8_BAR __builtin_amdgcn_s_barrier()
#define PG8_SCHED __builtin_amdgcn_sched_barrier(0)
    Unit cur, nxt; int ui = 0;
    if (!S.next(0, cur)) return;
    f32x4 acc[2][2][4][2];
    bf16x8 At[4][2], B0[2][2], B1[2][2];
    const char* cA = (const char*)g.A + (size_t)cur.pa * tstepA + (size_t)cur.kofs * 2; const char* cB = (const char*)g.Bt + (size_t)cur.pb * tstepB + (size_t)cur.kofs * 2;
    S.a_ready(cur);
    if constexpr (Epi::SCALES) E.prefetch(cur, wid, lane);
    if constexpr (SP2) {
        PG8_STAGE(PG8_SB(0, 0), cB, voffB); PG8_STAGE(PG8_SB(0, 1), cB + hstepB, voffB); PG8_STAGE(PG8_SA(0, 0), cA, voffA); PG8_STAGE(PG8_SA(0, 1), cA + hstepA, voffA);
        if (wr == 1) PG8_BAR;
        PG8_WAIT_V(2); PG8_BAR;
        PG8_STAGE(PG8_SB(1, 0), cB + kstep, voffB); PG8_STAGE(PG8_SA(1, 0), cA + kstep, voffA); PG8_STAGE(PG8_SB(1, 1), cB + hstepB + kstep, voffB);
        PG8_WAIT_V(6); PG8_BAR;
    } else {
        PG8_STAGE(PG8_SB(0, 0), cB, voffB); PG8_STAGE(PG8_SA(0, 0), cA, voffA); PG8_STAGE(PG8_SB(0, 1), cB + hstepB, voffB); PG8_STAGE(PG8_SA(0, 1), cA + hstepA, voffA);
        if (wr == 1) PG8_BAR;
        PG8_WAIT_V(4); PG8_BAR;
        PG8_STAGE(PG8_SB(1, 0), cB + kstep, voffB); PG8_STAGE(PG8_SA(1, 0), cA + kstep, voffA); PG8_STAGE(PG8_SB(1, 1), cB + hstepB + kstep, voffB);
        PG8_WAIT_V(6); PG8_BAR;
    }
    for (;;) {
#pragma unroll
        for (int a = 0; a < 2; ++a)
#pragma unroll
            for (int b = 0; b < 2; ++b)
#pragma unroll
                for (int m = 0; m < 4; ++m)
#pragma unroll
                    for (int n = 0; n < 2; ++n) acc[a][b][m][n] = (f32x4){0.f, 0.f, 0.f, 0.f};
        const bool has_next = S.next(ui + 1, nxt);
        const char* nA = has_next ? (const char*)g.A + (size_t)nxt.pa * tstepA + (size_t)nxt.kofs * 2 : cA; const char* nB = has_next ? (const char*)g.Bt + (size_t)nxt.pb * tstepB + (size_t)nxt.kofs * 2 : cB;
        int t = 0; do {
            const bool last = (t == nt - 2);
            const char* a1 = cA + (size_t)(t + 1) * kstep;
            const char* a2 = last ? nA : cA + (size_t)(t + 2) * kstep; const char* b2 = last ? nB : cB + (size_t)(t + 2) * kstep;
            const char* a3 = a2 + kstep; const char* b3 = b2 + kstep;
            if (last && has_next) { S.a_ready(nxt); if constexpr (Epi::SCALES) E.prefetch(nxt, wid, lane); }
            if constexpr (SP2) {
            PG8_LDB(B0, 0, 0); PG8_LDB(B1, 0, 1); PG8_SCHED; PG8_LDA(At, 0, 0); PG8_STAGE(PG8_SA(1, 1), a1 + hstepA, voffA);
            PG8_WAIT_V(8); PG8_WAIT_L(0); PG8_BAR; PG8_MMA(0, 0, At, B0); PG8_MMA(0, 1, At, B1); PG8_BAR; PG8_SCHED;
            PG8_LDA(At, 0, 1); PG8_STAGE(PG8_SB(0, 0), b2, voffB); PG8_STAGE(PG8_SB(0, 1), b2 + hstepB, voffB); PG8_STAGE(PG8_SA(0, 0), a2, voffA);
            PG8_WAIT_V(8); PG8_WAIT_L(0); PG8_BAR; PG8_MMA(1, 0, At, B0); PG8_MMA(1, 1, At, B1); PG8_BAR; PG8_SCHED;
            PG8_LDB(B0, 1, 0); PG8_LDB(B1, 1, 1); PG8_SCHED; PG8_LDA(At, 1, 0); PG8_STAGE(PG8_SA(0, 1), a2 + hstepA, voffA);
            PG8_WAIT_V(8); PG8_WAIT_L(0); PG8_BAR; PG8_MMA(0, 0, At, B0); PG8_MMA(0, 1, At, B1); PG8_BAR; PG8_SCHED;
            PG8_LDA(At, 1, 1); PG8_STAGE(PG8_SB(1, 0), b3, voffB); PG8_STAGE(PG8_SB(1, 1), b3 + hstepB, voffB); PG8_STAGE(PG8_SA(1, 0), a3, voffA);
            PG8_WAIT_V(8); PG8_WAIT_L(0); PG8_BAR; PG8_MMA(1, 0, At, B0); PG8_MMA(1, 1, At, B1); PG8_BAR; PG8_SCHED;
            } else {
            PG8_LDB(B0, 0, 0); PG8_SCHED; PG8_LDA(At, 0, 0); PG8_STAGE(PG8_SA(1, 1), a1 + hstepA, voffA);
            PG8_WAIT_L(8); PG8_BAR; PG8_WAIT_L(0); PG8_MMA(0, 0, At, B0); PG8_BAR; PG8_SCHED;
            PG8_LDB(B1, 0, 1); PG8_STAGE(PG8_SB(0, 0), b2, voffB);
            PG8_BAR; PG8_WAIT_L(0); PG8_MMA(0, 1, At, B1); PG8_BAR;
            PG8_LDA(At, 0, 1); PG8_STAGE(PG8_SA(0, 0), a2, voffA);
            PG8_BAR; PG8_WAIT_L(0); PG8_MMA(1, 0, At, B0); PG8_BAR; PG8_SCHED;
            PG8_STAGE(PG8_SB(0, 1), b2 + hstepB, voffB);
            PG8_WAIT_V(6); PG8_BAR; PG8_MMA(1, 1, At, B1); PG8_BAR;
            PG8_LDB(B0, 1, 0); PG8_SCHED; PG8_LDA(At, 1, 0); PG8_STAGE(PG8_SA(0, 1), a2 + hstepA, voffA);
            PG8_WAIT_L(8); PG8_BAR; PG8_WAIT_L(0); PG8_MMA(0, 0, At, B0); PG8_BAR; PG8_SCHED;
            PG8_LDB(B1, 1, 1); PG8_STAGE(PG8_SB(1, 0), b3, voffB);
            PG8_BAR; PG8_WAIT_L(0); PG8_MMA(0, 1, At, B1); PG8_BAR;
            PG8_LDA(At, 1, 1); PG8_STAGE(PG8_SA(1, 0), a3, voffA);
            PG8_BAR; PG8_WAIT_L(0); PG8_MMA(1, 0, At, B0); PG8_BAR; PG8_SCHED;
            PG8_STAGE(PG8_SB(1, 1), b3 + hstepB, voffB);
            PG8_WAIT_V(6); PG8_BAR; PG8_MMA(1, 1, At, B1); PG8_BAR;
            }
        t += 2; } while (t < nt);
        if constexpr (ALIGN_EPI) { if (wr == 0) PG8_BAR; }
        if constexpr (!Epi::AFTER_DRAIN) { E(acc, cur, wr, wc, fr, fq); S.done(cur); }
        if (!has_next) break;
        cur = nxt; cA = nA; cB = nB; ++ui;
        if constexpr (ALIGN_EPI) { if (wr == 1) PG8_BAR; }
    }
    PG8_WAIT_V(0);
    if constexpr (!ALIGN_EPI) { if (wr == 0) PG8_BAR; }
    PG8_BAR;
    if constexpr (Epi::AFTER_DRAIN) { E.fused(acc, cur, wr, wc, fr, fq, lds, wid, lane); S.done(cur); }
#undef PG8_SA
#undef PG8_SB
#undef PG8_STAGE
#undef PG8_LDA
#undef PG8_LDB
#undef PG8_MMA
#undef PG8_WAIT_V
#undef PG8_WAIT_L
#undef PG8_BAR
#undef PG8_SCHED
}
}
#ifndef EPI_FENCE_GRP
#define EPI_FENCE_GRP 8
#endif
namespace pg8 {
typedef unsigned u32x2 __attribute__((ext_vector_type(2)));
__device__ __forceinline__ float sigm(float x) { return __builtin_amdgcn_rcpf(1.0f + __builtin_amdgcn_exp2f(-1.4426950408889634f * x)); }
__device__ __forceinline__ void sigm8(f32x4& a, f32x4& b) {
    f32x4 ea = a * -1.4426950408889634f, eb = b * -1.4426950408889634f;
#pragma unroll
    for (int j = 0; j < 4; ++j) ea[j] = __builtin_amdgcn_exp2f(ea[j]);
#pragma unroll
    for (int j = 0; j < 4; ++j) eb[j] = __builtin_amdgcn_exp2f(eb[j]);
    ea = ea + 1.0f; eb = eb + 1.0f;
#pragma unroll
    for (int j = 0; j < 4; ++j) ea[j] = __builtin_amdgcn_rcpf(ea[j]);
#pragma unroll
    for (int j = 0; j < 4; ++j) eb[j] = __builtin_amdgcn_rcpf(eb[j]);
    a = ea; b = eb;
}
__device__ __forceinline__ u32x4 pack8(const f32x4& v0, const f32x4& v1) { u32x4 w; w.x = cvt_pk_bf16(v0[0], v0[1]); w.y = cvt_pk_bf16(v0[2], v0[3]); w.z = cvt_pk_bf16(v1[0], v1[1]); w.w = cvt_pk_bf16(v1[2], v1[3]); return w; }
__device__ __forceinline__ void unpack8(const u32x4& w, f32x4& v0, f32x4& v1) {
    v0[0] = __uint_as_float(w.x << 16); v0[1] = __uint_as_float(w.x & 0xffff0000u); v0[2] = __uint_as_float(w.y << 16); v0[3] = __uint_as_float(w.y & 0xffff0000u);
    v1[0] = __uint_as_float(w.z << 16); v1[1] = __uint_as_float(w.z & 0xffff0000u); v1[2] = __uint_as_float(w.w << 16); v1[3] = __uint_as_float(w.w & 0xffff0000u); }
__device__ __forceinline__ f32x4 i2f4(const f32x4& x) { return __builtin_convertvector(__builtin_bit_cast(i32x4, x), f32x4); }
struct RopeTab { f32x4 c0, c1, c2, c3; };
__device__ __forceinline__ RopeTab rope_load(const float* tab, int fq) { const float* t = tab + 16 * (fq & 1); RopeTab r; r.c0 = *(const f32x4*)(t); r.c1 = *(const f32x4*)(t + 4); r.c2 = *(const f32x4*)(t + 8); r.c3 = *(const f32x4*)(t + 12); return r; }
__device__ __forceinline__ void rope_apply(f32x4& v0, f32x4& v1, const RopeTab& r, int fq) {
    f32x4 p0, p1;
#pragma unroll
    for (int j = 0; j < 4; ++j) { const auto a_ = __builtin_amdgcn_permlane32_swap(__float_as_uint(v0[j]), __float_as_uint(v0[j]), false, false), b_ = __builtin_amdgcn_permlane32_swap(__float_as_uint(v1[j]), __float_as_uint(v1[j]), false, false);
        p0[j] = __uint_as_float(fq < 2 ? a_[1] : a_[0]); p1[j] = __uint_as_float(fq < 2 ? b_[1] : b_[0]); }
    const f32x4 c0 = r.c0, c1 = r.c1, c2 = r.c2, c3 = r.c3;
    const float sg = (fq < 2) ? -1.f : 1.f;
    v0[0] = v0[0] * c0[0] + sg * p0[0] * c0[1]; v0[1] = v0[1] * c0[2] + sg * p0[1] * c0[3];
    v0[2] = v0[2] * c1[0] + sg * p0[2] * c1[1]; v0[3] = v0[3] * c1[2] + sg * p0[3] * c1[3];
    v1[0] = v1[0] * c2[0] + sg * p1[0] * c2[1]; v1[1] = v1[1] * c2[2] + sg * p1[1] * c2[3];
    v1[2] = v1[2] * c3[0] + sg * p1[2] * c3[1]; v1[3] = v1[3] * c3[2] + sg * p1[3] * c3[3];
}
#define EPI_MEMBAR() asm volatile("" ::: "memory")
struct EpiProj {
    static constexpr bool PERM = true, AFTER_DRAIN = false, SCALES = true;
    bf16_t *NAQKV, *QLAT, *GATES, *KVLAT, *KMLA; const float* bgate; const float* rope; float qscale; float* PS; const float* sa; const float* sb; PG8_LAS float* tbl;
    __device__ __forceinline__ void prefetch(const Unit& u, int wid, int) const {
        int lane; asm volatile("v_mbcnt_lo_u32_b32 %0, -1, 0\n\tv_mbcnt_hi_u32_b32 %0, -1, %0" : "=v"(lane));
        const float* src = (wid < 4) ? sa + (size_t)u.pa * BM + wid * 64 + lane : sb + (size_t)u.pb * BM + (wid - 4) * 64 + lane;
        __builtin_amdgcn_global_load_lds((const unsigned*)src, (PG8_LAS unsigned*)(tbl + (u.slot & 1) * 512 + wid * 64), 4, 0, 0);
    }
    __device__ __forceinline__ void operator()(f32x4 (&acc)[2][2][4][2], const Unit& u, int wr, int wc, int fr, int fq) const {
        const int pn = u.pn; const int row0 = u.pm * BM + wr * 64 + fr;
        {
            const PG8_LAS float* tb = tbl + (u.slot & 1) * 512; const PG8_LAS float* sbp = tb + 256 + wc * 32 + 8 * fq;
            const f32x4 s00 = *(const PG8_LAS f32x4*)(sbp), s01 = *(const PG8_LAS f32x4*)(sbp + 4), s10 = *(const PG8_LAS f32x4*)(sbp + HALF), s11 = *(const PG8_LAS f32x4*)(sbp + HALF + 4);
#pragma unroll
            for (int ai = 0; ai < 2; ++ai)
#pragma unroll
                for (int m = 0; m < 4; ++m) { const float ra = tb[wr * 64 + fr + ai * HALF + m * 16];
                    acc[ai][0][m][0] = i2f4(acc[ai][0][m][0]) * (s00 * ra); acc[ai][0][m][1] = i2f4(acc[ai][0][m][1]) * (s01 * ra);
                    acc[ai][1][m][0] = i2f4(acc[ai][1][m][0]) * (s10 * ra); acc[ai][1][m][1] = i2f4(acc[ai][1][m][1]) * (s11 * ra); }
        }
        if (pn == 18) {
            if (wc == 0) {
#pragma unroll
                for (int ai = 0; ai < 2; ++ai) { RopeTab rt[4];
#pragma unroll
                    for (int m = 0; m < 4; ++m) rt[m] = rope_load(rope + (size_t)((row0 + ai * HALF + m * 16) & 8191) * 32, fq);
                    EPI_MEMBAR();
#pragma unroll
                    for (int m = 0; m < 4; ++m) { const int row = row0 + ai * HALF + m * 16; f32x4 v0 = acc[ai][0][m][0], v1 = acc[ai][0][m][1];
                        rope_apply(v0, v1, rt[m], fq); const u32x4 w = pack8(v0, v1); bf16_t* dp = KMLA + (size_t)row * 768 + 64 + 8 * fq;
#pragma unroll
                        for (int h = 0; h < 8; ++h) *(u32x4*)(dp + 96 * h) = w; }
                    EPI_MEMBAR(); }
            }
            return;
        }
        if (pn >= 9 && pn < 17) {
            const int col0 = (pn - 9) * BM + wc * 32 + 8 * fq;
            f32x4 bv[2][2];
#pragma unroll
            for (int bj = 0; bj < 2; ++bj)
#pragma unroll
                for (int n = 0; n < 2; ++n) bv[bj][n] = *(const f32x4*)(bgate + col0 + bj * HALF + 4 * n);
#pragma unroll
            for (int ai = 0; ai < 2; ++ai)
#pragma unroll
                for (int m = 0; m < 4; ++m) { unsigned char* rowp = (unsigned char*)GATES + (size_t)(row0 + ai * HALF + m * 16) * 2048 + col0;
#pragma unroll
                    for (int bj = 0; bj < 2; ++bj) { f32x4 v0 = acc[ai][bj][m][0] + bv[bj][0], v1 = acc[ai][bj][m][1] + bv[bj][1]; u32x2 w = {0u, 0u};
                        sigm8(v0, v1); v0 = v0 * 255.f; v1 = v1 * 255.f;
#pragma unroll
                        for (int j = 0; j < 4; ++j) { w.x = __builtin_amdgcn_cvt_pk_u8_f32(v0[j], j, w.x); w.y = __builtin_amdgcn_cvt_pk_u8_f32(v1[j], j, w.y); }
                        *(u32x2*)(rowp + bj * HALF) = w; } }
            return;
        }
        bf16_t* base; int ldc, colt, mode = 0;
        if (pn < 6) { base = NAQKV; ldc = 1536; colt = pn * BM; mode = (pn < 2) ? 1 : 0; }
        else if (pn < 9) { base = QLAT; ldc = 768; colt = (pn - 6) * BM; }
        else { base = KVLAT; ldc = 256; colt = 0; }
        const int col0 = colt + wc * 32 + 8 * fq;
        if (mode == 0 && pn >= 6) {
            const int slot = (pn == 17) ? 12 + wc : (pn - 6) * 4 + wc;
#pragma unroll
            for (int ai = 0; ai < 2; ++ai)
#pragma unroll
                for (int m = 0; m < 4; ++m) { float q = 0.f;
#pragma unroll
                    for (int bj = 0; bj < 2; ++bj)
#pragma unroll
                        for (int n = 0; n < 2; ++n) { const f32x4 x = acc[ai][bj][m][n]; q += (x[0] * x[0] + x[1] * x[1]) + (x[2] * x[2] + x[3] * x[3]); }
                    { const auto r_ = __builtin_amdgcn_permlane16_swap(__float_as_uint(q), __float_as_uint(q), false, false); q = __uint_as_float(r_[0]) + __uint_as_float(r_[1]); }
                    { const auto r_ = __builtin_amdgcn_permlane32_swap(__float_as_uint(q), __float_as_uint(q), false, false); q = __uint_as_float(r_[0]) + __uint_as_float(r_[1]); }
                    if (fq == 0) PS[(size_t)(row0 + ai * HALF + m * 16) * 16 + slot] = q; }
        }
        const float sc = (mode == 1) ? qscale : 1.f;
#pragma unroll
        for (int ai = 0; ai < 2; ++ai)
#pragma unroll
            for (int m = 0; m < 4; ++m) { bf16_t* rowp = base + (size_t)(row0 + ai * HALF + m * 16) * ldc + col0;
#pragma unroll
                for (int bj = 0; bj < 2; ++bj) *(u32x4*)(rowp + bj * HALF) = pack8(acc[ai][bj][m][0] * sc, acc[ai][bj][m][1] * sc); }
    }
};
struct EpiQup {
    static constexpr bool PERM = true, AFTER_DRAIN = false, SCALES = false;
    bf16_t* Q; const PG8_LAS float* rtab; const float* rope; float sc;
    __device__ __forceinline__ void operator()(const f32x4 (&acc)[2][2][4][2], const Unit& u, int wr, int wc, int fr, int fq) const {
        const int lr0 = wr * 64 + fr;
        const int rb0 = ((8 * u.pn + wc) % 3 == 2), rb1 = ((8 * u.pn + 4 + wc) % 3 == 2);
#pragma unroll
        for (int g2 = 0; g2 < 4; ++g2) { const int ai = g2 >> 1, m0 = (g2 & 1) * 2; RopeTab rt[2]; float rrs[2];
#pragma unroll
            for (int i = 0; i < 2; ++i) rrs[i] = rtab[u.slot * BM + lr0 + ai * HALF + (m0 + i) * 16];
            if (rb0 | rb1) {
#pragma unroll
                for (int i = 0; i < 2; ++i) rt[i] = rope_load(rope + (size_t)((u.pm * BM + lr0 + ai * HALF + (m0 + i) * 16) & 8191) * 32, fq);
#pragma unroll
                for (int i = 0; i < 2; ++i) asm volatile("" : "+v"(rt[i].c0), "+v"(rt[i].c1), "+v"(rt[i].c2), "+v"(rt[i].c3));
            }
            EPI_MEMBAR();
#pragma unroll
            for (int i = 0; i < 2; ++i) { const int m = m0 + i; const int lr = lr0 + ai * HALF + m * 16, row = u.pm * BM + lr; const float rr = rrs[i];
                bf16_t* rowp = Q + (size_t)row * 768 + u.pn * BM + wc * 32 + 8 * fq;
#pragma unroll
                for (int bj = 0; bj < 2; ++bj) { f32x4 v0 = acc[ai][bj][m][0] * rr, v1 = acc[ai][bj][m][1] * rr;
                    if (bj == 0 ? rb0 : rb1) rope_apply(v0, v1, rt[i], fq);
                    v0 = v0 * sc; v1 = v1 * sc; *(u32x4*)(rowp + bj * HALF) = pack8(v0, v1); } }
            EPI_MEMBAR(); }
    }
};
struct EpiKVup {
    static constexpr bool PERM = true, AFTER_DRAIN = false, SCALES = false;
    bf16_t *KM, *VM; const PG8_LAS float* rtab;
    __device__ __forceinline__ void operator()(const f32x4 (&acc)[2][2][4][2], const Unit& u, int wr, int wc, int fr, int fq) const {
        const int lr0 = wr * 64 + fr;
#pragma unroll
        for (int ai = 0; ai < 2; ++ai)
#pragma unroll
            for (int m = 0; m < 4; ++m) { const int lr = lr0 + ai * HALF + m * 16, row = u.pm * BM + lr; const float rr = rtab[u.slot * BM + lr];
#pragma unroll
                for (int bj = 0; bj < 2; ++bj) { const f32x4 v0 = acc[ai][bj][m][0] * rr, v1 = acc[ai][bj][m][1] * rr;
                    bf16_t* dp;
                    if (u.pn < 2) { const int h = 4 * u.pn + 2 * bj + (wc >> 1); dp = KM + (size_t)row * 768 + 96 * h + 32 * (wc & 1) + 8 * fq; }
                    else { dp = VM + (size_t)row * 512 + (u.pn - 2) * BM + bj * HALF + wc * 32 + 8 * fq; }
                    *(u32x4*)dp = pack8(v0, v1); }
                if (((ai * 4 + m + 1) % EPI_FENCE_GRP) == 0) asm volatile("" ::: "memory"); }
    }
};
struct EpiMerge {
    static constexpr bool PERM = true, AFTER_DRAIN = false, SCALES = false;
    const unsigned char* G; bf16_t* T; int second;
    __device__ __forceinline__ void operator()(const f32x4 (&acc)[2][2][4][2], const Unit& u, int wr, int wc, int fr, int fq) const {
        const int row0 = u.pm * BM + wr * 64 + fr, col0 = u.pn * BM + wc * 32 + 8 * fq;
#pragma unroll
        for (int ai = 0; ai < 2; ++ai) { u32x2 gw[4][2]; u32x4 tw[4][2];
#pragma unroll
            for (int m = 0; m < 4; ++m) { const size_t row = (size_t)(row0 + ai * HALF + m * 16);
#pragma unroll
                for (int bj = 0; bj < 2; ++bj) { const int c = col0 + bj * HALF; gw[m][bj] = *(const u32x2*)(G + row * 2048 + c); if (second) tw[m][bj] = *(const u32x4*)(T + row * 1024 + c); } }
            EPI_MEMBAR();
#pragma unroll
            for (int m = 0; m < 4; ++m) { const size_t row = (size_t)(row0 + ai * HALF + m * 16);
#pragma unroll
                for (int bj = 0; bj < 2; ++bj) { const int c = col0 + bj * HALF; const u32x2 g_ = gw[m][bj];
                    const f32x4 g0 = {(float)(g_.x & 255u), (float)((g_.x >> 8) & 255u), (float)((g_.x >> 16) & 255u), (float)(g_.x >> 24)}, g1 = {(float)(g_.y & 255u), (float)((g_.y >> 8) & 255u), (float)((g_.y >> 16) & 255u), (float)(g_.y >> 24)};
                    f32x4 v0 = acc[ai][bj][m][0] * (g0 * (1.f / 255.f)), v1 = acc[ai][bj][m][1] * (g1 * (1.f / 255.f));
                    if (second) { f32x4 t0, t1; unpack8(tw[m][bj], t0, t1); v0 = v0 + t0; v1 = v1 + t1; }
                    *(u32x4*)(T + row * 1024 + c) = pack8(v0, v1); } }
            EPI_MEMBAR(); }
    }
};
struct EpiPlain {
    static constexpr bool PERM = true, AFTER_DRAIN = false, SCALES = false;
    bf16_t* O; int ldc;
    __device__ __forceinline__ void operator()(const f32x4 (&acc)[2][2][4][2], const Unit& u, int wr, int wc, int fr, int fq) const {
        const int row0 = u.pm * BM + wr * 64 + fr, col0 = u.pn * BM + wc * 32 + 8 * fq;
#pragma unroll
        for (int ai = 0; ai < 2; ++ai)
#pragma unroll
            for (int m = 0; m < 4; ++m) { bf16_t* rowp = O + (size_t)(row0 + ai * HALF + m * 16) * ldc + col0;
#pragma unroll
                for (int bj = 0; bj < 2; ++bj) *(u32x4*)(rowp + bj * HALF) = pack8(acc[ai][bj][m][0], acc[ai][bj][m][1]); }
    }
};
template <int MODE> struct EpiRes {
    static constexpr bool PERM = true, AFTER_DRAIN = false, SCALES = (MODE == 3);
    const bf16_t* xres; bf16_t* Y; bf16_t* P; float alpha; const float* sa; const float* sb; PG8_LAS float* tbl;
    __device__ __forceinline__ void prefetch(const Unit& u, int wid, int) const {
        int lane; asm volatile("v_mbcnt_lo_u32_b32 %0, -1, 0\n\tv_mbcnt_hi_u32_b32 %0, -1, %0" : "=v"(lane));
        const float* src = (wid < 4) ? sa + (size_t)u.pa * BM + wid * 64 + lane : sb + (size_t)u.pb * BM + (wid - 4) * 64 + lane;
        __builtin_amdgcn_global_load_lds((const unsigned*)src, (PG8_LAS unsigned*)(tbl + (u.slot & 1) * 512 + wid * 64), 4, 0, 0);
    }
    __device__ __forceinline__ void operator()(const f32x4 (&acc)[2][2][4][2], const Unit& u, int wr, int wc, int fr, int fq) const {
        const int row0 = u.pm * BM + wr * 64 + fr, col0 = u.pn * BM + wc * 32 + 8 * fq;
        const PG8_LAS float* tb = (MODE == 3) ? tbl + (u.slot & 1) * 512 : nullptr;
        f32x4 sb0[2], sb1[2];
        if (MODE == 3) {
#pragma unroll
            for (int bj = 0; bj < 2; ++bj) { const PG8_LAS float* sbp = tb + 256 + bj * HALF + wc * 32 + 8 * fq; sb0[bj] = *(const PG8_LAS f32x4*)sbp; sb1[bj] = *(const PG8_LAS f32x4*)(sbp + 4); } }
#pragma unroll
        for (int ai = 0; ai < 2; ++ai) { u32x4 lx[4][2], lp[4][2];
#pragma unroll
            for (int m = 0; m < 4; ++m) { const size_t off = (size_t)(row0 + ai * HALF + m * 16) * 1024 + col0;
#pragma unroll
                for (int bj = 0; bj < 2; ++bj) { const size_t o = off + bj * HALF;
                    if (MODE == 0 || MODE == 2) lx[m][bj] = *(const u32x4*)(xres + o);
                    if (MODE != 0) lp[m][bj] = *(const u32x4*)(P + o); } }
            EPI_MEMBAR();
#pragma unroll
            for (int m = 0; m < 4; ++m) { const size_t off = (size_t)(row0 + ai * HALF + m * 16) * 1024 + col0;
#pragma unroll
                for (int bj = 0; bj < 2; ++bj) { const size_t o = off + bj * HALF; f32x4 v0 = acc[ai][bj][m][0], v1 = acc[ai][bj][m][1];
                    if (MODE == 0) { f32x4 x0, x1; unpack8(lx[m][bj], x0, x1); v0 = x0 * alpha + v0; v1 = x1 * alpha + v1; *(u32x4*)(Y + o) = pack8(v0, v1); }
                    else if (MODE == 3) { f32x4 p0, p1; unpack8(lp[m][bj], p0, p1); const float ra = tb[wr * 64 + fr + ai * HALF + m * 16];
                        v0 = i2f4(v0) * (sb0[bj] * ra); v1 = i2f4(v1) * (sb1[bj] * ra);
                        sigm8(v0, v1); v0 = v0 * p0; v1 = v1 * p1;
                        *(u32x4*)(P + o) = pack8(v0, v1); }
                    else if (MODE == 1) { f32x4 p0, p1; unpack8(lp[m][bj], p0, p1);
                        sigm8(v0, v1); v0 = v0 * p0; v1 = v1 * p1;
                        *(u32x4*)(P + o) = pack8(v0, v1); }
                    else { f32x4 x0, x1, p0, p1; unpack8(lx[m][bj], x0, x1); unpack8(lp[m][bj], p0, p1);
                        v0 = x0 * alpha + p0 + v0; v1 = x1 * alpha + p1 + v1; *(u32x4*)(Y + o) = pack8(v0, v1); } } }
            EPI_MEMBAR(); }
    }
};
struct EpiGate8 {
    static constexpr bool PERM = true, AFTER_DRAIN = false, SCALES = true;
    unsigned char* G8; const float* sa; const float* sb; PG8_LAS float* tbl;
    __device__ __forceinline__ void prefetch(const Unit& u, int wid, int) const {
        int lane; asm volatile("v_mbcnt_lo_u32_b32 %0, -1, 0\n\tv_mbcnt_hi_u32_b32 %0, -1, %0" : "=v"(lane));
        const float* src = (wid < 4) ? sa + (size_t)u.pa * BM + wid * 64 + lane : sb + (size_t)u.pb * BM + (wid - 4) * 64 + lane;
        __builtin_amdgcn_global_load_lds((const unsigned*)src, (PG8_LAS unsigned*)(tbl + (u.slot & 1) * 512 + wid * 64), 4, 0, 0);
    }
    __device__ __forceinline__ void operator()(const f32x4 (&acc)[2][2][4][2], const Unit& u, int wr, int wc, int fr, int fq) const {
        const int row0 = u.pm * BM + wr * 64 + fr, col0 = u.pn * BM + wc * 32 + 8 * fq;
        const PG8_LAS float* tb = tbl + (u.slot & 1) * 512;
        f32x4 sb0[2], sb1[2];
#pragma unroll
        for (int bj = 0; bj < 2; ++bj) { const PG8_LAS float* sbp = tb + 256 + bj * HALF + wc * 32 + 8 * fq; sb0[bj] = *(const PG8_LAS f32x4*)sbp; sb1[bj] = *(const PG8_LAS f32x4*)(sbp + 4); }
#pragma unroll
        for (int ai = 0; ai < 2; ++ai)
#pragma unroll
            for (int m = 0; m < 4; ++m) { const float ra = tb[wr * 64 + fr + ai * HALF + m * 16]; unsigned char* rowp = G8 + (size_t)(row0 + ai * HALF + m * 16) * 1024 + col0;
#pragma unroll
                for (int bj = 0; bj < 2; ++bj) { f32x4 v0 = i2f4(acc[ai][bj][m][0]) * (sb0[bj] * ra), v1 = i2f4(acc[ai][bj][m][1]) * (sb1[bj] * ra); u32x2 w = {0u, 0u};
                    sigm8(v0, v1); v0 = v0 * 255.f; v1 = v1 * 255.f;
#pragma unroll
                    for (int j = 0; j < 4; ++j) { w.x = __builtin_amdgcn_cvt_pk_u8_f32(v0[j], j, w.x); w.y = __builtin_amdgcn_cvt_pk_u8_f32(v1[j], j, w.y); }
                    *(u32x2*)(rowp + bj * HALF) = w; } }
    }
};
struct EpiGateMul {
    static constexpr bool PERM = true, AFTER_DRAIN = false, SCALES = false;
    const unsigned char* G8; bf16_t* P;
    __device__ __forceinline__ void operator()(const f32x4 (&acc)[2][2][4][2], const Unit& u, int wr, int wc, int fr, int fq) const {
        const int row0 = u.pm * BM + wr * 64 + fr, col0 = u.pn * BM + wc * 32 + 8 * fq;
        u32x2 gw[8][2];
#pragma unroll
        for (int i = 0; i < 8; ++i)
#pragma unroll
            for (int bj = 0; bj < 2; ++bj) gw[i][bj] = *(const u32x2*)(G8 + (size_t)(row0 + (i >> 2) * HALF + (i & 3) * 16) * 1024 + col0 + bj * HALF);
        EPI_MEMBAR();
#pragma unroll
        for (int i = 0; i < 8; ++i) { const int ai = i >> 2, m = i & 3; bf16_t* rowp = P + (size_t)(row0 + ai * HALF + m * 16) * 1024 + col0;
#pragma unroll
            for (int bj = 0; bj < 2; ++bj) { const u32x2 g_ = gw[i][bj];
                const f32x4 g0 = {(float)(g_.x & 255u), (float)((g_.x >> 8) & 255u), (float)((g_.x >> 16) & 255u), (float)(g_.x >> 24)}, g1 = {(float)(g_.y & 255u), (float)((g_.y >> 8) & 255u), (float)((g_.y >> 16) & 255u), (float)(g_.y >> 24)};
                *(u32x4*)(rowp + bj * HALF) = pack8(acc[ai][bj][m][0] * (g0 * (1.f / 255.f)), acc[ai][bj][m][1] * (g1 * (1.f / 255.f))); } }
    }
};
struct EpiGLU {
    static constexpr bool PERM = true, AFTER_DRAIN = false, SCALES = false;
    bf16_t* H; int ldh;
    __device__ __forceinline__ void operator()(const f32x4 (&acc)[2][2][4][2], const Unit& u, int wr, int wc, int fr, int fq) const {
        const int row0 = u.pm * BM + wr * 64 + fr, col0 = u.pn * HALF + wc * 32 + 8 * fq;
#pragma unroll
        for (int ai = 0; ai < 2; ++ai)
#pragma unroll
            for (int m = 0; m < 4; ++m) { f32x4 h0, h1;
#pragma unroll
                for (int j = 0; j < 4; ++j) { const float a0 = acc[ai][0][m][0][j], a1 = acc[ai][0][m][1][j]; h0[j] = a0 * sigm(a0) * acc[ai][1][m][0][j]; h1[j] = a1 * sigm(a1) * acc[ai][1][m][1][j]; }
                *(u32x4*)(H + (size_t)(row0 + ai * HALF + m * 16) * ldh + col0) = pack8(h0, h1); }
    }
};
struct EpiGLUQ {
    static constexpr bool PERM = true, AFTER_DRAIN = false, SCALES = true;
    bf16_t* H; int ldh; const float* sa; const float* sb; PG8_LAS float* tbl;
    __device__ __forceinline__ void prefetch(const Unit& u, int wid, int) const {
        int lane; asm volatile("v_mbcnt_lo_u32_b32 %0, -1, 0\n\tv_mbcnt_hi_u32_b32 %0, -1, %0" : "=v"(lane));
        const float* src = (wid < 4) ? sa + (size_t)u.pa * BM + wid * 64 + lane : sb + (size_t)u.pb * BM + (wid - 4) * 64 + lane;
        __builtin_amdgcn_global_load_lds((const unsigned*)src, (PG8_LAS unsigned*)(tbl + (u.slot & 1) * 512 + wid * 64), 4, 0, 0);
    }
    __device__ __forceinline__ void operator()(const f32x4 (&acc)[2][2][4][2], const Unit& u, int wr, int wc, int fr, int fq) const {
        const int lrow0 = wr * 64 + fr, row0 = u.pm * BM + lrow0, col0 = u.pn * HALF + wc * 32 + 8 * fq;
        const PG8_LAS float* tb = tbl + (u.slot & 1) * 512; const PG8_LAS float* sbp = tb + 256 + wc * 32 + 8 * fq;
        const f32x4 s10 = *(const PG8_LAS f32x4*)(sbp), s11 = *(const PG8_LAS f32x4*)(sbp + 4), s30 = *(const PG8_LAS f32x4*)(sbp + HALF), s31 = *(const PG8_LAS f32x4*)(sbp + HALF + 4);
#pragma unroll
        for (int ai = 0; ai < 2; ++ai)
#pragma unroll
            for (int m = 0; m < 4; ++m) { const float ra = tb[lrow0 + ai * HALF + m * 16];
                const f32x4 a0 = i2f4(acc[ai][0][m][0]) * (s10 * ra), a1 = i2f4(acc[ai][0][m][1]) * (s11 * ra), b0 = i2f4(acc[ai][1][m][0]) * (s30 * ra), b1 = i2f4(acc[ai][1][m][1]) * (s31 * ra);
                f32x4 h0 = a0, h1 = a1; sigm8(h0, h1); h0 = (a0 * h0) * b0; h1 = (a1 * h1) * b1;
                *(u32x4*)(H + (size_t)(row0 + ai * HALF + m * 16) * ldh + col0) = pack8(h0, h1); }
    }
};
struct EpiMoeDown {
    static constexpr bool PERM = true, AFTER_DRAIN = false, SCALES = false;
    bf16_t* O; const float* SW;
    __device__ __forceinline__ void operator()(const f32x4 (&acc)[2][2][4][2], const Unit& u, int wr, int wc, int fr, int fq) const {
        const int row0 = u.pm * BM + wr * 64 + fr, col0 = u.pn * BM + wc * 32 + 8 * fq;
        float gws[8];
#pragma unroll
        for (int i = 0; i < 8; ++i) gws[i] = SW[row0 + (i >> 2) * HALF + (i & 3) * 16];
        EPI_MEMBAR();
#pragma unroll
        for (int ai = 0; ai < 2; ++ai)
#pragma unroll
            for (int m = 0; m < 4; ++m) { const int row = row0 + ai * HALF + m * 16; const float gw = gws[ai * 4 + m]; bf16_t* rowp = O + (size_t)row * 1024 + col0;
#pragma unroll
                for (int bj = 0; bj < 2; ++bj) *(u32x4*)(rowp + bj * HALF) = pack8(acc[ai][bj][m][0] * gw, acc[ai][bj][m][1] * gw); }
    }
};
template <bool UP> struct MoeOrder {
    int nMc, nN, nwg, G, c, t0; int ts1, ts2, ts3, ts4, ts5, ts6, ts7;
    __device__ __forceinline__ bool next(int i, Unit& u) const {
        const long L = (long)i * G + c; if (L >= nwg) return false;
        int wgid = (int)L; { const int q = nwg / NXCD, r = nwg % NXCD, xcd = wgid % NXCD, off = wgid / NXCD; wgid = (xcd < r ? xcd * (q + 1) : r * (q + 1) + (xcd - r) * q) + off; }
        const int nig = WGM * nN, gid = wgid / nig, fm = gid * WGM, gsz = (nMc - fm) < WGM ? (nMc - fm) : WGM;
        const int pml = fm + ((wgid % nig) % gsz), pn = (wgid % nig) / gsz, t = t0 + pml;
        const int e = (t >= ts1) + (t >= ts2) + (t >= ts3) + (t >= ts4) + (t >= ts5) + (t >= ts6) + (t >= ts7);
        u.pn = pn; u.pb = e * nN + pn; u.slot = i; u.kofs = 0; u.aux = 0;
        if (UP) { u.pa = t; u.pm = pml; } else { u.pa = pml; u.pm = t; }
        return true;
    }
    __device__ __forceinline__ void a_ready(const Unit&) const {}
    __device__ __forceinline__ void done(const Unit&) const {}
};
struct MoeRemOrder {
    int nT, G, c, t0, KQ, pa0; int ts1, ts2, ts3, ts4, ts5, ts6, ts7;
    __device__ __forceinline__ bool next(int i, Unit& u) const {
        const int L = i * G + c; if (L >= nT * 16) return false;
        const int tl = L >> 4, pn = (L >> 2) & 3, kq = L & 3, t = t0 + tl;
        const int e = (t >= ts1) + (t >= ts2) + (t >= ts3) + (t >= ts4) + (t >= ts5) + (t >= ts6) + (t >= ts7);
        u.pa = pa0 + tl; u.pm = tl; u.pn = pn; u.pb = e * 4 + pn; u.slot = i; u.kofs = kq * KQ; u.aux = kq; return true;
    }
    __device__ __forceinline__ void a_ready(const Unit&) const {}
    __device__ __forceinline__ void done(const Unit&) const {}
};
struct EpiMoeRem {
    static constexpr bool PERM = true, AFTER_DRAIN = false, SCALES = false;
    bf16_t* PART; const float* SW; int t0, prows;
    __device__ __forceinline__ void operator()(const f32x4 (&acc)[2][2][4][2], const Unit& u, int wr, int wc, int fr, int fq) const {
        const int row0 = u.pm * BM + wr * 64 + fr, col0 = u.pn * BM + wc * 32 + 8 * fq;
        float gws[8];
#pragma unroll
        for (int i = 0; i < 8; ++i) gws[i] = SW[t0 * BM + row0 + (i >> 2) * HALF + (i & 3) * 16];
        EPI_MEMBAR();
#pragma unroll
        for (int ai = 0; ai < 2; ++ai)
#pragma unroll
            for (int m = 0; m < 4; ++m) { const int row = row0 + ai * HALF + m * 16; const float gw = gws[ai * 4 + m]; bf16_t* rowp = PART + ((size_t)u.aux * prows + row) * 1024 + col0;
#pragma unroll
                for (int bj = 0; bj < 2; ++bj) *(u32x4*)(rowp + bj * HALF) = pack8(acc[ai][bj][m][0] * gw, acc[ai][bj][m][1] * gw); }
    }
};
}
namespace att {
#define ATT_LAS __attribute__((address_space(3)))
typedef unsigned short bf16;
using bf16x8 = __attribute__((ext_vector_type(8))) short;
using s16x4  = __attribute__((ext_vector_type(4))) short;
using f32x16 = __attribute__((ext_vector_type(16))) float;
using u32x4  = __attribute__((ext_vector_type(4))) unsigned;
#define SBAR() __builtin_amdgcn_sched_barrier(0)
__device__ __forceinline__ int crow(int r, int hi) { return (r & 3) + 8 * (r >> 2) + 4 * hi; }
__device__ __forceinline__ unsigned cvtpk(float lo, float hi) { unsigned r; asm volatile("v_cvt_pk_bf16_f32 %0, %1, %2" : "=v"(r) : "v"(lo), "v"(hi)); return r; }
__device__ __forceinline__ unsigned short f2bf(float f) { return (unsigned short)(cvtpk(f, f) & 0xffffu); }
constexpr int OIMG_WAVE = 32 * 144;
__device__ __forceinline__ int crow(int r, int hi);
__device__ __forceinline__ void store_o(const f32x16 (&o)[2], const ATT_LAS float* li_l, bf16* Ow, ATT_LAS char* img, int lane, int r32, int hi) {
  typedef unsigned u32x4_t __attribute__((ext_vector_type(4)));
#pragma unroll
  for (int r = 0; r < 16; ++r) { const int orow = (r & 3) + 8 * (r >> 2) + 4 * hi; const float rl = __builtin_amdgcn_rcpf(li_l[orow]);
    ATT_LAS unsigned short* rp = (ATT_LAS unsigned short*)(img + orow * 144) + r32;
    rp[0] = f2bf(o[0][r] * rl); rp[32] = f2bf(o[1][r] * rl); }
  asm volatile("s_waitcnt lgkmcnt(0)" ::: "memory");
#pragma unroll
  for (int j = 0; j < 4; ++j) { const int pc = j * 64 + lane, row = pc >> 3, c16 = pc & 7;
    const u32x4_t v = *(const ATT_LAS u32x4_t*)(img + row * 144 + c16 * 16);
    *reinterpret_cast<u32x4_t*>(Ow + (long)row * 512 + c16 * 8) = v; }
}
__device__ __forceinline__ int v_st(int k, int c) { const int kk = (k & ~0xC) | ((k & 4) << 1) | ((k & 8) >> 1); return ((kk >> 3) * 2 + (c >> 5)) * 512 + ((kk & 7) * 32 + (c & 31)) * 2; }
__device__ __forceinline__ int v_rd_base(int lane) { return ((lane & 3) << 3) | (((lane >> 2) & 3) << 6) | (((lane >> 4) & 1) << 5) | (((lane >> 5) & 1) << 8); }
constexpr int v_rd_off(int d0, int ks, int half) { return d0 * 512 + ks * 2048 + half * 1024; }
template <int OFF> __device__ __forceinline__ s16x4 tr_read(int vb) { s16x4 r; asm volatile("ds_read_b64_tr_b16 %0, %1 offset:%2" : "=&v"(r) : "v"(vb), "i"(OFF) : "memory"); return r; }
template <int D0> __device__ __forceinline__ void pv_one(f32x16& od, int vb, bf16x8 pa0, bf16x8 pa1, bf16x8 pa2, bf16x8 pa3) {
  const s16x4 l0 = tr_read<v_rd_off(D0, 0, 0)>(vb), h0 = tr_read<v_rd_off(D0, 0, 1)>(vb), l1 = tr_read<v_rd_off(D0, 1, 0)>(vb), h1 = tr_read<v_rd_off(D0, 1, 1)>(vb);
  const s16x4 l2 = tr_read<v_rd_off(D0, 2, 0)>(vb), h2 = tr_read<v_rd_off(D0, 2, 1)>(vb), l3 = tr_read<v_rd_off(D0, 3, 0)>(vb), h3 = tr_read<v_rd_off(D0, 3, 1)>(vb);
  asm volatile("s_waitcnt lgkmcnt(0)" ::: "memory"); SBAR();
#define PK(L, H) (bf16x8){L[0], L[1], L[2], L[3], H[0], H[1], H[2], H[3]}
  od = __builtin_amdgcn_mfma_f32_32x32x16_bf16(pa0, PK(l0, h0), od, 0, 0, 0);
  od = __builtin_amdgcn_mfma_f32_32x32x16_bf16(pa1, PK(l1, h1), od, 0, 0, 0);
  od = __builtin_amdgcn_mfma_f32_32x32x16_bf16(pa2, PK(l2, h2), od, 0, 0, 0);
  od = __builtin_amdgcn_mfma_f32_32x32x16_bf16(pa3, PK(l3, h3), od, 0, 0, 0);
#undef PK
}
__device__ __forceinline__ void pv2(f32x16* o, int vb, bf16x8 pa0, bf16x8 pa1, bf16x8 pa2, bf16x8 pa3) { pv_one<0>(o[0], vb, pa0, pa1, pa2, pa3); pv_one<1>(o[1], vb, pa0, pa1, pa2, pa3); }
template <int NS, int ROWB> __device__ __forceinline__ void qkt(f32x16& p0, f32x16& p1, const ATT_LAS char* Ks, const bf16x8* qr, int r32, int hi) {
  p0 = f32x16{}; p1 = f32x16{};
#pragma unroll
  for (int d0 = 0; d0 < NS; ++d0) { const int cb = d0 * 32 + hi * 16;
    const bf16x8 b0 = *(const ATT_LAS bf16x8*)(Ks + r32 * ROWB + cb);
    const bf16x8 b1 = *(const ATT_LAS bf16x8*)(Ks + (32 + r32) * ROWB + cb);
    p0 = __builtin_amdgcn_mfma_f32_32x32x16_bf16(b0, qr[d0], p0, 0, 0, 0);
    p1 = __builtin_amdgcn_mfma_f32_32x32x16_bf16(b1, qr[d0], p1, 0, 0, 0); }
}
constexpr float THR = 8.f;
__device__ __forceinline__ void partialSM(f32x16& p0, f32x16& p1, float& m_reg, float& alpha) {
  float pmax = p0[0];
#pragma unroll
  for (int r = 1; r < 16; ++r) pmax = fmaxf(pmax, p0[r]);
#pragma unroll
  for (int r = 0; r < 16; ++r) pmax = fmaxf(pmax, p1[r]);
  { auto rr = __builtin_amdgcn_permlane32_swap(__float_as_uint(pmax), __float_as_uint(pmax), false, false); pmax = fmaxf(__uint_as_float(rr[0]), __uint_as_float(rr[1])); }
  float mn;
  if (__builtin_expect(__all(pmax - m_reg <= THR), 1)) { mn = m_reg; alpha = 1.f; }
  else { mn = fmaxf(m_reg, pmax); alpha = __builtin_amdgcn_exp2f(m_reg - mn); m_reg = mn; }
#pragma unroll
  for (int r = 0; r < 16; ++r) p0[r] = p0[r] - mn;
#pragma unroll
  for (int r = 0; r < 16; ++r) p1[r] = p1[r] - mn;
#pragma unroll
  for (int r = 0; r < 16; ++r) p0[r] = __builtin_amdgcn_exp2f(p0[r]);
}
__device__ __forceinline__ void finishSM(f32x16& p0, f32x16& p1, float alpha, float& l_reg, bf16x8& pa0, bf16x8& pa1, bf16x8& pa2, bf16x8& pa3) {
#pragma unroll
  for (int r = 0; r < 16; ++r) p1[r] = __builtin_amdgcn_exp2f(p1[r]);
  float ps = 0;
#pragma unroll
  for (int r = 0; r < 16; ++r) ps += p0[r];
#pragma unroll
  for (int r = 0; r < 16; ++r) ps += p1[r];
  { auto rr = __builtin_amdgcn_permlane32_swap(__float_as_uint(ps), __float_as_uint(ps), false, false); ps = __uint_as_float(rr[0]) + __uint_as_float(rr[1]); }
  l_reg = l_reg * alpha + ps;
#define PK4(P, BASE, OUT) do { unsigned a0 = cvtpk(P[BASE + 0], P[BASE + 1]), a1 = cvtpk(P[BASE + 2], P[BASE + 3]);   \
    unsigned b0 = cvtpk(P[BASE + 4], P[BASE + 5]), b1 = cvtpk(P[BASE + 6], P[BASE + 7]);                              \
    auto r0 = __builtin_amdgcn_permlane32_swap(a0, b0, false, false); auto r1 = __builtin_amdgcn_permlane32_swap(a1, b1, false, false); \
    u32x4 w = {r0[0], r1[0], r0[1], r1[1]}; OUT = *reinterpret_cast<bf16x8*>(&w); } while (0)
  PK4(p0, 0, pa0); PK4(p0, 8, pa1); PK4(p1, 0, pa2); PK4(p1, 8, pa3);
#undef PK4
}

#define MX3(a, b, c) __builtin_fmaxf(__builtin_fmaxf((a), (b)), (c))
__device__ __forceinline__ float rowmax32(const f32x16& p0, const f32x16& p1) {
  float a = MX3(p0[0], p0[1], p1[0]), b = MX3(p0[2], p0[3], p1[1]); a = MX3(a, p1[2], p1[3]);
#pragma unroll
  for (int r = 4; r < 16; r += 4) { a = MX3(a, p0[r], p0[r + 1]); b = MX3(b, p0[r + 2], p0[r + 3]); a = MX3(a, p1[r], p1[r + 1]); b = MX3(b, p1[r + 2], p1[r + 3]); }
  float m = __builtin_fmaxf(a, b);
  { auto rr = __builtin_amdgcn_permlane32_swap(__float_as_uint(m), __float_as_uint(m), false, false); m = __builtin_fmaxf(__uint_as_float(rr[0]), __uint_as_float(rr[1])); }
  return m;
}
template <int NS, int ROWB> __device__ __forceinline__ void qkt_from(f32x16& p0, f32x16& p1, const ATT_LAS char* Ks, const bf16x8* qr, const f32x16& c0, int r32, int hi) {
#pragma unroll
  for (int d0 = 0; d0 < NS; ++d0) { const int cb = d0 * 32 + hi * 16;
    const bf16x8 b0 = *(const ATT_LAS bf16x8*)(Ks + r32 * ROWB + cb);
    const bf16x8 b1 = *(const ATT_LAS bf16x8*)(Ks + (32 + r32) * ROWB + cb);
    if (d0 == 0) { p0 = __builtin_amdgcn_mfma_f32_32x32x16_bf16(b0, qr[0], c0, 0, 0, 0); p1 = __builtin_amdgcn_mfma_f32_32x32x16_bf16(b1, qr[0], c0, 0, 0, 0); }
    else { p0 = __builtin_amdgcn_mfma_f32_32x32x16_bf16(b0, qr[d0], p0, 0, 0, 0); p1 = __builtin_amdgcn_mfma_f32_32x32x16_bf16(b1, qr[d0], p1, 0, 0, 0); } }
}
template <bool FIRST> __device__ __forceinline__ void partialSM2(f32x16& p0, f32x16& p1, float& m_ref, f32x16& negm, float& alpha) {
  const float rm = rowmax32(p0, p1);
  alpha = 1.f;
  if (FIRST || !__builtin_expect(__all(rm <= THR), 1)) {
    const float dl = FIRST ? rm : __builtin_fmaxf(rm, 0.f);
    m_ref += dl;
#pragma unroll
    for (int r = 0; r < 16; ++r) { p0[r] -= dl; p1[r] -= dl; }
#pragma unroll
    for (int r = 0; r < 16; ++r) negm[r] = -m_ref;
    asm volatile("" : "+v"(negm));
    if (!FIRST) alpha = __builtin_amdgcn_exp2f(-dl);
  }
#pragma unroll
  for (int r = 0; r < 16; ++r) p0[r] = __builtin_amdgcn_exp2f(p0[r]);
}
__device__ __forceinline__ void finishSM2(f32x16& p0, f32x16& p1, bf16x8& pa0, bf16x8& pa1, bf16x8& pa2, bf16x8& pa3) {
#pragma unroll
  for (int r = 0; r < 16; ++r) p1[r] = __builtin_amdgcn_exp2f(p1[r]);
#define PK4(P, BASE, OUT) do { unsigned a0 = cvtpk(P[BASE + 0], P[BASE + 1]), a1 = cvtpk(P[BASE + 2], P[BASE + 3]);   \
    unsigned b0 = cvtpk(P[BASE + 4], P[BASE + 5]), b1 = cvtpk(P[BASE + 6], P[BASE + 7]);                              \
    auto r0 = __builtin_amdgcn_permlane32_swap(a0, b0, false, false); auto r1 = __builtin_amdgcn_permlane32_swap(a1, b1, false, false); \
    u32x4 w = {r0[0], r1[0], r0[1], r1[1]}; OUT = *reinterpret_cast<bf16x8*>(&w); } while (0)
  PK4(p0, 0, pa0); PK4(p0, 8, pa1); PK4(p1, 0, pa2); PK4(p1, 8, pa3);
#undef PK4
}
__device__ __forceinline__ void pv3(f32x16* o, f32x16& ol, int vb, bf16x8 pa0, bf16x8 pa1, bf16x8 pa2, bf16x8 pa3) {
  const bf16x8 ones = {0x3F80, 0x3F80, 0x3F80, 0x3F80, 0x3F80, 0x3F80, 0x3F80, 0x3F80};
  pv_one<0>(o[0], vb, pa0, pa1, pa2, pa3);
  ol = __builtin_amdgcn_mfma_f32_32x32x16_bf16(pa0, ones, ol, 0, 0, 0); ol = __builtin_amdgcn_mfma_f32_32x32x16_bf16(pa1, ones, ol, 0, 0, 0);
  pv_one<1>(o[1], vb, pa0, pa1, pa2, pa3);
  ol = __builtin_amdgcn_mfma_f32_32x32x16_bf16(pa2, ones, ol, 0, 0, 0); ol = __builtin_amdgcn_mfma_f32_32x32x16_bf16(pa3, ones, ol, 0, 0, 0);
}
#ifndef MLA_CHK_ODD
#define MLA_CHK_ODD 0
#endif
constexpr int KSLOT = 12288, VSLOT = 8192, NSLOT = 4, MLA_OIMG = NSLOT * (KSLOT + VSLOT) + 8 * 256  , MLA_LDS = MLA_OIMG + 8 * OIMG_WAVE;
__device__ __forceinline__ void glds16(const void* gsrc, unsigned lds_dst) { unsigned keep;
  asm volatile("s_mov_b32 %0, m0\n\ts_mov_b32 m0, %2\n\ts_nop 0\n\tglobal_load_lds_dwordx4 %1, off\n\ts_mov_b32 m0, %0" : "=&s"(keep) : "v"(gsrc), "s"(lds_dst) : "memory"); }
#define BAR_L() asm volatile("s_waitcnt lgkmcnt(0)\n\ts_barrier" ::: "memory")
#define BAR_V(N) asm volatile("s_waitcnt vmcnt(" #N ") lgkmcnt(0)\n\ts_barrier" ::: "memory")
typedef short v4i16_t __attribute__((ext_vector_type(4)));
__device__ __forceinline__ s16x4 vtr(const ATT_LAS char* p) { return __builtin_bit_cast(s16x4, __builtin_amdgcn_ds_read_tr16_b64_v4i16((ATT_LAS v4i16_t*)p)); }
__device__ __forceinline__ void kfetch(bf16x8 (&kf)[12], const ATT_LAS char* Ks, int r32, int hi) {
#pragma unroll
  for (int d0 = 0; d0 < 6; ++d0) { const ATT_LAS char* p = Ks + (2 * d0 + hi) * 1024 + r32 * 16;
    kf[2 * d0] = *(const ATT_LAS bf16x8*)p; kf[2 * d0 + 1] = *(const ATT_LAS bf16x8*)(p + 512); }
}
#define MX3(a, b, c) __builtin_fmaxf(__builtin_fmaxf((a), (b)), (c))
__device__ __forceinline__ void mla_unit(const bf16* __restrict__ Qb, const bf16* __restrict__ Kh, const bf16* __restrict__ Vh, bf16* __restrict__ Ob, int seq, ATT_LAS char* lds, const int wave_id) {
  int lane_; asm volatile("v_mbcnt_lo_u32_b32 %0, -1, 0\n\tv_mbcnt_hi_u32_b32 %0, -1, %0" : "=v"(lane_));
  int w_ = wave_id; asm volatile("" : "+s"(w_));
  const int wid = w_, lane = lane_, r32 = lane & 31, hi = lane >> 5;
  const int half = wid >> 2;
  ATT_LAS char* K_lds = lds; ATT_LAS char* V_lds = lds + NSLOT * KSLOT;
  ATT_LAS float* al_l = (ATT_LAS float*)(lds + NSLOT * (KSLOT + VSLOT)) + wid * 64; ATT_LAS float* li_l = al_l + 32;
  const unsigned lds0 = (unsigned)(uintptr_t)lds;
  const int NT = seq / 64;
  const bf16* ksrc0 = Kh + (long)lane * 768 + wid * 8; const bf16* ksrc1 = ksrc0 + 64;
  const bf16* vsrc = Vh + (long)(16 * (wid & 3) + (lane >> 2)) * 512 + (wid >> 2) * 32 + (lane & 3) * 8;
  const unsigned kdst0 = lds0 + wid * 1024, vdst = lds0 + NSLOT * KSLOT + wid * 1024;
#define DMA_K(tile, slot) do { const int tl_ = (tile) < NT ? (tile) : NT - 1; const unsigned d_ = (unsigned)__builtin_amdgcn_readfirstlane(kdst0 + ((slot) & 3) * KSLOT); \
    glds16(ksrc0 + (long)tl_ * 64 * 768, d_); if (!half) glds16(ksrc1 + (long)tl_ * 64 * 768, d_ + 8192); } while (0)
#define DMA_V(tile, slot) do { const int tl_ = (tile) < NT ? (tile) : NT - 1; glds16(vsrc + (long)tl_ * 64 * 512, (unsigned)__builtin_amdgcn_readfirstlane(vdst + ((slot) & 3) * VSLOT)); } while (0)
#define STEP_BAR() do { SBAR(); if (!half) { BAR_V(6); } else { BAR_V(4); } SBAR(); } while (0)
  DMA_K(0, 0); DMA_K(1, 1); DMA_K(2, 2); DMA_K(3, 3); DMA_V(0, 0); DMA_V(1, 1);
  float m_ref = 0.f, l_reg = 0.f, pend = 0.f; f32x16 o[2] = {}; f32x16 negm = {}; bf16x8 qr[6];
  const bf16* Qw = Qb + (long)(wid * 32 + r32) * 768 + hi * 8;
#pragma unroll
  for (int d0 = 0; d0 < 6; ++d0) qr[d0] = *reinterpret_cast<const bf16x8*>(Qw + d0 * 16);
  const ATT_LAS char* vbp0 = V_lds + ((lane >> 4) & 1) * 32 + (lane & 3) * 8 + (4 * hi + ((lane & 15) >> 2)) * 64; const ATT_LAS char* kb0 = K_lds + hi * 1024 + r32 * 16;
  BAR_V(0);
  f32x16 pA0, pA1, pB0, pB1; bf16x8 paA0, paA1, paA2, paA3, paB0, paB1, paB2, paB3;
  paB0 = paB1 = paB2 = paB3 = (bf16x8){0, 0, 0, 0, 0, 0, 0, 0};
#define KFR(kb, i) (*(const ATT_LAS bf16x8*)((kb) + ((i) >> 1) * 2048 + ((i) & 1) * 512))
#pragma unroll
  for (int i = 0; i < 12; i += 2) { const bf16x8 k0_ = KFR(kb0, i), k1_ = KFR(kb0, i + 1);
    if (i == 0) { pA0 = __builtin_amdgcn_mfma_f32_32x32x16_bf16(k0_, qr[0], negm, 0, 0, 0); pA1 = __builtin_amdgcn_mfma_f32_32x32x16_bf16(k1_, qr[0], negm, 0, 0, 0); }
    else { pA0 = __builtin_amdgcn_mfma_f32_32x32x16_bf16(k0_, qr[i >> 1], pA0, 0, 0, 0); pA1 = __builtin_amdgcn_mfma_f32_32x32x16_bf16(k1_, qr[i >> 1], pA1, 0, 0, 0); } }
#define QKM(i, N0, N1) do { if ((i) == 0) N0 = __builtin_amdgcn_mfma_f32_32x32x16_bf16(kf[0], qr[0], negm, 0, 0, 0); else if ((i) == 1) N1 = __builtin_amdgcn_mfma_f32_32x32x16_bf16(kf[1], qr[0], negm, 0, 0, 0); \
    else if (((i) & 1) == 0) N0 = __builtin_amdgcn_mfma_f32_32x32x16_bf16(kf[i], qr[(i) >> 1], N0, 0, 0, 0); else N1 = __builtin_amdgcn_mfma_f32_32x32x16_bf16(kf[i], qr[(i) >> 1], N1, 0, 0, 0); } while (0)
#define VRDJ(j) do { vl[j] = vtr(vbp + ((j) >> 2) * 4096 + ((j) & 3) * 1024); vh[j] = vtr(vbp + ((j) >> 2) * 4096 + ((j) & 3) * 1024 + 512); } while (0)
#define PKV(i) (bf16x8){vl[i][0], vl[i][1], vl[i][2], vl[i][3], vh[i][0], vh[i][1], vh[i][2], vh[i][3]}
#define EXQ(idx, C0, C1) do { if ((idx) < 16) C0[(idx)] = __builtin_amdgcn_exp2f(C0[(idx)]); else C1[(idx) - 16] = __builtin_amdgcn_exp2f(C1[(idx) - 16]); } while (0)
#define CV(idx, C0, C1) ((idx) < 16 ? C0[(idx)] : C1[(idx) - 16])
#define EX2(k, C0, C1) do { EXQ(2 * (k), C0, C1); EXQ(2 * (k) + 1, C0, C1); ps2 += (f32x2_t){CV(2 * (k), C0, C1), CV(2 * (k) + 1, C0, C1)}; } while (0)
#define PK4(P, BASE, OUT) do { u32x4 w = {cvtpk(P[BASE + 0], P[BASE + 1]), cvtpk(P[BASE + 2], P[BASE + 3]), cvtpk(P[BASE + 4], P[BASE + 5]), cvtpk(P[BASE + 6], P[BASE + 7])}; OUT = *reinterpret_cast<bf16x8*>(&w); } while (0)
#define STEP(t, C0, C1, N0, N1, PC0, PC1, PC2, PC3, PO0, PO1, PO2, PO3, FIRST, CHK) do { \
    typedef float f32x2_t __attribute__((ext_vector_type(2))); \
    STEP_BAR(); \
    DMA_K((t) + 4, (t)); DMA_V((t) + 2, (t) + 2); \
    const ATT_LAS char* kb = kb0 + (((t) + 1) & 3) * KSLOT; const ATT_LAS char* vbp = vbp0 + (((t) - 1) & 3) * VSLOT; \
    bf16x8 kf[12]; s16x4 vl[8], vh[8]; f32x2_t ps2 = {0.f, 0.f}; float al = 1.f; \
    kf[0] = KFR(kb, 0); kf[1] = KFR(kb, 1); kf[2] = KFR(kb, 2); kf[3] = KFR(kb, 3); \
    float a_ = 0.f, b_ = 0.f, rm = 0.f; \
    if (CHK) { a_ = MX3(C0[0], C0[1], C1[0]); b_ = MX3(C0[2], C0[3], C1[1]); a_ = MX3(a_, C1[2], C1[3]); \
    a_ = MX3(a_, C0[4], C0[5]); b_ = MX3(b_, C0[6], C0[7]); a_ = MX3(a_, C1[4], C1[5]); b_ = MX3(b_, C1[6], C1[7]); } SBAR(); \
    QKM(0, N0, N1); kf[4] = KFR(kb, 4); if (CHK) { a_ = MX3(a_, C0[8], C0[9]); b_ = MX3(b_, C0[10], C0[11]); a_ = MX3(a_, C1[8], C1[9]); b_ = MX3(b_, C1[10], C1[11]); } SBAR(); \
    QKM(1, N0, N1); kf[5] = KFR(kb, 5); if (CHK) { a_ = MX3(a_, C0[12], C0[13]); b_ = MX3(b_, C0[14], C0[15]); a_ = MX3(a_, C1[12], C1[13]); b_ = MX3(b_, C1[14], C1[15]); } SBAR(); \
    QKM(2, N0, N1); kf[6] = KFR(kb, 6); if (CHK) { rm = __builtin_fmaxf(a_, b_); { auto rr = __builtin_amdgcn_permlane32_swap(__float_as_uint(rm), __float_as_uint(rm), false, false); rm = __builtin_fmaxf(__uint_as_float(rr[0]), __uint_as_float(rr[1])); } } SBAR(); \
    QKM(3, N0, N1); kf[7] = KFR(kb, 7); SBAR(); \
    if ((CHK) && ((FIRST) || !__builtin_expect(__all(rm <= THR), 1))) { const float dl = (FIRST) ? rm : __builtin_fmaxf(rm, 0.f); m_ref += dl; pend = dl; \
      _Pragma("unroll") for (int r = 0; r < 16; ++r) { C0[r] -= dl; C1[r] -= dl; } \
      _Pragma("unroll") for (int r = 0; r < 16; ++r) negm[r] = -m_ref; \
      asm volatile("" : "+v"(negm)); if (!(FIRST)) al = __builtin_amdgcn_exp2f(-dl); } \
    SBAR(); \
    QKM(4, N0, N1); kf[8] = KFR(kb, 8); EX2(0, C0, C1); SBAR(); \
    QKM(5, N0, N1); kf[9] = KFR(kb, 9); EX2(1, C0, C1); SBAR(); \
    QKM(6, N0, N1); kf[10] = KFR(kb, 10); EX2(2, C0, C1); SBAR(); \
    QKM(7, N0, N1); kf[11] = KFR(kb, 11); EX2(3, C0, C1); SBAR(); \
    QKM(8, N0, N1); EX2(4, C0, C1); PK4(C0, 0, PC0); SBAR(); \
    QKM(9, N0, N1); if (!(FIRST)) { VRDJ(0); } EX2(5, C0, C1); SBAR(); \
    QKM(10, N0, N1); if (!(FIRST)) { VRDJ(4); } EX2(6, C0, C1); SBAR(); \
    QKM(11, N0, N1); if (!(FIRST)) { VRDJ(1); } EX2(7, C0, C1); SBAR(); \
    if (!(FIRST)) o[0] = __builtin_amdgcn_mfma_f32_32x32x16_bf16(PO0, PKV(0), o[0], 0, 0, 0); if (!(FIRST)) { VRDJ(5); } EX2(8, C0, C1); PK4(C0, 8, PC1); SBAR(); \
    if (!(FIRST)) o[1] = __builtin_amdgcn_mfma_f32_32x32x16_bf16(PO0, PKV(4), o[1], 0, 0, 0); if (!(FIRST)) { VRDJ(2); } EX2(9, C0, C1); SBAR(); \
    if (!(FIRST)) o[0] = __builtin_amdgcn_mfma_f32_32x32x16_bf16(PO1, PKV(1), o[0], 0, 0, 0); if (!(FIRST)) { VRDJ(6); } EX2(10, C0, C1); SBAR(); \
    if (!(FIRST)) o[1] = __builtin_amdgcn_mfma_f32_32x32x16_bf16(PO1, PKV(5), o[1], 0, 0, 0); if (!(FIRST)) { VRDJ(3); } EX2(11, C0, C1); SBAR(); \
    if (!(FIRST)) o[0] = __builtin_amdgcn_mfma_f32_32x32x16_bf16(PO2, PKV(2), o[0], 0, 0, 0); if (!(FIRST)) { VRDJ(7); } EX2(12, C0, C1); PK4(C1, 0, PC2); SBAR(); \
    if (!(FIRST)) o[1] = __builtin_amdgcn_mfma_f32_32x32x16_bf16(PO2, PKV(6), o[1], 0, 0, 0); EX2(13, C0, C1); SBAR(); \
    if (!(FIRST)) o[0] = __builtin_amdgcn_mfma_f32_32x32x16_bf16(PO3, PKV(3), o[0], 0, 0, 0); EX2(14, C0, C1); SBAR(); \
    if (!(FIRST)) o[1] = __builtin_amdgcn_mfma_f32_32x32x16_bf16(PO3, PKV(7), o[1], 0, 0, 0); EX2(15, C0, C1); PK4(C1, 8, PC3); SBAR(); \
    l_reg = l_reg * al + (ps2.x + ps2.y); \
    if (__builtin_expect(__any(pend != 0.f), 0)) {       \
      const float f_ = (FIRST) ? 1.f : __builtin_amdgcn_exp2f(-pend); if (hi == 0) al_l[r32] = f_; asm volatile("s_waitcnt lgkmcnt(0)" ::: "memory"); \
      _Pragma("unroll") for (int r = 0; r < 16; ++r) { const float g_ = al_l[crow(r, hi)]; o[0][r] *= g_; o[1][r] *= g_; N0[r] -= pend; N1[r] -= pend; } \
      pend = 0.f; } \
  } while (0)
  STEP(0, pA0, pA1, pB0, pB1, paA0, paA1, paA2, paA3, paB0, paB1, paB2, paB3, true, 1);
  for (int t = 1; t + 1 < NT; t += 2) {
    STEP(t, pB0, pB1, pA0, pA1, paB0, paB1, paB2, paB3, paA0, paA1, paA2, paA3, false, MLA_CHK_ODD);
    STEP(t + 1, pA0, pA1, pB0, pB1, paA0, paA1, paA2, paA3, paB0, paB1, paB2, paB3, false, 1);
  }
  STEP(NT - 1, pB0, pB1, pA0, pA1, paB0, paB1, paB2, paB3, paA0, paA1, paA2, paA3, false, MLA_CHK_ODD);
  STEP_BAR();
  { const ATT_LAS char* vbp = vbp0 + ((NT - 1) & 3) * VSLOT; s16x4 vl[8], vh[8];
#pragma unroll
    for (int j = 0; j < 8; ++j) VRDJ(j);
    o[0] = __builtin_amdgcn_mfma_f32_32x32x16_bf16(paB0, PKV(0), o[0], 0, 0, 0); o[1] = __builtin_amdgcn_mfma_f32_32x32x16_bf16(paB0, PKV(4), o[1], 0, 0, 0);
    o[0] = __builtin_amdgcn_mfma_f32_32x32x16_bf16(paB1, PKV(1), o[0], 0, 0, 0); o[1] = __builtin_amdgcn_mfma_f32_32x32x16_bf16(paB1, PKV(5), o[1], 0, 0, 0);
    o[0] = __builtin_amdgcn_mfma_f32_32x32x16_bf16(paB2, PKV(2), o[0], 0, 0, 0); o[1] = __builtin_amdgcn_mfma_f32_32x32x16_bf16(paB2, PKV(6), o[1], 0, 0, 0);
    o[0] = __builtin_amdgcn_mfma_f32_32x32x16_bf16(paB3, PKV(3), o[0], 0, 0, 0); o[1] = __builtin_amdgcn_mfma_f32_32x32x16_bf16(paB3, PKV(7), o[1], 0, 0, 0); }
  { auto rr = __builtin_amdgcn_permlane32_swap(__float_as_uint(l_reg), __float_as_uint(l_reg), false, false); l_reg = __uint_as_float(rr[0]) + __uint_as_float(rr[1]); }
  if (hi == 0) li_l[r32] = l_reg; asm volatile("s_waitcnt lgkmcnt(0)" ::: "memory");
  store_o(o, li_l, Ob + (long)(wid * 32) * 512, lds + MLA_OIMG + wid * OIMG_WAVE, lane, r32, hi);
  BAR_V(0);
#undef DMA_K
#undef DMA_V
#undef STEP_BAR
#undef KFR
#undef QKM
#undef VRDJ
#undef PKV
#undef EXQ
#undef CV
#undef EX2
#undef PK4
#undef STEP
}
#undef BAR_L
#undef BAR_V

constexpr int NA_KROWB = 144, NA_LDS_K = 64 * NA_KROWB  , NA_SLOT = NA_LDS_K + 8192  , NA_OIMG = 2 * NA_SLOT + 15 * 32 * 4 + 8 * 256  , NA_LDS = NA_OIMG + 8 * OIMG_WAVE;
template <int CH> __device__ __forceinline__ constexpr bool na_live0(int q) { return CH == 0 ? true : q >= 12; }
template <int CH> __device__ __forceinline__ constexpr bool na_live1(int q) { return CH == 0 ? q < 4 : true; }
template <int CH> __device__ __forceinline__ void na_tile(f32x16& p0, f32x16& p1, const ATT_LAS float* trow, int qcol, int wstart, int hi, int r32, bool first,
                                                          float& m_ref, float& l_reg, f32x16& negm, f32x16 (&o)[2], ATT_LAS float* al_l, int vb) {
  float bz0[16], bz1[16];
#pragma unroll
  for (int q = 0; q < 16; ++q) { const int kc0 = crow(q, hi), kc1 = kc0 + 32;
    if (na_live0<CH>(q)) { const int i0 = min(max(kc0 - qcol + 15, 0), 30); bz0[q] = trow[i0]; }
    if (na_live1<CH>(q)) { const int i1 = min(max(kc1 - qcol + 15, 0), 30); bz1[q] = trow[i1]; } }
#pragma unroll
  for (int q = 0; q < 16; ++q) { if (na_live0<CH>(q)) asm volatile("" : "+v"(bz0[q])); if (na_live1<CH>(q)) asm volatile("" : "+v"(bz1[q])); }
#pragma unroll
  for (int q = 0; q < 16; ++q) { const int kc0 = crow(q, hi), kc1 = kc0 + 32;
    if (na_live0<CH>(q)) p0[q] = ((unsigned)(kc0 - wstart) < 16u) ? p0[q] + bz0[q] : -1e30f;
    if (na_live1<CH>(q)) p1[q] = ((unsigned)(kc1 - wstart) < 16u) ? p1[q] + bz1[q] : -1e30f; }
  float rm = -1e30f;
#pragma unroll
  for (int q = 0; q < 16; ++q) { if (na_live0<CH>(q)) rm = __builtin_fmaxf(rm, p0[q]); if (na_live1<CH>(q)) rm = __builtin_fmaxf(rm, p1[q]); }
  { auto rr = __builtin_amdgcn_permlane32_swap(__float_as_uint(rm), __float_as_uint(rm), false, false); rm = __builtin_fmaxf(__uint_as_float(rr[0]), __uint_as_float(rr[1])); }
  float al = 1.f;
  if (first || !__builtin_expect(__all(rm <= THR), 1)) {
    const float dl = first ? rm : __builtin_fmaxf(rm, 0.f); m_ref += dl;
#pragma unroll
    for (int q = 0; q < 16; ++q) { if (na_live0<CH>(q)) p0[q] -= dl; if (na_live1<CH>(q)) p1[q] -= dl; }
#pragma unroll
    for (int q = 0; q < 16; ++q) negm[q] = -m_ref;
    asm volatile("" : "+v"(negm));
    if (!first) al = __builtin_amdgcn_exp2f(-dl);
    if (__any(al < 1.f)) { if (hi == 0) al_l[r32] = al; asm volatile("s_waitcnt lgkmcnt(0)" ::: "memory");
#pragma unroll
      for (int q = 0; q < 16; ++q) { const float f_ = al_l[crow(q, hi)]; o[0][q] *= f_; o[1][q] *= f_; } }
  }
  float ps = 0.f;
#pragma unroll
  for (int q = 0; q < 16; ++q) { if (na_live0<CH>(q)) { p0[q] = __builtin_amdgcn_exp2f(p0[q]); ps += p0[q]; } else p0[q] = 0.f;
    if (na_live1<CH>(q)) { p1[q] = __builtin_amdgcn_exp2f(p1[q]); ps += p1[q]; } else p1[q] = 0.f; }
  l_reg = l_reg * al + ps;
  bf16x8 pa0, pa1, pa2, pa3;
#define PK4(P, BASE, OUT) do { unsigned a0 = cvtpk(P[BASE + 0], P[BASE + 1]), a1 = cvtpk(P[BASE + 2], P[BASE + 3]);   \
    unsigned b0_ = cvtpk(P[BASE + 4], P[BASE + 5]), b1_ = cvtpk(P[BASE + 6], P[BASE + 7]);                              \
    auto r0_ = __builtin_amdgcn_permlane32_swap(a0, b0_, false, false); auto r1_ = __builtin_amdgcn_permlane32_swap(a1, b1_, false, false); \
    u32x4 w = {r0_[0], r1_[0], r0_[1], r1_[1]}; OUT = *reinterpret_cast<bf16x8*>(&w); } while (0)
  if (CH == 1) { PK4(p0, 8, pa1); PK4(p1, 0, pa2); PK4(p1, 8, pa3); } else { PK4(p0, 0, pa0); PK4(p0, 8, pa1); PK4(p1, 0, pa2); }
#undef PK4
  SBAR();
  { const ATT_LAS char* vbp = (const ATT_LAS char*)(unsigned)vb;
#define NA_VF(D0, KS) const s16x4 l##D0##KS = vtr(vbp + v_rd_off(D0, KS, 0)), h##D0##KS = vtr(vbp + v_rd_off(D0, KS, 1))
#define NA_PV(D0, KS, PA) o[D0] = __builtin_amdgcn_mfma_f32_32x32x16_bf16(PA, (bf16x8){l##D0##KS[0], l##D0##KS[1], l##D0##KS[2], l##D0##KS[3], h##D0##KS[0], h##D0##KS[1], h##D0##KS[2], h##D0##KS[3]}, o[D0], 0, 0, 0)
    NA_VF(0, 1); NA_VF(1, 1); NA_VF(0, 2); NA_VF(1, 2);
    if (CH == 0) { NA_VF(0, 0); NA_VF(1, 0); NA_PV(0, 0, pa0); NA_PV(1, 0, pa0); }
    NA_PV(0, 1, pa1); NA_PV(1, 1, pa1); NA_PV(0, 2, pa2); NA_PV(1, 2, pa2);
    if (CH == 1) { NA_VF(0, 3); NA_VF(1, 3); NA_PV(0, 3, pa3); NA_PV(1, 3, pa3); }
#undef NA_VF
#undef NA_PV
  }
}
__device__ __forceinline__ void na_unit(int b, int h, int rg, const bf16* __restrict__ QKV, bf16* __restrict__ O, const float* __restrict__ rpb, ATT_LAS char* lds, const int wave_id) {
  int lane_; asm volatile("v_mbcnt_lo_u32_b32 %0, -1, 0\n\tv_mbcnt_hi_u32_b32 %0, -1, %0" : "=v"(lane_));
  int w_ = wave_id; asm volatile("" : "+s"(w_));
  const int wid = w_, lane = lane_, tid = wid * 64 + lane, r32 = lane & 31, hi = lane >> 5;
  ATT_LAS char* K_lds = lds; ATT_LAS char* V_lds = lds + NA_LDS_K; ATT_LAS float* tab = (ATT_LAS float*)(lds + 2 * NA_SLOT);
  ATT_LAS float* ws = (ATT_LAS float*)(lds + 2 * NA_SLOT + 15 * 32 * 4) + wid * 64; ATT_LAS float* li_l = ws; ATT_LAS float* al_l = ws + 32;
  const int r0 = 4 * rg, r = r0 + (wid >> 1), ch = wid & 1, qcol = 32 * ch + r32;
  const int rs = min(max(r - 4, 0), 120), lo = min(max(r0 - 4, 0), 120), hiR = min(max(r0 + 3 - 4, 0), 120) + 7;
  const int wstart = min(max(qcol - 8, 0), 48);
  const long tok0 = (long)b * 8192;
  if (tid < 15 * 32) { const int dr = tid >> 5, dc = tid & 31; tab[tid] = (dc < 31) ? rpb[(h * 15 + dr) * 31 + dc] * 1.4426950408889634f : 0.f; }
  bf16x8 qr[4];
  { const bf16* Qw = QKV + (tok0 + r * 64 + qcol) * 1536 + h * 64 + hi * 8;
#pragma unroll
    for (int d0 = 0; d0 < 4; ++d0) qr[d0] = *reinterpret_cast<const bf16x8*>(Qw + d0 * 16); }
  const int srow = tid >> 3, sch = tid & 7; const int kst = srow * NA_KROWB + sch * 16, vst = v_st(srow, sch * 8);
  const int vb0 = (int)(unsigned)(uintptr_t)V_lds + v_rd_base(lane);
  const bf16* Ksrc = QKV + (tok0 + srow) * 1536 + 512 + h * 64 + sch * 8; const bf16* Vsrc = Ksrc + 512;
  float m_ref = 0.f, l_reg = 0.f; f32x16 o[2] = {}; f32x16 negm = {};
#define NA_LD(KR, KV, VV) do { const int kk_ = min((KR), hiR); KV = *reinterpret_cast<const bf16x8*>(Ksrc + (long)kk_ * 64 * 1536); VV = *reinterpret_cast<const bf16x8*>(Vsrc + (long)kk_ * 64 * 1536); } while (0)
#define NA_BODY(KR, KN, VN, CHV) do { \
    __syncthreads();                                               \
    if ((KR) + 1 <= hiR) { *(ATT_LAS bf16x8*)(K_lds + (par ^ 1) * NA_SLOT + kst) = KN; *(ATT_LAS bf16x8*)(V_lds + (par ^ 1) * NA_SLOT + vst) = VN; NA_LD((KR) + 3, KN, VN); } \
    if ((KR) >= rs && (KR) < rs + 8) {                              \
      f32x16 p0, p1; qkt_from<4, NA_KROWB>(p0, p1, K_lds + par * NA_SLOT, qr, negm, r32, hi); \
      const ATT_LAS float* trow = tab + ((KR) - r + 7) * 32; \
      na_tile<CHV>(p0, p1, trow, qcol, wstart, hi, r32, (KR) == rs, m_ref, l_reg, negm, o, al_l, vb0 + par * NA_SLOT); \
    } \
    par ^= 1; } while (0)
  bf16x8 k0, v0, k1, v1;
  NA_LD(lo, k0, v0); NA_LD(lo + 1, k1, v1);
  *(ATT_LAS bf16x8*)(K_lds + kst) = k0; *(ATT_LAS bf16x8*)(V_lds + vst) = v0; NA_LD(lo + 2, k0, v0);
  int par = 0;
  if (ch == 0) {
    for (int kr = lo; kr <= hiR; kr += 2) {
      NA_BODY(kr, k1, v1, 0);
      if (kr + 1 > hiR) break;
      NA_BODY(kr + 1, k0, v0, 0);
    }
  } else {
    for (int kr = lo; kr <= hiR; kr += 2) {
      NA_BODY(kr, k1, v1, 1);
      if (kr + 1 > hiR) break;
      NA_BODY(kr + 1, k0, v0, 1);
    }
  }
#undef NA_LD
#undef NA_BODY
  { auto rr = __builtin_amdgcn_permlane32_swap(__float_as_uint(l_reg), __float_as_uint(l_reg), false, false); l_reg = __uint_as_float(rr[0]) + __uint_as_float(rr[1]); }
  if (hi == 0) li_l[r32] = l_reg; asm volatile("s_waitcnt lgkmcnt(0)" ::: "memory");
  store_o(o, li_l, O + (tok0 + r * 64 + 32 * ch) * 512 + h * 64, lds + NA_OIMG + wid * OIMG_WAVE, lane, r32, hi);
  __syncthreads();
}
#undef SBAR
}

constexpr int NWAVES = 8;
constexpr int NB = 8, SEQ = 8192, DM = 1024, MTOK = NB * SEQ;
constexpr int NIN = 4640, NPROJ = 4864;
constexpr int DFF = 2816, DFFE = 3584, NEXP = 8, PLED = 256;
constexpr int QLORA = 768, KVLORA = 256;
constexpr float ALPHA = 1.4142135623730951f;
constexpr float LN_EPS = 1e-5f, RMS_EPS = 1e-6f;
constexpr float LOG2E = 1.4426950408889634f;
constexpr float NA_QSCALE = 0.125f * LOG2E;
constexpr float MLA_QSCALE = 0.10206207261596575f * LOG2E;
constexpr int MOE_CHUNK = 128, MOE_NCHUNK = 4, MOE_REMT = 8, MOE_MAXT = 520;

constexpr size_t MiB = 1u << 20;
constexpr size_t WS_CTL = 0, CTL_ZERO_BYTES = 64 * 1024;
constexpr size_t WS_ROPE = 1 * MiB;
constexpr size_t WS_W = 2 * MiB;
constexpr size_t W_WIN = 0, W_WUQ = W_WIN + (size_t)NPROJ * 1024 * 2, W_WUKV = W_WUQ + 768 * 768 * 2, W_WNAO = W_WUKV + 1024 * 256 * 2, W_WMLAO = W_WNAO + 1024 * 512 * 2,
                 W_WOUT = W_WMLAO + 1024 * 512 * 2, W_WPG = W_WOUT + 1024 * 1024 * 2, W_WPLE = W_WPG + 1024 * 1024 * 2, W_LAYER = W_WPLE + 1024 * 256 * 2;
constexpr size_t WS_W13 = WS_W + 2 * W_LAYER, WS_W2 = WS_W13 + (size_t)2 * DFF * 1024 * 2, WS_WEND = WS_W2 + (size_t)1024 * DFF * 2;
static_assert(WS_WEND <= 56 * MiB, "weights");
constexpr size_t WS_SX = 54 * MiB, WS_SX1 = WS_SX + 256 * 1024, WS_SXS = WS_SX + 512 * 1024;
constexpr size_t WS_SWIN = 55 * MiB + 256 * 1024, WS_SW13 = WS_SWIN + 64 * 1024, WS_SWM13 = WS_SW13 + 32 * 1024;
constexpr size_t WS_SWPG = WS_SWM13 + 8 * 7168 * 4;
static_assert(WS_WEND <= WS_SX && WS_SWPG + 2 * 1024 * 4 <= 56 * MiB, "scales");
constexpr size_t WS_PB = 56 * MiB;
constexpr size_t WS_TE = 88 * MiB, WS_TP = 88 * MiB + 512 * 1024, WS_TW = 89 * MiB, WS_TPOS = 89 * MiB + 512 * 1024, WS_SW = 90 * MiB, WS_CNT = 91 * MiB;
constexpr size_t WS_PS = 92 * MiB;
constexpr size_t WS_XB = 96 * MiB;
constexpr size_t WS_QMLA = WS_XB;
constexpr size_t WS_GATES = 224 * MiB;
constexpr size_t WS_NAQKV = 480 * MiB;
constexpr size_t WS_MERGED = WS_NAQKV;
constexpr size_t WS_QLAT = 672 * MiB, WS_KVLAT = 768 * MiB;
constexpr size_t WS_ONA = 672 * MiB, WS_OMLA = 736 * MiB;
constexpr size_t WS_KMLA = 800 * MiB, WS_VMLA = 896 * MiB;
constexpr size_t WS_H = 224 * MiB, WS_PP_DENSE = 576 * MiB;
constexpr size_t WS_PP_MOE = 224 * MiB, WS_XS = 352 * MiB, WS_HS = 612 * MiB, WS_WM13 = 856 * MiB, WS_WM2 = 968 * MiB, WS_END = 1024 * MiB;
static_assert(WS_XS + (size_t)MOE_MAXT * 256 * 1024 * 2 <= WS_HS && WS_HS + (size_t)(MOE_CHUNK + MOE_REMT) * 256 * DFFE * 2 <= WS_WM13 && WS_WM13 + (size_t)NEXP * 2 * DFFE * 1024 * 2 == WS_WM2 && WS_WM2 + (size_t)NEXP * 1024 * DFFE * 2 == WS_END, "moe map");
static_assert(WS_H + (size_t)MTOK * DFF * 2 <= WS_PP_DENSE, "dense map");
constexpr size_t WS_G8 = 704 * MiB;
constexpr size_t WS_PART = 912 * MiB;
constexpr int MOE_REM_ROWS = MOE_REMT * 256, MOE_FULL = MOE_NCHUNK * MOE_CHUNK;
static_assert(WS_PART >= WS_WM13 + (size_t)NEXP * 2 * DFFE * 1024 && WS_PART + (size_t)4 * MOE_REM_ROWS * 1024 * 2 <= WS_WM2, "partials");
static_assert(WS_G8 >= WS_PP_DENSE + (size_t)MTOK * 1024 * 2 && WS_G8 >= WS_HS && WS_G8 + (size_t)MTOK * 1024 <= WS_WM13, "gate map");
constexpr int CW_BAR = 4096;
constexpr int RING_OFF = 0, RING_BYTES = 131072;
constexpr int LDSCTL_OFF = RING_BYTES;
constexpr int X_LCNT = RING_BYTES + 512, X_OFF = X_LCNT + 64, X_TOT = X_OFF + 64, X_RTAB = X_TOT + 64, X_PRE = X_RTAB + 4 * 256 * 4, X_END = X_PRE + 256 * 8 * 4;
constexpr int X_SCL = 147456;
constexpr int LDS_BYTES = 155648;
static_assert(X_END <= X_SCL && X_SCL + 4096 <= LDS_BYTES, "LDS map");

#include <hip/hip_bf16.h>
#define GAS __attribute__((address_space(1)))
#define LAS __attribute__((address_space(3)))
typedef unsigned short bf16;
typedef unsigned v4u __attribute__((ext_vector_type(4)));
typedef float f32x4 __attribute__((ext_vector_type(4)));
typedef short bf16x8 __attribute__((ext_vector_type(8)));
typedef GAS unsigned gu32;
typedef GAS unsigned long long gu64;
#define RLX_AGENT __ATOMIC_RELAXED, __HIP_MEMORY_SCOPE_AGENT
#define LDS_WAIT() asm volatile("s_waitcnt lgkmcnt(0)" ::: "memory")
#define VM_WAIT() asm volatile("s_waitcnt vmcnt(0)" ::: "memory")
__device__ __forceinline__ unsigned long long rt() { return __builtin_amdgcn_s_memrealtime(); }
__device__ __forceinline__ unsigned f2bf(float f) { unsigned u = __builtin_bit_cast(unsigned, f); return (u + 0x7fffu + ((u >> 16) & 1u)) >> 16; }
__device__ __forceinline__ unsigned pk2(float lo, float hi) { return f2bf(lo) | (f2bf(hi) << 16); }

#define XB_TMO      128
#define XB_XCNT(j)  (256  + 64 * (j))
#define XB_XSUB(j)  (1280 + 64 * (j))
#define XB_XGEN(j)  (2304 + 64 * (j))
#define XB_TOP      3328
#define XB_TOPGEN   3392
#define XCD_BAR_WORDS 3456
#define XB_SPIN_CAP (1u << 18)

__device__ __forceinline__ unsigned xb_ld(unsigned* p)              { return __hip_atomic_load(p, __ATOMIC_RELAXED, __HIP_MEMORY_SCOPE_AGENT); }
__device__ __forceinline__ unsigned xb_add(unsigned* p, unsigned v) { return __hip_atomic_fetch_add(p, v, __ATOMIC_RELAXED, __HIP_MEMORY_SCOPE_AGENT); }
__device__ __forceinline__ unsigned xb_xcc_id() { return (unsigned)__builtin_amdgcn_s_getreg((3 << 11) | 20) & 0xFu; }
#define XB_SPIN(cond, bar) do { unsigned _sp = 0; while (cond) { __builtin_amdgcn_s_sleep(1); \
    if ((++_sp & 255u) == 0u) { if (xb_ld(&(bar)[XB_TMO])) break; if (_sp > XB_SPIN_CAP) { atomicAdd(&(bar)[XB_TMO], 1u); break; } } } } while (0)

struct XcdBarrier {
    unsigned* bar; unsigned x;
    volatile LAS unsigned* st;
    unsigned w0;
};

__device__ __forceinline__ XcdBarrier xcd_barrier_post(unsigned* bar, volatile LAS unsigned* st) {
    XcdBarrier b; b.bar = bar; b.x = xb_xcc_id(); b.st = st; b.w0 = (unsigned)__builtin_amdgcn_readfirstlane(threadIdx.x < 64u ? 1 : 0);
    if (threadIdx.x == 0) (void)xb_add(&bar[XB_XCNT(b.x)], 1u);
    return b;
}
__device__ __forceinline__ void xcd_barrier_complete(unsigned* bar, unsigned x, unsigned& nloc, unsigned& nx) {
    const unsigned G = gridDim.x * gridDim.y * gridDim.z;
    unsigned sum, cnt, mine, sp = 0u;
    for (;;) {
        sum = 0u; cnt = 0u; mine = 0u;
#pragma unroll
        for (unsigned j = 0; j < 16; ++j) { const unsigned c = xb_ld(&bar[XB_XCNT(j)]); sum += c; cnt += (c > 0u) ? 1u : 0u; mine = (j == x) ? c : mine; }
        if (sum == G) break;
        __builtin_amdgcn_s_sleep(1);
        if ((++sp & 255u) == 0u) { if (xb_ld(&bar[XB_TMO])) break; if (sp > XB_SPIN_CAP) { atomicAdd(&bar[XB_TMO], 1u); break; } }
    }
    nloc = mine > 0u ? mine : 1u; nx = cnt > 0u ? cnt : 1u;
}

__device__ __forceinline__ void xcd_barrier(const XcdBarrier& b) {
    asm volatile("s_waitcnt vmcnt(0)" ::: "memory");
    __syncthreads();
    int xl_; asm volatile("v_mbcnt_lo_u32_b32 %0, -1, 0\n\tv_mbcnt_hi_u32_b32 %0, -1, %0" : "=v"(xl_));
    if (b.w0 && xl_ == 0) {
        unsigned* bar = b.bar;
        __builtin_amdgcn_s_waitcnt(0);
        unsigned nloc = b.st[0], nx = b.st[1];
        if (nloc == 0u) { xcd_barrier_complete(bar, b.x, nloc, nx); b.st[0] = nloc; b.st[1] = nx; }
        const unsigned old = xb_add(&bar[XB_XSUB(b.x)], 1u);
        const unsigned gen = old / nloc;
        if (old + 1u == (gen + 1u) * nloc) {
            __builtin_amdgcn_fence(__ATOMIC_RELEASE, "agent");
            asm volatile("s_waitcnt vmcnt(0)" ::: "memory");
            const unsigned og = xb_add(&bar[XB_TOP], 1u);
            const unsigned tg = og / nx;
            if (og + 1u == (tg + 1u) * nx) xb_add(&bar[XB_TOPGEN], 1u);
            else XB_SPIN(xb_ld(&bar[XB_TOPGEN]) == tg, bar);
            __builtin_amdgcn_fence(__ATOMIC_ACQUIRE, "agent");
            xb_add(&bar[XB_XGEN(b.x)], 1u);
            asm volatile("s_waitcnt vmcnt(0)" ::: "memory");
        } else {
            XB_SPIN(xb_ld(&bar[XB_XGEN(b.x)]) == gen, bar);
            __builtin_amdgcn_fence(__ATOMIC_ACQUIRE, "agent");
            asm volatile("s_waitcnt vmcnt(0)" ::: "memory");
        }
    }
    __syncthreads();
}


typedef unsigned v2u __attribute__((ext_vector_type(2)));
struct Args { const float* in[26]; float* out; unsigned char* ws; int ph_lo, ph_hi; };
struct Frame {
    LAS unsigned char* lds;
    int tid, lane, wave, vcu, G;
};
#define WR_DPP(v, ctrl) __int_as_float(__builtin_amdgcn_update_dpp(0, __float_as_int(v), (ctrl), 0xf, 0xf, true))
__device__ __forceinline__ float wave_sum(float v) {
    v += WR_DPP(v, 0xB1); v += WR_DPP(v, 0x4E); v += WR_DPP(v, 0x141); v += WR_DPP(v, 0x140);
    { const auto r = __builtin_amdgcn_permlane16_swap(__float_as_uint(v), __float_as_uint(v), false, false); v = __uint_as_float(r[0]) + __uint_as_float(r[1]); }
    { const auto r = __builtin_amdgcn_permlane32_swap(__float_as_uint(v), __float_as_uint(v), false, false); v = __uint_as_float(r[0]) + __uint_as_float(r[1]); }
    return v;
}
__device__ __forceinline__ float wave_max(float v) {
    v = fmaxf(v, WR_DPP(v, 0xB1)); v = fmaxf(v, WR_DPP(v, 0x4E)); v = fmaxf(v, WR_DPP(v, 0x141)); v = fmaxf(v, WR_DPP(v, 0x140));
    { const auto r = __builtin_amdgcn_permlane16_swap(__float_as_uint(v), __float_as_uint(v), false, false); v = fmaxf(__uint_as_float(r[0]), __uint_as_float(r[1])); }
    { const auto r = __builtin_amdgcn_permlane32_swap(__float_as_uint(v), __float_as_uint(v), false, false); v = fmaxf(__uint_as_float(r[0]), __uint_as_float(r[1])); }
    return v;
}
__device__ __forceinline__ float half_max32(float v) { const auto r = __builtin_amdgcn_permlane32_swap(__float_as_uint(v), __float_as_uint(v), false, false); return fmaxf(__uint_as_float(r[0]), __uint_as_float(r[1])); }
__device__ __forceinline__ float bflo(unsigned w) { return __uint_as_float(w << 16); }
__device__ __forceinline__ float bfhi(unsigned w) { return __uint_as_float(w & 0xffff0000u); }

__device__ __forceinline__ void tr_item(const float* W, int K, int N, bf16* WT, int g, int s0, int ss, int d0, int ds, const float* gs, LAS float* scr, int item, int ncols, int lane) {
    const int nblk = ncols / 32, kb = item / nblk, nb = item % nblk, k0 = 64 * kb, j0 = 32 * nb;
    const int grp = j0 / g, jin = j0 % g, sn0 = s0 + grp * ss + jin, dn0 = d0 + grp * ds + jin;
    float v[32];
#pragma unroll
    for (int i = 0; i < 32; ++i) { const int kk = 2 * i + (lane >> 5); v[i] = W[(size_t)(k0 + kk) * N + sn0 + (lane & 31)]; }
    if (gs) {
#pragma unroll
        for (int i = 0; i < 32; ++i) v[i] *= gs[k0 + 2 * i + (lane >> 5)]; }
#pragma unroll
    for (int i = 0; i < 32; ++i) scr[(2 * i + (lane >> 5)) * 33 + (lane & 31)] = v[i];
    LDS_WAIT(); asm volatile("" ::: "memory");
    const int c = lane & 7;
#pragma unroll
    for (int j = 0; j < 4; ++j) { const int n = (lane >> 3) + 8 * j; const LAS float* s = scr + (8 * c) * 33 + n;
        v4u o; o.x = pk2(s[0 * 33], s[1 * 33]); o.y = pk2(s[2 * 33], s[3 * 33]); o.z = pk2(s[4 * 33], s[5 * 33]); o.w = pk2(s[6 * 33], s[7 * 33]);
        *(GAS v4u*)(WT + (size_t)(dn0 + n) * K + k0 + 8 * c) = o; }
    LDS_WAIT(); asm volatile("" ::: "memory");
}
__device__ __forceinline__ void tr_job(Frame& F, int& rot, const float* W, int K, int N, int ncols, bf16* WT, int g, int s0, int ss, int d0, int ds, const float* gs) {
    LAS float* scr = (LAS float*)(F.lds + RING_OFF + F.wave * 16384);
    const int NGW = F.G * NWAVES, gw = F.vcu * NWAVES + F.wave, nitems = (K / 64) * (ncols / 32);
    int first = (gw - rot) % NGW; if (first < 0) first += NGW;
    for (int it = first; it < nitems; it += NGW) tr_item(W, K, N, WT, g, s0, ss, d0, ds, gs, scr, it, ncols, F.lane);
    rot = (rot + nitems) % NGW;
}
__device__ __forceinline__ void tr_plain(Frame& F, int& rot, const float* W, int K, int N, bf16* WT) { tr_job(F, rot, W, K, N, N, WT, N, 0, 0, 0, 0, nullptr); }
__device__ __forceinline__ void cvt_rows(Frame& F, const float* src, bf16* dst, size_t n8) {
    const size_t NT = (size_t)F.G * NWAVES * 64, t0 = (size_t)(F.vcu * NWAVES + F.wave) * 64 + F.lane;
    size_t i = t0;
    for (; i + 3 * NT < n8; i += 4 * NT) { f32x4 a[4], b[4];
#pragma unroll
        for (int q = 0; q < 4; ++q) { a[q] = *(const GAS f32x4*)(src + (i + q * NT) * 8); b[q] = *(const GAS f32x4*)(src + (i + q * NT) * 8 + 4); }
#pragma unroll
        for (int q = 0; q < 4; ++q) { v4u o; o.x = pk2(a[q].x, a[q].y); o.y = pk2(a[q].z, a[q].w); o.z = pk2(b[q].x, b[q].y); o.w = pk2(b[q].z, b[q].w); *(GAS v4u*)(dst + (i + q * NT) * 8) = o; } }
    for (; i < n8; i += NT) { const f32x4 a = *(const GAS f32x4*)(src + i * 8), b = *(const GAS f32x4*)(src + i * 8 + 4);
        v4u o; o.x = pk2(a.x, a.y); o.y = pk2(a.z, a.w); o.z = pk2(b.x, b.y); o.w = pk2(b.z, b.w); *(GAS v4u*)(dst + i * 8) = o; }
}

__device__ __forceinline__ unsigned pack4i8(float a, float b, float c, float d) {
    const int ia = (int)__builtin_rintf(a), ib = (int)__builtin_rintf(b), ic = (int)__builtin_rintf(c), id = (int)__builtin_rintf(d);
    return (unsigned)(ia & 0xff) | ((unsigned)(ib & 0xff) << 8) | ((unsigned)(ic & 0xff) << 16) | ((unsigned)id << 24);
}
__device__ __forceinline__ void trq_job(Frame& F, int& rot, const float* W, int K, int N, int ncols, signed char* WQ, float* SC, int g, int s0, int ss, int d0, int ds) {
    LAS float* T = (LAS float*)(F.lds + RING_OFF);
    LAS float* PM = (LAS float*)(F.lds + X_RTAB);
    const int nitems = ncols / 32, lane = F.lane, w = F.wave;
    int first = (F.vcu - rot) % F.G; if (first < 0) first += F.G;
    __syncthreads();
    for (int it = first; it < nitems; it += F.G) {
        const int j0 = 32 * it, grp = j0 / g, jin = j0 % g, sn0 = s0 + grp * ss + jin, dn0 = d0 + grp * ds + jin;
        const float* wp = W + sn0 + (lane & 31) + (size_t)(128 * w + (lane >> 5)) * N;
        LAS float* tw = T + (128 * w + (lane >> 5)) * 32 + (lane & 31);
        float mx = 0.f;
        for (int hb = 0; hb < 2; ++hb) { float v[32];
#pragma unroll
            for (int i = 0; i < 32; ++i) v[i] = wp[(size_t)(hb * 64 + 2 * i) * N];
#pragma unroll
            for (int i = 0; i < 32; ++i) { mx = fmaxf(mx, fabsf(v[i])); tw[(hb * 64 + 2 * i) * 32] = v[i]; } }
        mx = half_max32(mx);
        if (lane < 32) PM[w * 32 + lane] = mx;
        LDS_WAIT(); __syncthreads();
        const int n = lane >> 1, hf = lane & 1;
        float cm = PM[n];
#pragma unroll
        for (int w2 = 1; w2 < 8; ++w2) cm = fmaxf(cm, PM[w2 * 32 + n]);
        const float inv = cm > 0.f ? 127.f / cm : 0.f;
        if (w == 0 && hf == 0) SC[dn0 + n] = cm > 0.f ? cm * (1.f / 127.f) : 1.f;
        const LAS float* s = T + (128 * w + 64 * hf) * 32 + n;
        GAS v4u* dp = (GAS v4u*)(WQ + (size_t)(dn0 + n) * K + 128 * w + 64 * hf);
#pragma unroll
        for (int q = 0; q < 4; ++q) { v4u o;
            o.x = pack4i8(s[(16 * q + 0) * 32] * inv, s[(16 * q + 1) * 32] * inv, s[(16 * q + 2) * 32] * inv, s[(16 * q + 3) * 32] * inv);
            o.y = pack4i8(s[(16 * q + 4) * 32] * inv, s[(16 * q + 5) * 32] * inv, s[(16 * q + 6) * 32] * inv, s[(16 * q + 7) * 32] * inv);
            o.z = pack4i8(s[(16 * q + 8) * 32] * inv, s[(16 * q + 9) * 32] * inv, s[(16 * q + 10) * 32] * inv, s[(16 * q + 11) * 32] * inv);
            o.w = pack4i8(s[(16 * q + 12) * 32] * inv, s[(16 * q + 13) * 32] * inv, s[(16 * q + 14) * 32] * inv, s[(16 * q + 15) * 32] * inv);
            dp[q] = o; }
        LDS_WAIT(); __syncthreads();
    }
    rot = (rot + nitems) % F.G;
}
__device__ __forceinline__ void store_q8(signed char* XQ, float* SX, size_t m, const f32x4 (&v)[4], int lane) {
    float mx = 0.f;
#pragma unroll
    for (int j = 0; j < 4; ++j) mx = fmaxf(fmaxf(mx, fmaxf(fabsf(v[j].x), fabsf(v[j].y))), fmaxf(fabsf(v[j].z), fabsf(v[j].w)));
    mx = wave_max(mx);
    const float inv = mx > 0.f ? 127.f / mx : 0.f;
    GAS unsigned* o4 = (GAS unsigned*)(XQ + m * DM) + lane;
#pragma unroll
    for (int j = 0; j < 4; ++j) o4[64 * j] = pack4i8(v[j].x * inv, v[j].y * inv, v[j].z * inv, v[j].w * inv);
    if (lane == 0) SX[m] = mx > 0.f ? mx * (1.f / 127.f) : 1.f;
}

template <class Sched> __device__ __forceinline__ void rms_prepass(Frame& F, const Sched& S, const float* PS, int p0, int NP, int K) {
    LAS float* rtab = (LAS float*)(F.lds + X_RTAB); pg8::Unit u;
    if (F.tid < 256) {
        for (int i = 0; i < 4 && S.next(i, u); ++i) { const GAS f32x4* pp = (const GAS f32x4*)(PS + (size_t)(u.pa * 256 + F.tid) * 16 + p0);
            float s = 0.f;
            for (int j = 0; j < NP / 4; ++j) { const f32x4 x = pp[j]; s += (x[0] + x[1]) + (x[2] + x[3]); }
            rtab[i * 256 + F.tid] = 1.0f / sqrtf(s / (float)K + RMS_EPS); }
    }
    LDS_WAIT(); __syncthreads();
}

__device__ __forceinline__ void ln_core(f32x4 (&v)[4], const f32x4 (&g)[4], const f32x4 (&bb)[4]) {
    float s = 0.f;
#pragma unroll
    for (int j = 0; j < 4; ++j) s += (v[j].x + v[j].y) + (v[j].z + v[j].w);
    const float mean = wave_sum(s) * (1.f / DM); float s2 = 0.f;
#pragma unroll
    for (int j = 0; j < 4; ++j) { v[j] = v[j] - mean; s2 += (v[j].x * v[j].x + v[j].y * v[j].y) + (v[j].z * v[j].z + v[j].w * v[j].w); }
    const float rstd = 1.f / sqrtf(wave_sum(s2) * (1.f / DM) + LN_EPS);
#pragma unroll
    for (int j = 0; j < 4; ++j) v[j] = v[j] * rstd * g[j] + bb[j];
}
__device__ __forceinline__ void store_row(float* R, bf16* XB, size_t m, const f32x4 (&v)[4], int lane, bool wb) {
    GAS f32x4* o = (GAS f32x4*)(R + m * DM) + lane;
#pragma unroll
    for (int j = 0; j < 4; ++j) o[64 * j] = v[j];
    if (wb) { GAS unsigned long long* o8 = (GAS unsigned long long*)(XB + m * DM) + lane;
#pragma unroll
        for (int j = 0; j < 4; ++j) o8[64 * j] = (unsigned long long)pk2(v[j].x, v[j].y) | ((unsigned long long)pk2(v[j].z, v[j].w) << 32); }
}

__device__ __forceinline__ void load_bf(f32x4 (&v)[4], const bf16* Y, size_t m, int lane) {
    const GAS v2u* p = (const GAS v2u*)(Y + m * DM) + lane;
#pragma unroll
    for (int j = 0; j < 4; ++j) { const v2u w = p[64 * j]; v[j].x = bflo(w.x); v[j].y = bfhi(w.x); v[j].z = bflo(w.y); v[j].w = bfhi(w.y); }
}
__device__ __forceinline__ void store_bf(bf16* XB, size_t m, const f32x4 (&v)[4], int lane) {
    GAS unsigned long long* o8 = (GAS unsigned long long*)(XB + m * DM) + lane;
#pragma unroll
    for (int j = 0; j < 4; ++j) o8[64 * j] = (unsigned long long)pk2(v[j].x, v[j].y) | ((unsigned long long)pk2(v[j].z, v[j].w) << 32);
}
__device__ __forceinline__ void moe_tables(Frame& F, const int* CNT, bool wantPre) {
    LAS int* tot = (LAS int*)(F.lds + X_TOT); LAS int* off = (LAS int*)(F.lds + X_OFF); LAS int* pre = (LAS int*)(F.lds + X_PRE);
    const int e = F.wave;
    int carry = 0;
    for (int b0 = 0; b0 < F.G; b0 += 64) { const int blk = b0 + F.lane; const int v = (blk < F.G) ? CNT[blk * 8 + e] : 0;
        int inc = v;
#pragma unroll
        for (int o = 1; o < 64; o <<= 1) { const int t = __builtin_amdgcn_ds_bpermute(4 * (F.lane - o), inc); if (F.lane >= o) inc += t; }
        if (wantPre && blk < F.G && blk < 256) pre[blk * 8 + e] = carry + inc - v;
        carry += __builtin_amdgcn_readlane(inc, 63); }
    if (F.lane == 0) tot[e] = carry;
    LDS_WAIT(); __syncthreads();
    if (F.tid == 0) { int o = 0; for (int j = 0; j < 8; ++j) { off[j] = o; o += (tot[j] + 255) & ~255; } off[8] = o; }
    LDS_WAIT(); __syncthreads();
}

#ifndef REP_P0
#define REP_P0 1
#endif
#ifndef REP_MC
#define REP_MC 1
#endif
#ifndef REP_A
#define REP_A 1
#endif
#ifndef REP_MU
#define REP_MU 1
#endif
#ifndef REP_MD
#define REP_MD 1
#endif
#ifndef REP_B
#define REP_B 1
#endif
#ifndef REP_D
#define REP_D 1
#endif
#ifndef REP_FU
#define REP_FU 1
#endif
#ifndef REP_PM
#define REP_PM 1
#endif
#ifndef REP_LN
#define REP_LN 1
#endif
#ifndef REP_NA
#define REP_NA 1
#endif
#ifndef REP_MLA
#define REP_MLA 1
#endif
#ifndef EN_P0
#define EN_P0 1
#endif
#ifndef EN_A
#define EN_A 1
#endif
#ifndef EN_B
#define EN_B 1
#endif
#ifndef EN_C
#define EN_C 1
#endif
#ifndef EN_D
#define EN_D 1
#endif
#ifndef EN_E
#define EN_E 1
#endif
#ifndef EN_F
#define EN_F 1
#endif
#ifndef EN_G0
#define EN_G0 1
#endif
#ifndef EN_H0
#define EN_H0 1
#endif
#ifndef EN_G1
#define EN_G1 1
#endif
#ifndef EN_U1
#define EN_U1 1
#endif
#ifndef EN_D1
#define EN_D1 1
#endif
#ifndef EN_I
#define EN_I 1
#endif
__global__ void __launch_bounds__(NWAVES * 64, 2) mk_fwd(Args args) {
    extern __shared__ __attribute__((aligned(16))) unsigned char lds[];
    Frame F;
    F.lds = (LAS unsigned char*)lds;
    volatile LAS unsigned* MISC = (volatile LAS unsigned*)(F.lds + LDSCTL_OFF);
    F.tid = threadIdx.x; F.lane = F.tid & 63; F.wave = __builtin_amdgcn_readfirstlane(F.tid >> 6);
    F.G = gridDim.x; { const int bx = blockIdx.x; F.vcu = (F.G % 8 == 0) ? (bx % 8) * (F.G / 8) + bx / 8 : bx; }
    unsigned char* ws = args.ws; float* R = args.out;
    for (int u = F.tid; u < 128; u += NWAVES * 64) ((LAS unsigned*)(F.lds + LDSCTL_OFF))[u] = 0u;
    __syncthreads();
    const int lo = args.ph_lo, hi = args.ph_hi;
    const bool multi = (hi - lo) > 1;
    XcdBarrier bar; bar.bar = (unsigned*)(ws + WS_CTL) + CW_BAR; bar.x = 0; bar.st = nullptr; bar.w0 = 0;
    if (multi) bar = xcd_barrier_post((unsigned*)(ws + WS_CTL) + CW_BAR, MISC + 8);
    int ph = 0;
#define IN() (lo <= ph && ph < hi)
#define PH_BEGIN() do { int l_; asm volatile("v_mbcnt_lo_u32_b32 %0, -1, 0\n\tv_mbcnt_hi_u32_b32 %0, -1, %0" : "=v"(l_)); F.lane = l_; F.tid = F.wave * 64 + l_; } while (0)
#define SEAM() do { if (lo <= ph && ph + 1 < hi) xcd_barrier(bar); ++ph; } while (0)
    LAS unsigned char* ring = F.lds + RING_OFF;
    bf16* const XB = (bf16*)(ws + WS_XB);
    const float* const ROPE = (const float*)(ws + WS_ROPE);

    if (IN() && EN_P0) { PH_BEGIN();
        int rot = 0;
        for (int rep_ = 0; rep_ < REP_P0; ++rep_)
        for (int L = 0; L < 2; ++L) {
            bf16* WL = (bf16*)(ws + WS_W + (size_t)L * W_LAYER);
            const float* win = args.in[2] + (size_t)L * 1024 * NIN;
            bf16* WIN = (bf16*)((unsigned char*)WL + W_WIN);
            signed char* WINQ = (signed char*)WIN; float* swin = (float*)(ws + WS_SWIN) + L * NPROJ;
            trq_job(F, rot, win, 1024, NIN, 1536, WINQ, swin, 1536, 0, 0, 0, 0);
            trq_job(F, rot, win, 1024, NIN, 768, WINQ, swin, 768, 1536, 0, 1536, 0);
            trq_job(F, rot, win, 1024, NIN, 2048, WINQ, swin, 2048, 2592, 0, 2304, 0);
            trq_job(F, rot, win, 1024, NIN, 256, WINQ, swin, 256, 2304, 0, 4352, 0);
            trq_job(F, rot, win, 1024, NIN, 32, WINQ, swin, 32, 2560, 0, 4608, 0);
            { const size_t n16 = (size_t)(NPROJ - 4640) * 1024 / 16, NT = (size_t)F.G * NWAVES * 64; signed char* z = WINQ + (size_t)4640 * 1024;
              for (size_t i = (size_t)(F.vcu * NWAVES + F.wave) * 64 + F.lane; i < n16; i += NT) *(GAS v4u*)(z + i * 16) = (v4u){0u, 0u, 0u, 0u};
              for (size_t i = (size_t)(F.vcu * NWAVES + F.wave) * 64 + F.lane; i < (size_t)(NPROJ - 4640); i += NT) swin[4640 + i] = 1.f; }
            tr_job(F, rot, args.in[5] + (size_t)L * 768 * 768, 768, 768, 768, (bf16*)((unsigned char*)WL + W_WUQ), 768, 0, 0, 0, 0, args.in[4] + L * 768);
            const float* wukv = args.in[7] + (size_t)L * 256 * 1024; const float* kvg = args.in[6] + L * 256;
            tr_job(F, rot, wukv, 256, 1024, 512, (bf16*)((unsigned char*)WL + W_WUKV), 64, 0, 128, 0, 64, kvg);
            tr_job(F, rot, wukv, 256, 1024, 512, (bf16*)((unsigned char*)WL + W_WUKV), 64, 64, 128, 512, 64, kvg);
            tr_plain(F, rot, args.in[9] + (size_t)L * 512 * 1024, 512, 1024, (bf16*)((unsigned char*)WL + W_WNAO));
            tr_plain(F, rot, args.in[10] + (size_t)L * 512 * 1024, 512, 1024, (bf16*)((unsigned char*)WL + W_WMLAO));
            tr_plain(F, rot, args.in[11] + (size_t)L * 1024 * 1024, 1024, 1024, (bf16*)((unsigned char*)WL + W_WOUT));
            trq_job(F, rot, args.in[22] + (size_t)L * 1024 * 1024, 1024, 1024, 1024, (signed char*)((unsigned char*)WL + W_WPG), (float*)(ws + WS_SWPG) + L * 1024, 1024, 0, 0, 0, 0);
            tr_plain(F, rot, args.in[23] + (size_t)L * 256 * 1024, 256, 1024, (bf16*)((unsigned char*)WL + W_WPLE));
        }
        trq_job(F, rot, args.in[14], 1024, DFF, DFF, (signed char*)(ws + WS_W13), (float*)(ws + WS_SW13), 128, 0, 128, 0, 256);
        trq_job(F, rot, args.in[15], 1024, DFF, DFF, (signed char*)(ws + WS_W13), (float*)(ws + WS_SW13), 128, 0, 128, 128, 256);
        tr_plain(F, rot, args.in[16], DFF, 1024, (bf16*)(ws + WS_W2));
        { const int NT = F.G * NWAVES * 64; float* rt_ = (float*)(ws + WS_ROPE);
          for (int i = (F.vcu * NWAVES + F.wave) * 64 + F.lane; i < SEQ * 16; i += NT) { const int pos = i >> 4, k = i & 15;
              double invf = 1.0; for (int q_ = 0; q_ < k; ++q_) invf *= 0.5623413251903491;
              const double rev = (double)pos * invf * 0.15915494309189535; const float fr_ = (float)(rev - floor(rev));
              rt_[2 * i] = __builtin_amdgcn_cosf(fr_); rt_[2 * i + 1] = __builtin_amdgcn_sinf(fr_); } }
        { const int gw = F.vcu * NWAVES + F.wave, NGW = F.G * NWAVES;
          for (int m = gw; m < MTOK; m += NGW) { f32x4 v[4]; const GAS f32x4* xr = (const GAS f32x4*)(args.in[0] + (size_t)m * DM) + F.lane;
#pragma unroll
              for (int j = 0; j < 4; ++j) v[j] = xr[64 * j];
              store_bf(XB, (size_t)m, v, F.lane); store_q8((signed char*)R + (128u << 20), (float*)(ws + WS_SX), (size_t)m, v, F.lane); } }
    }
    SEAM();

    for (int L = 0; L < 2; ++L) {
        unsigned char* WL = ws + WS_W + (size_t)L * W_LAYER;
        if (IN() && EN_A) { PH_BEGIN();
            pg8::Gemm g{(const pg8::bf16_t*)((const signed char*)R + (128u << 20)), (const pg8::bf16_t*)(WL + W_WIN), MTOK, NPROJ, 512, 0, 0}; pg8::StaticOrder S; S.init(MTOK, NPROJ, F.G, (int)blockIdx.x);
            pg8::EpiProj E{(bf16*)(ws + WS_NAQKV), (bf16*)(ws + WS_QLAT), (bf16*)(ws + WS_GATES), (bf16*)(ws + WS_KVLAT), (bf16*)(ws + WS_KMLA), args.in[3] + L * 2048, ROPE, NA_QSCALE, (float*)(ws + WS_PS), (const float*)(ws + WS_SX), (const float*)(ws + WS_SWIN) + L * NPROJ, (LAS float*)(F.lds + X_SCL)};
            for (int rep_ = 0; rep_ < REP_A; ++rep_) { pg8::gemm_phase<pg8::EpiProj, pg8::StaticOrder, true, true, true>(ring, g, S, E, F.wave); __syncthreads(); }
        }
        SEAM();
        if (IN() && EN_B) { PH_BEGIN();
            for (int rep_ = 0; rep_ < REP_B; ++rep_) {
            { pg8::Gemm g{(const pg8::bf16_t*)(ws + WS_QLAT), (const pg8::bf16_t*)(WL + W_WUQ), MTOK, 768, 768}; pg8::StaticOrder S; S.init(MTOK, 768, F.G, (int)blockIdx.x);
              asm volatile("" : "+s"(S.c), "+s"(S.G)); rms_prepass(F, S, (const float*)(ws + WS_PS), 0, 12, 768); asm volatile("" : "+s"(S.c), "+s"(S.G));
              pg8::EpiQup E{(bf16*)R, (const LAS float*)(F.lds + X_RTAB), ROPE, MLA_QSCALE};
              pg8::gemm_phase<pg8::EpiQup, pg8::StaticOrder, true, true>(ring, g, S, E, F.wave); }
            __syncthreads(); PH_BEGIN();
            { pg8::Gemm g{(const pg8::bf16_t*)(ws + WS_KVLAT), (const pg8::bf16_t*)(WL + W_WUKV), MTOK, 1024, 256}; pg8::StaticOrder S; S.init(MTOK, 1024, F.G, (int)blockIdx.x);
              asm volatile("" : "+s"(S.c), "+s"(S.G)); rms_prepass(F, S, (const float*)(ws + WS_PS), 12, 4, 256); asm volatile("" : "+s"(S.c), "+s"(S.G));
              pg8::EpiKVup E{(bf16*)(ws + WS_KMLA), (bf16*)(ws + WS_VMLA), (const LAS float*)(F.lds + X_RTAB)};
              pg8::gemm_phase<pg8::EpiKVup, pg8::StaticOrder, true, true>(ring, g, S, E, F.wave); }
            __syncthreads(); }
        }
        SEAM();
        if (IN() && EN_C) { PH_BEGIN();
            const float* rpb = args.in[8] + (size_t)L * 8 * 15 * 31;
            for (int rep_ = 0; rep_ < REP_NA; ++rep_)
            for (int uid = F.vcu; uid < 2048; uid += F.G) { const int pair = uid >> 5, rg = uid & 31;
                att::na_unit(pair >> 3, pair & 7, rg, (const att::bf16*)(ws + WS_NAQKV), (att::bf16*)(ws + WS_ONA), rpb, (LAS char*)ring, F.wave); }
            for (int rep_ = 0; rep_ < REP_MLA; ++rep_)
            for (int uid = F.vcu; uid < 2048; uid += F.G) { const int pair = uid >> 5, qb = uid & 31, b = pair >> 3, h = pair & 7;
                const size_t row0 = (size_t)b * SEQ;
                att::mla_unit((const att::bf16*)R + (row0 + qb * 256) * 768 + h * 96, (const att::bf16*)(ws + WS_KMLA) + row0 * 768 + h * 96,
                              (const att::bf16*)(ws + WS_VMLA) + row0 * 512 + h * 64, (att::bf16*)(ws + WS_OMLA) + (row0 + qb * 256) * 512 + h * 64, SEQ, (LAS char*)ring, F.wave); }
        }
        SEAM();
        if (IN() && EN_D) { PH_BEGIN();
            for (int rep_ = 0; rep_ < REP_D; ++rep_) {
            pg8::StaticOrder S; S.init(MTOK, 1024, F.G, (int)blockIdx.x);
            { pg8::Gemm g{(const pg8::bf16_t*)(ws + WS_ONA), (const pg8::bf16_t*)(WL + W_WNAO), MTOK, 1024, 512};
              pg8::EpiMerge E{(const unsigned char*)(ws + WS_GATES), (pg8::bf16_t*)(ws + WS_MERGED), 0};
              pg8::gemm_phase<pg8::EpiMerge, pg8::StaticOrder, true, true>(ring, g, S, E, F.wave); }
            __syncthreads();
            { pg8::Gemm g{(const pg8::bf16_t*)(ws + WS_OMLA), (const pg8::bf16_t*)(WL + W_WMLAO), MTOK, 1024, 512};
              pg8::EpiMerge E{(const unsigned char*)(ws + WS_GATES) + 1024, (pg8::bf16_t*)(ws + WS_MERGED), 1};
              pg8::gemm_phase<pg8::EpiMerge, pg8::StaticOrder, true, true>(ring, g, S, E, F.wave); }
            __syncthreads(); }
        }
        SEAM();
        if (IN() && EN_E) { PH_BEGIN();
            { pg8::Gemm g{(const pg8::bf16_t*)(ws + WS_MERGED), (const pg8::bf16_t*)(WL + W_WOUT), MTOK, 1024, 1024}; pg8::StaticOrder S; S.init(MTOK, 1024, F.G, (int)blockIdx.x);
              pg8::EpiRes<0> E{(const pg8::bf16_t*)XB, (pg8::bf16_t*)R, nullptr, ALPHA};
              pg8::gemm_phase<pg8::EpiRes<0>, pg8::StaticOrder, true, true>(ring, g, S, E, F.wave); }
            if (L == 1) { __syncthreads(); PH_BEGIN(); int rot = 0;
                for (int rep_ = 0; rep_ < REP_MC; ++rep_)
                for (int e = 0; e < NEXP; ++e) {
                    signed char* w13 = (signed char*)(ws + WS_WM13) + (size_t)e * 2 * DFFE * 1024; float* sc13 = (float*)(ws + WS_SWM13) + (size_t)e * 2 * DFFE;
                    trq_job(F, rot, args.in[19] + (size_t)e * 1024 * DFFE, 1024, DFFE, DFFE, w13, sc13, 128, 0, 128, 0, 256);
                    trq_job(F, rot, args.in[20] + (size_t)e * 1024 * DFFE, 1024, DFFE, DFFE, w13, sc13, 128, 0, 128, 128, 256);
                    tr_plain(F, rot, args.in[21] + (size_t)e * DFFE * 1024, DFFE, 1024, (bf16*)(ws + WS_WM2) + (size_t)e * 1024 * DFFE); } }
        }
        SEAM();
        if (IN() && EN_F) { PH_BEGIN();
            f32x4 g[4], bb[4];
            { const GAS f32x4* gp = (const GAS f32x4*)(args.in[12] + L * DM) + F.lane; const GAS f32x4* bp = (const GAS f32x4*)(args.in[13] + L * DM) + F.lane;
#pragma unroll
              for (int j = 0; j < 4; ++j) { g[j] = gp[64 * j]; bb[j] = bp[64 * j]; } }
            LAS float* wrl = (LAS float*)ring; LAS int* lcnt = (LAS int*)(F.lds + X_LCNT);
            if (L == 1) { const float* wr = args.in[17];
                for (int i = F.tid; i < 1024 * 8 / 4; i += NWAVES * 64) ((LAS f32x4*)wrl)[i] = ((const GAS f32x4*)wr)[i];
                if (F.tid < 8) lcnt[F.tid] = 0;
                LDS_WAIT(); __syncthreads(); }
            const int gw = F.vcu * NWAVES + F.wave, NGW = F.G * NWAVES;
            if (REP_LN > 1) for (int m = gw; m < MTOK; m += NGW) {
                f32x4 v[4]; const GAS f32x4* xr = (const GAS f32x4*)(R + (size_t)m * DM) + F.lane;
#pragma unroll
                for (int j = 0; j < 4; ++j) v[j] = xr[64 * j];
                ln_core(v, g, bb);
                store_row((float*)(ws + WS_GATES), XB, (size_t)m, v, F.lane, true); }
            v2u raw[4];
            { const GAS v2u* p_ = (const GAS v2u*)((const bf16*)R + (size_t)gw * DM) + F.lane;
#pragma unroll
              for (int j = 0; j < 4; ++j) raw[j] = p_[64 * j]; }
            for (int m = gw; m < MTOK; m += NGW) {
                f32x4 v[4];
#pragma unroll
                for (int j = 0; j < 4; ++j) { v[j].x = bflo(raw[j].x); v[j].y = bfhi(raw[j].x); v[j].z = bflo(raw[j].y); v[j].w = bfhi(raw[j].y); }
                if (m + NGW < MTOK) { const GAS v2u* p_ = (const GAS v2u*)((const bf16*)R + (size_t)(m + NGW) * DM) + F.lane;
#pragma unroll
                    for (int j = 0; j < 4; ++j) raw[j] = p_[64 * j]; }
                ln_core(v, g, bb);
                store_bf(XB, (size_t)m, v, F.lane);
                store_q8((signed char*)R + (192u << 20), (float*)(ws + WS_SX1), (size_t)m, v, F.lane);
                if (L == 1) {
                    float lg[8];
#pragma unroll
                    for (int e = 0; e < 8; ++e) lg[e] = 0.f;
#pragma unroll
                    for (int j = 0; j < 4; ++j)
#pragma unroll
                        for (int t = 0; t < 4; ++t) { const int k = 4 * F.lane + 256 * j + t; const f32x4 w0 = *(const LAS f32x4*)(wrl + k * 8), w1 = *(const LAS f32x4*)(wrl + k * 8 + 4); const float xv = v[j][t];
                            lg[0] += xv * w0.x; lg[1] += xv * w0.y; lg[2] += xv * w0.z; lg[3] += xv * w0.w; lg[4] += xv * w1.x; lg[5] += xv * w1.y; lg[6] += xv * w1.z; lg[7] += xv * w1.w; }
#pragma unroll
                    for (int e = 0; e < 8; ++e) lg[e] = wave_sum(lg[e]) + args.in[18][e];
                    int i0 = 0; float l0 = lg[0];
#pragma unroll
                    for (int e = 1; e < 8; ++e) if (lg[e] > l0) { l0 = lg[e]; i0 = e; }
                    int i1 = -1; float l1 = -3.0e38f;
#pragma unroll
                    for (int e = 0; e < 8; ++e) if (e != i0 && lg[e] > l1) { l1 = lg[e]; i1 = e; }
                    const float w0 = 1.0f / (1.0f + __expf(l1 - l0)), w1 = 1.0f - w0;
                    if (F.lane == 0) {
                        const int lp0 = __hip_atomic_fetch_add(lcnt + i0, 1, __ATOMIC_RELAXED, __HIP_MEMORY_SCOPE_WORKGROUP), lp1 = __hip_atomic_fetch_add(lcnt + i1, 1, __ATOMIC_RELAXED, __HIP_MEMORY_SCOPE_WORKGROUP);
                        ((int*)(ws + WS_TE))[m] = i0 | (i1 << 4) | ((int)blockIdx.x << 8);
                        ((int2*)(ws + WS_TP))[m] = make_int2(lp0, lp1); ((float2*)(ws + WS_TW))[m] = make_float2(w0, w1); }
                }
            }
            if (L == 1) { LDS_WAIT(); __syncthreads(); if (F.tid < 8) ((int*)(ws + WS_CNT))[blockIdx.x * 8 + F.tid] = lcnt[F.tid]; }
            cvt_rows(F, args.in[1] + (size_t)L * MTOK * PLED, (bf16*)(ws + WS_PB), (size_t)MTOK * PLED / 8);
        }
        SEAM();
        if (L == 0) {
            if (IN() && EN_G0) { PH_BEGIN();
                { pg8::Gemm g{(const pg8::bf16_t*)((const signed char*)R + (192u << 20)), (const pg8::bf16_t*)(ws + WS_W13), MTOK, 2 * DFF, 512, 0, 0}; pg8::StaticOrder S; S.init(MTOK, 2 * DFF, F.G, (int)blockIdx.x);
                  pg8::EpiGLUQ E{(pg8::bf16_t*)(ws + WS_H), DFF, (const float*)(ws + WS_SX1), (const float*)(ws + WS_SW13), (LAS float*)(F.lds + X_SCL)};
                  for (int rep_ = 0; rep_ < REP_FU; ++rep_) { pg8::gemm_phase<pg8::EpiGLUQ, pg8::StaticOrder, true, true, true>(ring, g, S, E, F.wave); __syncthreads(); } }
                __syncthreads();
                pg8::StaticOrder S; S.init(MTOK, 1024, F.G, (int)blockIdx.x);
                { pg8::Gemm g{(const pg8::bf16_t*)((const signed char*)R + (192u << 20)), (const pg8::bf16_t*)(WL + W_WPG), MTOK, 1024, 512, 0, 0};
                  pg8::EpiGate8 E{(unsigned char*)(ws + WS_G8), (const float*)(ws + WS_SX1), (const float*)(ws + WS_SWPG) + L * 1024, (LAS float*)(F.lds + X_SCL)};
                  pg8::gemm_phase<pg8::EpiGate8, pg8::StaticOrder, true, true, true>(ring, g, S, E, F.wave); }
                __syncthreads();
                { pg8::Gemm g{(const pg8::bf16_t*)(ws + WS_PB), (const pg8::bf16_t*)(WL + W_WPLE), MTOK, 1024, 256};
                  pg8::EpiGateMul E{(const unsigned char*)(ws + WS_G8), (pg8::bf16_t*)(ws + WS_PP_DENSE)};
                  pg8::gemm_phase<pg8::EpiGateMul, pg8::StaticOrder, true, true>(ring, g, S, E, F.wave); }
            }
            SEAM();
            if (IN() && EN_H0) { PH_BEGIN();
                pg8::Gemm g{(const pg8::bf16_t*)(ws + WS_H), (const pg8::bf16_t*)(ws + WS_W2), MTOK, 1024, DFF}; pg8::StaticOrder S; S.init(MTOK, 1024, F.G, (int)blockIdx.x);
                pg8::EpiRes<2> E{(const pg8::bf16_t*)XB, (pg8::bf16_t*)R, (pg8::bf16_t*)(ws + WS_PP_DENSE), ALPHA};
                pg8::gemm_phase<pg8::EpiRes<2>, pg8::StaticOrder, true, true>(ring, g, S, E, F.wave);
            }
            SEAM();
        } else {
            if (IN() && EN_G1) { PH_BEGIN();
                moe_tables(F, (const int*)(ws + WS_CNT), true);
                if (blockIdx.x == 0 && F.tid < 9) ((int*)(ws + WS_CNT + 49152))[F.tid] = ((const LAS int*)(F.lds + X_OFF))[F.tid];
                { const LAS int* off = (const LAS int*)(F.lds + X_OFF); const LAS int* pre = (const LAS int*)(F.lds + X_PRE);
                  const int gw = F.vcu * NWAVES + F.wave, NGW = F.G * NWAVES;
                  for (int m0 = gw; m0 < MTOK; m0 += 4 * NGW) {
                      int te[4]; int2 tp[4]; float2 tw[4]; int d0[4], d1[4]; v4u ra[4], rb[4];
#pragma unroll
                      for (int q = 0; q < 4; ++q) { const int m = m0 + q * NGW; te[q] = ((const int*)(ws + WS_TE))[m]; tp[q] = ((const int2*)(ws + WS_TP))[m]; tw[q] = ((const float2*)(ws + WS_TW))[m]; }
#pragma unroll
                      for (int q = 0; q < 4; ++q) { const int m = m0 + q * NGW; ra[q] = ((const GAS v4u*)((const signed char*)R + (192u << 20) + (size_t)m * DM))[F.lane]; rb[q].x = __float_as_uint(((const float*)(ws + WS_SX1))[m]); }
#pragma unroll
                      for (int q = 0; q < 4; ++q) { const int e0 = te[q] & 15, e1 = (te[q] >> 4) & 15, blk = te[q] >> 8;
                          d0[q] = off[e0] + pre[blk * 8 + e0] + tp[q].x; d1[q] = off[e1] + pre[blk * 8 + e1] + tp[q].y; }
#pragma unroll
                      for (int q = 0; q < 4; ++q) { const int m = m0 + q * NGW;
                          ((GAS v4u*)((signed char*)R + (size_t)d0[q] * DM))[F.lane] = ra[q]; ((GAS v4u*)((signed char*)R + (size_t)d1[q] * DM))[F.lane] = ra[q];
                          if (F.lane == 0) { ((float*)(ws + WS_SW))[d0[q]] = tw[q].x; ((float*)(ws + WS_SW))[d1[q]] = tw[q].y; ((int2*)(ws + WS_TPOS))[m] = make_int2(d0[q], d1[q]);
                              ((float*)(ws + WS_SXS))[d0[q]] = __uint_as_float(rb[q].x); ((float*)(ws + WS_SXS))[d1[q]] = __uint_as_float(rb[q].x); } } } }
                __syncthreads();
                pg8::StaticOrder S; S.init(MTOK, 1024, F.G, (int)blockIdx.x);
                { pg8::Gemm g{(const pg8::bf16_t*)((const signed char*)R + (192u << 20)), (const pg8::bf16_t*)(WL + W_WPG), MTOK, 1024, 512, 0, 0};
                  pg8::EpiGate8 E{(unsigned char*)(ws + WS_G8), (const float*)(ws + WS_SX1), (const float*)(ws + WS_SWPG) + L * 1024, (LAS float*)(F.lds + X_SCL)};
                  pg8::gemm_phase<pg8::EpiGate8, pg8::StaticOrder, true, true, true>(ring, g, S, E, F.wave); }
                __syncthreads();
                { pg8::Gemm g{(const pg8::bf16_t*)(ws + WS_PB), (const pg8::bf16_t*)(WL + W_WPLE), MTOK, 1024, 256};
                  pg8::EpiGateMul E{(const unsigned char*)(ws + WS_G8), (pg8::bf16_t*)(ws + WS_PP_MOE)};
                  pg8::gemm_phase<pg8::EpiGateMul, pg8::StaticOrder, true, true>(ring, g, S, E, F.wave); }
            }
            SEAM();
            for (int c = 0; c < MOE_NCHUNK; ++c) {
                if (IN() && EN_U1) { PH_BEGIN();
                    if (F.tid < 9) ((LAS int*)(F.lds + X_OFF))[F.tid] = ((const int*)(ws + WS_CNT + 49152))[F.tid];
                    LDS_WAIT(); __syncthreads();
                    const LAS int* off = (const LAS int*)(F.lds + X_OFF);
                    const int NT = __builtin_amdgcn_readfirstlane(off[8]) >> 8; const int capU = (c == MOE_NCHUNK - 1) ? MOE_CHUNK + MOE_REMT : MOE_CHUNK;
                    int nMc = NT - c * MOE_CHUNK; nMc = nMc < 0 ? 0 : (nMc > capU ? capU : nMc);
                    pg8::MoeOrder<true> S; S.nMc = nMc; S.nN = 2 * DFFE / 256; S.nwg = nMc * S.nN; S.G = F.G; S.c = (int)blockIdx.x; S.t0 = c * MOE_CHUNK;
                    S.ts1 = __builtin_amdgcn_readfirstlane(off[1]) >> 8; S.ts2 = __builtin_amdgcn_readfirstlane(off[2]) >> 8; S.ts3 = __builtin_amdgcn_readfirstlane(off[3]) >> 8; S.ts4 = __builtin_amdgcn_readfirstlane(off[4]) >> 8;
                    S.ts5 = __builtin_amdgcn_readfirstlane(off[5]) >> 8; S.ts6 = __builtin_amdgcn_readfirstlane(off[6]) >> 8; S.ts7 = __builtin_amdgcn_readfirstlane(off[7]) >> 8;
                    pg8::Gemm g{(const pg8::bf16_t*)R, (const pg8::bf16_t*)(ws + WS_WM13), MOE_MAXT * 256, 2 * DFFE, 512, 0, 0};
                    pg8::EpiGLUQ E{(pg8::bf16_t*)(ws + WS_HS), DFFE, (const float*)(ws + WS_SXS), (const float*)(ws + WS_SWM13), (LAS float*)(F.lds + X_SCL)};
                    for (int rep_ = 0; rep_ < REP_MU; ++rep_) { pg8::gemm_phase<pg8::EpiGLUQ, pg8::MoeOrder<true>, true, true, true>(ring, g, S, E, F.wave); __syncthreads(); }
                }
                SEAM();
                if (IN() && EN_D1) { PH_BEGIN();
                    if (F.tid < 9) ((LAS int*)(F.lds + X_OFF))[F.tid] = ((const int*)(ws + WS_CNT + 49152))[F.tid];
                    LDS_WAIT(); __syncthreads();
                    const LAS int* off = (const LAS int*)(F.lds + X_OFF);
                    const int NT = __builtin_amdgcn_readfirstlane(off[8]) >> 8; int nMc = NT - c * MOE_CHUNK; nMc = nMc < 0 ? 0 : (nMc > MOE_CHUNK ? MOE_CHUNK : nMc);
                    const int t1 = __builtin_amdgcn_readfirstlane(off[1]) >> 8, t2 = __builtin_amdgcn_readfirstlane(off[2]) >> 8, t3 = __builtin_amdgcn_readfirstlane(off[3]) >> 8, t4 = __builtin_amdgcn_readfirstlane(off[4]) >> 8,
                              t5 = __builtin_amdgcn_readfirstlane(off[5]) >> 8, t6 = __builtin_amdgcn_readfirstlane(off[6]) >> 8, t7 = __builtin_amdgcn_readfirstlane(off[7]) >> 8;
                    {
                        pg8::MoeOrder<false> S; S.nMc = nMc; S.nN = 4; S.nwg = nMc * 4; S.G = F.G; S.c = (int)blockIdx.x; S.t0 = c * MOE_CHUNK;
                        S.ts1 = t1; S.ts2 = t2; S.ts3 = t3; S.ts4 = t4; S.ts5 = t5; S.ts6 = t6; S.ts7 = t7;
                        pg8::Gemm g{(const pg8::bf16_t*)(ws + WS_HS), (const pg8::bf16_t*)(ws + WS_WM2), MOE_CHUNK * 256, 1024, DFFE, 0, 0};
                        pg8::EpiMoeDown E{(pg8::bf16_t*)(ws + WS_XS), (const float*)(ws + WS_SW)};
                        for (int rep_ = 0; rep_ < REP_MD; ++rep_) { pg8::gemm_phase<pg8::EpiMoeDown, pg8::MoeOrder<false>, true, true>(ring, g, S, E, F.wave); __syncthreads(); }
                    }
                    if (c == MOE_NCHUNK - 1) {
                        PH_BEGIN();
                        pg8::MoeRemOrder S; S.nT = NT - MOE_FULL; S.G = F.G; S.c = (int)blockIdx.x; S.t0 = MOE_FULL; S.KQ = DFFE / 4; S.pa0 = MOE_CHUNK;
                        S.ts1 = t1; S.ts2 = t2; S.ts3 = t3; S.ts4 = t4; S.ts5 = t5; S.ts6 = t6; S.ts7 = t7;
                        pg8::Gemm g{(const pg8::bf16_t*)(ws + WS_HS), (const pg8::bf16_t*)(ws + WS_WM2), MOE_REM_ROWS, 1024, DFFE / 4, DFFE, DFFE};
                        pg8::EpiMoeRem E{(pg8::bf16_t*)(ws + WS_PART), (const float*)(ws + WS_SW), MOE_FULL, MOE_REM_ROWS};
                        pg8::gemm_phase<pg8::EpiMoeRem, pg8::MoeRemOrder, true, true>(ring, g, S, E, F.wave);
                    }
                }
                SEAM();
            }
        }
        if (L == 1) {
            if (IN() && EN_I) { PH_BEGIN();
                if (F.tid < 9) ((LAS int*)(F.lds + X_OFF))[F.tid] = ((const int*)(ws + WS_CNT + 49152))[F.tid];
                LDS_WAIT(); __syncthreads();
                const int nrem = (__builtin_amdgcn_readfirstlane(((const LAS int*)(F.lds + X_OFF))[8]) >> 8) - MOE_FULL;
                const int gw = F.vcu * NWAVES + F.wave, NGW = F.G * NWAVES;
                for (int r = gw; r < nrem * 256; r += NGW) {
                    const GAS v2u* pp = (const GAS v2u*)((const bf16*)(ws + WS_PART) + (size_t)r * DM) + F.lane; GAS v2u* dst = (GAS v2u*)((bf16*)(ws + WS_XS) + (size_t)(MOE_FULL * 256 + r) * DM) + F.lane;
#pragma unroll
                    for (int j = 0; j < 4; ++j) { float s0 = 0.f, s1 = 0.f, s2 = 0.f, s3 = 0.f;
#pragma unroll
                        for (int q = 0; q < 4; ++q) { const v2u a = pp[(size_t)q * MOE_REM_ROWS * DM / 4 + 64 * j]; s0 += bflo(a.x); s1 += bfhi(a.x); s2 += bflo(a.y); s3 += bfhi(a.y); }
                        v2u o; o.x = pk2(s0, s1); o.y = pk2(s2, s3); dst[64 * j] = o; }
                }
            }
            SEAM();
        }
        if (IN() && EN_I) { PH_BEGIN();
            f32x4 g[4], bb[4];
            { const GAS f32x4* gp = (const GAS f32x4*)(args.in[24] + L * DM) + F.lane; const GAS f32x4* bp = (const GAS f32x4*)(args.in[25] + L * DM) + F.lane;
#pragma unroll
              for (int j = 0; j < 4; ++j) { g[j] = gp[64 * j]; bb[j] = bp[64 * j]; } }
            const int gw = F.vcu * NWAVES + F.wave, NGW = F.G * NWAVES;
            const bool tmo = (L == 1) && (__hip_atomic_load((unsigned*)(ws + WS_CTL) + CW_BAR + XB_TMO, __ATOMIC_RELAXED, __HIP_MEMORY_SCOPE_AGENT) != 0u);
            if (L == 0) {
                v2u rx[4];
                { const GAS v2u* p_ = (const GAS v2u*)((const bf16*)R + (size_t)gw * DM) + F.lane;
#pragma unroll
                  for (int j = 0; j < 4; ++j) rx[j] = p_[64 * j]; }
                for (int m = gw; m < MTOK; m += NGW) {
                    f32x4 v[4];
#pragma unroll
                    for (int j = 0; j < 4; ++j) { v[j].x = bflo(rx[j].x); v[j].y = bfhi(rx[j].x); v[j].z = bflo(rx[j].y); v[j].w = bfhi(rx[j].y); }
                    if (m + NGW < MTOK) { const GAS v2u* p_ = (const GAS v2u*)((const bf16*)R + (size_t)(m + NGW) * DM) + F.lane;
#pragma unroll
                        for (int j = 0; j < 4; ++j) rx[j] = p_[64 * j]; }
                    ln_core(v, g, bb);
                    store_bf(XB, (size_t)m, v, F.lane); store_q8((signed char*)R + (128u << 20), (float*)(ws + WS_SX), (size_t)m, v, F.lane);
                }
            } else {
                v2u rx[4], rp[4], ra[4], rb[4]; int2 tpn = ((const int2*)(ws + WS_TPOS))[gw];
#define LN2_LOAD(mm, tp_) do { const GAS v2u* x1 = (const GAS v2u*)(XB + (size_t)(mm) * DM) + F.lane; const GAS v2u* pl = (const GAS v2u*)((const bf16*)(ws + WS_PP_MOE) + (size_t)(mm) * DM) + F.lane; \
        const GAS v2u* f0 = (const GAS v2u*)((const bf16*)(ws + WS_XS) + (size_t)(tp_).x * DM) + F.lane; const GAS v2u* f1 = (const GAS v2u*)((const bf16*)(ws + WS_XS) + (size_t)(tp_).y * DM) + F.lane; \
        _Pragma("unroll") for (int j = 0; j < 4; ++j) { rx[j] = x1[64 * j]; rp[j] = pl[64 * j]; ra[j] = f0[64 * j]; rb[j] = f1[64 * j]; } } while (0)
                LN2_LOAD(gw, tpn);
                if (gw + NGW < MTOK) tpn = ((const int2*)(ws + WS_TPOS))[gw + NGW];
                for (int m = gw; m < MTOK; m += NGW) {
                    f32x4 v[4];
#pragma unroll
                    for (int j = 0; j < 4; ++j) { const v2u x = rx[j], p = rp[j], a = ra[j], b = rb[j];
                        v[j].x = ALPHA * bflo(x.x) + bflo(p.x) + (bflo(a.x) + bflo(b.x)); v[j].y = ALPHA * bfhi(x.x) + bfhi(p.x) + (bfhi(a.x) + bfhi(b.x));
                        v[j].z = ALPHA * bflo(x.y) + bflo(p.y) + (bflo(a.y) + bflo(b.y)); v[j].w = ALPHA * bfhi(x.y) + bfhi(p.y) + (bfhi(a.y) + bfhi(b.y)); }
                    if (m + NGW < MTOK) { LN2_LOAD(m + NGW, tpn); if (m + 2 * NGW < MTOK) tpn = ((const int2*)(ws + WS_TPOS))[m + 2 * NGW]; }
                    ln_core(v, g, bb);
                    if (tmo) { const float qn = __builtin_nanf("");
#pragma unroll
                        for (int j = 0; j < 4; ++j) v[j] = (f32x4){qn, qn, qn, qn}; }
                    store_row(R, XB, (size_t)m, v, F.lane, false);
                }
            }
        }
        if (L == 0) SEAM();
    }
#undef LN2_LOAD
#undef IN
#undef SEAM
}

constexpr int N_PHASES = 27;
#ifndef MK_ONE_LAUNCH
#define MK_ONE_LAUNCH 1
#endif
extern "C" void kernel_launch(void* const* d_in, const int* in_sizes, int n_in, void* d_out, int out_size, void* d_ws, size_t ws_size, hipStream_t stream) {
    static int grid = 0;
    if (grid == 0) {
        if (n_in != 26 || in_sizes[0] != MTOK * DM || out_size != MTOK * DM || ws_size < WS_END) {
            fprintf(stderr, "kernel_launch: shape mismatch: n_in %d in0 %d out %d ws %zu (need %zu)\n", n_in, n_in > 0 ? in_sizes[0] : -1, out_size, ws_size, (size_t)WS_END); grid = -1; return; }
        int dev = 0, cus = 0, per_cu = 0;
        if (hipGetDevice(&dev) != hipSuccess || hipDeviceGetAttribute(&cus, hipDeviceAttributeMultiprocessorCount, dev) != hipSuccess) { fprintf(stderr, "kernel_launch: device query failed\n"); grid = -1; return; }
        if (hipFuncSetAttribute((const void*)mk_fwd, hipFuncAttributeMaxDynamicSharedMemorySize, LDS_BYTES) != hipSuccess) { fprintf(stderr, "kernel_launch: hipFuncSetAttribute failed\n"); grid = -1; return; }
        if (hipOccupancyMaxActiveBlocksPerMultiprocessor(&per_cu, (const void*)mk_fwd, NWAVES * 64, LDS_BYTES) != hipSuccess || per_cu < 1)
            fprintf(stderr, "kernel_launch: note: occupancy query reports %d workgroups per CU\n", per_cu);
        (void)hipGetLastError();
        grid = cus > 256 ? 256 : cus;
    }
    if (grid < 0) return;
    if (hipMemsetAsync((char*)d_ws + WS_CTL, 0, CTL_ZERO_BYTES, stream) != hipSuccess) { fprintf(stderr, "kernel_launch: memset failed\n"); return; }
    Args a{};
    for (int i = 0; i < 26; ++i) a.in[i] = (const float*)d_in[i];
    a.out = (float*)d_out; a.ws = (unsigned char*)d_ws;
#if MK_ONE_LAUNCH
    a.ph_lo = 0; a.ph_hi = N_PHASES;
    hipLaunchKernelGGL(mk_fwd, dim3(grid), dim3(NWAVES * 64), LDS_BYTES, stream, a);
#else
    for (int p = 0; p < N_PHASES; ++p) { a.ph_lo = p; a.ph_hi = p + 1; hipLaunchKernelGGL(mk_fwd, dim3(grid), dim3(NWAVES * 64), LDS_BYTES, stream, a); }
#endif
    const hipError_t le = hipPeekAtLastError();
    if (le != hipSuccess) fprintf(stderr, "kernel_launch: launch failed: %s (grid %d)\n", hipGetErrorName(le), grid);
}
```
